# Optimizing an MI355X kernel written in HIP

```python
import numpy as np
import jax
import jax.numpy as jnp
from jax import lax

D_MODEL = 2048
BATCH = 4
SEQ = 4096
DEPTH = 2

M_HEADS = 4
M_DQK = 256
M_DV = 512
M_CHUNK = 64
N_KV = 4
N_HPG = 4
N_HEADS = N_KV * N_HPG
N_HD = 128
CMP_BLOCK = 32
CMP_STRIDE = 16
SEL_BLOCK = 64
SEL_TOPK = 16
WINDOW = 512
Q_BLOCK = 32
ROPE_THETA = 10000.0
N_EXPERTS = 32
N_GROUPS = 8
EXP_PER_GROUP = N_EXPERTS // N_GROUPS
TOP_K = 2
D_FF = 1024
ALPHA = (2 * DEPTH) ** 0.25
BETA = (8 * DEPTH) ** -0.25
EPS = 1e-5
NEG = -1e30

M_QK_W = M_HEADS * M_DQK
M_V_W = M_HEADS * M_DV
N_Q_W = N_HEADS * N_HD
N_KV_W = N_KV * N_HD
IN_SIZES = (M_QK_W, M_QK_W, M_V_W, M_V_W, M_HEADS, M_HEADS, N_Q_W, N_KV_W, N_KV_W, N_KV_W, N_KV_W, N_KV_W, N_KV_W, 3 * N_HEADS, 2 * D_MODEL)
IN_WIDTH = sum(IN_SIZES)
F_GATE_OFF = 2 * M_QK_W + 2 * M_V_W + M_HEADS

kernel_name = 'hybrid_mlstm_nsa_grouped_moe_deepnorm'


def _standardize(x):
    xf = x.astype(jnp.float32)
    mu = jnp.mean(xf, -1, keepdims=True)
    var = jnp.mean(jnp.square(xf - mu), -1, keepdims=True)
    return (xf - mu) * lax.rsqrt(var + EPS)


def _layer_norm(x, g, b):
    return (_standardize(x) * g + b).astype(x.dtype)


def _rope(x, pos):
    half = x.shape[-1] // 2
    inv = ROPE_THETA ** (-jnp.arange(half, dtype=jnp.float32) / half)
    ang = pos.astype(jnp.float32)[:, None] * inv[None, :]
    cos, sin = jnp.cos(ang), jnp.sin(ang)
    xf = x.astype(jnp.float32)
    x1, x2 = xf[..., :half], xf[..., half:]
    return jnp.concatenate([x1 * cos - x2 * sin, x2 * cos + x1 * sin], -1).astype(x.dtype)


def _masked_softmax(s, mask):
    s = jnp.where(mask, s, NEG)
    return jax.nn.softmax(s, axis=-1) * mask


def _mlstm(q, k, v, ig, fg):
    B, H, T, _ = q.shape
    L = M_CHUNK
    NC = T // L
    f32 = jnp.float32
    q = q.astype(f32) * (M_DQK ** -0.5)
    k = k.astype(f32)
    v = v.astype(f32)
    lf = jax.nn.log_sigmoid(fg.astype(f32))
    li = ig.astype(f32)

    def to_chunks(a):
        return jnp.moveaxis(a.reshape(a.shape[:2] + (NC, L) + a.shape[3:]), 2, 0)

    causal = jnp.tril(jnp.ones((L, L), dtype=bool))

    def step(carry, inp):
        C, n, m = carry
        qi, ki, vi, lfi, lii = inp
        b = jnp.cumsum(lfi, -1)
        dmat = jnp.where(causal, b[..., :, None] - b[..., None, :] + lii[..., None, :], -jnp.inf)
        inter = b + m[..., None]
        m_t = jnp.maximum(inter, jnp.max(dmat, -1))
        w_inter = jnp.exp(inter - m_t)
        s = jnp.einsum('bhtd,bhsd->bhts', qi, ki) * jnp.exp(dmat - m_t[..., None])
        num = jnp.einsum('bhts,bhsv->bhtv', s, vi) + w_inter[..., None] * jnp.einsum('bhvd,bhtd->bhtv', C, qi)
        den = jnp.sum(s, -1) + w_inter * jnp.einsum('bhd,bhtd->bht', n, qi)
        h = num / jnp.maximum(jnp.abs(den), jnp.exp(-m_t))[..., None]
        b_last = b[..., -1]
        g_s = b_last[..., None] - b + lii
        m_new = jnp.maximum(b_last + m, jnp.max(g_s, -1))
        decay = jnp.exp(b_last + m - m_new)
        ws = jnp.exp(g_s - m_new[..., None])
        C_new = decay[..., None, None] * C + jnp.einsum('bhsv,bhsd->bhvd', vi * ws[..., None], ki)
        n_new = decay[..., None] * n + jnp.einsum('bhs,bhsd->bhd', ws, ki)
        return (C_new, n_new, m_new), h

    init = (jnp.zeros((B, H, M_DV, M_DQK), f32), jnp.zeros((B, H, M_DQK), f32), jnp.zeros((B, H), f32))
    _, hs = lax.scan(step, init, (to_chunks(q), to_chunks(k), to_chunks(v), to_chunks(lf), to_chunks(li)))
    return jnp.moveaxis(hs, 0, 2).reshape(B, H, T, M_DV)


def _compress(x, pos_emb, w1, b1, w2, b2):
    T = x.shape[2]
    n_cmp = (T - CMP_BLOCK) // CMP_STRIDE + 1
    idx = np.arange(n_cmp)[:, None] * CMP_STRIDE + np.arange(CMP_BLOCK)[None, :]
    blocks = x[:, :, idx, :] + pos_emb
    h = jax.nn.gelu(jnp.einsum('bgnld,ldf->bgnf', blocks, w1) + b1)
    return jnp.einsum('bgnf,fd->bgnd', h, w2) + b2


def _nsa(q, k_cmp, v_cmp, k_sel, v_sel, k_win, v_win, gates):
    B, G, HPG, T, hd = q.shape
    n_cmp = k_cmp.shape[2]
    n_sel = T // SEL_BLOCK
    top = min(SEL_TOPK, n_sel)
    nqb = T // Q_BLOCK
    scale = hd ** -0.5
    cmp_start = np.arange(n_cmp) * CMP_STRIDE
    cmp_end = cmp_start + CMP_BLOCK - 1
    sel_start_np = np.arange(n_sel) * SEL_BLOCK
    overlap = jnp.asarray(((cmp_start[:, None] <= sel_start_np[None, :] + SEL_BLOCK - 1) & (cmp_end[:, None] >= sel_start_np[None, :])).astype(np.float32))
    cmp_end_j = jnp.asarray(cmp_end)
    sel_start = jnp.arange(n_sel) * SEL_BLOCK
    blk_ids = jnp.arange(n_sel)
    ks_blk = k_sel.reshape(B, G, n_sel, SEL_BLOCK, hd)
    vs_blk = v_sel.reshape(B, G, n_sel, SEL_BLOCK, hd)
    kw_pad = jnp.pad(k_win, ((0, 0), (0, 0), (WINDOW, 0), (0, 0)))
    vw_pad = jnp.pad(v_win, ((0, 0), (0, 0), (WINDOW, 0), (0, 0)))
    bi = jnp.arange(B)[:, None, None, None]
    gi = jnp.arange(G)[None, :, None, None]
    q_blocks = jnp.moveaxis(q.reshape(B, G, HPG, nqb, Q_BLOCK, hd), 3, 0)
    g_blocks = jnp.moveaxis(gates.reshape(B, G, HPG, nqb, Q_BLOCK, 3), 3, 0)
    t0s = jnp.arange(nqb) * Q_BLOCK

    def one_block(args):
        qb, gb, t0 = args
        t = t0 + jnp.arange(Q_BLOCK)
        s = jnp.einsum('bghqd,bgnd->bghqn', qb, k_cmp).astype(jnp.float32) * scale
        p_c = _masked_softmax(s, cmp_end_j[None, :] <= t[:, None])
        o_c = jnp.einsum('bghqn,bgnd->bghqd', p_c.astype(v_cmp.dtype), v_cmp)
        imp = jnp.einsum('bghqn,ns->bgqs', p_c, overlap)
        cur = t // SEL_BLOCK
        valid_s = sel_start[None, :] <= t[:, None]
        forced = (blk_ids[None, :] == 0) | (blk_ids[None, :] == cur[:, None]) | (blk_ids[None, :] == cur[:, None] - 1)
        score = jnp.where(forced, jnp.inf, jnp.where(valid_s, imp, -jnp.inf))
        _, idx = lax.top_k(score, top)
        kg = ks_blk[bi, gi, idx].reshape(B, G, Q_BLOCK, top * SEL_BLOCK, hd)
        vg = vs_blk[bi, gi, idx].reshape(B, G, Q_BLOCK, top * SEL_BLOCK, hd)
        kpos = (idx[..., None] * SEL_BLOCK + jnp.arange(SEL_BLOCK)).reshape(B, G, Q_BLOCK, top * SEL_BLOCK)
        valid_k = kpos <= t[:, None]
        s = jnp.einsum('bghqd,bgqkd->bghqk', qb, kg).astype(jnp.float32) * scale
        p_s = _masked_softmax(s, valid_k[:, :, None])
        o_s = jnp.einsum('bghqk,bgqkd->bghqd', p_s.astype(vg.dtype), vg)
        kw = lax.dynamic_slice_in_dim(kw_pad, t0, WINDOW + Q_BLOCK, axis=2)
        vw = lax.dynamic_slice_in_dim(vw_pad, t0, WINDOW + Q_BLOCK, axis=2)
        wpos = t0 - WINDOW + jnp.arange(WINDOW + Q_BLOCK)
        dlt = t[:, None] - wpos[None, :]
        valid_w = (dlt >= 0) & (dlt < WINDOW) & (wpos[None, :] >= 0)
        s = jnp.einsum('bghqd,bgkd->bghqk', qb, kw).astype(jnp.float32) * scale
        p_w = _masked_softmax(s, valid_w)
        o_w = jnp.einsum('bghqk,bgkd->bghqd', p_w.astype(vw.dtype), vw)
        o = gb[..., 0:1] * o_c + gb[..., 1:2] * o_s + gb[..., 2:3] * o_w
        return o.astype(qb.dtype)

    out = lax.map(one_block, (q_blocks, g_blocks, t0s))
    return jnp.moveaxis(out, 0, 3).reshape(B, G, HPG, T, hd)


def _mixer(x, w_in, b_in, m_norm_w, cmp_k, cmp_v, w_branch_m, w_branch_n, w_out):
    B, T, _ = x.shape
    pos = jnp.arange(T)
    z = jnp.einsum('btd,dc->btc', x, w_in) + b_in
    (mq, mk, mv, mo, mi, mf, nq, nkc, nvc, nks, nvs, nkw, nvw, ng, gmerge) = jnp.split(z, np.cumsum(IN_SIZES)[:-1].tolist(), axis=-1)

    def heads(a, h):
        return a.reshape(B, T, h, -1).transpose(0, 2, 1, 3)

    h = _mlstm(heads(mq, M_HEADS), heads(mk, M_HEADS), heads(mv, M_HEADS), mi.transpose(0, 2, 1), mf.transpose(0, 2, 1))
    h = _standardize(h) * m_norm_w.reshape(M_HEADS, 1, M_DV)
    h = h.transpose(0, 2, 1, 3).reshape(B, T, M_V_W).astype(x.dtype) * jax.nn.sigmoid(mo)
    y_m = h @ w_branch_m
    def kvh(a):
        return a.reshape(B, T, N_KV, N_HD).transpose(0, 2, 1, 3)
    q = _rope(nq.reshape(B, T, N_KV, N_HPG, N_HD).transpose(0, 2, 3, 1, 4), pos)
    n_cmp = (T - CMP_BLOCK) // CMP_STRIDE + 1
    cmp_pos = jnp.arange(n_cmp) * CMP_STRIDE + CMP_BLOCK - 1
    k_cmp = _rope(_compress(kvh(nkc), *cmp_k), cmp_pos)
    v_cmp = _compress(kvh(nvc), *cmp_v)
    gates = jax.nn.sigmoid(ng.reshape(B, T, N_KV, N_HPG, 3).transpose(0, 2, 3, 1, 4))
    o = _nsa(q, k_cmp, v_cmp, _rope(kvh(nks), pos), kvh(nvs), _rope(kvh(nkw), pos), kvh(nvw), gates)
    y_n = o.transpose(0, 3, 1, 2, 4).reshape(B, T, N_Q_W) @ w_branch_n
    g_m, g_n = jnp.split(jax.nn.sigmoid(gmerge), 2, axis=-1)
    return (g_m * y_m + g_n * y_n) @ w_out


def _moe(x, router_w, router_b, w1, w3, w2):
    N = x.shape[0]
    aff = jax.nn.sigmoid(x.astype(jnp.float32) @ router_w.astype(jnp.float32))
    sel = aff + router_b.astype(jnp.float32)
    grp = sel.reshape(N, N_GROUPS, EXP_PER_GROUP)
    grp_score = jnp.sum(lax.top_k(grp, TOP_K)[0], -1)
    g_idx = jnp.argmax(grp_score, -1)
    in_grp = grp[jnp.arange(N), g_idx]
    _, top_i = lax.top_k(in_grp, TOP_K)
    e_idx = g_idx[:, None] * EXP_PER_GROUP + top_i
    w = jnp.take_along_axis(aff, e_idx, -1)
    w = w / jnp.sum(w, -1, keepdims=True)
    gate = jnp.sum(jax.nn.one_hot(e_idx, N_EXPERTS, dtype=jnp.float32) * w[..., None], 1)
    y = jnp.zeros_like(x)
    for e in range(N_EXPERTS):
        h = jax.nn.silu(x @ w1[e]) * (x @ w3[e])
        y = y + gate[:, e:e + 1].astype(x.dtype) * (h @ w2[e])
    return y


def setup_inputs(seed: int = 0) -> dict:
    key = jax.random.key(seed)
    keys = iter(jax.random.split(key, 32))

    def nrm(shape, scale):
        return jax.random.normal(next(keys), shape, jnp.float32) * scale

    L, D, hd = DEPTH, D_MODEL, N_HD
    x = nrm((BATCH, SEQ, D), 1.0)
    w_in = nrm((L, D, IN_WIDTH), D ** -0.5)
    b_in = nrm((L, IN_WIDTH), 0.02)
    b_in = b_in.at[:, F_GATE_OFF:F_GATE_OFF + M_HEADS].add(jnp.linspace(3.0, 6.0, M_HEADS))
    m_norm_w = 1.0 + nrm((L, M_V_W), 0.02)
    cmp_pos_k = nrm((L, CMP_BLOCK, hd), 0.02)
    cmp_w1_k = nrm((L, CMP_BLOCK, hd, hd), (CMP_BLOCK * hd) ** -0.5)
    cmp_b1_k = nrm((L, hd), 0.02)
    cmp_w2_k = nrm((L, hd, hd), hd ** -0.5)
    cmp_b2_k = nrm((L, hd), 0.02)
    cmp_pos_v = nrm((L, CMP_BLOCK, hd), 0.02)
    cmp_w1_v = nrm((L, CMP_BLOCK, hd, hd), (CMP_BLOCK * hd) ** -0.5)
    cmp_b1_v = nrm((L, hd), 0.02)
    cmp_w2_v = nrm((L, hd, hd), hd ** -0.5)
    cmp_b2_v = nrm((L, hd), 0.02)
    w_branch_m = nrm((L, M_V_W, D), M_V_W ** -0.5)
    w_branch_n = nrm((L, N_Q_W, D), N_Q_W ** -0.5)
    w_out = nrm((L, D, D), BETA * D ** -0.5)
    ln1_g = 1.0 + nrm((L, D), 0.02)
    ln1_b = nrm((L, D), 0.02)
    router_w = nrm((D, N_EXPERTS), D ** -0.5)
    router_b = nrm((N_EXPERTS,), 0.01)
    exp_w1 = nrm((L, N_EXPERTS, D, D_FF), D ** -0.5)
    exp_w3 = nrm((L, N_EXPERTS, D, D_FF), D ** -0.5)
    exp_w2 = nrm((L, N_EXPERTS, D_FF, D), BETA * D_FF ** -0.5)
    ln2_g = 1.0 + nrm((L, D), 0.02)
    ln2_b = nrm((L, D), 0.02)
    return {'x': x, 'w_in': w_in, 'b_in': b_in, 'm_norm_w': m_norm_w,
            'cmp_pos_k': cmp_pos_k, 'cmp_w1_k': cmp_w1_k, 'cmp_b1_k': cmp_b1_k, 'cmp_w2_k': cmp_w2_k, 'cmp_b2_k': cmp_b2_k,
            'cmp_pos_v': cmp_pos_v, 'cmp_w1_v': cmp_w1_v, 'cmp_b1_v': cmp_b1_v, 'cmp_w2_v': cmp_w2_v, 'cmp_b2_v': cmp_b2_v,
            'w_branch_m': w_branch_m, 'w_branch_n': w_branch_n, 'w_out': w_out, 'ln1_g': ln1_g, 'ln1_b': ln1_b,
            'router_w': router_w, 'router_b': router_b, 'exp_w1': exp_w1, 'exp_w3': exp_w3, 'exp_w2': exp_w2,
            'ln2_g': ln2_g, 'ln2_b': ln2_b}


def reference(x, w_in, b_in, m_norm_w, cmp_pos_k, cmp_w1_k, cmp_b1_k, cmp_w2_k, cmp_b2_k,
              cmp_pos_v, cmp_w1_v, cmp_b1_v, cmp_w2_v, cmp_b2_v, w_branch_m, w_branch_n, w_out,
              ln1_g, ln1_b, router_w, router_b, exp_w1, exp_w3, exp_w2, ln2_g, ln2_b):
    B, T, D = x.shape
    for l in range(DEPTH):
        cmp_k = (cmp_pos_k[l], cmp_w1_k[l], cmp_b1_k[l], cmp_w2_k[l], cmp_b2_k[l])
        cmp_v = (cmp_pos_v[l], cmp_w1_v[l], cmp_b1_v[l], cmp_w2_v[l], cmp_b2_v[l])
        mix = _mixer(x, w_in[l], b_in[l], m_norm_w[l], cmp_k, cmp_v, w_branch_m[l], w_branch_n[l], w_out[l])
        x = _layer_norm(ALPHA * x + mix, ln1_g[l], ln1_b[l])
        ff = _moe(x.reshape(B * T, D), router_w, router_b, exp_w1[l], exp_w3[l], exp_w2[l]).reshape(B, T, D)
        x = _layer_norm(ALPHA * x + ff, ln2_g[l], ln2_b[l])
    return x
```

```cpp
#include <hip/hip_runtime.h>
#include <cstdio>
#include <cstdint>

#ifndef MK_ONE_LAUNCH
#define MK_ONE_LAUNCH 1
#endif

#define LAS __attribute__((address_space(3)))
#define DEVI __device__ __forceinline__
typedef unsigned short u16;
typedef short bf16x8 __attribute__((ext_vector_type(8)));
typedef float f32x4 __attribute__((ext_vector_type(4)));
typedef float f32x2 __attribute__((ext_vector_type(2)));
typedef unsigned u32x4 __attribute__((ext_vector_type(4)));
typedef unsigned u32x2 __attribute__((ext_vector_type(2)));

constexpr int T_ = 4096, D_ = 2048, M_ = 16384;
constexpr int NPAD = 15616, IN_W = 15416;
constexpr int C_MQ = 0, C_MK = 1024, C_MV = 2048, C_MO = 4096, C_NQ = 6144, C_KC = 8192, C_VC = 8704, C_KS = 9216, C_VS = 9728, C_KW = 10240,
              C_VW = 10752, C_GM = 11264, C_GT = 15360;
constexpr int S_MI = 6144, S_NQ = 6152, S_KC = 8200, S_KS = 9224, S_VS = 9736, S_KW = 10248, S_VW = 10760, S_NG = 11272, S_GM = 11320;
constexpr float ALPHA = 1.4142135623730951f;
constexpr float LN_EPS = 1e-5f;
constexpr int NEXP = 32, DFF = 1024;
constexpr int MOE_ROWS = 40960;

constexpr size_t MiB = 1u << 20;
constexpr size_t WS_CTL = 0, CTL_BYTES = 1 * MiB;
constexpr size_t WS_ROPE = 1 * MiB;
constexpr size_t WS_BIASP = 3 * MiB;
constexpr size_t WS_WIN = 4 * MiB;
constexpr size_t WS_WB = 126 * MiB;
constexpr size_t WS_CW1 = 174 * MiB;
constexpr size_t WS_W13 = 178 * MiB;
constexpr size_t WS_W2 = 434 * MiB;
constexpr size_t WS_XBF = 562 * MiB;
constexpr size_t WS_XA = 626 * MiB;
constexpr size_t WS_XB = 754 * MiB;
constexpr size_t WS_Z = 882 * MiB;
constexpr size_t WS_GATES = 1370 * MiB;
constexpr size_t WS_KC = 1374 * MiB;
constexpr size_t WS_U = 1406 * MiB;
constexpr size_t WS_KCMP = 1414 * MiB;
constexpr size_t WS_MISC = 1416 * MiB;
constexpr size_t WS_CHS = WS_MISC + 1800 * 1024;
constexpr size_t WS_H = 1418 * MiB;
constexpr size_t WS_HG = 1546 * MiB;
constexpr size_t WS_O = 1610 * MiB;
constexpr size_t WS_MRG = 1674 * MiB;
constexpr size_t WS_END = 1738 * MiB, WS_END2 = 1739 * MiB;
constexpr size_t WS_OC = WS_H, WS_OW = WS_H + 64 * MiB, WS_IMP = WS_MRG, WS_OVL = WS_MISC + 1728 * 1024, WS_SEL = WS_END;
constexpr size_t WS_RWT = WS_MISC + 512 * 1024;
constexpr size_t WS_X8 = 1739 * MiB, WS_END3 = 1771 * MiB;
constexpr size_t WS_Z8 = 1771 * MiB, WS_KCMP8 = 1819 * MiB, WS_END4 = 1820 * MiB;
constexpr size_t WS_OCG = 1820 * MiB, WS_END5 = 1884 * MiB;
constexpr size_t WS_XG = WS_Z, WS_HB = WS_Z + 160 * MiB, WS_Y = WS_Z + 240 * MiB;
constexpr int CW_BAR = 4096;
constexpr int CW_CNT = 16384;
constexpr int CW_B1P = 16640;

constexpr int RING_BYTES = 131072;
constexpr int LDSCTL_OFF = 143360;
constexpr int LDS_BYTES = 147456;

DEVI float bf2f(unsigned h) { return __uint_as_float(h << 16); }
DEVI unsigned f2bf(float f) { unsigned u = __float_as_uint(f); return (u + 0x7fffu + ((u >> 16) & 1u)) >> 16; }
DEVI unsigned pk2(float lo, float hi) { unsigned r; asm("v_cvt_pk_bf16_f32 %0, %1, %2" : "=v"(r) : "v"(lo), "v"(hi)); return r; }
DEVI unsigned pk4_fp8(float a, float b, float c, float d) {
    a = __builtin_amdgcn_fmed3f(a, 448.f, -448.f); b = __builtin_amdgcn_fmed3f(b, 448.f, -448.f); c = __builtin_amdgcn_fmed3f(c, 448.f, -448.f); d = __builtin_amdgcn_fmed3f(d, 448.f, -448.f);
    int w = __builtin_amdgcn_cvt_pk_fp8_f32(a, b, 0, false); w = __builtin_amdgcn_cvt_pk_fp8_f32(c, d, w, true); return (unsigned)w; }
DEVI float sigm(float x) { return 1.f / (1.f + __expf(-x)); }
DEVI float wsum(float v) {
#pragma unroll
    for (int o = 32; o; o >>= 1) v += __shfl_xor(v, o);
    return v; }
DEVI float wmax(float v) {
#pragma unroll
    for (int o = 32; o; o >>= 1) v = fmaxf(v, __shfl_xor(v, o));
    return v; }
#define WAVE_SYNC() asm volatile("s_waitcnt lgkmcnt(0)" ::: "memory")
DEVI void unpack8(u32x4 v, float* f) {
    f[0] = __uint_as_float(v.x << 16); f[1] = __uint_as_float(v.x & 0xffff0000u); f[2] = __uint_as_float(v.y << 16); f[3] = __uint_as_float(v.y & 0xffff0000u);
    f[4] = __uint_as_float(v.z << 16); f[5] = __uint_as_float(v.z & 0xffff0000u); f[6] = __uint_as_float(v.w << 16); f[7] = __uint_as_float(v.w & 0xffff0000u); }

#define XB_TMO      128
#define XB_XCNT(j)  (256  + 64 * (j))
#define XB_XSUB(j)  (1280 + 64 * (j))
#define XB_XGEN(j)  (2304 + 64 * (j))
#define XB_TOP      3328
#define XB_TOPGEN   3392
#define XCD_BAR_WORDS 3456
#define XB_SPIN_CAP (1u << 21)
DEVI unsigned xb_ld(unsigned* p)              { return __hip_atomic_load(p, __ATOMIC_RELAXED, __HIP_MEMORY_SCOPE_AGENT); }
DEVI unsigned xb_add(unsigned* p, unsigned v) { return __hip_atomic_fetch_add(p, v, __ATOMIC_RELAXED, __HIP_MEMORY_SCOPE_AGENT); }
DEVI unsigned xb_xcc_id() { return (unsigned)__builtin_amdgcn_s_getreg((3 << 11) | 20) & 0xFu; }
#define XB_SPIN(cond, bar) do { unsigned _sp = 0; while (cond) { __builtin_amdgcn_s_sleep(1); \
    if ((++_sp & 255u) == 0u) { if (xb_ld(&(bar)[XB_TMO])) break; if (_sp > XB_SPIN_CAP) { atomicAdd(&(bar)[XB_TMO], 1u); break; } } } } while (0)
struct XcdBarrier { unsigned* bar; unsigned x; volatile LAS unsigned* st; int wv; };
DEVI bool xb_leader(int wv) { return wv == 0 && __builtin_amdgcn_mbcnt_hi(~0u, __builtin_amdgcn_mbcnt_lo(~0u, 0u)) == 0u; }
DEVI XcdBarrier xcd_barrier_post(unsigned* bar, volatile LAS unsigned* st, int wv) {
    XcdBarrier b; b.bar = bar; b.x = xb_xcc_id(); b.st = st; b.wv = wv;
    if (xb_leader(wv)) (void)xb_add(&bar[XB_XCNT(b.x)], 1u);
    return b;
}
DEVI void xcd_barrier_complete(unsigned* bar, unsigned x, unsigned& nloc, unsigned& nx) {
    const unsigned G = gridDim.x * gridDim.y * gridDim.z;
    unsigned sum, cnt, mine, sp = 0u;
    for (;;) {
        sum = 0u; cnt = 0u; mine = 0u;
#pragma unroll
        for (unsigned j = 0; j < 16; ++j) { const unsigned c = xb_ld(&bar[XB_XCNT(j)]); sum += c; cnt += (c > 0u) ? 1u : 0u; mine = (j == x) ? c : mine; }
        if (sum == G) break;
        __builtin_amdgcn_s_sleep(1);
        if ((++sp & 255u) == 0u) { if (xb_ld(&bar[XB_TMO])) break; if (sp > XB_SPIN_CAP) { atomicAdd(&bar[XB_TMO], 1u); break; } }
    }
    nloc = mine > 0u ? mine : 1u; nx = cnt > 0u ? cnt : 1u;
}
__device__ __noinline__ void xcd_barrier_impl(unsigned* bar_, unsigned x_, volatile LAS unsigned* st_, int wv_) {
    XcdBarrier b; b.bar = bar_; b.x = x_; b.st = st_; b.wv = wv_;
    asm volatile("s_waitcnt vmcnt(0)" ::: "memory");
    __syncthreads();
    if (xb_leader(b.wv)) {
        unsigned* bar = b.bar;
        __builtin_amdgcn_s_waitcnt(0);
        unsigned nloc = b.st[0], nx = b.st[1];
        if (nloc == 0u) { xcd_barrier_complete(bar, b.x, nloc, nx); b.st[0] = nloc; b.st[1] = nx; }
        const unsigned old = xb_add(&bar[XB_XSUB(b.x)], 1u);
        const unsigned gen = old / nloc;
        if (old + 1u == (gen + 1u) * nloc) {
            __builtin_amdgcn_fence(__ATOMIC_RELEASE, "agent");
            asm volatile("s_waitcnt vmcnt(0)" ::: "memory");
            const unsigned og = xb_add(&bar[XB_TOP], 1u);
            const unsigned tg = og / nx;
            if (og + 1u == (tg + 1u) * nx) xb_add(&bar[XB_TOPGEN], 1u);
            else XB_SPIN(xb_ld(&bar[XB_TOPGEN]) == tg, bar);
            __builtin_amdgcn_fence(__ATOMIC_ACQUIRE, "agent");
            xb_add(&bar[XB_XGEN(b.x)], 1u);
            asm volatile("s_waitcnt vmcnt(0)" ::: "memory");
        } else {
            XB_SPIN(xb_ld(&bar[XB_XGEN(b.x)]) == gen, bar);
            __builtin_amdgcn_fence(__ATOMIC_ACQUIRE, "agent");
            asm volatile("s_waitcnt vmcnt(0)" ::: "memory");
        }
    }
    __syncthreads();
}

DEVI void xcd_barrier(const XcdBarrier& b) { xcd_barrier_impl(b.bar, b.x, b.st, b.wv); }

namespace pg8 {
constexpr int BM = 256, BK = 64, HALF = 128, HTB = HALF * BK * 2, STAGE_BYTES = 8 * HTB, NXCD = 8, WGM = 4;
__host__ __device__ __forceinline__ int lds_byte(int r, int c) { const int st = (r >> 4) * 2 + (c >> 5), rr = r & 15, cc = c & 31, ob = rr * 64 + cc * 2; return st * 1024 + (ob ^ (((ob >> 9) & 1) << 5)); }
__host__ __device__ __forceinline__ void stage_rc(int b, int& R, int& C) { const int st = b / 1024, sb = b % 1024, swz = sb ^ (((sb >> 9) & 1) << 5); R = (st >> 1) * 16 + swz / 64; C = (st & 1) * 32 + (swz % 64) / 2; }
__host__ __device__ __forceinline__ int perm32(int rho) { const int n = rho >> 4, i = rho & 15; return 8 * (i >> 2) + 4 * n + (i & 3); }

struct Unit { int pm, pn, pb; };
struct Gemm { const u16* A; const u16* Bt; int lda, K; int sclW = 0x7f7f7f7f, sclA = 0x7f7f7f7f; };

struct StaticOrder {
    int nM, nN, nwg, G, c;
    DEVI void init(int M, int N, int G_, int c_) { nM = M / BM; nN = N / BM; nwg = nM * nN; G = G_; c = c_; }
    DEVI bool next(int i, Unit& u) const {
        const long L = (long)i * G + c; if (L >= nwg) return false;
        int wgid = (int)L; { const int q = nwg / NXCD, r = nwg % NXCD, xcd = wgid % NXCD, off = wgid / NXCD; wgid = (xcd < r ? xcd * (q + 1) : r * (q + 1) + (xcd - r) * q) + off; }
        const int nig = WGM * nN, gid = wgid / nig, fm = gid * WGM, gsz = (nM - fm) < WGM ? (nM - fm) : WGM;
        u.pm = fm + ((wgid % nig) % gsz); u.pn = (wgid % nig) / gsz; u.pb = u.pn; return true;
    }
};

typedef int i32x4_ __attribute__((ext_vector_type(4)));
typedef int i32x8_ __attribute__((ext_vector_type(8)));
template <class Epi, class Sched, bool FP8 = false>
DEVI void gemm_phase(LAS unsigned char* lds, const Gemm g, const Sched& S, const Epi& E, const int tid) {
    const int wid = __builtin_amdgcn_readfirstlane(tid >> 6), lane = tid & 63, wr = wid >> 2, wc = wid & 3, fr = lane & 15, fq = lane >> 4;
    const int K = g.K, nt = K / BK, lda = g.lda; const int sclW = g.sclW, sclA = g.sclA; (void)sclW; (void)sclA;
    unsigned voffA[2], voffB[2];
#pragma unroll
    for (int i = 0; i < 2; ++i) { int R, C; stage_rc(tid * 16 + i * 8192, R, C); const int Rb = Epi::PERM ? ((R & ~31) + perm32(R & 31)) : R;
        voffA[i] = (unsigned)(R * lda + C) * 2u; voffB[i] = (unsigned)(Rb * K + C) * 2u; }
    const size_t kstep = (size_t)(BK * 2);
    const size_t hstepA = (size_t)HALF * lda * 2, tstepA = 2 * hstepA;
    const size_t hstepB = (size_t)HALF * K * 2, tstepB = 2 * hstepB;
    const unsigned ldsw = (unsigned)wid * 1024u;
    const int aoff = lds_byte(wr * 64 + fr, fq * 8), boff = lds_byte(wc * 32 + fr, fq * 8);
#define PG8_SA(b, h) (((b) * 2 + (h)) * HTB)
#define PG8_SB(b, h) ((4 + (b) * 2 + (h)) * HTB)
#define PG8_STAGE(bufoff, gbase, voff) do { _Pragma("unroll") for (int _i = 0; _i < 2; ++_i) \
        __builtin_amdgcn_global_load_lds((const unsigned*)((const char*)(gbase) + (voff)[_i]), (LAS unsigned*)(lds + (bufoff) + ldsw + _i * 8192), 16, 0, 0); } while (0)
#define PG8_LD2(addr) __builtin_shufflevector(*(const LAS i32x4_*)(addr), *(const LAS i32x4_*)((addr) + 1024), 0, 1, 2, 3, 4, 5, 6, 7)
#define PG8_LDA(dst, b, h) do { _Pragma("unroll") for (int m = 0; m < 4; ++m) dst[m] = PG8_LD2(lds + PG8_SA(b, h) + aoff + m * 2048); } while (0)
#define PG8_LDB(dst, b, h) do { _Pragma("unroll") for (int n = 0; n < 2; ++n) dst[n] = PG8_LD2(lds + PG8_SB(b, h) + boff + n * 2048); } while (0)
#define PG8_HALF(v, k) ((k) == 0 ? (bf16x8)__builtin_shufflevector(v, v, 0, 1, 2, 3) : (bf16x8)__builtin_shufflevector(v, v, 4, 5, 6, 7))
#define PG8_MMA(ai, bj, At, Bt) do { __builtin_amdgcn_s_setprio(1); _Pragma("unroll") for (int m = 0; m < 4; ++m) _Pragma("unroll") for (int n = 0; n < 2; ++n) { \
        if constexpr (FP8) { asm volatile("v_mfma_scale_f32_16x16x128_f8f6f4 %0, %1, %2, %0, %3, %4 op_sel_hi:[0,0,0]" : "+v"(acc[ai][bj][m][n]) : "v"(Bt[n]), "v"(At[m]), "v"(sclW), "v"(sclA)); } \
        else { _Pragma("unroll") for (int k = 0; k < 2; ++k) acc[ai][bj][m][n] = __builtin_amdgcn_mfma_f32_16x16x32_bf16(PG8_HALF(Bt[n], k), PG8_HALF(At[m], k), acc[ai][bj][m][n], 0, 0, 0); } } \
        __builtin_amdgcn_s_setprio(0); } while (0)
#define PG8_WAIT_V(n) asm volatile("s_waitcnt vmcnt(" #n ")" ::: "memory")
#define PG8_WAIT_L(n) asm volatile("s_waitcnt lgkmcnt(" #n ")" ::: "memory")
#define PG8_BAR __builtin_amdgcn_s_barrier()
#define PG8_SCHED __builtin_amdgcn_sched_barrier(0)
    Unit cur, nxt; int ui = 0;
    if (!S.next(0, cur)) return;
    f32x4 acc[2][2][4][2];
#pragma unroll
    for (int a = 0; a < 2; ++a)
#pragma unroll
        for (int b = 0; b < 2; ++b)
#pragma unroll
            for (int m = 0; m < 4; ++m)
#pragma unroll
                for (int n = 0; n < 2; ++n) acc[a][b][m][n] = (f32x4){0.f, 0.f, 0.f, 0.f};
    i32x8_ At[4], B0[2], B1[2];
    const char* cA = (const char*)g.A + (size_t)cur.pm * tstepA; const char* cB = (const char*)g.Bt + (size_t)cur.pb * tstepB;
    PG8_STAGE(PG8_SB(0, 0), cB, voffB); PG8_STAGE(PG8_SB(0, 1), cB + hstepB, voffB); PG8_STAGE(PG8_SA(0, 0), cA, voffA); PG8_STAGE(PG8_SA(0, 1), cA + hstepA, voffA);
    if (wr == 1) PG8_BAR;
    PG8_WAIT_V(2); PG8_BAR;
    PG8_STAGE(PG8_SB(1, 0), cB + kstep, voffB); PG8_STAGE(PG8_SA(1, 0), cA + kstep, voffA); PG8_STAGE(PG8_SB(1, 1), cB + hstepB + kstep, voffB);
    PG8_WAIT_V(6); PG8_BAR;
    for (;;) {
        const bool has_next = S.next(ui + 1, nxt);
        const char* nA = has_next ? (const char*)g.A + (size_t)nxt.pm * tstepA : cA; const char* nB = has_next ? (const char*)g.Bt + (size_t)nxt.pb * tstepB : cB;
        for (int t = 0; t < nt; t += 2) {
            const bool last = (t == nt - 2);
            const char* a1 = cA + (size_t)(t + 1) * kstep;
            const char* a2 = last ? nA : cA + (size_t)(t + 2) * kstep; const char* b2 = last ? nB : cB + (size_t)(t + 2) * kstep;
            const char* a3 = a2 + kstep; const char* b3 = b2 + kstep;
            PG8_LDB(B0, 0, 0); PG8_LDB(B1, 0, 1); PG8_SCHED; PG8_LDA(At, 0, 0); PG8_STAGE(PG8_SA(1, 1), a1 + hstepA, voffA);
            PG8_WAIT_V(8); PG8_WAIT_L(0); PG8_BAR; PG8_MMA(0, 0, At, B0); PG8_MMA(0, 1, At, B1); PG8_BAR; PG8_SCHED;
            PG8_LDA(At, 0, 1); PG8_STAGE(PG8_SB(0, 0), b2, voffB); PG8_STAGE(PG8_SB(0, 1), b2 + hstepB, voffB); PG8_STAGE(PG8_SA(0, 0), a2, voffA);
            PG8_WAIT_V(8); PG8_WAIT_L(0); PG8_BAR; PG8_MMA(1, 0, At, B0); PG8_MMA(1, 1, At, B1); PG8_BAR; PG8_SCHED;
            PG8_LDB(B0, 1, 0); PG8_LDB(B1, 1, 1); PG8_SCHED; PG8_LDA(At, 1, 0); PG8_STAGE(PG8_SA(0, 1), a2 + hstepA, voffA);
            PG8_WAIT_V(8); PG8_WAIT_L(0); PG8_BAR; PG8_MMA(0, 0, At, B0); PG8_MMA(0, 1, At, B1); PG8_BAR; PG8_SCHED;
            PG8_LDA(At, 1, 1); PG8_STAGE(PG8_SB(1, 0), b3, voffB); PG8_STAGE(PG8_SB(1, 1), b3 + hstepB, voffB); PG8_STAGE(PG8_SA(1, 0), a3, voffA);
            PG8_WAIT_V(8); PG8_WAIT_L(0); PG8_BAR; PG8_MMA(1, 0, At, B0); PG8_MMA(1, 1, At, B1); PG8_BAR; PG8_SCHED;
        }
        if (wr == 0) PG8_BAR;
        if constexpr (FP8) asm volatile("s_nop 15\n\ts_nop 15\n\ts_nop 15\n\ts_nop 15" ::: "memory");
        E(acc, cur, wr, wc, fr, fq);
        if (!has_next) break;
#pragma unroll
        for (int a = 0; a < 2; ++a)
#pragma unroll
            for (int b = 0; b < 2; ++b)
#pragma unroll
                for (int m = 0; m < 4; ++m)
#pragma unroll
                    for (int n = 0; n < 2; ++n) acc[a][b][m][n] = (f32x4){0.f, 0.f, 0.f, 0.f};
        cur = nxt; cA = nA; cB = nB; ++ui;
        if (wr == 1) PG8_BAR;
    }
    PG8_WAIT_V(0);
    PG8_BAR;
#undef PG8_SA
#undef PG8_SB
#undef PG8_STAGE
#undef PG8_LDA
#undef PG8_LD2
#undef PG8_HALF
#undef PG8_LDB
#undef PG8_MMA
#undef PG8_WAIT_V
#undef PG8_WAIT_L
#undef PG8_BAR
#undef PG8_SCHED
}
}
using pg8::Unit;

struct EpiInProj {
    static constexpr bool PERM = true;
    u16* z; const float* bias; float* gates; u16* kc; const float* cosT; const float* sinT; unsigned char* z8;
    DEVI void operator()(const f32x4 (&acc)[2][2][4][2], const Unit& u, int wr, int wc, int fr, int fq) const {
        const int pn = u.pn, row0 = u.pm * 256 + wr * 64 + fr, colt = pn * 256, cl0 = wc * 32 + 8 * fq;
        f32x4 bv[2][2];
#pragma unroll
        for (int bj = 0; bj < 2; ++bj)
#pragma unroll
            for (int n = 0; n < 2; ++n) bv[bj][n] = *(const f32x4*)(bias + colt + cl0 + bj * 128 + 4 * n);
        const float scale = pn < 4 ? 0.0625f : 1.f;
        const bool rope = (pn >= 24 && pn < 32) || pn == 36 || pn == 37 || pn == 40 || pn == 41;
        const bool kcv = pn >= 32 && pn < 36;
#pragma unroll
        for (int ai = 0; ai < 2; ++ai)
#pragma unroll
            for (int m = 0; m < 4; ++m) { const int row = row0 + ai * 128 + m * 16, t = row & 4095;
                f32x4 cs = {1.f, 1.f, 1.f, 1.f}, sn = {0.f, 0.f, 0.f, 0.f};
                if (rope) { cs = *(const f32x4*)(cosT + t * 64 + (cl0 >> 1)); sn = *(const f32x4*)(sinT + t * 64 + (cl0 >> 1)); }
#pragma unroll
                for (int bj = 0; bj < 2; ++bj) {
                    f32x4 v0 = (acc[ai][bj][m][0] + bv[bj][0]) * scale, v1 = (acc[ai][bj][m][1] + bv[bj][1]) * scale;
                    if (rope) {
                        const f32x4 a0 = v0, a1 = v1;
                        v0[0] = a0[0] * cs[0] - a0[1] * sn[0]; v0[1] = a0[1] * cs[0] + a0[0] * sn[0];
                        v0[2] = a0[2] * cs[1] - a0[3] * sn[1]; v0[3] = a0[3] * cs[1] + a0[2] * sn[1];
                        v1[0] = a1[0] * cs[2] - a1[1] * sn[2]; v1[1] = a1[1] * cs[2] + a1[0] * sn[2];
                        v1[2] = a1[2] * cs[3] - a1[3] * sn[3]; v1[3] = a1[3] * cs[3] + a1[2] * sn[3];
                    }
                    u32x4 w; w.x = pk2(v0[0], v0[1]); w.y = pk2(v0[2], v0[3]); w.z = pk2(v1[0], v1[1]); w.w = pk2(v1[2], v1[3]);
                    if (rope) { const int c8 = (pn < 32 ? (pn - 24) * 256 : pn < 38 ? 2048 + (pn - 36) * 256 : 2560 + (pn - 40) * 256) + bj * 128 + cl0;
                        u32x2 w8; w8.x = pk4_fp8(v0[0], v0[1], v0[2], v0[3]); w8.y = pk4_fp8(v1[0], v1[1], v1[2], v1[3]); *(u32x2*)(z8 + (size_t)row * 3072 + c8) = w8; }
                    if (rope) { }
                    else if (kcv) { const int cs_ = (pn - 32) * 256 + bj * 128 + cl0, which = cs_ >> 9, gg = (cs_ >> 7) & 3, dd = cs_ & 127, b = row >> 12;
                        u32x2 w8; w8.x = pk4_fp8(v0[0], v0[1], v0[2], v0[3]); w8.y = pk4_fp8(v1[0], v1[1], v1[2], v1[3]);
                        *(u32x2*)((unsigned char*)kc + ((size_t)((which * 16 + b * 4 + gg) * 4096 + t) * 128 + dd)) = w8; }
                    else *(u32x4*)(z + (size_t)row * NPAD + colt + bj * 128 + cl0) = w;
                }
            }
    }
};
struct EpiF32Tile {
    static constexpr bool PERM = false;
    float* C; int ldc;
    DEVI void operator()(const f32x4 (&acc)[2][2][4][2], const Unit& u, int wr, int wc, int fr, int fq) const {
        const int row0 = u.pm * 256 + wr * 64 + fr, col0 = u.pn * 256 + wc * 32 + 4 * fq;
#pragma unroll
        for (int ai = 0; ai < 2; ++ai)
#pragma unroll
            for (int m = 0; m < 4; ++m) { float* rowp = C + (size_t)(row0 + ai * 128 + m * 16) * ldc + col0;
#pragma unroll
                for (int bj = 0; bj < 2; ++bj)
#pragma unroll
                    for (int n = 0; n < 2; ++n) *(f32x4*)(rowp + bj * 128 + n * 16) = acc[ai][bj][m][n]; }
    }
};
template <bool ADD> struct EpiGate {
    static constexpr bool PERM = true;
    u16* mrg; const u16* z; int gcol0;
    DEVI void operator()(const f32x4 (&acc)[2][2][4][2], const Unit& u, int wr, int wc, int fr, int fq) const {
        const int row0 = u.pm * 256 + wr * 64 + fr, col0 = u.pn * 256 + wc * 32 + 8 * fq;
#pragma unroll
        for (int ai = 0; ai < 2; ++ai)
#pragma unroll
            for (int m = 0; m < 4; ++m) { const int row = row0 + ai * 128 + m * 16;
#pragma unroll
                for (int bj = 0; bj < 2; ++bj) { const int col = col0 + bj * 128;
                    float gz[8], pv[8]; unpack8(*(const u32x4*)(z + (size_t)row * NPAD + gcol0 + col), gz);
                    u16* dst = mrg + (size_t)row * D_ + col;
                    if (ADD) unpack8(*(const u32x4*)dst, pv);
                    float o[8];
#pragma unroll
                    for (int j = 0; j < 4; ++j) { o[j] = acc[ai][bj][m][0][j] * sigm(gz[j]); o[4 + j] = acc[ai][bj][m][1][j] * sigm(gz[4 + j]); }
                    if (ADD) {
#pragma unroll
                        for (int j = 0; j < 8; ++j) o[j] += pv[j]; }
                    u32x4 w; w.x = pk2(o[0], o[1]); w.y = pk2(o[2], o[3]); w.z = pk2(o[4], o[5]); w.w = pk2(o[6], o[7]);
                    *(u32x4*)dst = w; } }
    }
};
struct EpiResid {
    static constexpr bool PERM = false;
    u16* pre; const float* x; const u16* xh;
    DEVI void operator()(const f32x4 (&acc)[2][2][4][2], const Unit& u, int wr, int wc, int fr, int fq) const {
        const int row0 = u.pm * 256 + wr * 64 + fr, col0 = u.pn * 256 + wc * 32 + 4 * fq;
#pragma unroll
        for (int ai = 0; ai < 2; ++ai)
#pragma unroll
            for (int m = 0; m < 4; ++m) { const size_t off = (size_t)(row0 + ai * 128 + m * 16) * D_ + col0;
#pragma unroll
                for (int bj = 0; bj < 2; ++bj)
#pragma unroll
                    for (int n = 0; n < 2; ++n) { f32x4 xv; if (xh) { const u32x2 t_ = *(const u32x2*)(xh + off + bj * 128 + n * 16); xv = (f32x4){__uint_as_float(t_.x << 16), __uint_as_float(t_.x & 0xffff0000u), __uint_as_float(t_.y << 16), __uint_as_float(t_.y & 0xffff0000u)}; } else xv = *(const f32x4*)(x + off + bj * 128 + n * 16);
                        const f32x4 r = xv * ALPHA + acc[ai][bj][m][n];
                        u32x2 w; w.x = pk2(r[0], r[1]); w.y = pk2(r[2], r[3]); *(u32x2*)(pre + off + bj * 128 + n * 16) = w; } }
    }
};
struct EpiSwiGLU {
    static constexpr bool PERM = true;
    unsigned char* H;
    DEVI void operator()(const f32x4 (&acc)[2][2][4][2], const Unit& u, int wr, int wc, int fr, int fq) const {
        const int row0 = u.pm * 256 + wr * 64 + fr, f0 = u.pn * 128 + wc * 16 + 4 * fq;
#pragma unroll
        for (int ai = 0; ai < 2; ++ai)
#pragma unroll
            for (int m = 0; m < 4; ++m) { const int row = row0 + ai * 128 + m * 16;
#pragma unroll
                for (int bj = 0; bj < 2; ++bj) { const f32x4 a = acc[ai][bj][m][0], b = acc[ai][bj][m][1]; float o[4];
#pragma unroll
                    for (int j = 0; j < 4; ++j) o[j] = a[j] * sigm(a[j]) * b[j];
                    *(unsigned*)(H + (size_t)row * DFF + f0 + bj * 64) = pk4_fp8(o[0], o[1], o[2], o[3]); } }
    }
};
struct EpiScaleRow {
    static constexpr bool PERM = true;
    u16* Y; const float* roww;
    DEVI void operator()(const f32x4 (&acc)[2][2][4][2], const Unit& u, int wr, int wc, int fr, int fq) const {
        const int row0 = u.pm * 256 + wr * 64 + fr, col0 = u.pn * 256 + wc * 32 + 8 * fq;
#pragma unroll
        for (int ai = 0; ai < 2; ++ai)
#pragma unroll
            for (int m = 0; m < 4; ++m) { const int row = row0 + ai * 128 + m * 16; const float w_ = roww[row];
#pragma unroll
                for (int bj = 0; bj < 2; ++bj) { const f32x4 v0 = acc[ai][bj][m][0] * w_, v1 = acc[ai][bj][m][1] * w_;
                    u32x4 w; w.x = pk2(v0[0], v0[1]); w.y = pk2(v0[2], v0[3]); w.z = pk2(v1[0], v1[1]); w.w = pk2(v1[2], v1[3]);
                    *(u32x4*)(Y + (size_t)row * D_ + col0 + bj * 128) = w; } }
    }
};

struct CmpOrder {
    int G, c;
    DEVI bool next(int i, Unit& u) const { const int L = i * G + c; if (L >= 32) return false; u.pm = L; u.pn = 0; u.pb = L >> 4; return true; }
};
struct MoeOrder {
    int G, c, ntiles; const volatile LAS int* tstart;
    DEVI bool next(int i, Unit& u) const {
        const int L = i * G + c; if (L >= ntiles * 8) return false;
        const int tile = L >> 3, pn = L & 7;
        const int lk_ = (int)__builtin_amdgcn_mbcnt_hi(~0u, __builtin_amdgcn_mbcnt_lo(~0u, 0u));
        const int e = __popcll(__ballot(lk_ >= 1 && lk_ < 32 && tstart[lk_ & 31] <= tile));
        u.pm = tile; u.pn = pn; u.pb = e * 8 + pn; return true;
    }
};

struct Args { const float* in[26]; float* out; unsigned char* ws; int ph_lo, ph_hi; };
typedef const __attribute__((address_space(4))) Args* KP;
constexpr int PPL = 13;
constexpr int NPH = 1 + 2 * PPL;

DEVI int src_col(int n) {
    if (n < C_NQ) return n;
    if (n < C_KC) { const int r = n - C_NQ, hd = r >> 7, p = r & 127; return S_NQ + hd * 128 + (p >> 1) + 64 * (p & 1); }
    if (n < C_KS) return S_KC + (n - C_KC);
    if (n < C_VS) { const int r = n - C_KS, hd = r >> 7, p = r & 127; return S_KS + hd * 128 + (p >> 1) + 64 * (p & 1); }
    if (n < C_KW) return S_VS + (n - C_VS);
    if (n < C_VW) { const int r = n - C_KW, hd = r >> 7, p = r & 127; return S_KW + hd * 128 + (p >> 1) + 64 * (p & 1); }
    if (n < C_GM) return S_VW + (n - C_VW);
    if (n < C_GT) return S_GM + (n - C_GM);
    const int r = n - C_GT; if (r < 8) return S_MI + r; if (r < 56) return S_NG + (r - 8); return -1;
}

template <class ColPtr>
DEVI void tr_item32(const ColPtr& cp, size_t ldw, int K, u16* WT, int k0, int n0, float* scr, int lane) {
    const float* src = cp(n0 + (lane & 31));
#pragma unroll 8
    for (int i = 0; i < 32; ++i) { const int kk = 2 * i + (lane >> 5); scr[kk * 33 + (lane & 31)] = src ? src[(size_t)(k0 + kk) * ldw] : 0.f; }
    WAVE_SYNC();
    const int c = lane & 7;
#pragma unroll
    for (int j = 0; j < 4; ++j) { const int n = (lane >> 3) + 8 * j; const float* s = scr + (8 * c) * 33 + n;
        u32x4 o; o.x = pk2(s[0 * 33], s[1 * 33]); o.y = pk2(s[2 * 33], s[3 * 33]); o.z = pk2(s[4 * 33], s[5 * 33]); o.w = pk2(s[6 * 33], s[7 * 33]);
        *(u32x4*)(WT + (size_t)(n0 + n) * K + k0 + 8 * c) = o; }
    WAVE_SYNC();
}
template <class ColPtr>
DEVI void tr_item64(const ColPtr& cp, size_t ldw, int K, u16* WT, int k0, int n0, float* scr, int lane) {
    const int nq = lane & 15, kr = lane >> 4;
    const float* src = cp(n0 + 4 * nq);
    f32x4 v[16];
#pragma unroll
    for (int i = 0; i < 16; ++i) v[i] = src ? __builtin_nontemporal_load((const f32x4*)(src + (size_t)(k0 + kr + 4 * i) * ldw)) : (f32x4){0.f, 0.f, 0.f, 0.f};
#pragma unroll
    for (int i = 0; i < 16; ++i) { float* d = scr + (kr + 4 * i) * 65 + 4 * nq; d[0] = v[i][0]; d[1] = v[i][1]; d[2] = v[i][2]; d[3] = v[i][3]; }
    WAVE_SYNC();
    const int c = lane & 7;
#pragma unroll
    for (int j = 0; j < 8; ++j) { const int n = (lane >> 3) + 8 * j; const float* sp = scr + (8 * c) * 65 + n;
        u32x4 o; o.x = pk2(sp[0 * 65], sp[1 * 65]); o.y = pk2(sp[2 * 65], sp[3 * 65]); o.z = pk2(sp[4 * 65], sp[5 * 65]); o.w = pk2(sp[6 * 65], sp[7 * 65]);
        *(u32x4*)(WT + (size_t)(n0 + n) * K + k0 + 8 * c) = o; }
    WAVE_SYNC();
}
template <class ColPtr>
DEVI void tr_item64_f8(const ColPtr& cp, size_t ldw, int K, unsigned char* WT, int k0, int n0, float* scr, int lane, float scale) {
    const int nq = lane & 15, kr = lane >> 4;
    const float* src = cp(n0 + 4 * nq);
    f32x4 v[16];
#pragma unroll
    for (int i = 0; i < 16; ++i) v[i] = src ? __builtin_nontemporal_load((const f32x4*)(src + (size_t)(k0 + kr + 4 * i) * ldw)) : (f32x4){0.f, 0.f, 0.f, 0.f};
#pragma unroll
    for (int i = 0; i < 16; ++i) { float* d = scr + (kr + 4 * i) * 65 + 4 * nq; d[0] = v[i][0]; d[1] = v[i][1]; d[2] = v[i][2]; d[3] = v[i][3]; }
    WAVE_SYNC();
    const int c = lane & 3;
#pragma unroll
    for (int j = 0; j < 4; ++j) { const int n = (lane >> 2) + 16 * j; const float* sp = scr + (16 * c) * 65 + n;
        u32x4 o; o.x = pk4_fp8(sp[0 * 65] * scale, sp[1 * 65] * scale, sp[2 * 65] * scale, sp[3 * 65] * scale); o.y = pk4_fp8(sp[4 * 65] * scale, sp[5 * 65] * scale, sp[6 * 65] * scale, sp[7 * 65] * scale);
        o.z = pk4_fp8(sp[8 * 65] * scale, sp[9 * 65] * scale, sp[10 * 65] * scale, sp[11 * 65] * scale); o.w = pk4_fp8(sp[12 * 65] * scale, sp[13 * 65] * scale, sp[14 * 65] * scale, sp[15 * 65] * scale);
        *(u32x4*)(WT + (size_t)(n0 + n) * K + k0 + 16 * c) = o; }
    WAVE_SYNC();
}
DEVI void tr_item64_f8_rope(const float* Wh  , size_t ldw, int K, unsigned char* WT, int k0, int n0, float* scr, int lane, float scale) {
    const int nq = lane & 15, kr = lane >> 4, hf = nq >> 3, d4 = 4 * (nq & 7);
    const float* src = Wh + hf * 64 + d4;
    f32x4 v[16];
#pragma unroll
    for (int i = 0; i < 16; ++i) v[i] = __builtin_nontemporal_load((const f32x4*)(src + (size_t)(k0 + kr + 4 * i) * ldw));
#pragma unroll
    for (int i = 0; i < 16; ++i) { float* d = scr + (kr + 4 * i) * 65 + 2 * d4 + hf; d[0] = v[i][0]; d[2] = v[i][1]; d[4] = v[i][2]; d[6] = v[i][3]; }
    WAVE_SYNC();
    const int c = lane & 3;
#pragma unroll
    for (int j = 0; j < 4; ++j) { const int n = (lane >> 2) + 16 * j; const float* sp = scr + (16 * c) * 65 + n;
        u32x4 o; o.x = pk4_fp8(sp[0 * 65] * scale, sp[1 * 65] * scale, sp[2 * 65] * scale, sp[3 * 65] * scale); o.y = pk4_fp8(sp[4 * 65] * scale, sp[5 * 65] * scale, sp[6 * 65] * scale, sp[7 * 65] * scale);
        o.z = pk4_fp8(sp[8 * 65] * scale, sp[9 * 65] * scale, sp[10 * 65] * scale, sp[11 * 65] * scale); o.w = pk4_fp8(sp[12 * 65] * scale, sp[13 * 65] * scale, sp[14 * 65] * scale, sp[15 * 65] * scale);
        *(u32x4*)(WT + (size_t)(n0 + n) * K + k0 + 16 * c) = o; }
    WAVE_SYNC();
}
template <class ColPtr>
DEVI void tr_item32_f8(const ColPtr& cp, size_t ldw, int K, unsigned char* WT, int k0, int n0, float* scr, int lane, float scale) {
    const float* src = cp(n0 + (lane & 31));
#pragma unroll 8
    for (int i = 0; i < 32; ++i) { const int kk = 2 * i + (lane >> 5); scr[kk * 33 + (lane & 31)] = src ? src[(size_t)(k0 + kk) * ldw] : 0.f; }
    WAVE_SYNC();
    const int c = lane & 7;
#pragma unroll
    for (int j = 0; j < 4; ++j) { const int n = (lane >> 3) + 8 * j; const float* sp = scr + (8 * c) * 33 + n;
        u32x2 o; o.x = pk4_fp8(sp[0 * 33] * scale, sp[1 * 33] * scale, sp[2 * 33] * scale, sp[3 * 33] * scale); o.y = pk4_fp8(sp[4 * 33] * scale, sp[5 * 33] * scale, sp[6 * 33] * scale, sp[7 * 33] * scale);
        *(u32x2*)(WT + (size_t)(n0 + n) * K + k0 + 8 * c) = o; }
    WAVE_SYNC();
}
struct ColPlain { const float* W; DEVI const float* operator()(int n) const { return W + n; } };
struct ColInProj { const float* W; DEVI const float* operator()(int n) const { const int s = src_col(n); return s >= 0 ? W + s : nullptr; } };
struct ColW13 { const float* w1; const float* w3; DEVI const float* operator()(int n) const { const int f = (n >> 3) * 4 + (n & 3); return ((n >> 2) & 1) ? w3 + f : w1 + f; } };

DEVI void phase_prologue(KP a, unsigned char* lds, int tid, int lane, int wave, int G) {
    unsigned char* ws = a->ws;
    float* cosT = (float*)(ws + WS_ROPE); float* sinT = cosT + 4096 * 64;
    for (int idx = blockIdx.x * 512 + tid; idx < 4096 * 64; idx += G * 512) {
        const int pos = idx >> 6, i = idx & 63;
        const float inv = exp2f(-(float)i * (13.287712379549449f / 64.f));
        const double ang = (double)pos * (double)inv;
        const double k = __builtin_rint(ang * 0.15915494309189535);
        const float r = (float)(ang - k * 6.283185307179586);
        cosT[idx] = cosf(r); sinT[idx] = sinf(r);
    }
    { const float* x = a->in[0]; unsigned char* x8 = ws + WS_X8;
      const size_t NI = (size_t)M_ * D_ / 8, st = (size_t)G * 512; size_t i = (size_t)blockIdx.x * 512 + tid;
      for (; i + 3 * st < NI; i += 4 * st) {
          f32x4 v0[4], v1[4];
#pragma unroll
          for (int u = 0; u < 4; ++u) { v0[u] = *(const f32x4*)(x + (i + u * st) * 8); v1[u] = *(const f32x4*)(x + (i + u * st) * 8 + 4); }
#pragma unroll
          for (int u = 0; u < 4; ++u) { u32x2 w; w.x = pk4_fp8(v0[u][0], v0[u][1], v0[u][2], v0[u][3]); w.y = pk4_fp8(v1[u][0], v1[u][1], v1[u][2], v1[u][3]); *(u32x2*)(x8 + (i + u * st) * 8) = w; } }
      for (; i < NI; i += st) {
          const f32x4 v0 = *(const f32x4*)(x + i * 8), v1 = *(const f32x4*)(x + i * 8 + 4);
          u32x2 w; w.x = pk4_fp8(v0[0], v0[1], v0[2], v0[3]); w.y = pk4_fp8(v1[0], v1[1], v1[2], v1[3]);
          *(u32x2*)(x8 + i * 8) = w; } }
    { float* bp = (float*)(ws + WS_BIASP);
      for (int i = blockIdx.x * 512 + tid; i < 2 * NPAD; i += G * 512) { const int l = i / NPAD, n = i % NPAD, s = src_col(n); bp[i] = s >= 0 ? a->in[2][l * IN_W + s] : 0.f; } }
    { u16* ov = (u16*)(ws + WS_OVL);
      for (int i = blockIdx.x * 512 + tid; i < 256 * 128; i += G * 512) { const int n = i >> 7, j = i & 127;
          const bool on = j < 64 && n < 255 && (16 * n <= 64 * j + 63) && (16 * n + 31 >= 64 * j); ov[i] = on ? (u16)0x3f80 : (u16)0; } }
    { float* wT = (float*)(ws + WS_RWT); const float* rw = a->in[19];
      for (int i = blockIdx.x * 512 + tid; i < 32 * 2048; i += G * 512) { const int e = i >> 11, d = i & 2047; wT[i] = rw[d * 32 + e]; } }
    const int gw = blockIdx.x * 8 + wave, NGW = G * 8;
    { float* b1p = (float*)(ws + WS_MISC + 1536 * 1024);
      for (int task = gw; task < 512; task += NGW) { const int kc = task & 63, fh = (task >> 6) & 1, kv = (task >> 7) & 1, l = task >> 8;
          const float* pos = a->in[kv ? 9 : 4] + (size_t)l * 4096; const float* w1 = a->in[kv ? 10 : 5] + (size_t)l * 4096 * 128; const int f = fh * 64 + lane;
          float s = 0.f;
          for (int k = kc * 64; k < kc * 64 + 64; ++k) s += pos[k] * w1[(size_t)k * 128 + f];
          b1p[((l * 2 + kv) * 64 + kc) * 128 + f] = s; } }
    float* scr = (float*)(lds + wave * 16640);
    constexpr int IT_WIN = 32 * (NPAD / 64), IT_WB = 32 * 32, IT_CW = 32 * 2;
    constexpr int NIT = 2 * IT_WIN + 6 * IT_WB + 8 * IT_CW;
    for (int it = gw; it < NIT; it += NGW) {
        int r = it;
        if (r < 2 * IT_WIN) { const int l = r / IT_WIN; r %= IT_WIN; const int kb = r / (NPAD / 64), nb = r % (NPAD / 64), n0 = nb * 64;
            const ColInProj cp{a->in[1] + (size_t)l * D_ * IN_W}; unsigned char* WT = ws + WS_WIN + (size_t)l * NPAD * D_;
            const bool rope = (n0 >= C_NQ && n0 < C_KC) || (n0 >= C_KS && n0 < C_VS) || (n0 >= C_KW && n0 < C_VW);
            if (rope) { const int segd = n0 >= C_KW ? C_KW : n0 >= C_KS ? C_KS : C_NQ, segs = n0 >= C_KW ? S_KW : n0 >= C_KS ? S_KS : S_NQ;
                const int r_ = n0 - segd, hd = r_ >> 7, m32 = (r_ & 127) >> 6;
                tr_item64_f8_rope(a->in[1] + (size_t)l * D_ * IN_W + segs + hd * 128 + 32 * m32, IN_W, D_, WT, kb * 64, n0, scr, lane, 64.f); }
            else tr_item64_f8(cp, IN_W, D_, WT, kb * 64, n0, scr, lane, 64.f);
            continue; }
        r -= 2 * IT_WIN;
        if (r < 6 * IT_WB) { const int q = r / IT_WB, l = q / 3, w = q % 3; r %= IT_WB; const int kb = r / 32, nb = r % 32;
            if (w <= 1) tr_item64_f8(ColPlain{a->in[14 + w] + (size_t)l * D_ * D_}, D_, D_, ws + WS_WB + (size_t)(l * 3 + w) * D_ * D_ * 2, kb * 64, nb * 64, scr, lane, 64.f);
            else tr_item64(ColPlain{a->in[14 + w] + (size_t)l * D_ * D_}, D_, D_, (u16*)(ws + WS_WB) + (size_t)(l * 3 + w) * D_ * D_, kb * 64, nb * 64, scr, lane);
            continue; }
        r -= 6 * IT_WB;
        { const int q = r / IT_CW, l = q >> 2, kv = (q >> 1) & 1, ab = q & 1; r %= IT_CW; const int kb = r / 2, nb = r % 2;
          const float* w1 = a->in[kv ? 10 : 5] + (size_t)l * 4096 * 128 + (size_t)ab * 2048 * 128;
          tr_item64_f8(ColPlain{w1}, 128, 2048, ws + WS_CW1 + (size_t)(l * 512 + kv * 256 + ab * 128) * 2048, kb * 64, nb * 64, scr, lane, 64.f); }
    }
}
DEVI void phase_experts(KP a, unsigned char* lds, int lane, int wave, int G, int l) {
    unsigned char* ws = a->ws;
    float* scr = (float*)(lds + wave * 16640);
    const int gw = blockIdx.x * 8 + wave, NGW = G * 8;
    constexpr int IT13 = 32 * 32, IT2 = 16 * 32;
    for (int it = gw; it < NEXP * (IT13 + IT2); it += NGW) {
        const int e = it / (IT13 + IT2); int r = it % (IT13 + IT2);
        if (r < IT13) { const int kb = r / 32, nb = r % 32;
            const float* w1 = a->in[21] + ((size_t)l * NEXP + e) * D_ * DFF; const float* w3 = a->in[22] + ((size_t)l * NEXP + e) * D_ * DFF;
            tr_item64_f8(ColW13{w1, w3}, DFF, D_, ws + WS_W13 + (size_t)e * 2048 * D_, kb * 64, nb * 64, scr, lane, 64.f); }
        else { r -= IT13; const int kb = r / 32, nb = r % 32;
            const float* w2 = a->in[23] + ((size_t)l * NEXP + e) * DFF * D_;
            tr_item64_f8(ColPlain{w2}, D_, DFF, ws + WS_W2 + (size_t)e * D_ * DFF, kb * 64, nb * 64, scr, lane, 64.f); }
    }
}

namespace ml {
constexpr int QP = 272, VP = 72;
constexpr int O_Q = 0, O_K = 34816, O_CB = 69632, O_VT = 95744, O_VW = 102656, O_SP = 109568, O_SC = 118784;
constexpr int S_A = 0, S_M = 64, S_WI = 128, S_EN = 192, S_WS = 256, S_DEN = 320, S_DEC = 384;
typedef short s16x4 __attribute__((ext_vector_type(4)));
DEVI bf16x8 frag(const unsigned char* lds, int off) { return *(const bf16x8*)(lds + off); }
DEVI bf16x8 frag_tr(unsigned addr) {
    s16x4 lo, hi;
    asm volatile("ds_read_b64_tr_b16 %0, %2\n\tds_read_b64_tr_b16 %1, %2 offset:2176\n\ts_waitcnt lgkmcnt(0)" : "=&v"(lo), "=&v"(hi) : "v"(addr) : "memory");
    return (bf16x8){lo[0], lo[1], lo[2], lo[3], hi[0], hi[1], hi[2], hi[3]};
}
}
constexpr size_t WS_SP = WS_O, WS_MSC = WS_O + 16 * MiB, WS_MDEC = WS_O + 20 * MiB;
DEVI void phase_mlstm_pre(KP a, unsigned char* lds, const int tid, int G, int first_blk) {
    using namespace ml;
    unsigned char* ws = a->ws;
    const u16* z = (const u16*)(ws + WS_Z); const float* gates = (const float*)(ws + WS_GATES);
    u16* SPg = (u16*)(ws + WS_SP); float* MSC = (float*)(ws + WS_MSC); float* MDEC = (float*)(ws + WS_MDEC);
    const int lane = tid & 63, wave = __builtin_amdgcn_readfirstlane(tid >> 6), g4 = lane >> 4, l15 = lane & 15;
    float* sc = (float*)(lds + O_SC);
    const int nblk = G - first_blk, bi = (int)blockIdx.x - first_blk;
    if (bi < 0) return;
    const int u0 = (int)(((long)bi * 1024) / nblk), u1 = (int)(((long)(bi + 1) * 1024) / nblk);
    float off = 0.f, Gp = 0.f; int have = -1;
    const unsigned qkoff = (unsigned)((tid >> 5) * NPAD + (tid & 31) * 8) * 2u; const int qklds = (tid >> 5) * (QP * 2) + (tid & 31) * 16;
    for (int u = u0; u < u1; ++u) { const int bh = u >> 6, c = u & 63, b = bh >> 2, h = bh & 3;
        const char* zq = (const char*)(z + (size_t)(b * 4096 + c * 64) * NPAD + C_MQ + h * 256);
        const char* zk = (const char*)(z + (size_t)(b * 4096 + c * 64) * NPAD + C_MK + h * 256);
        const float* gp = gates + (size_t)b * 4096 * 64 + h;
#pragma unroll
        for (int k = 0; k < 4; ++k) { *(u32x4*)(lds + O_Q + qklds + k * 16 * QP * 2) = *(const u32x4*)(zq + qkoff + (size_t)k * 16 * NPAD * 2); *(u32x4*)(lds + O_K + qklds + k * 16 * QP * 2) = *(const u32x4*)(zk + qkoff + (size_t)k * 16 * NPAD * 2); }
        if (wave == 0) {
            if (have != u) { off = 0.f; Gp = 0.f;
                if (c > 0) { const float* ch = (const float*)(ws + WS_CHS) + ((size_t)(b * 64) * 4 + h) * 2;
                    float Sv = 0.f, Lv = -INFINITY; if (lane < c) { Sv = ch[lane * 8]; Lv = ch[lane * 8 + 1]; }
#pragma unroll
                    for (int cc = 0; cc < 63; ++cc) { const float s_ = __int_as_float(__builtin_amdgcn_readlane(__float_as_int(Sv), cc)), l_ = __int_as_float(__builtin_amdgcn_readlane(__float_as_int(Lv), cc));
                        Gp = fmaxf(Gp, l_ - off); off += s_; } } }
            const float fg = gp[(size_t)(c * 64 + lane) * 64 + 4], ig = gp[(size_t)(c * 64 + lane) * 64];
            float bc = fminf(fg, 0.f) - log1pf(__expf(-fabsf(fg)));
#pragma unroll
            for (int o = 1; o < 64; o <<= 1) { const float t_ = __shfl_up(bc, o); if (lane >= o) bc += t_; }
            const float Bg = off + bc, gv = ig - Bg; float pm = gv;
#pragma unroll
            for (int o = 1; o < 64; o <<= 1) { const float t_ = __shfl_up(pm, o); if (lane >= o) pm = fmaxf(pm, t_); }
            const float Gt = fmaxf(Gp, pm), Ge = __shfl(Gt, 63);
            sc[S_A + lane] = gv; sc[S_M + lane] = Gt;
            *(f32x4*)(MSC + ((size_t)bh * 4096 + c * 64 + lane) * 4) = (f32x4){__expf(Gp - Gt), __expf(-(Bg + Gt)), __expf(gv - Ge), 0.f};
            if (lane == 0) MDEC[bh * 64 + c] = __expf(Gp - Ge);
            off = __shfl(Bg, 63); Gp = Ge; have = u + 1;
            if (c == 63) have = -1;
        }
        __syncthreads();
        const int tt = wave >> 1, st0 = 2 * (wave & 1); const int t = 16 * tt + l15; const float Gt_ = sc[S_M + t];
        u16* spo = SPg + (size_t)u * 4096 + (size_t)t * 64;
#pragma unroll
        for (int si = 0; si < 2; ++si) { const int st = st0 + si; u32x2 pk_ = {0u, 0u};
            if (st <= tt) { f32x4 sacc = {0.f, 0.f, 0.f, 0.f};
#pragma unroll
                for (int ks = 0; ks < 8; ++ks) sacc = __builtin_amdgcn_mfma_f32_16x16x32_bf16(frag(lds, O_K + (16 * st + l15) * (QP * 2) + (32 * ks + 8 * g4) * 2), frag(lds, O_Q + (16 * tt + l15) * (QP * 2) + (32 * ks + 8 * g4) * 2), sacc, 0, 0, 0);
                float w_[4];
#pragma unroll
                for (int j = 0; j < 4; ++j) { const int sj = 16 * st + 4 * g4 + j; w_[j] = sj <= t ? sacc[j] * __expf(sc[S_A + sj] - Gt_) : 0.f; }
                pk_.x = pk2(w_[0], w_[1]); pk_.y = pk2(w_[2], w_[3]); }
            *(u32x2*)(spo + 16 * st + 4 * g4) = pk_; }
        __syncthreads();
    }
}
DEVI void phase_mlstm(KP a, unsigned char* lds, const int tid, int G) {
    using namespace ml;
    unsigned char* ws = a->ws;
    const u16* z = (const u16*)(ws + WS_Z); u16* hbuf = (u16*)(ws + WS_HG);
    const u16* SPg = (const u16*)(ws + WS_SP); const float* MSC = (const float*)(ws + WS_MSC); const float* MDEC = (const float*)(ws + WS_MDEC);
    const int lane = tid & 63, wave = __builtin_amdgcn_readfirstlane(tid >> 6), g4 = lane >> 4, l15 = lane & 15;
    float* sc = (float*)(lds + O_SC);
    const unsigned lds32 = (unsigned)(uintptr_t)lds;
    const unsigned qkoff = (unsigned)((tid >> 5) * NPAD + (tid & 31) * 8) * 2u;
    const int qklds = (tid >> 5) * (QP * 2) + (tid & 31) * 16;
    const int vs_ = tid >> 3, v4 = (tid & 7) * 4;
    for (int unit0 = blockIdx.x; unit0 < 256; unit0 += G) {
        const int unit = (G % 8 == 0 && G >= 256) ? (((unit0 & 7) + 8 * (unit0 >> 7)) * 16 + ((unit0 >> 3) & 15)) : unit0;
        const int b = unit >> 6, h = (unit >> 4) & 3, jv = unit & 15, bh = b * 4 + h;
        const char* zq = (const char*)(z + (size_t)b * 4096 * NPAD + C_MQ + h * 256);
        const char* zk = (const char*)(z + (size_t)b * 4096 * NPAD + C_MK + h * 256);
        const char* zv = (const char*)(z + (size_t)b * 4096 * NPAD + C_MV + h * 512 + jv * 32);
        const char* spg = (const char*)(SPg + (size_t)bh * 64 * 4096);
        const float* msc = MSC + (size_t)bh * 4096 * 4;
        for (int i = tid; i < 48 * QP / 2; i += 512) ((unsigned*)(lds + O_CB))[i] = 0u;
        for (int i = tid; i < 16 * VP / 2; i += 512) { ((unsigned*)(lds + O_VT + 32 * VP * 2))[i] = i < VP / 2 ? 0x3f803f80u : 0u; ((unsigned*)(lds + O_VW + 32 * VP * 2))[i] = 0u; }
        f32x4 Cacc[2][3];
#pragma unroll
        for (int i = 0; i < 2; ++i)
#pragma unroll
            for (int j = 0; j < 3; ++j) Cacc[i][j] = (f32x4){0.f, 0.f, 0.f, 0.f};
        u32x4 pq[4], pk[4], psp; u32x2 pv; f32x4 pms = {0.f, 0.f, 0.f, 0.f}; float pdec = 0.f, pws = 0.f;
#pragma unroll
        for (int k = 0; k < 4; ++k) { pq[k] = *(const u32x4*)(zq + qkoff + (size_t)k * 16 * NPAD * 2); pk[k] = *(const u32x4*)(zk + qkoff + (size_t)k * 16 * NPAD * 2); }
        pv = *(const u32x2*)(zv + ((size_t)vs_ * NPAD + v4) * 2); pws = msc[(size_t)vs_ * 4 + 2];
        psp = *(const u32x4*)(spg + (size_t)tid * 16);
        if (wave == 0) { pms = *(const f32x4*)(msc + (size_t)lane * 4); pdec = MDEC[bh * 64]; }
        for (int c = 0; c < 64; ++c) {
#pragma unroll
            for (int k = 0; k < 4; ++k) { *(u32x4*)(lds + O_Q + qklds + k * 16 * QP * 2) = pq[k]; *(u32x4*)(lds + O_K + qklds + k * 16 * QP * 2) = pk[k]; }
            { u16* vt = (u16*)(lds + O_VT); u16* vw = (u16*)(lds + O_VW); const unsigned short e0 = (u16)(pv.x & 0xffffu), e1 = (u16)(pv.x >> 16), e2 = (u16)(pv.y & 0xffffu), e3 = (u16)(pv.y >> 16);
              vt[(v4 + 0) * VP + vs_] = e0; vt[(v4 + 1) * VP + vs_] = e1; vt[(v4 + 2) * VP + vs_] = e2; vt[(v4 + 3) * VP + vs_] = e3;
              vw[(v4 + 0) * VP + vs_] = (u16)f2bf(bf2f(e0) * pws); vw[(v4 + 1) * VP + vs_] = (u16)f2bf(bf2f(e1) * pws); vw[(v4 + 2) * VP + vs_] = (u16)f2bf(bf2f(e2) * pws); vw[(v4 + 3) * VP + vs_] = (u16)f2bf(bf2f(e3) * pws); }
            *(u32x4*)(lds + O_SP + (tid >> 3) * (VP * 2) + (tid & 7) * 16) = psp;
            if (wave == 0) { sc[S_WI + lane] = pms[0]; sc[S_EN + lane] = pms[1]; ((u16*)(lds + O_VW))[32 * VP + lane] = (u16)f2bf(pms[2]); if (lane == 0) sc[S_DEC] = pdec; }
            __syncthreads();
            { const int cn = c < 63 ? c + 1 : 63; const size_t ro = (size_t)cn * 64 * NPAD * 2;
#pragma unroll
              for (int k = 0; k < 4; ++k) { pq[k] = *(const u32x4*)(zq + ro + qkoff + (size_t)k * 16 * NPAD * 2); pk[k] = *(const u32x4*)(zk + ro + qkoff + (size_t)k * 16 * NPAD * 2); }
              pv = *(const u32x2*)(zv + ro + ((size_t)vs_ * NPAD + v4) * 2); pws = msc[(size_t)(cn * 64 + vs_) * 4 + 2];
              psp = *(const u32x4*)(spg + (size_t)cn * 8192 + (size_t)tid * 16);
              if (wave == 0) { pms = *(const f32x4*)(msc + (size_t)(cn * 64 + lane) * 4); pdec = MDEC[bh * 64 + cn]; } }
            const int tt1 = wave & 3, vt1 = wave >> 2;
            f32x4 inter1 = {0.f, 0.f, 0.f, 0.f}, inter2 = {0.f, 0.f, 0.f, 0.f};
#pragma unroll
            for (int ks = 0; ks < 8; ++ks) { const bf16x8 aq = frag(lds, O_Q + (16 * tt1 + l15) * (QP * 2) + (32 * ks + 8 * g4) * 2);
                inter1 = __builtin_amdgcn_mfma_f32_16x16x32_bf16(aq, frag(lds, O_CB + (16 * vt1 + l15) * (QP * 2) + (32 * ks + 8 * g4) * 2), inter1, 0, 0, 0);
                inter2 = __builtin_amdgcn_mfma_f32_16x16x32_bf16(aq, frag(lds, O_CB + (32 + l15) * (QP * 2) + (32 * ks + 8 * g4) * 2), inter2, 0, 0, 0); }
            f32x4 num1 = {0.f, 0.f, 0.f, 0.f}, num2 = {0.f, 0.f, 0.f, 0.f};
#pragma unroll
            for (int ks = 0; ks < 2; ++ks) { const bf16x8 ap = frag(lds, O_SP + (16 * tt1 + l15) * (VP * 2) + (32 * ks + 8 * g4) * 2);
                num1 = __builtin_amdgcn_mfma_f32_16x16x32_bf16(ap, frag(lds, O_VT + (16 * vt1 + l15) * (VP * 2) + (32 * ks + 8 * g4) * 2), num1, 0, 0, 0);
                num2 = __builtin_amdgcn_mfma_f32_16x16x32_bf16(ap, frag(lds, O_VT + (32 + l15) * (VP * 2) + (32 * ks + 8 * g4) * 2), num2, 0, 0, 0); }
            { const int row0 = b * 4096 + c * 64;
#pragma unroll
              for (int j = 0; j < 4; ++j) { const int tj = 16 * tt1 + 4 * g4 + j; const float wi = sc[S_WI + tj];
                  float d_ = num2[j] + wi * inter2[j];
                  d_ = __shfl(d_, lane & 48);
                  const float den = fmaxf(fabsf(d_), sc[S_EN + tj]);
                  const float hv = (num1[j] + wi * inter1[j]) / den;
                  const float hn = __int_as_float(__builtin_amdgcn_mov_dpp(__float_as_int(hv), 0xB1, 0xF, 0xF, true));
                  if ((l15 & 1) == 0) *(unsigned*)(hbuf + (size_t)(row0 + tj) * D_ + h * 512 + jv * 32 + 16 * vt1 + l15) = pk2(hv, hn); } }
            { const float decay = sc[S_DEC];
#pragma unroll
              for (int di = 0; di < 2; ++di) { const int dt = 2 * wave + di;
#pragma unroll
                  for (int vt = 0; vt < 3; ++vt) Cacc[di][vt] = Cacc[di][vt] * decay;
#pragma unroll
                  for (int ks = 0; ks < 2; ++ks) { const bf16x8 ak = frag_tr(lds32 + O_K + (32 * ks + 8 * g4 + (l15 >> 2)) * (QP * 2) + (16 * dt + 4 * (lane & 3)) * 2);
#pragma unroll
                      for (int vt = 0; vt < 3; ++vt) Cacc[di][vt] = __builtin_amdgcn_mfma_f32_16x16x32_bf16(ak, frag(lds, O_VW + (16 * vt + l15) * (VP * 2) + (32 * ks + 8 * g4) * 2), Cacc[di][vt], 0, 0, 0); }
              } }
            __syncthreads();
#pragma unroll
            for (int di = 0; di < 2; ++di) { const int dt = 2 * wave + di;
#pragma unroll
                for (int vt = 0; vt < 3; ++vt) { u32x2 w_; w_.x = pk2(Cacc[di][vt][0], Cacc[di][vt][1]); w_.y = pk2(Cacc[di][vt][2], Cacc[di][vt][3]);
                    *(u32x2*)(lds + O_CB + (16 * vt + l15) * (QP * 2) + (16 * dt + 4 * g4) * 2) = w_; } }
        }
        __syncthreads();
    }
}

DEVI void phase_cmp2(KP a, unsigned char* lds, int tid, int G, int l) {
    unsigned char* ws = a->ws;
    const float* U = (const float*)(ws + WS_U); u16* kcmp = (u16*)(ws + WS_KCMP);
    const float* cosT = (const float*)(ws + WS_ROPE); const float* sinT = cosT + 4096 * 64;
    const float* b1part = (const float*)(ws + WS_MISC + 1536 * 1024);
    constexpr int HP = 132;
    float* hs = (float*)lds;
    float* os = hs + 32 * HP;
    float* b1p = os + 32 * HP;
    const int sub = tid >> 7, f = tid & 127, lane = tid & 63, wv = tid >> 6, g4 = lane >> 4, l15 = lane & 15;
    __syncthreads();
    if (tid < 256) { const int which = tid >> 7; float s = a->in[which ? 11 : 6][l * 128 + f]; float p[64];
#pragma unroll
        for (int kc = 0; kc < 64; ++kc) p[kc] = b1part[((l * 2 + which) * 64 + kc) * 128 + f];
#pragma unroll
        for (int kc = 0; kc < 64; ++kc) s += p[kc];
        b1p[tid] = s; }
    __syncthreads();
    for (int unit = blockIdx.x; unit < 256; unit += G) {
        const int which = unit >> 7, rb = which * 4096 + (unit & 127) * 32;
        const float* w2 = a->in[which ? 12 : 7] + (size_t)l * 128 * 128; const float* b2 = a->in[which ? 13 : 8] + l * 128;
        float bw[8][4];
#pragma unroll
        for (int ks = 0; ks < 8; ++ks)
#pragma unroll
            for (int u = 0; u < 4; ++u) bw[ks][u] = w2[(16 * ks + 4 * g4 + u) * 128 + wv * 16 + l15];
        float ua[8], ub[8];
#pragma unroll
        for (int j = 0; j < 8; ++j) { const int r = rb + sub + 4 * j; const bool ok = (r & 255) < 255;
            ua[j] = ok ? U[(size_t)r * 256 + f] : 0.f; ub[j] = ok ? U[(size_t)(r + 1) * 256 + 128 + f] : 0.f; }
        const float b1v = b1p[which * 128 + f];
#pragma unroll
        for (int j = 0; j < 8; ++j) { const int r = rb + sub + 4 * j; float hp = 0.f;
            if ((r & 255) < 255) { hp = ua[j] + ub[j] + b1v;
                const float u_ = 0.7978845608028654f * (hp + 0.044715f * hp * hp * hp); const float th = 1.f - 2.f / (1.f + __expf(2.f * u_)); hp = 0.5f * hp * (1.f + th); }
            hs[(sub + 4 * j) * HP + f] = hp; }
        __syncthreads();
        { f32x4 acc0 = {0.f, 0.f, 0.f, 0.f}, acc1 = {0.f, 0.f, 0.f, 0.f};
#pragma unroll
          for (int ks = 0; ks < 8; ++ks) { const f32x4 a0 = *(const f32x4*)(hs + l15 * HP + 16 * ks + 4 * g4), a1 = *(const f32x4*)(hs + (16 + l15) * HP + 16 * ks + 4 * g4);
#pragma unroll
              for (int u = 0; u < 4; ++u) { acc0 = __builtin_amdgcn_mfma_f32_16x16x4f32(a0[u], bw[ks][u], acc0, 0, 0, 0); acc1 = __builtin_amdgcn_mfma_f32_16x16x4f32(a1[u], bw[ks][u], acc1, 0, 0, 0); } }
          const float bb = b2[wv * 16 + l15];
#pragma unroll
          for (int j = 0; j < 4; ++j) { os[(4 * g4 + j) * HP + wv * 16 + l15] = acc0[j] + bb; os[(16 + 4 * g4 + j) * HP + wv * 16 + l15] = acc1[j] + bb; } }
        __syncthreads();
        if (which == 0) { const int i = f >> 1; float cs[8], sn[8];
#pragma unroll
            for (int j = 0; j < 8; ++j) { const int r = rb + sub + 4 * j, n = r & 255, pos = 16 * n + 31; cs[j] = n < 255 ? cosT[pos * 64 + i] : 1.f; sn[j] = n < 255 ? sinT[pos * 64 + i] : 0.f; }
#pragma unroll
            for (int j = 0; j < 8; ++j) { const int lr = sub + 4 * j, r = rb + lr, n = r & 255; const float x1 = os[lr * HP + i], x2 = os[lr * HP + i + 64];
                float val = (f & 1) ? x2 * cs[j] + x1 * sn[j] : x1 * cs[j] - x2 * sn[j]; if (n == 255) val = 0.f;
                kcmp[(size_t)r * 128 + f] = (u16)f2bf(val); (ws + WS_KCMP8)[(size_t)r * 128 + f] = (unsigned char)(pk4_fp8(val, 0.f, 0.f, 0.f) & 0xffu); } }
        else {
#pragma unroll
            for (int j = 0; j < 8; ++j) { const int lr = sub + 4 * j, r = rb + lr, n = r & 255; float val = os[lr * HP + f]; if (n == 255) val = 0.f;
                kcmp[(size_t)r * 128 + f] = (u16)f2bf(val); } }
        __syncthreads();
    }
}
DEVI void phase_norm(KP a, int lane, int wave, int G, int l) {
    unsigned char* ws = a->ws;
    const u16* z = (const u16*)(ws + WS_Z); u16* hg = (u16*)(ws + WS_HG); const float* mw = a->in[3] + l * 2048;
    const int gw = blockIdx.x * 8 + wave, NGW = G * 8;
    f32x4 mwq[4][2];
#pragma unroll
    for (int h = 0; h < 4; ++h) { mwq[h][0] = *(const f32x4*)(mw + h * 512 + lane * 8); mwq[h][1] = *(const f32x4*)(mw + h * 512 + lane * 8 + 4); }
    for (int row = gw; row < M_; row += NGW) {
        u32x4 hv[4], ov[4];
#pragma unroll
        for (int h = 0; h < 4; ++h) { hv[h] = *(const u32x4*)(hg + (size_t)row * D_ + h * 512 + lane * 8); ov[h] = *(const u32x4*)(z + (size_t)row * NPAD + C_MO + h * 512 + lane * 8); }
#pragma unroll
        for (int h = 0; h < 4; ++h) {
            float v[8]; unpack8(hv[h], v);
            float s = 0.f;
#pragma unroll
            for (int j = 0; j < 8; ++j) s += v[j];
            const float mean = wsum(s) * (1.f / 512.f); float q = 0.f;
#pragma unroll
            for (int j = 0; j < 8; ++j) { v[j] -= mean; q += v[j] * v[j]; }
            const float rstd = 1.f / sqrtf(wsum(q) * (1.f / 512.f) + LN_EPS);
            float og[8]; unpack8(ov[h], og);
            const f32x4 w0 = mwq[h][0], w1 = mwq[h][1];
            const float wv[8] = {w0[0], w0[1], w0[2], w0[3], w1[0], w1[1], w1[2], w1[3]};
            float o[8];
#pragma unroll
            for (int j = 0; j < 8; ++j) o[j] = v[j] * rstd * wv[j] * sigm(og[j]);
            u32x2 w8; w8.x = pk4_fp8(o[0] * 2.f, o[1] * 2.f, o[2] * 2.f, o[3] * 2.f); w8.y = pk4_fp8(o[4] * 2.f, o[5] * 2.f, o[6] * 2.f, o[7] * 2.f);
            *(u32x2*)(ws + WS_XBF + (size_t)row * D_ + h * 512 + lane * 8) = w8; }
    }
}

#ifndef GQ_CV
#define GQ_CV true
#endif
#ifndef GQ_CI
#define GQ_CI true
#endif
#ifndef GQ_W
#define GQ_W true
#endif
#ifndef GQ_S
#define GQ_S false
#endif
namespace att {
constexpr int NW = 8, QBLK = 32, KVBLK = 64, QB = 256, D = 128, WIN = 512;
constexpr int SHM_V = KVBLK * D * 2, SHM_K = KVBLK * D * 2;
constexpr float SCALE = 0.08838834764831845f, THR = 8.f;
typedef short s16x4 __attribute__((ext_vector_type(4)));
typedef float f32x16 __attribute__((ext_vector_type(16)));
enum { M_WIN = 0, M_SEL = 1, M_CMP = 2 };
enum { E_GATED = 0, E_IMP = 1, E_FINAL = 2 };
#define KSWZ8(row, colB) ((row) * 128 + ((colB) ^ (((row) & 7) << 4)))
#define SBAR() __builtin_amdgcn_sched_barrier(0)
DEVI int v_st(int k, int c) { const int kk = (k & ~0xC) | ((k & 4) << 1) | ((k & 8) >> 1); return ((kk >> 3) * 4 + (c >> 5)) * 512 + ((kk & 7) * 32 + (c & 31)) * 2; }
DEVI int v_rd_base(int lane) { return ((lane & 3) << 3) | (((lane >> 2) & 3) << 6) | (((lane >> 4) & 1) << 5) | (((lane >> 5) & 1) << 8); }
constexpr int v_rd_off(int d0, int ks, int half) { return d0 * 512 + ks * 4096 + half * 2048; }
DEVI int crow(int r, int hi) { return (r & 3) + 8 * (r >> 2) + 4 * hi; }
DEVI unsigned cvtpk(float lo, float hi) { unsigned r; asm volatile("v_cvt_pk_bf16_f32 %0, %1, %2" : "=v"(r) : "v"(lo), "v"(hi)); return r; }
DEVI bf16x8 load8(const u16* p) { return *reinterpret_cast<const bf16x8*>(p); }
DEVI int nvis(int pos) { return pos >= 31 ? ((pos - 31) >> 4) + 1 : 0; }
DEVI void mask_tile(f32x16& p0, f32x16& p1, int dq, unsigned W) {
    const float NEG = -__builtin_inff();
#pragma unroll
    for (int r = 0; r < 16; ++r) { const int c = (r & 3) + 8 * (r >> 2);
        if ((unsigned)(dq - c) >= W) p0[r] = NEG;
        if ((unsigned)(dq - c - 32) >= W) p1[r] = NEG; }
}
DEVI void mask_cmp(f32x16& p0, f32x16& p1, int lim) {
    const float NEG = -__builtin_inff();
#pragma unroll
    for (int r = 0; r < 16; ++r) { const int c = (r & 3) + 8 * (r >> 2);
        if (c >= lim) p0[r] = NEG;
        if (c + 32 >= lim) p1[r] = NEG; }
}
DEVI void mask_all(f32x16& p0, f32x16& p1, bool kill) {
    const float NEG = -__builtin_inff();
#pragma unroll
    for (int r = 0; r < 16; ++r) { if (kill) p0[r] = NEG; if (kill) p1[r] = NEG; }
}
DEVI void partialSM(f32x16& p0, f32x16& p1, float& m_reg, float& mn, float& alpha, const bool kill = false) {
    float pmax = p0[0];
#pragma unroll
    for (int r = 1; r < 16; ++r) pmax = fmaxf(pmax, p0[r]);
#pragma unroll
    for (int r = 0; r < 16; ++r) pmax = fmaxf(pmax, p1[r]);
    { auto rr = __builtin_amdgcn_permlane32_swap(__float_as_uint(pmax), __float_as_uint(pmax), false, false);
      pmax = fmaxf(__uint_as_float(rr[0]), __uint_as_float(rr[1])); }
    if (kill) pmax = -__builtin_inff();
    constexpr float C2 = 1.4426950408889634f * SCALE;
    if (__builtin_expect(__all((pmax - m_reg) * SCALE <= THR), 1)) { mn = m_reg; alpha = 1.f; }
    else { mn = fmaxf(m_reg, pmax); alpha = __builtin_amdgcn_exp2f((m_reg - mn) * C2); m_reg = mn; }
    const float mnL = kill ? -__builtin_inff() : -mn * C2;
#pragma unroll
    for (int r = 0; r < 16; ++r) p0[r] = fmaf(p0[r], C2, mnL);
#pragma unroll
    for (int r = 0; r < 16; ++r) p1[r] = fmaf(p1[r], C2, mnL);
#pragma unroll
    for (int r = 0; r < 16; ++r) p0[r] = __builtin_amdgcn_exp2f(p0[r]);
}
DEVI void finishSM(f32x16& p0, f32x16& p1, float alpha, float& l_reg, bf16x8& pa0, bf16x8& pa1, bf16x8& pa2, bf16x8& pa3) {
#pragma unroll
    for (int r = 0; r < 16; ++r) p1[r] = __builtin_amdgcn_exp2f(p1[r]);
    float ps = 0;
#pragma unroll
    for (int r = 0; r < 16; ++r) ps += p0[r];
#pragma unroll
    for (int r = 0; r < 16; ++r) ps += p1[r];
    { auto rr = __builtin_amdgcn_permlane32_swap(__float_as_uint(ps), __float_as_uint(ps), false, false);
      ps = __uint_as_float(rr[0]) + __uint_as_float(rr[1]); }
    l_reg = l_reg * alpha + ps;
#define PK4(P, B_, OUT) do { unsigned a0 = cvtpk(P[B_+0], P[B_+1]), a1 = cvtpk(P[B_+2], P[B_+3]);                          \
        unsigned b0 = cvtpk(P[B_+4], P[B_+5]), b1 = cvtpk(P[B_+6], P[B_+7]);                                             \
        auto r0 = __builtin_amdgcn_permlane32_swap(a0, b0, false, false); auto r1 = __builtin_amdgcn_permlane32_swap(a1, b1, false, false); \
        u32x4 w = {r0[0], r1[0], r0[1], r1[1]}; OUT = *reinterpret_cast<bf16x8*>(&w); } while (0)
    PK4(p0, 0, pa0); PK4(p0, 8, pa1); PK4(p1, 0, pa2); PK4(p1, 8, pa3);
#undef PK4
}
template <int KB, bool SK>
DEVI void qkt(f32x16& p0, f32x16& p1, const char* K_lds, int r32, int hi, const pg8::i32x8_* q8, bool act) {
    if (SK && !act) { const float NEG = -__builtin_inff();
#pragma unroll
        for (int r = 0; r < 16; ++r) { p0[r] = NEG; p1[r] = NEG; } return; }
    const char* kb = K_lds + KB * SHM_K;
    const int one = 0x7f7f7f7f;
    typedef int i4 __attribute__((ext_vector_type(4)));
    { const pg8::i32x8_ a00 = __builtin_shufflevector(*(const i4*)(kb + KSWZ8(r32, 32 * hi)), *(const i4*)(kb + KSWZ8(r32, 32 * hi + 16)), 0, 1, 2, 3, 4, 5, 6, 7);
      const pg8::i32x8_ a10 = __builtin_shufflevector(*(const i4*)(kb + 4096 + KSWZ8(r32, 32 * hi)), *(const i4*)(kb + 4096 + KSWZ8(r32, 32 * hi + 16)), 0, 1, 2, 3, 4, 5, 6, 7);
      asm volatile("s_waitcnt lgkmcnt(0)\n\tv_mfma_scale_f32_32x32x64_f8f6f4 %0, %2, %4, 0, %5, %5 op_sel_hi:[0,0,0]\n\tv_mfma_scale_f32_32x32x64_f8f6f4 %1, %3, %4, 0, %5, %5 op_sel_hi:[0,0,0]"
                   : "=&v"(p0), "=&v"(p1) : "v"(a00), "v"(a10), "v"(q8[0]), "v"(one) : "memory"); }
    { const pg8::i32x8_ a01 = __builtin_shufflevector(*(const i4*)(kb + KSWZ8(r32, 64 + 32 * hi)), *(const i4*)(kb + KSWZ8(r32, 64 + 32 * hi + 16)), 0, 1, 2, 3, 4, 5, 6, 7);
      const pg8::i32x8_ a11 = __builtin_shufflevector(*(const i4*)(kb + 4096 + KSWZ8(r32, 64 + 32 * hi)), *(const i4*)(kb + 4096 + KSWZ8(r32, 64 + 32 * hi + 16)), 0, 1, 2, 3, 4, 5, 6, 7);
      asm volatile("s_waitcnt lgkmcnt(0)\n\tv_mfma_scale_f32_32x32x64_f8f6f4 %0, %2, %4, %0, %5, %5 op_sel_hi:[0,0,0]\n\tv_mfma_scale_f32_32x32x64_f8f6f4 %1, %3, %4, %1, %5, %5 op_sel_hi:[0,0,0]\n\ts_nop 15\n\ts_nop 15\n\ts_nop 15\n\ts_nop 15"
                   : "+v"(p0), "+v"(p1) : "v"(a01), "v"(a11), "v"(q8[1]), "v"(one) : "memory"); }
}
template <int VB, bool SK>
DEVI void pv_tile(f32x16* o, int vb0, bf16x8 pa0, bf16x8 pa1, bf16x8 pa2, bf16x8 pa3, bool act) {
    if (SK && !act) return;
#define TRRD(dst, off) asm volatile("ds_read_b64_tr_b16 %0, %1 offset:%2" : "=&v"(dst) : "v"(vb0), "i"(off) : "memory")
#define PV_D0(d0) do { s16x4 l0, l1, l2, l3, h0, h1, h2, h3; constexpr int b_ = VB * SHM_V + v_rd_off(d0, 0, 0); \
        TRRD(l0, b_); TRRD(h0, b_ + 2048); TRRD(l1, b_ + 4096); TRRD(h1, b_ + 6144); TRRD(l2, b_ + 8192); TRRD(h2, b_ + 10240); TRRD(l3, b_ + 12288); TRRD(h3, b_ + 14336); \
        asm volatile("s_waitcnt lgkmcnt(0)" ::: "memory"); SBAR();   \
        o[d0] = __builtin_amdgcn_mfma_f32_32x32x16_bf16(pa0, (bf16x8){l0[0], l0[1], l0[2], l0[3], h0[0], h0[1], h0[2], h0[3]}, o[d0], 0, 0, 0);   \
        o[d0] = __builtin_amdgcn_mfma_f32_32x32x16_bf16(pa1, (bf16x8){l1[0], l1[1], l1[2], l1[3], h1[0], h1[1], h1[2], h1[3]}, o[d0], 0, 0, 0);   \
        o[d0] = __builtin_amdgcn_mfma_f32_32x32x16_bf16(pa2, (bf16x8){l2[0], l2[1], l2[2], l2[3], h2[0], h2[1], h2[2], h2[3]}, o[d0], 0, 0, 0);   \
        o[d0] = __builtin_amdgcn_mfma_f32_32x32x16_bf16(pa3, (bf16x8){l3[0], l3[1], l3[2], l3[3], h3[0], h3[1], h3[2], h3[3]}, o[d0], 0, 0, 0); } while (0)
    PV_D0(0); PV_D0(1); PV_D0(2); PV_D0(3);
#undef PV_D0
#undef TRRD
}
struct ABlock { const unsigned char* Q; const unsigned char* K; const u16* V; int P0, row0, b, head; };
struct Seam { pg8::i32x8_ q8[2]; u32x4 st_k; bf16x8 st_v0, st_v1; };
struct Epi { const float* gates; u16* dst; const u16* oc; const u16* ow; float* imp; const unsigned long long* sel; };
template <int MODE> DEVI int jlo(int P0) { if (MODE == M_WIN) { const int lowk = P0 - WIN + 1; return lowk > 0 ? lowk / KVBLK : 0; } return 0; }
template <int MODE, int QBE = QB> DEVI int jhi(int P0) {
    if (MODE == M_CMP) { const int n = (nvis(P0 + QBE - 1) + KVBLK - 1) / KVBLK; return n < 1 ? 1 : n; }
    return (P0 + QBE - 1) / KVBLK + 1; }
#define ROWB(p, k0) ((const char*)((p) + (size_t)(k0) * LDK))
#define VMW() asm volatile("s_waitcnt vmcnt(0)" ::: "memory")
#define VMWN(n) asm volatile("s_waitcnt vmcnt(%0)" :: "i"(n) : "memory")
#define SLOAD_H(Kp, Vp, k0) do { const char* vb_ = ROWB(Vp, k0); const char* kb__ = (const char*)(Kp) + (size_t)(k0) * LDK8;                     \
                         S.st_v0 = load8((const u16*)(vb_ + voff0)); S.st_v1 = load8((const u16*)(vb_ + voff1));              \
                         S.st_k = *(const u32x4*)(kb__ + koff8); } while (0)
#define SWRITE_HK(bf) do { *(u32x4*)(K_lds + (bf) * SHM_K + kws) = S.st_k; } while (0)
#define SWRITE_HV(bf) do { *(bf16x8*)(V_lds + (bf) * SHM_V + vst0) = S.st_v0; *(bf16x8*)(V_lds + (bf) * SHM_V + vst1) = S.st_v1; } while (0)
#define SWRITE_H(bf) do { SWRITE_HV(bf); SWRITE_HK(bf); } while (0)
template <int MODE, int LDK, int LDK8, bool GQ = false>
DEVI void prime(const ABlock& cur, char* lds, Seam& S, const int tid) {
    const int wid = __builtin_amdgcn_readfirstlane(tid >> 6), lane = tid & 63, r32 = lane & 31, hi = lane >> 5;
    const int sr = tid >> 4, sc = (tid & 15) * 8, kws = KSWZ8(tid >> 3, (tid & 7) * 16); char* K_lds = lds + 2 * SHM_V;
    const unsigned voff0 = (unsigned)(sr * LDK + sc) * 2u, voff1 = (unsigned)((32 + sr) * LDK + sc) * 2u, koff8 = (unsigned)((tid >> 3) * LDK8 + (tid & 7) * 16);
    const unsigned qoff = GQ ? (unsigned)(((wid & 1) * QBLK + r32) * 3072 + (wid >> 1) * 128 + hi * 32) : (unsigned)((wid * QBLK + r32) * 3072 + hi * 32);
    const int kb0 = jlo<MODE>(cur.P0) * KVBLK;
    { typedef int i4 __attribute__((ext_vector_type(4)));
#pragma unroll
      for (int s_ = 0; s_ < 2; ++s_) S.q8[s_] = __builtin_shufflevector(*(const i4*)(cur.Q + qoff + 64 * s_), *(const i4*)(cur.Q + qoff + 64 * s_ + 16), 0, 1, 2, 3, 4, 5, 6, 7); }
    SLOAD_H(cur.K, cur.V, kb0); VMW(); SWRITE_HK(0);
    __syncthreads();
}
template <int MODE, int EPI, int GK, int LDK, int LDK8, bool SK, bool GQ = false>
DEVI void block(const ABlock& cur, const ABlock& nxt, char* lds, Seam& S, const Epi& E, const int tid) {
    const int wid = __builtin_amdgcn_readfirstlane(tid >> 6), lane = tid & 63, r32 = lane & 31, hi = lane >> 5;
    const int wrow = GQ ? (wid & 1) * QBLK : wid * QBLK, whead = GQ ? cur.head + (wid >> 1) : cur.head;
    const int j_lo = jlo<MODE>(cur.P0), j_hi = jhi<MODE, GQ ? 64 : QB>(cur.P0);
    const int NT = j_hi - j_lo;
    const int kbn = jlo<MODE>(nxt.P0) * KVBLK;
    const int qlo = cur.P0 + wrow, qm = qlo + r32 - 4 * hi;
    char* V_lds = lds; char* K_lds = lds + 2 * SHM_V;
    float* wsl = (float*)(lds + 2 * SHM_V + 2 * SHM_K) + wid * 64; float* li_l = wsl, * al_l = wsl + 32;
    float m_reg = -1e30f, l_reg = 0; f32x16 o[4] = {};
    const int sr = tid >> 4, sc = (tid & 15) * 8, vst0 = v_st(sr, sc), vst1 = v_st(32 + sr, sc), kws = KSWZ8(tid >> 3, (tid & 7) * 16);
    const unsigned voff0 = (unsigned)(sr * LDK + sc) * 2u, voff1 = (unsigned)((32 + sr) * LDK + sc) * 2u, koff8 = (unsigned)((tid >> 3) * LDK8 + (tid & 7) * 16);
    const unsigned qoff = GQ ? (unsigned)(((wid & 1) * QBLK + r32) * 3072 + (wid >> 1) * 128 + hi * 32) : (unsigned)((wid * QBLK + r32) * 3072 + hi * 32);
    const int vb0 = (int)(uintptr_t)V_lds + v_rd_base(lane);
    const unsigned char* Kh = cur.K; const u16* Vh = cur.V;
    unsigned sello = 0u, selhi = 0u; int nvl = 0;
    if (MODE == M_SEL) { const unsigned long long sw = E.sel[(size_t)(cur.b * 4 + (cur.head >> 2)) * 4096 + qlo + r32]; sello = (unsigned)sw; selhi = (unsigned)(sw >> 32); }
    if (MODE == M_CMP) nvl = nvis(qlo + r32) - 4 * hi;
#define RESC(a) do { if (__any((a) < 1.f)) { if (hi == 0) al_l[r32] = (a); asm volatile("s_waitcnt lgkmcnt(0)" ::: "memory");              \
                     for (int d_ = 0; d_ < 4; ++d_) for (int r = 0; r < 16; ++r) o[d_][r] *= al_l[crow(r, hi)]; } } while (0)
#define KBASE(t) ((j_lo + (t)) * KVBLK)
#define ACT(t) (MODE == M_WIN ? (KBASE(t) <= qlo + QBLK - 1 && KBASE(t) + KVBLK - 1 >= qlo - WIN + 1) : MODE == M_SEL ? (KBASE(t) <= qlo + QBLK - 1) : (KBASE(t) < nvis(qlo + QBLK - 1)))
#define MASKT(P0_, P1_, t) do { const int kb_ = KBASE(t); if (!SK || ACT(t)) {                                                             \
        if (MODE == M_WIN) { if (kb_ + KVBLK - 1 > qlo || kb_ <= qlo + QBLK - 1 - WIN) mask_tile(P0_, P1_, qm - kb_, (unsigned)WIN); }       \
        else if (MODE == M_SEL) { if (kb_ + KVBLK - 1 > qlo) mask_tile(P0_, P1_, qm - kb_, 0x40000000u);                                    \
            const int jt_ = j_lo + (t); const unsigned w_ = (jt_ & 32) ? selhi : sello; killf = ((w_ >> (jt_ & 31)) & 1u) == 0u; } \
        else { mask_cmp(P0_, P1_, nvl - kb_); } } } while (0)
    constexpr int NQL = 4;
#define SEAM_K0() do { VMWN(NQL); SWRITE_HK(0); SBAR(); } while (0)
    f32x16 pA0, pA1, pB0, pB1; float mnA, mnB, alA, alB; bf16x8 pa0, pa1, pa2, pa3; bool killf = false;
    SWRITE_HV(0); SBAR();
    if (NT > 1) { SLOAD_H(Kh, Vh, KBASE(1)); }
    SBAR(); qkt<0, SK>(pA0, pA1, K_lds, r32, hi, S.q8, ACT(0));
    MASKT(pA0, pA1, 0); partialSM(pA0, pA1, m_reg, mnA, alA, MODE == M_SEL && killf);
    if (NT > 1) { VMW(); SWRITE_H(1); }
    __syncthreads();
#define HALF_STEP(PX0, PX1, mnX, alX, PY0, PY1, alY, t, KB, VB, SB) do {                                                      \
        SBAR(); qkt<KB, SK>(PX0, PX1, K_lds, r32, hi, S.q8, ACT(t));                                             \
        finishSM(PY0, PY1, alY, l_reg, pa0, pa1, pa2, pa3); SBAR();                                                           \
        if ((t) + 1 < NT) { SLOAD_H(Kh, Vh, KBASE((t) + 1)); SBAR(); }                                               \
        pv_tile<VB, SK>(o, vb0, pa0, pa1, pa2, pa3, ACT((t) - 1)); MASKT(PX0, PX1, (t)); partialSM(PX0, PX1, m_reg, mnX, alX, MODE == M_SEL && killf);                                        \
        __syncthreads();                                                                                                      \
        if ((t) + 1 < NT) { VMW(); SWRITE_H(SB); }                                                                          \
        RESC(alX); __syncthreads(); } while (0)
    for (int t = 1; t + 1 < NT; t += 2) {
        HALF_STEP(pB0, pB1, mnB, alB, pA0, pA1, alA, t, 1, 0, 0);
        HALF_STEP(pA0, pA1, mnA, alA, pB0, pB1, alB, t + 1, 0, 1, 1);
    }
    const bool even = (NT & 1) == 0;
    if (even) { SBAR(); qkt<1, SK>(pB0, pB1, K_lds, r32, hi, S.q8, ACT(NT - 1)); SBAR(); }
    { const unsigned char* nK = nxt.K; const u16* nV = nxt.V; SLOAD_H(nK, nV, kbn); SBAR();
      typedef int i4 __attribute__((ext_vector_type(4)));
#pragma unroll
      for (int s_ = 0; s_ < 2; ++s_) S.q8[s_] = __builtin_shufflevector(*(const i4*)(nxt.Q + qoff + 64 * s_), *(const i4*)(nxt.Q + qoff + 64 * s_ + 16), 0, 1, 2, 3, 4, 5, 6, 7); }
    SBAR();
    finishSM(pA0, pA1, alA, l_reg, pa0, pa1, pa2, pa3); SBAR();
    pv_tile<0, SK>(o, vb0, pa0, pa1, pa2, pa3, ACT(even ? NT - 2 : NT - 1));
    if (even) { MASKT(pB0, pB1, NT - 1); partialSM(pB0, pB1, m_reg, mnB, alB, MODE == M_SEL && killf); __syncthreads(); RESC(alB);
        finishSM(pB0, pB1, alB, l_reg, pa0, pa1, pa2, pa3); SBAR(); pv_tile<1, SK>(o, vb0, pa0, pa1, pa2, pa3, ACT(NT - 1)); }
    SBAR(); SEAM_K0();
    if (hi == 0) { li_l[r32] = l_reg; if (EPI != E_IMP && GK >= 0) al_l[r32] = sigm(E.gates[(size_t)(cur.row0 + wrow + r32) * 64 + 8 + whead * 3 + (GK < 0 ? 0 : GK)]); }
    asm volatile("s_waitcnt lgkmcnt(0)" ::: "memory");
    float rli[16];
#pragma unroll
    for (int r = 0; r < 16; ++r) { const float l_ = li_l[crow(r, hi)]; rli[r] = l_ > 0.f ? __builtin_amdgcn_rcpf(l_) : 0.f; if (EPI != E_IMP && GK >= 0) rli[r] *= al_l[crow(r, hi)]; }
    const size_t ebase = ((size_t)cur.row0 * D_ + whead * 128) * 2;
    const unsigned elane = (unsigned)((wrow + 4 * hi) * D_ + r32) * 2u;
    float* impb = E.imp + ((size_t)(cur.b * 16 + whead) * 4096 + cur.P0) * 64;
    const unsigned ilane = (unsigned)((wrow + 4 * hi) * 64 + r32) * 4u;
    const size_t frb = ((((size_t)(cur.b * 16 + whead) * 128 + ((cur.P0 + wrow) >> 5)) * 64 + lane) * 64) * 2;
    LAS char* otr = (LAS char*)lds + 73728 + wid * 4608;
    if (EPI == E_GATED) {
#pragma unroll
        for (int i = 0; i < 8; ++i) { const int r0 = 2 * i, r1 = 2 * i + 1; u32x4 w;
            w.x = cvtpk(o[0][r0] * rli[r0], o[1][r0] * rli[r0]); w.y = cvtpk(o[2][r0] * rli[r0], o[3][r0] * rli[r0]);
            w.z = cvtpk(o[0][r1] * rli[r1], o[1][r1] * rli[r1]); w.w = cvtpk(o[2][r1] * rli[r1], o[3][r1] * rli[r1]);
            *(u32x4*)((char*)E.dst + frb + i * 16) = w; }
    } else if (EPI == E_FINAL) {
#pragma unroll
        for (int hq = 0; hq < 2; ++hq) {
            u32x4 cq[4], wq[4];
#pragma unroll
            for (int i = 0; i < 4; ++i) { cq[i] = *(const u32x4*)((const char*)E.oc + frb + (hq * 4 + i) * 16); wq[i] = *(const u32x4*)((const char*)E.ow + frb + (hq * 4 + i) * 16); }
#pragma unroll
            for (int rq = 0; rq < 8; ++rq) { const int r = hq * 8 + rq; const int cr = (r & 3) + 8 * (r >> 2);
#pragma unroll
                for (int d0 = 0; d0 < 4; ++d0) { const float v = o[d0][r] * rli[r];
                    const unsigned cw = cq[rq >> 1][(rq & 1) * 2 + (d0 >> 1)], ww = wq[rq >> 1][(rq & 1) * 2 + (d0 >> 1)];
                    const float cv = __uint_as_float((d0 & 1) ? (cw & 0xffff0000u) : (cw << 16)), wv = __uint_as_float((d0 & 1) ? (ww & 0xffff0000u) : (ww << 16));
                    const float f = (v + cv + wv) * 8.f;
                    const float f1 = __int_as_float(__builtin_amdgcn_mov_dpp(__float_as_int(f), 0x55, 0xF, 0xF, true)), f2 = __int_as_float(__builtin_amdgcn_mov_dpp(__float_as_int(f), 0xAA, 0xF, 0xF, true)),
                                f3 = __int_as_float(__builtin_amdgcn_mov_dpp(__float_as_int(f), 0xFF, 0xF, 0xF, true));
                    if ((r32 & 3) == 0) *(LAS unsigned*)(otr + (cr + 4 * hi) * 144 + d0 * 32 + r32) = pk4_fp8(f, f1, f2, f3); } } }
        asm volatile("s_waitcnt lgkmcnt(0)" ::: "memory");
        { const int rl = lane >> 1, hf = lane & 1; char* drow = (char*)E.dst + (ebase >> 1) + (size_t)(wrow + rl) * D_ + hf * 64;
#pragma unroll
          for (int i = 0; i < 4; ++i) *(u32x4*)(drow + i * 16) = *(const LAS u32x4*)(otr + rl * 144 + hf * 64 + i * 16); }
    } else {
#pragma unroll
        for (int r = 0; r < 16; ++r) { const int cr = (r & 3) + 8 * (r >> 2);
#pragma unroll
            for (int d0 = 0; d0 < 2; ++d0) *(float*)((char*)impb + ilane + (unsigned)(cr * 64 + d0 * 32) * 4u) = o[d0][r] * rli[r]; }
    }
    __syncthreads();
#undef RESC
#undef KBASE
#undef ACT
#undef MASKT
#undef SEAM_K0
#undef HALF_STEP
}
#undef ROWB
#undef VMW
#undef VMWN
#undef SLOAD_H
#undef SWRITE_HK
#undef SWRITE_HV
#undef SWRITE_H
struct Item { int b, head, qb0, qb1; };
template <bool PAIRED> DEVI Item decode(int L) {
    Item it; const int xcd = L & 7, k = L >> 3;
    if (PAIRED) { const int gi = k >> 5, r = k & 31, hl = r >> 3, x = r & 7; const int bg = gi * 8 + xcd; it.b = bg >> 2; it.head = (bg & 3) * 4 + hl; it.qb0 = x; it.qb1 = 15 - x; }
    else { const int gi = k >> 6, r = k & 63, hl = r >> 4, x = r & 15; const int bg = gi * 8 + xcd; it.b = bg >> 2; it.head = (bg & 3) * 4 + hl; it.qb0 = it.qb1 = (hl & 2) ? x : 15 - x; }
    return it;
}
template <bool PAIRED> DEVI Item decode_gq(int L) {
    Item it; const int xcd = L & 7, k = L >> 3;
    if (PAIRED) { const int gi = k >> 5, x = k & 31, bg = gi * 8 + xcd; it.b = bg >> 2; it.head = (bg & 3) * 4; it.qb0 = x; it.qb1 = 63 - x; }
    else { const int gi = k >> 6, x = k & 63, bg = gi * 8 + xcd; it.b = bg >> 2; it.head = (bg & 3) * 4; it.qb0 = it.qb1 = (x & 32) ? 63 - (x & 31) : (x & 31); }
    return it;
}
template <int MODE, bool GQ = false> DEVI ABlock mkref(const Item& it, int pass, const u16* z, const unsigned char* z8, const unsigned char* kcmp8, const u16* vcmp) {
    const int qb = pass ? it.qb1 : it.qb0; ABlock r; r.b = it.b; r.head = it.head; r.P0 = qb * (GQ ? 64 : QB); r.row0 = it.b * 4096 + r.P0;
    r.Q = z8 + (size_t)r.row0 * 3072 + it.head * 128;
    const int g = it.head >> 2;
    if (MODE == M_WIN) { r.K = z8 + (size_t)it.b * 4096 * 3072 + 2560 + g * 128; r.V = z + (size_t)it.b * 4096 * NPAD + C_VW + g * 128; }
    else if (MODE == M_SEL) { r.K = z8 + (size_t)it.b * 4096 * 3072 + 2048 + g * 128; r.V = z + (size_t)it.b * 4096 * NPAD + C_VS + g * 128; }
    else { r.K = kcmp8 + (size_t)(it.b * 4 + g) * 256 * 128; r.V = vcmp; }
    return r;
}
template <int MODE, int EPI, int GK, int LDK, int LDK8, bool SK, bool PAIRED, bool GQ = false>
DEVI void run_pass(const u16* z, const unsigned char* z8, const unsigned char* kcmp8, const u16* vcmp, size_t vcmp_stride, char* lds, const Epi& E, const int tid_in, int G) {
    int tz_ = tid_in; asm volatile("" : "+v"(tz_)); const int tid = tz_;
    constexpr int total = PAIRED ? 512 : 1024;
    int L = blockIdx.x; if (L >= total) return;
    Item it = GQ ? decode_gq<PAIRED>(L) : decode<PAIRED>(L); int pass = 0;
    ABlock cur = mkref<MODE, GQ>(it, 0, z, z8, kcmp8, vcmp + (size_t)(it.b * 4 + (it.head >> 2)) * vcmp_stride);
    Seam S;
    prime<MODE, LDK, LDK8, GQ>(cur, lds, S, tid);
    for (;;) {
        const bool more_pass = pass == 0 && it.qb1 != it.qb0, more_item = L + G < total, last = !more_pass && !more_item;
        Item itn = it; int passn = pass + 1, Ln = L;
        if (!more_pass) { passn = 0; Ln = more_item ? L + G : L; itn = GQ ? decode_gq<PAIRED>(Ln) : decode<PAIRED>(Ln); }
        const ABlock nxt = last ? cur : mkref<MODE, GQ>(itn, passn, z, z8, kcmp8, vcmp + (size_t)(itn.b * 4 + (itn.head >> 2)) * vcmp_stride);
        block<MODE, EPI, GK, LDK, LDK8, SK, GQ>(cur, nxt, lds, S, E, tid);
        if (last) break;
        cur = nxt; it = itn; pass = passn; L = Ln;
    }
}
}

DEVI void phase_nsa1(KP a, unsigned char* lds, const int tid, int G) {
    unsigned char* ws = a->ws;
    const u16* z = (const u16*)(ws + WS_Z); const u16* kcmp = (const u16*)(ws + WS_KCMP); const u16* vcmp = kcmp + (size_t)16 * 256 * 128;
    att::Epi E{(const float*)(ws + WS_GATES), (u16*)(ws + WS_OC), nullptr, nullptr, (float*)(ws + WS_IMP), nullptr};
#ifndef NSA1_PASSES
#define NSA1_PASSES 7
#endif
#ifndef WIN_SK
#define WIN_SK false
#endif
    const unsigned char* z8 = ws + WS_Z8; const unsigned char* kcmp8 = ws + WS_KCMP8;
    if (NSA1_PASSES & 1) att::run_pass<att::M_CMP, att::E_GATED, 0, 128, 128, false, false, GQ_CV>(z, z8, kcmp8, vcmp, (size_t)256 * 128, (char*)lds, E, tid, G);
    __syncthreads();
    if (NSA1_PASSES & 2) att::run_pass<att::M_CMP, att::E_IMP, 0, 128, 128, false, false, GQ_CI>(z, z8, kcmp8, (const u16*)(ws + WS_OVL), 0, (char*)lds, E, tid, G);
    __syncthreads();
    E.dst = (u16*)(ws + WS_OW);
    if (NSA1_PASSES & 4) att::run_pass<att::M_WIN, att::E_GATED, 2, NPAD, 3072, WIN_SK, false, GQ_W>(z, z8, kcmp8, nullptr, 0, (char*)lds, E, tid, G);
}
DEVI void phase_topk(KP a, int lane, int wave, int G) {
    unsigned char* ws = a->ws; const float* imp = (const float*)(ws + WS_IMP); unsigned long long* sel = (unsigned long long*)(ws + WS_SEL);
    const int gw = blockIdx.x * 8 + wave, NGW = G * 8;
    float pf0[4], pf1[4];
    { const int task = gw * 2; if (task < M_ * 4) { const int bg = task >> 12, t = task & 4095, b = bg >> 2, g = bg & 3;
#pragma unroll
        for (int h = 0; h < 4; ++h) { const float* p = imp + ((size_t)(b * 16 + g * 4 + h) * 4096 + t) * 64 + lane; pf0[h] = p[0]; pf1[h] = p[64]; } } }
    for (int task = gw * 2; task < M_ * 4; task += NGW * 2) { const int bg = task >> 12, t = task & 4095;
        const float v0 = (pf0[0] + pf0[1]) + (pf0[2] + pf0[3]), v1 = (pf1[0] + pf1[1]) + (pf1[2] + pf1[3]);
        { const int tn = task + NGW * 2; if (tn < M_ * 4) { const int bgn = tn >> 12, t2 = tn & 4095, b = bgn >> 2, g = bgn & 3;
#pragma unroll
            for (int h = 0; h < 4; ++h) { const float* p = imp + ((size_t)(b * 16 + g * 4 + h) * 4096 + t2) * 64 + lane; pf0[h] = p[0]; pf1[h] = p[64]; } } }
        const int cur0 = t >> 6, cur1 = (t + 1) >> 6;
        const float s0 = ((lane == 0) || (lane == cur0) || (lane == cur0 - 1)) ? INFINITY : (lane <= cur0 ? v0 : -INFINITY);
        const float s1 = ((lane == 0) || (lane == cur1) || (lane == cur1 - 1)) ? INFINITY : (lane <= cur1 ? v1 : -INFINITY);
        int r0 = 0, r1 = 0;
#pragma unroll
        for (int jj = 0; jj < 64; ++jj) { const float a0 = __int_as_float(__builtin_amdgcn_readlane(__float_as_int(s0), jj)), a1 = __int_as_float(__builtin_amdgcn_readlane(__float_as_int(s1), jj));
            r0 += (a0 > s0 || (a0 == s0 && jj < lane)) ? 1 : 0; r1 += (a1 > s1 || (a1 == s1 && jj < lane)) ? 1 : 0; }
        const unsigned long long m0 = __ballot(r0 < 16 && lane <= cur0), m1 = __ballot(r1 < 16 && lane <= cur1);
        if (lane == 0) { sel[(size_t)bg * 4096 + t] = m0; sel[(size_t)bg * 4096 + t + 1] = m1; } }
}
DEVI void phase_nsa2(KP a, unsigned char* lds, const int tid, int G) {
    unsigned char* ws = a->ws;
    const u16* z = (const u16*)(ws + WS_Z);
    att::Epi E{(const float*)(ws + WS_GATES), (u16*)(ws + WS_O), (const u16*)(ws + WS_OC), (const u16*)(ws + WS_OW), nullptr, (const unsigned long long*)(ws + WS_SEL)};
    att::run_pass<att::M_SEL, att::E_FINAL, 1, NPAD, 3072, false, true, GQ_S>(z, ws + WS_Z8, nullptr, nullptr, 0, (char*)lds, E, tid, G);
}

typedef float f32x4_t __attribute__((ext_vector_type(4)));
DEVI void phase_ln1_router(KP a, unsigned char* lds, int tid, int lane, int wave, int G, int l) {
    unsigned char* ws = a->ws;
    const u16* pre = (const u16*)(ws + WS_H); u16* xa = (u16*)(ws + WS_XA); unsigned char* xb = ws + WS_XBF;
    const float* g1 = a->in[17] + l * D_; const float* b1 = a->in[18] + l * D_; const float* rb = a->in[20]; const float* wT = (const float*)(ws + WS_RWT);
    int* tokinfo = (int*)(ws + WS_MISC); int* hist = (int*)(ws + WS_MISC + 1280 * 1024);
    int* be = (int*)lds;
    float* lg = (float*)(lds + 1024);
    const int g4 = lane >> 4, l15 = lane & 15;
    for (int chunk = blockIdx.x; chunk < 256; chunk += G) {
      f32x4 gq[4][2], bq[4][2];
#pragma unroll
      for (int j = 0; j < 4; ++j)
#pragma unroll
          for (int hh = 0; hh < 2; ++hh) { gq[j][hh] = *(const f32x4*)(g1 + j * 512 + lane * 8 + 4 * hh); bq[j][hh] = *(const f32x4*)(b1 + j * 512 + lane * 8 + 4 * hh); }
      u32x4 pc[4], pn[4];
#pragma unroll
      for (int j = 0; j < 4; ++j) pc[j] = *(const u32x4*)(pre + (size_t)(chunk * 64 + wave * 8) * D_ + j * 512 + lane * 8);
      for (int rr = 0; rr < 8; ++rr) {
        const int row = chunk * 64 + wave * 8 + rr;
        if (rr < 7) {
#pragma unroll
            for (int j = 0; j < 4; ++j) pn[j] = *(const u32x4*)(pre + (size_t)(row + 1) * D_ + j * 512 + lane * 8); }
        float v[4][8]; float s = 0.f;
#pragma unroll
        for (int j = 0; j < 4; ++j) { unpack8(pc[j], v[j]); s += ((v[j][0] + v[j][1]) + (v[j][2] + v[j][3])) + ((v[j][4] + v[j][5]) + (v[j][6] + v[j][7])); }
        const float mean = wsum(s) * (1.f / D_); float q = 0.f;
#pragma unroll
        for (int j = 0; j < 4; ++j)
#pragma unroll
            for (int e = 0; e < 8; ++e) { v[j][e] -= mean; q += v[j][e] * v[j][e]; }
        const float rstd = 1.f / sqrtf(wsum(q) * (1.f / D_) + LN_EPS);
#pragma unroll
        for (int j = 0; j < 4; ++j) { const int c0 = j * 512 + lane * 8; float y[8];
#pragma unroll
            for (int e = 0; e < 8; ++e) y[e] = v[j][e] * rstd * gq[j][e >> 2][e & 3] + bq[j][e >> 2][e & 3];
            u32x4 wx; wx.x = pk2(y[0], y[1]); wx.y = pk2(y[2], y[3]); wx.z = pk2(y[4], y[5]); wx.w = pk2(y[6], y[7]); *(u32x4*)(xa + (size_t)row * D_ + c0) = wx;
            u32x2 w8; w8.x = pk4_fp8(y[0], y[1], y[2], y[3]); w8.y = pk4_fp8(y[4], y[5], y[6], y[7]); *(u32x2*)(xb + (size_t)row * D_ + c0) = w8; }
#pragma unroll
        for (int j = 0; j < 4; ++j) pc[j] = pn[j];
      }
      asm volatile("s_waitcnt vmcnt(0)" ::: "memory"); __syncthreads();
      { const int rg = wave & 3, kh = wave >> 2;
          const u16* ap = xa + (size_t)(chunk * 64 + rg * 16 + l15) * D_ + kh * 1024 + 4 * g4; const float* bp0 = wT + (size_t)l15 * D_ + kh * 1024 + 4 * g4; const float* bp1 = bp0 + (size_t)16 * D_;
          f32x4 acc0 = {0.f, 0.f, 0.f, 0.f}, acc1 = {0.f, 0.f, 0.f, 0.f};
#pragma unroll 8
          for (int ks = 0; ks < 64; ++ks) { const u32x2 at_ = *(const u32x2*)(ap + 16 * ks); const f32x4 a4 = (f32x4){__uint_as_float(at_.x << 16), __uint_as_float(at_.x & 0xffff0000u), __uint_as_float(at_.y << 16), __uint_as_float(at_.y & 0xffff0000u)}, b0 = *(const f32x4*)(bp0 + 16 * ks), b1_ = *(const f32x4*)(bp1 + 16 * ks);
#pragma unroll
              for (int u = 0; u < 4; ++u) { acc0 = __builtin_amdgcn_mfma_f32_16x16x4f32(a4[u], b0[u], acc0, 0, 0, 0); acc1 = __builtin_amdgcn_mfma_f32_16x16x4f32(a4[u], b1_[u], acc1, 0, 0, 0); } }
          if (kh == 1) {
#pragma unroll
              for (int j = 0; j < 4; ++j) { lg[(rg * 16 + 4 * g4 + j) * 33 + l15] = acc0[j]; lg[(rg * 16 + 4 * g4 + j) * 33 + 16 + l15] = acc1[j]; } }
          __syncthreads();
          if (kh == 0) {
#pragma unroll
              for (int j = 0; j < 4; ++j) { lg[(rg * 16 + 4 * g4 + j) * 33 + l15] += acc0[j]; lg[(rg * 16 + 4 * g4 + j) * 33 + 16 + l15] += acc1[j]; } }
      }
      __syncthreads();
      if (tid < 64) { const int row = chunk * 64 + tid;
        float aff[32], sel[32];
#pragma unroll
        for (int e = 0; e < 32; ++e) { aff[e] = sigm(lg[tid * 33 + e]); sel[e] = aff[e] + rb[e]; }
        int bg_ = 0; float bs = -INFINITY;
#pragma unroll
        for (int gq = 0; gq < 8; ++gq) { const float s0 = sel[gq * 4], s1 = sel[gq * 4 + 1], s2 = sel[gq * 4 + 2], s3 = sel[gq * 4 + 3];
            const float mx = fmaxf(fmaxf(s0, s1), fmaxf(s2, s3));
            const float m2 = fmaxf(fmaxf(fminf(s0, s1), fminf(s2, s3)), fminf(fmaxf(s0, s1), fmaxf(s2, s3)));
            const float gs = mx + m2; if (gs > bs) { bs = gs; bg_ = gq; } }
        float c0 = 0.f, c1 = 0.f, c2 = 0.f, c3 = 0.f, a0 = 0.f, a1 = 0.f, a2 = 0.f, a3 = 0.f;
#pragma unroll
        for (int gq = 0; gq < 8; ++gq) if (gq == bg_) { c0 = sel[gq * 4]; c1 = sel[gq * 4 + 1]; c2 = sel[gq * 4 + 2]; c3 = sel[gq * 4 + 3]; a0 = aff[gq * 4]; a1 = aff[gq * 4 + 1]; a2 = aff[gq * 4 + 2]; a3 = aff[gq * 4 + 3]; }
        int i1 = 0; float m1 = c0;
        if (c1 > m1) { m1 = c1; i1 = 1; } if (c2 > m1) { m1 = c2; i1 = 2; } if (c3 > m1) { m1 = c3; i1 = 3; }
        int i2 = -1; float m2v = -INFINITY;
        if (i1 != 0 && c0 > m2v) { m2v = c0; i2 = 0; } if (i1 != 1 && c1 > m2v) { m2v = c1; i2 = 1; } if (i1 != 2 && c2 > m2v) { m2v = c2; i2 = 2; } if (i1 != 3 && c3 > m2v) { m2v = c3; i2 = 3; }
        if (i2 < 0) i2 = (i1 == 0) ? 1 : 0;
        float w1 = i1 == 0 ? a0 : i1 == 1 ? a1 : i1 == 2 ? a2 : a3, w2 = i2 == 0 ? a0 : i2 == 1 ? a1 : i2 == 2 ? a2 : a3;
        const float ws_ = w1 + w2; w1 /= ws_; w2 /= ws_;
        const int e1 = bg_ * 4 + i1, e2 = bg_ * 4 + i2;
        int* ti = tokinfo + (size_t)row * 8; ti[0] = e1; ti[2] = e2; ti[4] = __float_as_int(w1); ti[5] = __float_as_int(w2);
        int r1 = 0, r2 = 0, myh = 0;
        const unsigned long long lt = (1ull << lane) - 1ull;
        for (int e = 0; e < 32; ++e) { const unsigned long long mm1 = __ballot(e1 == e), mm2 = __ballot(e2 == e);
            const int below = __popcll(mm1 & lt) + __popcll(mm2 & lt);
            if (e1 == e) r1 = below; if (e2 == e) r2 = below; if (lane == e) myh = __popcll(mm1) + __popcll(mm2); }
        ti[1] = r1; ti[3] = r2;
        if (lane < 32) hist[chunk * 32 + lane] = myh; }
      __syncthreads();
    }
    (void)be;
}
DEVI int moe_base(const unsigned* cnt, int lane, int& base_out) {
    const unsigned c = cnt[lane & 31]; const int tiles = (int)((c + 255u) >> 8); int incl = tiles;
#pragma unroll
    for (int o = 1; o < 32; o <<= 1) { const int t_ = __shfl_up(incl, o); if ((lane & 31) >= o) incl += t_; }
    base_out = (incl - tiles) * 256; return __shfl(incl, 31);
}
DEVI void phase_moe_gather(KP a, unsigned char* lds, int tid, int lane, int wave, int G, int l) {
    unsigned char* ws = a->ws;
    unsigned* cnt = (unsigned*)(ws + WS_CTL) + CW_CNT + l * 32; int* tokinfo = (int*)(ws + WS_MISC); const int* hist = (const int*)(ws + WS_MISC + 1280 * 1024);
    const unsigned char* xb = ws + WS_XBF; unsigned char* xg = ws + WS_XG; float* roww = (float*)(ws + WS_MISC + 1 * MiB);
    int* so = (int*)lds;
    for (int chunk = blockIdx.x; chunk < 256; chunk += G) {
        if (tid < 64) so[tid] = 0;
        __syncthreads();
        { const int e = tid & 31, seg = tid >> 5; int below = 0, all = 0;
          for (int b2 = seg * 16; b2 < seg * 16 + 16; ++b2) { const int h = hist[b2 * 32 + e]; all += h; if (b2 < chunk) below += h; }
          atomicAdd(&so[e], below); atomicAdd(&so[32 + e], all); }
        __syncthreads();
        if (wave == 0) { const int c = so[32 + (lane & 31)]; const int tiles = (c + 255) >> 8; int incl = tiles;
#pragma unroll
            for (int o = 1; o < 32; o <<= 1) { const int t_ = __shfl_up(incl, o); if ((lane & 31) >= o) incl += t_; }
            if (lane < 32) { so[64 + lane] = (incl - tiles) * 256; if (chunk == 0) cnt[lane] = (unsigned)c; } }
        __syncthreads();
        for (int r0 = 0; r0 < 8; r0 += 4) { u32x4 cp[4][2]; int sl0[4], sl1[4];
#pragma unroll
            for (int q = 0; q < 4; ++q) { const int row = chunk * 64 + wave * 8 + r0 + q; const int* ti = tokinfo + (size_t)row * 8;
                const int e0 = ti[0], rk0 = ti[1], e1 = ti[2], rk1 = ti[3]; sl0[q] = so[64 + e0] + so[e0] + rk0; sl1[q] = so[64 + e1] + so[e1] + rk1;
                const u32x4* src = (const u32x4*)(xb + (size_t)row * D_); cp[q][0] = src[lane]; cp[q][1] = src[64 + lane]; }
#pragma unroll
            for (int q = 0; q < 4; ++q) { const int row = chunk * 64 + wave * 8 + r0 + q; int* ti = tokinfo + (size_t)row * 8;
                u32x4* d0 = (u32x4*)(xg + (size_t)sl0[q] * D_); u32x4* d1 = (u32x4*)(xg + (size_t)sl1[q] * D_);
                d0[lane] = cp[q][0]; d0[64 + lane] = cp[q][1]; d1[lane] = cp[q][0]; d1[64 + lane] = cp[q][1];
                if (lane == 0) { roww[sl0[q]] = __int_as_float(ti[4]); roww[sl1[q]] = __int_as_float(ti[5]); ti[6] = sl0[q]; ti[7] = sl1[q]; } } }
        __syncthreads();
    }
}
DEVI void phase_ln2(KP a, int lane, int wave, int G, int l) {
    unsigned char* ws = a->ws;
    const int* tokinfo = (const int*)(ws + WS_MISC);
    const u16* xa = (const u16*)(ws + WS_XA); const u16* Y = (const u16*)(ws + WS_Y); unsigned char* x8 = ws + WS_X8;
    float* xo = a->out; u16* xoh = (u16*)(ws + WS_XB);
    const float* g2 = a->in[24] + l * D_; const float* b2 = a->in[25] + l * D_;
    const int gw = blockIdx.x * 8 + wave, NGW = G * 8;
    int row = gw; if (row >= M_) return;
    f32x4 gq[4][2], bq[4][2];
#pragma unroll
    for (int j = 0; j < 4; ++j)
#pragma unroll
        for (int hh = 0; hh < 2; ++hh) { gq[j][hh] = *(const f32x4*)(g2 + j * 512 + lane * 8 + 4 * hh); bq[j][hh] = *(const f32x4*)(b2 + j * 512 + lane * 8 + 4 * hh); }
    u32x4 cx[4], c1[4], c2[4], nx[4], n1[4], n2[4];
    int s1 = tokinfo[(size_t)row * 8 + 6], s2 = tokinfo[(size_t)row * 8 + 7];
#pragma unroll
    for (int j = 0; j < 4; ++j) { const int c0 = j * 512 + lane * 8; cx[j] = *(const u32x4*)(xa + (size_t)row * D_ + c0); c1[j] = *(const u32x4*)(Y + (size_t)s1 * D_ + c0); c2[j] = *(const u32x4*)(Y + (size_t)s2 * D_ + c0); }
    int rn = row + NGW, t1 = 0, t2 = 0;
    if (rn < M_) { t1 = tokinfo[(size_t)rn * 8 + 6]; t2 = tokinfo[(size_t)rn * 8 + 7]; }
    for (;;) {
        const bool more = rn < M_;
        if (more) {
#pragma unroll
            for (int j = 0; j < 4; ++j) { const int c0 = j * 512 + lane * 8; nx[j] = *(const u32x4*)(xa + (size_t)rn * D_ + c0); n1[j] = *(const u32x4*)(Y + (size_t)t1 * D_ + c0); n2[j] = *(const u32x4*)(Y + (size_t)t2 * D_ + c0); } }
        const int rnn = rn + NGW; int u1 = 0, u2 = 0;
        if (rnn < M_) { u1 = tokinfo[(size_t)rnn * 8 + 6]; u2 = tokinfo[(size_t)rnn * 8 + 7]; }
        float v[4][8]; float s = 0.f;
#pragma unroll
        for (int j = 0; j < 4; ++j) { float xv[8], y1[8], y2[8]; unpack8(cx[j], xv); unpack8(c1[j], y1); unpack8(c2[j], y2);
#pragma unroll
            for (int e = 0; e < 8; ++e) { v[j][e] = xv[e] * ALPHA + (y1[e] + y2[e]); }
            s += ((v[j][0] + v[j][1]) + (v[j][2] + v[j][3])) + ((v[j][4] + v[j][5]) + (v[j][6] + v[j][7])); }
        const float mean = wsum(s) * (1.f / D_); float q = 0.f;
#pragma unroll
        for (int j = 0; j < 4; ++j)
#pragma unroll
            for (int e = 0; e < 8; ++e) { v[j][e] -= mean; q += v[j][e] * v[j][e]; }
        const float rstd = 1.f / sqrtf(wsum(q) * (1.f / D_) + LN_EPS);
#pragma unroll
        for (int j = 0; j < 4; ++j) { const int c0 = j * 512 + lane * 8; float y[8];
#pragma unroll
            for (int e = 0; e < 8; ++e) y[e] = v[j][e] * rstd * gq[j][e >> 2][e & 3] + bq[j][e >> 2][e & 3];
            if (l == 0) { u32x4 wo; wo.x = pk2(y[0], y[1]); wo.y = pk2(y[2], y[3]); wo.z = pk2(y[4], y[5]); wo.w = pk2(y[6], y[7]); *(u32x4*)(xoh + (size_t)row * D_ + c0) = wo;
                u32x2 w8; w8.x = pk4_fp8(y[0], y[1], y[2], y[3]); w8.y = pk4_fp8(y[4], y[5], y[6], y[7]); *(u32x2*)(x8 + (size_t)row * D_ + c0) = w8; }
            else { *(f32x4*)(xo + (size_t)row * D_ + c0) = (f32x4){y[0], y[1], y[2], y[3]}; *(f32x4*)(xo + (size_t)row * D_ + c0 + 4) = (f32x4){y[4], y[5], y[6], y[7]}; } }
        if (!more) break;
        row = rn; rn = rnn; t1 = u1; t2 = u2;
#pragma unroll
        for (int j = 0; j < 4; ++j) { cx[j] = nx[j]; c1[j] = n1[j]; c2[j] = n2[j]; }
    }
}

constexpr int NGEMM = 15360;
DEVI void phase_gates(KP a, unsigned char* lds, int tid, int G, int l) {
    using pg8::i32x8_; using pg8::i32x4_;
    unsigned char* ws = a->ws;
    const unsigned char* X = ws + WS_X8; const unsigned char* W = ws + WS_WIN + (size_t)l * NPAD * D_ + (size_t)NGEMM * D_;
    const float* bias = (const float*)(ws + WS_BIASP) + l * NPAD + NGEMM; float* gates = (float*)(ws + WS_GATES);
    const int lane = tid & 63, wave = tid >> 6, g4 = lane >> 4, l15 = lane & 15;
    f32x4* red = (f32x4*)lds;
    float* gl = (float*)(lds + 131072);
    const int sclW = 0x79797979, sclA = 0x7f7f7f7f;
    for (int unit = blockIdx.x; unit < M_ / 64; unit += G) {
        const unsigned char* ap = X + (size_t)(unit * 64 + l15) * D_ + wave * 256 + 32 * g4;
        const unsigned char* bp = W + (size_t)l15 * D_ + wave * 256 + 32 * g4;
        i32x8_ af[4][2], bf[4][2];
#pragma unroll
        for (int t = 0; t < 4; ++t)
#pragma unroll
            for (int ks = 0; ks < 2; ++ks) {
                af[t][ks] = __builtin_shufflevector(*(const i32x4_*)(ap + (size_t)t * 16 * D_ + 128 * ks), *(const i32x4_*)(ap + (size_t)t * 16 * D_ + 128 * ks + 16), 0, 1, 2, 3, 4, 5, 6, 7);
                bf[t][ks] = __builtin_shufflevector(*(const i32x4_*)(bp + (size_t)t * 16 * D_ + 128 * ks), *(const i32x4_*)(bp + (size_t)t * 16 * D_ + 128 * ks + 16), 0, 1, 2, 3, 4, 5, 6, 7); }
        f32x4 acc[4][4];
#pragma unroll
        for (int rt = 0; rt < 4; ++rt)
#pragma unroll
            for (int ct = 0; ct < 4; ++ct) acc[rt][ct] = (f32x4){0.f, 0.f, 0.f, 0.f};
#pragma unroll
        for (int ks = 0; ks < 2; ++ks)
#pragma unroll
            for (int rt = 0; rt < 4; ++rt)
#pragma unroll
                for (int ct = 0; ct < 4; ++ct) asm volatile("v_mfma_scale_f32_16x16x128_f8f6f4 %0, %1, %2, %0, %3, %4 op_sel_hi:[0,0,0]" : "+v"(acc[rt][ct]) : "v"(bf[ct][ks]), "v"(af[rt][ks]), "v"(sclW), "v"(sclA));
        asm volatile("s_nop 15\n\ts_nop 15\n\ts_nop 15\n\ts_nop 15" ::: "memory");
#pragma unroll
        for (int rt = 0; rt < 4; ++rt)
#pragma unroll
            for (int ct = 0; ct < 4; ++ct) red[(wave * 16 + rt * 4 + ct) * 64 + lane] = acc[rt][ct];
        __syncthreads();
#pragma unroll
        for (int q = 0; q < 2; ++q) { const int tile = 2 * wave + q, rt = tile >> 2, ct = tile & 3, row = unit * 64 + rt * 16 + l15, col = ct * 16 + 4 * g4;
            f32x4 v = red[tile * 64 + lane];
#pragma unroll
            for (int w = 1; w < 8; ++w) v = v + red[(w * 16 + tile) * 64 + lane];
            if (col < 56) { const f32x4 gv_ = v + *(const f32x4*)(bias + col); *(f32x4*)(gates + (size_t)row * 64 + col) = gv_;
                if (col < 8) *(f32x4*)(gl + (rt * 16 + l15) * 8 + col) = gv_; } }
        __syncthreads();
        if (wave < 4) {
            const float ig = gl[lane * 8 + wave], fg = gl[lane * 8 + 4 + wave];
            float bc = fminf(fg, 0.f) - log1pf(__expf(-fabsf(fg)));
#pragma unroll
            for (int o = 1; o < 64; o <<= 1) { const float t_ = __shfl_up(bc, o); if (lane >= o) bc += t_; }
            const float L_ = wmax(ig - bc), S_ = __shfl(bc, 63);
            if (lane == 0) { float* ch = (float*)(ws + WS_CHS) + ((size_t)unit * 4 + wave) * 2; ch[0] = S_; ch[1] = L_; } }
        __syncthreads();
    }
}
__global__ void __launch_bounds__(512, 2) fwd_kernel(Args args) {
    extern __shared__ __attribute__((aligned(16))) unsigned char lds_raw[];
    LAS unsigned char* ldsl = (LAS unsigned char*)lds_raw;
    unsigned char* lds = lds_raw;
    const int G = gridDim.x;
    const int wave_sg = __builtin_amdgcn_readfirstlane(threadIdx.x >> 6);
    unsigned char* ws = args.ws;
    volatile LAS unsigned* lctl = (volatile LAS unsigned*)(ldsl + LDSCTL_OFF);
    if (wave_sg == 0) { const int l_ = (int)__builtin_amdgcn_mbcnt_hi(~0u, __builtin_amdgcn_mbcnt_lo(~0u, 0u)); for (int u = l_; u < 256; u += 64) lctl[u] = 0u; }
    __syncthreads();
    const int lo = args.ph_lo, hi = args.ph_hi;
    const bool one = (hi - lo) > 1;
    XcdBarrier bar; bar.bar = (unsigned*)(ws + WS_CTL) + CW_BAR; bar.x = 0; bar.st = lctl; bar.wv = wave_sg;
    if (one) bar = xcd_barrier_post((unsigned*)(ws + WS_CTL) + CW_BAR, lctl, wave_sg);
#ifndef ONLY_PHASE
#define ONLY_PHASE -1
#endif
#define LAUNDER() int wv_ = wave_sg; asm volatile("" : "+s"(wv_)); int tz_ = wv_ * 64 + (int)__builtin_amdgcn_mbcnt_hi(~0u, __builtin_amdgcn_mbcnt_lo(~0u, 0u)); asm volatile("" : "+v"(tz_)); const int tid = tz_, lane = tz_ & 63, wave = wv_; (void)tid; (void)lane; (void)wave; \
    unsigned long long kp_ = (unsigned long long)__builtin_amdgcn_kernarg_segment_ptr(); asm volatile("" : "+s"(kp_)); \
    const KP la = (KP)kp_; unsigned char* const ws = la->ws; (void)ws
#define INR(k) (lo <= (k) && (k) < hi)
#define IN0 ((ONLY_PHASE < 0 || ONLY_PHASE == 0) && INR(0))
#define INL(j) ((ONLY_PHASE < 0 || ONLY_PHASE == 1 + (j)) && INR(pb + (j)))
#define SEAM(k) do { if (INR(k) && INR((k) + 1)) xcd_barrier(bar); else __syncthreads(); } while (0)

    if (IN0) { LAUNDER(); phase_prologue(la, lds, tid, lane, wave, G); phase_experts(la, lds, lane, wave, G, 0); SEAM(0); }

    for (int l = 0; l < 2; ++l) {
        const int pb = 1 + l * PPL;
        if (INL(0)) { LAUNDER();
            pg8::Gemm g{(const u16*)(ws + WS_X8), (const u16*)(ws + WS_WIN + (size_t)l * NPAD * D_), D_ / 2, D_ / 2, 0x79797979, 0x7f7f7f7f};
            pg8::StaticOrder S; S.init(M_, NGEMM, G, (int)blockIdx.x);
            EpiInProj E{(u16*)(ws + WS_Z), (const float*)(ws + WS_BIASP) + l * NPAD, (float*)(ws + WS_GATES), (u16*)(ws + WS_KC), (const float*)(ws + WS_ROPE), (const float*)(ws + WS_ROPE) + 4096 * 64, ws + WS_Z8};
            pg8::gemm_phase<EpiInProj, pg8::StaticOrder, true>(ldsl, g, S, E, tid);
            __syncthreads();
            phase_gates(la, lds, tid, G, l);
            SEAM(pb + 0);
        }
        if (INL(1)) { LAUNDER();
            pg8::Gemm g{(const u16*)(ws + WS_KC), (const u16*)(ws + WS_CW1 + (size_t)l * 512 * 2048), 1024, 1024, 0x79797979, 0x7f7f7f7f};
            CmpOrder S{G, (int)blockIdx.x};
            EpiF32Tile E{(float*)(ws + WS_U), 256};
            pg8::gemm_phase<EpiF32Tile, CmpOrder, true>(ldsl, g, S, E, tid);
            phase_mlstm_pre(la, lds, tid, G, G >= 64 ? 32 : 0);
            SEAM(pb + 1);
        }
        if (INL(2)) { LAUNDER(); phase_mlstm(la, lds, tid, G); phase_cmp2(la, lds, tid, G, l); SEAM(pb + 2); }
        if (INL(3)) { LAUNDER(); phase_nsa1(la, lds, tid, G); phase_norm(la, lane, wave, G, l); SEAM(pb + 3); }
        if (INL(4)) { LAUNDER(); phase_topk(la, lane, wave, G); SEAM(pb + 4); }
        if (INL(5)) { LAUNDER(); phase_nsa2(la, lds, tid, G); __syncthreads();
            {
            pg8::Gemm g{(const u16*)(ws + WS_XBF), (const u16*)(ws + WS_WB) + (size_t)(l * 3 + 0) * D_ * D_, D_ / 2, D_ / 2, 0x79797979, 0x7e7e7e7e};
            pg8::StaticOrder S; S.init(M_, D_, G, (int)blockIdx.x);
            EpiGate<false> E{(u16*)(ws + WS_MRG), (const u16*)(ws + WS_Z), C_GM};
            pg8::gemm_phase<EpiGate<false>, pg8::StaticOrder, true>(ldsl, g, S, E, tid);
            }
            SEAM(pb + 5);
        }
        if (INL(6)) { LAUNDER();
            pg8::Gemm g{(const u16*)(ws + WS_O), (const u16*)(ws + WS_WB) + (size_t)(l * 3 + 1) * D_ * D_, D_ / 2, D_ / 2, 0x79797979, 0x7c7c7c7c};
            pg8::StaticOrder S; S.init(M_, D_, G, (int)blockIdx.x);
            EpiGate<true> E{(u16*)(ws + WS_MRG), (const u16*)(ws + WS_Z), C_GM + 2048};
            pg8::gemm_phase<EpiGate<true>, pg8::StaticOrder, true>(ldsl, g, S, E, tid);
            SEAM(pb + 6);
        }
        if (INL(7)) { LAUNDER();
            pg8::Gemm g{(const u16*)(ws + WS_MRG), (const u16*)(ws + WS_WB) + (size_t)(l * 3 + 2) * D_ * D_, D_, D_};
            pg8::StaticOrder S; S.init(M_, D_, G, (int)blockIdx.x);
            EpiResid E{(u16*)(ws + WS_H), la->in[0], l == 0 ? (const u16*)nullptr : (const u16*)(ws + WS_XB)};
            pg8::gemm_phase(ldsl, g, S, E, tid);
            SEAM(pb + 7);
        }
        if (INL(8)) { LAUNDER(); phase_ln1_router(la, lds, tid, lane, wave, G, l); SEAM(pb + 8); }
        if (INL(9)) { LAUNDER(); phase_moe_gather(la, lds, tid, lane, wave, G, l); SEAM(pb + 9); }
        if (INL(10) || INL(11)) { LAUNDER();
            const unsigned* cnt = (const unsigned*)(ws + WS_CTL) + CW_CNT + l * 32;
            volatile LAS int* tstart = (volatile LAS int*)(lctl + 16);
            if (wave == 0) { int mybase; const int nt_ = moe_base(cnt, lane, mybase); if (lane < 32) tstart[lane] = mybase >> 8; if (lane == 32) tstart[32] = nt_; }
            __syncthreads();
            const int ntiles = tstart[32];
            if (INL(10)) { LAUNDER();
                pg8::Gemm g{(const u16*)(ws + WS_XG), (const u16*)(ws + WS_W13), D_ / 2, D_ / 2, 0x79797979, 0x7f7f7f7f};
                MoeOrder S{G, (int)blockIdx.x, ntiles, tstart};
                EpiSwiGLU E{ws + WS_HB};
                pg8::gemm_phase<EpiSwiGLU, MoeOrder, true>(ldsl, g, S, E, tid);
                SEAM(pb + 10);
            }
            if (INL(11)) { LAUNDER();
                pg8::Gemm g{(const u16*)(ws + WS_HB), (const u16*)(ws + WS_W2), DFF / 2, DFF / 2, 0x79797979, 0x7f7f7f7f};
                MoeOrder S{G, (int)blockIdx.x, ntiles, tstart};
                EpiScaleRow E{(u16*)(ws + WS_Y), (const float*)(ws + WS_MISC + 1 * MiB)};
                pg8::gemm_phase<EpiScaleRow, MoeOrder, true>(ldsl, g, S, E, tid);
                SEAM(pb + 11);
            }
        }
        if (INL(12)) { LAUNDER(); phase_ln2(la, lane, wave, G, l); if (l == 0) phase_experts(la, lds, lane, wave, G, 1); SEAM(pb + 12); }
    }
#undef INR
#undef IN0
#undef INL
#undef SEAM
}

extern "C" void kernel_launch(void* const* d_in, const int* in_sizes, int n_in, void* d_out, int out_size, void* d_ws, size_t ws_size, hipStream_t stream) {
    static int grid = 0;
    if (grid == 0) {
        if (n_in != 26 || out_size != M_ * D_ || ws_size < WS_END5) { fprintf(stderr, "kernel_launch: unexpected problem (n_in %d out %d ws %zu need %zu)\n", n_in, out_size, ws_size, (size_t)WS_END); grid = -1; return; }
        int dev = 0, cus = 0;
        if (hipGetDevice(&dev) != hipSuccess || hipDeviceGetAttribute(&cus, hipDeviceAttributeMultiprocessorCount, dev) != hipSuccess) { grid = -1; return; }
        if (hipFuncSetAttribute((const void*)fwd_kernel, hipFuncAttributeMaxDynamicSharedMemorySize, LDS_BYTES) != hipSuccess) { fprintf(stderr, "kernel_launch: hipFuncSetAttribute failed\n"); grid = -1; return; }
        int per_cu = 0;
        if (hipOccupancyMaxActiveBlocksPerMultiprocessor(&per_cu, (const void*)fwd_kernel, 512, LDS_BYTES) != hipSuccess || per_cu < 1) fprintf(stderr, "kernel_launch: occupancy query reports %d\n", per_cu);
        (void)hipGetLastError();
        grid = cus;
    }
    if (grid < 0) return;
    (void)hipMemsetAsync((char*)d_ws + WS_CTL, 0, CTL_BYTES, stream);
    Args a{};
    for (int i = 0; i < 26; ++i) a.in[i] = (const float*)d_in[i];
    a.out = (float*)d_out; a.ws = (unsigned char*)d_ws;
#if MK_ONE_LAUNCH
    a.ph_lo = 0; a.ph_hi = NPH;
    hipLaunchKernelGGL(fwd_kernel, dim3(grid), dim3(512), LDS_BYTES, stream, a);
#else
#ifdef DBG_STOP
    for (int p = 0; p < DBG_STOP; ++p) { a.ph_lo = p; a.ph_hi = p + 1; hipLaunchKernelGGL(fwd_kernel, dim3(grid), dim3(512), LDS_BYTES, stream, a); }
    (void)hipMemcpyAsync(d_out, (char*)d_ws + DBG_SRC, (size_t)M_ * D_ * 4, hipMemcpyDeviceToDevice, stream);
#else
#ifndef REP_N
#define REP_N 1
#define REP_LO 99
#define REP_HI 99
#endif
    for (int p = 0; p < NPH; ++p) {
        const int j = p == 0 ? -1 : (p - 1) % PPL;
        if (j == REP_LO) { for (int r = 0; r < REP_N; ++r) for (int q = p; q <= p + (REP_HI - REP_LO); ++q) { a.ph_lo = q; a.ph_hi = q + 1; hipLaunchKernelGGL(fwd_kernel, dim3(grid), dim3(512), LDS_BYTES, stream, a); } p += REP_HI - REP_LO; continue; }
        a.ph_lo = p; a.ph_hi = p + 1; hipLaunchKernelGGL(fwd_kernel, dim3(grid), dim3(512), LDS_BYTES, stream, a); }
#endif
#endif
}
```

```cpp
#include <hip/hip_runtime.h>
#include <cstdio>
#include <cstdint>

#ifndef MK_ONE_LAUNCH
#define MK_ONE_LAUNCH 1
#endif

#define LAS __attribute__((address_space(3)))
#define DEVI __device__ __forceinline__
typedef unsigned short u16;
typedef short bf16x8 __attribute__((ext_vector_type(8)));
typedef float f32x4 __attribute__((ext_vector_type(4)));
typedef float f32x2 __attribute__((ext_vector_type(2)));
typedef unsigned u32x4 __attribute__((ext_vector_type(4)));
typedef unsigned u32x2 __attribute__((ext_vector_type(2)));

constexpr int T_ = 4096, D_ = 2048, M_ = 16384;
constexpr int NPAD = 15616, IN_W = 15416;
constexpr int C_MQ = 0, C_MK = 1024, C_MV = 2048, C_MO = 4096, C_NQ = 6144, C_KC = 8192, C_VC = 8704, C_KS = 9216, C_VS = 9728, C_KW = 10240,
              C_VW = 10752, C_GM = 11264, C_GT = 15360;
constexpr int S_MI = 6144, S_NQ = 6152, S_KC = 8200, S_KS = 9224, S_VS = 9736, S_KW = 10248, S_VW = 10760, S_NG = 11272, S_GM = 11320;
constexpr float ALPHA = 1.4142135623730951f;
constexpr float LN_EPS = 1e-5f;
constexpr int NEXP = 32, DFF = 1024;
constexpr int MOE_ROWS = 40960;

constexpr size_t MiB = 1u << 20;
constexpr size_t WS_CTL = 0, CTL_BYTES = 1 * MiB;
constexpr size_t WS_ROPE = 1 * MiB;
constexpr size_t WS_BIASP = 3 * MiB;
constexpr size_t WS_WIN = 4 * MiB;
constexpr size_t WS_WB = 126 * MiB;
constexpr size_t WS_CW1 = 174 * MiB;
constexpr size_t WS_W13 = 178 * MiB;
constexpr size_t WS_W2 = 434 * MiB;
constexpr size_t WS_XBF = 562 * MiB;
constexpr size_t WS_XA = 626 * MiB;
constexpr size_t WS_XB = 754 * MiB;
constexpr size_t WS_Z = 882 * MiB;
constexpr size_t WS_GATES = 1370 * MiB;
constexpr size_t WS_KC = 1374 * MiB;
constexpr size_t WS_U = 1406 * MiB;
constexpr size_t WS_KCMP = 1414 * MiB;
constexpr size_t WS_MISC = 1416 * MiB;
constexpr size_t WS_CHS = WS_MISC + 1800 * 1024;
constexpr size_t WS_H = 1418 * MiB;
constexpr size_t WS_HG = 1546 * MiB;
constexpr size_t WS_O = 1610 * MiB;
constexpr size_t WS_MRG = 1674 * MiB;
constexpr size_t WS_END = 1738 * MiB, WS_END2 = 1739 * MiB;
constexpr size_t WS_OC = WS_H, WS_OW = WS_H + 64 * MiB, WS_IMP = WS_MRG, WS_OVL = WS_MISC + 1728 * 1024, WS_SEL = WS_END;
constexpr size_t WS_RWT = WS_MISC + 512 * 1024;
constexpr size_t WS_X8 = 1739 * MiB, WS_END3 = 1771 * MiB;
constexpr size_t WS_Z8 = 1771 * MiB, WS_KCMP8 = 1819 * MiB, WS_END4 = 1820 * MiB;
constexpr size_t WS_OCG = 1820 * MiB, WS_END5 = 1884 * MiB;
constexpr size_t WS_XG = WS_Z, WS_HB = WS_Z + 160 * MiB, WS_Y = WS_Z + 240 * MiB;
constexpr int CW_BAR = 4096;
constexpr int CW_CNT = 16384;
constexpr int CW_B1P = 16640;

constexpr int RING_BYTES = 131072;
constexpr int LDSCTL_OFF = 143360;
constexpr int LDS_BYTES = 147456;

DEVI float bf2f(unsigned h) { return __uint_as_float(h << 16); }
DEVI unsigned f2bf(float f) { unsigned u = __float_as_uint(f); return (u + 0x7fffu + ((u >> 16) & 1u)) >> 16; }
DEVI unsigned pk2(float lo, float hi) { unsigned r; asm("v_cvt_pk_bf16_f32 %0, %1, %2" : "=v"(r) : "v"(lo), "v"(hi)); return r; }
DEVI unsigned pk4_fp8(float a, float b, float c, float d) {
    a = __builtin_amdgcn_fmed3f(a, 448.f, -448.f); b = __builtin_amdgcn_fmed3f(b, 448.f, -448.f); c = __builtin_amdgcn_fmed3f(c, 448.f, -448.f); d = __builtin_amdgcn_fmed3f(d, 448.f, -448.f);
    int w = __builtin_amdgcn_cvt_pk_fp8_f32(a, b, 0, false); w = __builtin_amdgcn_cvt_pk_fp8_f32(c, d, w, true); return (unsigned)w; }
DEVI float sigm(float x) { return 1.f / (1.f + __expf(-x)); }
DEVI float wsum(float v) {
#pragma unroll
    for (int o = 32; o; o >>= 1) v += __shfl_xor(v, o);
    return v; }
DEVI float wmax(float v) {
#pragma unroll
    for (int o = 32; o; o >>= 1) v = fmaxf(v, __shfl_xor(v, o));
    return v; }
#define WAVE_SYNC() asm volatile("s_waitcnt lgkmcnt(0)" ::: "memory")
DEVI void unpack8(u32x4 v, float* f) {
    f[0] = __uint_as_float(v.x << 16); f[1] = __uint_as_float(v.x & 0xffff0000u); f[2] = __uint_as_float(v.y << 16); f[3] = __uint_as_float(v.y & 0xffff0000u);
    f[4] = __uint_as_float(v.z << 16); f[5] = __uint_as_float(v.z & 0xffff0000u); f[6] = __uint_as_float(v.w << 16); f[7] = __uint_as_float(v.w & 0xffff0000u); }

#define XB_TMO      128
#define XB_XCNT(j)  (256  + 64 * (j))
#define XB_XSUB(j)  (1280 + 64 * (j))
#define XB_XGEN(j)  (2304 + 64 * (j))
#define XB_TOP      3328
#define XB_TOPGEN   3392
#define XCD_BAR_WORDS 3456
#define XB_SPIN_CAP (1u << 21)
DEVI unsigned xb_ld(unsigned* p)              { return __hip_atomic_load(p, __ATOMIC_RELAXED, __HIP_MEMORY_SCOPE_AGENT); }
DEVI unsigned xb_add(unsigned* p, unsigned v) { return __hip_atomic_fetch_add(p, v, __ATOMIC_RELAXED, __HIP_MEMORY_SCOPE_AGENT); }
DEVI unsigned xb_xcc_id() { return (unsigned)__builtin_amdgcn_s_getreg((3 << 11) | 20) & 0xFu; }
#define XB_SPIN(cond, bar) do { unsigned _sp = 0; while (cond) { __builtin_amdgcn_s_sleep(1); \
    if ((++_sp & 255u) == 0u) { if (xb_ld(&(bar)[XB_TMO])) break; if (_sp > XB_SPIN_CAP) { atomicAdd(&(bar)[XB_TMO], 1u); break; } } } } while (0)
struct XcdBarrier { unsigned* bar; unsigned x; volatile LAS unsigned* st; int wv; };
DEVI bool xb_leader(int wv) { return wv == 0 && __builtin_amdgcn_mbcnt_hi(~0u, __builtin_amdgcn_mbcnt_lo(~0u, 0u)) == 0u; }
DEVI XcdBarrier xcd_barrier_post(unsigned* bar, volatile LAS unsigned* st, int wv) {
    XcdBarrier b; b.bar = bar; b.x = xb_xcc_id(); b.st = st; b.wv = wv;
    if (xb_leader(wv)) (void)xb_add(&bar[XB_XCNT(b.x)], 1u);
    return b;
}
DEVI void xcd_barrier_complete(unsigned* bar, unsigned x, unsigned& nloc, unsigned& nx) {
    const unsigned G = gridDim.x * gridDim.y * gridDim.z;
    unsigned sum, cnt, mine, sp = 0u;
    for (;;) {
        sum = 0u; cnt = 0u; mine = 0u;
#pragma unroll
        for (unsigned j = 0; j < 16; ++j) { const unsigned c = xb_ld(&bar[XB_XCNT(j)]); sum += c; cnt += (c > 0u) ? 1u : 0u; mine = (j == x) ? c : mine; }
        if (sum == G) break;
        __builtin_amdgcn_s_sleep(1);
        if ((++sp & 255u) == 0u) { if (xb_ld(&bar[XB_TMO])) break; if (sp > XB_SPIN_CAP) { atomicAdd(&bar[XB_TMO], 1u); break; } }
    }
    nloc = mine > 0u ? mine : 1u; nx = cnt > 0u ? cnt : 1u;
}
__device__ __noinline__ void xcd_barrier_impl(unsigned* bar_, unsigned x_, volatile LAS unsigned* st_, int wv_) {
    XcdBarrier b; b.bar = bar_; b.x = x_; b.st = st_; b.wv = wv_;
    asm volatile("s_waitcnt vmcnt(0)" ::: "memory");
    __syncthreads();
    if (xb_leader(b.wv)) {
        unsigned* bar = b.bar;
        __builtin_amdgcn_s_waitcnt(0);
        unsigned nloc = b.st[0], nx = b.st[1];
        if (nloc == 0u) { xcd_barrier_complete(bar, b.x, nloc, nx); b.st[0] = nloc; b.st[1] = nx; }
        const unsigned old = xb_add(&bar[XB_XSUB(b.x)], 1u);
        const unsigned gen = old / nloc;
        if (old + 1u == (gen + 1u) * nloc) {
            __builtin_amdgcn_fence(__ATOMIC_RELEASE, "agent");
            asm volatile("s_waitcnt vmcnt(0)" ::: "memory");
            const unsigned og = xb_add(&bar[XB_TOP], 1u);
            const unsigned tg = og / nx;
            if (og + 1u == (tg + 1u) * nx) xb_add(&bar[XB_TOPGEN], 1u);
            else XB_SPIN(xb_ld(&bar[XB_TOPGEN]) == tg, bar);
            __builtin_amdgcn_fence(__ATOMIC_ACQUIRE, "agent");
            xb_add(&bar[XB_XGEN(b.x)], 1u);
            asm volatile("s_waitcnt vmcnt(0)" ::: "memory");
        } else {
            XB_SPIN(xb_ld(&bar[XB_XGEN(b.x)]) == gen, bar);
            __builtin_amdgcn_fence(__ATOMIC_ACQUIRE, "agent");
            asm volatile("s_waitcnt vmcnt(0)" ::: "memory");
        }
    }
    __syncthreads();
}

DEVI void xcd_barrier(const XcdBarrier& b) { xcd_barrier_impl(b.bar, b.x, b.st, b.wv); }

namespace pg8 {
constexpr int BM = 256, BK = 64, HALF = 128, HTB = HALF * BK * 2, STAGE_BYTES = 8 * HTB, NXCD = 8, WGM = 4;
__host__ __device__ __forceinline__ int lds_byte(int r, int c) { const int st = (r >> 4) * 2 + (c >> 5), rr = r & 15, cc = c & 31, ob = rr * 64 + cc * 2; return st * 1024 + (ob ^ (((ob >> 9) & 1) << 5)); }
__host__ __device__ __forceinline__ void stage_rc(int b, int& R, int& C) { const int st = b / 1024, sb = b % 1024, swz = sb ^ (((sb >> 9) & 1) << 5); R = (st >> 1) * 16 + swz / 64; C = (st & 1) * 32 + (swz % 64) / 2; }
__host__ __device__ __forceinline__ int perm32(int rho) { const int n = rho >> 4, i = rho & 15; return 8 * (i >> 2) + 4 * n + (i & 3); }

struct Unit { int pm, pn, pb; };
struct Gemm { const u16* A; const u16* Bt; int lda, K; int sclW = 0x7f7f7f7f, sclA = 0x7f7f7f7f; };

struct StaticOrder {
    int nM, nN, nwg, G, c;
    DEVI void init(int M, int N, int G_, int c_) { nM = M / BM; nN = N / BM; nwg = nM * nN; G = G_; c = c_; }
    DEVI bool next(int i, Unit& u) const {
        const long L = (long)i * G + c; if (L >= nwg) return false;
        int wgid = (int)L; { const int q = nwg / NXCD, r = nwg % NXCD, xcd = wgid % NXCD, off = wgid / NXCD; wgid = (xcd < r ? xcd * (q + 1) : r * (q + 1) + (xcd - r) * q) + off; }
        const int nig = WGM * nN, gid = wgid / nig, fm = gid * WGM, gsz = (nM - fm) < WGM ? (nM - fm) : WGM;
        u.pm = fm + ((wgid % nig) % gsz); u.pn = (wgid % nig) / gsz; u.pb = u.pn; return true;
    }
};

typedef int i32x4_ __attribute__((ext_vector_type(4)));
typedef int i32x8_ __attribute__((ext_vector_type(8)));
template <class Epi, class Sched, bool FP8 = false>
DEVI void gemm_phase(LAS unsigned char* lds, const Gemm g, const Sched& S, const Epi& E, const int tid) {
    const int wid = __builtin_amdgcn_readfirstlane(tid >> 6), lane = tid & 63, wr = wid >> 2, wc = wid & 3, fr = lane & 15, fq = lane >> 4;
    const int K = g.K, nt = K / BK, lda = g.lda; const int sclW = g.sclW, sclA = g.sclA; (void)sclW; (void)sclA;
    unsigned voffA[2], voffB[2];
#pragma unroll
    for (int i = 0; i < 2; ++i) { int R, C; stage_rc(tid * 16 + i * 8192, R, C); const int Rb = Epi::PERM ? ((R & ~31) + perm32(R & 31)) : R;
        voffA[i] = (unsigned)(R * lda + C) * 2u; voffB[i] = (unsigned)(Rb * K + C) * 2u; }
    const size_t kstep = (size_t)(BK * 2);
    const size_t hstepA = (size_t)HALF * lda * 2, tstepA = 2 * hstepA;
    const size_t hstepB = (size_t)HALF * K * 2, tstepB = 2 * hstepB;
    const unsigned ldsw = (unsigned)wid * 1024u;
    const int aoff = lds_byte(wr * 64 + fr, fq * 8), boff = lds_byte(wc * 32 + fr, fq * 8);
#define PG8_SA(b, h) (((b) * 2 + (h)) * HTB)
#define PG8_SB(b, h) ((4 + (b) * 2 + (h)) * HTB)
#define PG8_STAGE(bufoff, gbase, voff) do { _Pragma("unroll") for (int _i = 0; _i < 2; ++_i) \
        __builtin_amdgcn_global_load_lds((const unsigned*)((const char*)(gbase) + (voff)[_i]), (LAS unsigned*)(lds + (bufoff) + ldsw + _i * 8192), 16, 0, 0); } while (0)
#define PG8_LD2(addr) __builtin_shufflevector(*(const LAS i32x4_*)(addr), *(const LAS i32x4_*)((addr) + 1024), 0, 1, 2, 3, 4, 5, 6, 7)
#define PG8_LDA(dst, b, h) do { _Pragma("unroll") for (int m = 0; m < 4; ++m) dst[m] = PG8_LD2(lds + PG8_SA(b, h) + aoff + m * 2048); } while (0)
#define PG8_LDB(dst, b, h) do { _Pragma("unroll") for (int n = 0; n < 2; ++n) dst[n] = PG8_LD2(lds + PG8_SB(b, h) + boff + n * 2048); } while (0)
#define PG8_HALF(v, k) ((k) == 0 ? (bf16x8)__builtin_shufflevector(v, v, 0, 1, 2, 3) : (bf16x8)__builtin_shufflevector(v, v, 4, 5, 6, 7))
#define PG8_MMA(ai, bj, At, Bt) do { __builtin_amdgcn_s_setprio(1); _Pragma("unroll") for (int m = 0; m < 4; ++m) _Pragma("unroll") for (int n = 0; n < 2; ++n) { \
        if constexpr (FP8) { asm volatile("v_mfma_scale_f32_16x16x128_f8f6f4 %0, %1, %2, %0, %3, %4 op_sel_hi:[0,0,0]" : "+v"(acc[ai][bj][m][n]) : "v"(Bt[n]), "v"(At[m]), "v"(sclW), "v"(sclA)); } \
        else { _Pragma("unroll") for (int k = 0; k < 2; ++k) acc[ai][bj][m][n] = __builtin_amdgcn_mfma_f32_16x16x32_bf16(PG8_HALF(Bt[n], k), PG8_HALF(At[m], k), acc[ai][bj][m][n], 0, 0, 0); } } \
        __builtin_amdgcn_s_setprio(0); } while (0)
#define PG8_WAIT_V(n) asm volatile("s_waitcnt vmcnt(" #n ")" ::: "memory")
#define PG8_WAIT_L(n) asm volatile("s_waitcnt lgkmcnt(" #n ")" ::: "memory")
#define PG8_BAR __builtin_amdgcn_s_barrier()
#define PG8_SCHED __builtin_amdgcn_sched_barrier(0)
    Unit cur, nxt; int ui = 0;
    if (!S.next(0, cur)) return;
    f32x4 acc[2][2][4][2];
#pragma unroll
    for (int a = 0; a < 2; ++a)
#pragma unroll
        for (int b = 0; b < 2; ++b)
#pragma unroll
            for (int m = 0; m < 4; ++m)
#pragma unroll
                for (int n = 0; n < 2; ++n) acc[a][b][m][n] = (f32x4){0.f, 0.f, 0.f, 0.f};
    i32x8_ At[4], B0[2], B1[2];
    const char* cA = (const char*)g.A + (size_t)cur.pm * tstepA; const char* cB = (const char*)g.Bt + (size_t)cur.pb * tstepB;
    PG8_STAGE(PG8_SB(0, 0), cB, voffB); PG8_STAGE(PG8_SB(0, 1), cB + hstepB, voffB); PG8_STAGE(PG8_SA(0, 0), cA, voffA); PG8_STAGE(PG8_SA(0, 1), cA + hstepA, voffA);
    if (wr == 1) PG8_BAR;
    PG8_WAIT_V(2); PG8_BAR;
    PG8_STAGE(PG8_SB(1, 0), cB + kstep, voffB); PG8_STAGE(PG8_SA(1, 0), cA + kstep, voffA); PG8_STAGE(PG8_SB(1, 1), cB + hstepB + kstep, voffB);
    PG8_WAIT_V(6); PG8_BAR;
    for (;;) {
        const bool has_next = S.next(ui + 1, nxt);
        const char* nA = has_next ? (const char*)g.A + (size_t)nxt.pm * tstepA : cA; const char* nB = has_next ? (const char*)g.Bt + (size_t)nxt.pb * tstepB : cB;
        for (int t = 0; t < nt; t += 2) {
            const bool last = (t == nt - 2);
            const char* a1 = cA + (size_t)(t + 1) * kstep;
            const char* a2 = last ? nA : cA + (size_t)(t + 2) * kstep; const char* b2 = last ? nB : cB + (size_t)(t + 2) * kstep;
            const char* a3 = a2 + kstep; const char* b3 = b2 + kstep;
            PG8_LDB(B0, 0, 0); PG8_LDB(B1, 0, 1); PG8_SCHED; PG8_LDA(At, 0, 0); PG8_STAGE(PG8_SA(1, 1), a1 + hstepA, voffA);
            PG8_WAIT_V(8); PG8_WAIT_L(0); PG8_BAR; PG8_MMA(0, 0, At, B0); PG8_MMA(0, 1, At, B1); PG8_BAR; PG8_SCHED;
            PG8_LDA(At, 0, 1); PG8_STAGE(PG8_SB(0, 0), b2, voffB); PG8_STAGE(PG8_SB(0, 1), b2 + hstepB, voffB); PG8_STAGE(PG8_SA(0, 0), a2, voffA);
            PG8_WAIT_V(8); PG8_WAIT_L(0); PG8_BAR; PG8_MMA(1, 0, At, B0); PG8_MMA(1, 1, At, B1); PG8_BAR; PG8_SCHED;
            PG8_LDB(B0, 1, 0); PG8_LDB(B1, 1, 1); PG8_SCHED; PG8_LDA(At, 1, 0); PG8_STAGE(PG8_SA(0, 1), a2 + hstepA, voffA);
            PG8_WAIT_V(8); PG8_WAIT_L(0); PG8_BAR; PG8_MMA(0, 0, At, B0); PG8_MMA(0, 1, At, B1); PG8_BAR; PG8_SCHED;
            PG8_LDA(At, 1, 1); PG8_STAGE(PG8_SB(1, 0), b3, voffB); PG8_STAGE(PG8_SB(1, 1), b3 + hstepB, voffB); PG8_STAGE(PG8_SA(1, 0), a3, voffA);
            PG8_WAIT_V(8); PG8_WAIT_L(0); PG8_BAR; PG8_MMA(1, 0, At, B0); PG8_MMA(1, 1, At, B1); PG8_BAR; PG8_SCHED;
        }
        if (wr == 0) PG8_BAR;
        if constexpr (FP8) asm volatile("s_nop 15\n\ts_nop 15\n\ts_nop 15\n\ts_nop 15" ::: "memory");
        E(acc, cur, wr, wc, fr, fq);
        if (!has_next) break;
#pragma unroll
        for (int a = 0; a < 2; ++a)
#pragma unroll
            for (int b = 0; b < 2; ++b)
#pragma unroll
                for (int m = 0; m < 4; ++m)
#pragma unroll
                    for (int n = 0; n < 2; ++n) acc[a][b][m][n] = (f32x4){0.f, 0.f, 0.f, 0.f};
        cur = nxt; cA = nA; cB = nB; ++ui;
        if (wr == 1) PG8_BAR;
    }
    PG8_WAIT_V(0);
    PG8_BAR;
#undef PG8_SA
#undef PG8_SB
#undef PG8_STAGE
#undef PG8_LDA
#undef PG8_LD2
#undef PG8_HALF
#undef PG8_LDB
#undef PG8_MMA
#undef PG8_WAIT_V
#undef PG8_WAIT_L
#undef PG8_BAR
#undef PG8_SCHED
}
}
using pg8::Unit;

struct EpiInProj {
    static constexpr bool PERM = true;
    u16* z; const float* bias; float* gates; u16* kc; const float* cosT; const float* sinT; unsigned char* z8;
    DEVI void operator()(const f32x4 (&acc)[2][2][4][2], const Unit& u, int wr, int wc, int fr, int fq) const {
        const int pn = u.pn, row0 = u.pm * 256 + wr * 64 + fr, colt = pn * 256, cl0 = wc * 32 + 8 * fq;
        f32x4 bv[2][2];
#pragma unroll
        for (int bj = 0; bj < 2; ++bj)
#pragma unroll
            for (int n = 0; n < 2; ++n) bv[bj][n] = *(const f32x4*)(bias + colt + cl0 + bj * 128 + 4 * n);
        const float scale = pn < 4 ? 0.0625f : 1.f;
        const bool rope = (pn >= 24 && pn < 32) || pn == 36 || pn == 37 || pn == 40 || pn == 41;
        const bool kcv = pn >= 32 && pn < 36;
#pragma unroll
        for (int ai = 0; ai < 2; ++ai)
#pragma unroll
            for (int m = 0; m < 4; ++m) { const int row = row0 + ai * 128 + m * 16, t = row & 4095;
                f32x4 cs = {1.f, 1.f, 1.f, 1.f}, sn = {0.f, 0.f, 0.f, 0.f};
                if (rope) { cs = *(const f32x4*)(cosT + t * 64 + (cl0 >> 1)); sn = *(const f32x4*)(sinT + t * 64 + (cl0 >> 1)); }
#pragma unroll
                for (int bj = 0; bj < 2; ++bj) {
                    f32x4 v0 = (acc[ai][bj][m][0] + bv[bj][0]) * scale, v1 = (acc[ai][bj][m][1] + bv[bj][1]) * scale;
                    if (rope) {
                        const f32x4 a0 = v0, a1 = v1;
                        v0[0] = a0[0] * cs[0] - a0[1] * sn[0]; v0[1] = a0[1] * cs[0] + a0[0] * sn[0];
                        v0[2] = a0[2] * cs[1] - a0[3] * sn[1]; v0[3] = a0[3] * cs[1] + a0[2] * sn[1];
                        v1[0] = a1[0] * cs[2] - a1[1] * sn[2]; v1[1] = a1[1] * cs[2] + a1[0] * sn[2];
                        v1[2] = a1[2] * cs[3] - a1[3] * sn[3]; v1[3] = a1[3] * cs[3] + a1[2] * sn[3];
                    }
                    u32x4 w; w.x = pk2(v0[0], v0[1]); w.y = pk2(v0[2], v0[3]); w.z = pk2(v1[0], v1[1]); w.w = pk2(v1[2], v1[3]);
                    if (rope) { const int c8 = (pn < 32 ? (pn - 24) * 256 : pn < 38 ? 2048 + (pn - 36) * 256 : 2560 + (pn - 40) * 256) + bj * 128 + cl0;
                        u32x2 w8; w8.x = pk4_fp8(v0[0], v0[1], v0[2], v0[3]); w8.y = pk4_fp8(v1[0], v1[1], v1[2], v1[3]); *(u32x2*)(z8 + (size_t)row * 3072 + c8) = w8; }
                    if (rope) { }
                    else if (kcv) { const int cs_ = (pn - 32) * 256 + bj * 128 + cl0, which = cs_ >> 9, gg = (cs_ >> 7) & 3, dd = cs_ & 127, b = row >> 12;
                        u32x2 w8; w8.x = pk4_fp8(v0[0], v0[1], v0[2], v0[3]); w8.y = pk4_fp8(v1[0], v1[1], v1[2], v1[3]);
                        *(u32x2*)((unsigned char*)kc + ((size_t)((which * 16 + b * 4 + gg) * 4096 + t) * 128 + dd)) = w8; }
                    else *(u32x4*)(z + (size_t)row * NPAD + colt + bj * 128 + cl0) = w;
                }
            }
    }
};
struct EpiF32Tile {
    static constexpr bool PERM = false;
    float* C; int ldc;
    DEVI void operator()(const f32x4 (&acc)[2][2][4][2], const Unit& u, int wr, int wc, int fr, int fq) const {
        const int row0 = u.pm * 256 + wr * 64 + fr, col0 = u.pn * 256 + wc * 32 + 4 * fq;
#pragma unroll
        for (int ai = 0; ai < 2; ++ai)
#pragma unroll
            for (int m = 0; m < 4; ++m) { float* rowp = C + (size_t)(row0 + ai * 128 + m * 16) * ldc + col0;
#pragma unroll
                for (int bj = 0; bj < 2; ++bj)
#pragma unroll
                    for (int n = 0; n < 2; ++n) *(f32x4*)(rowp + bj * 128 + n * 16) = acc[ai][bj][m][n]; }
    }
};
template <bool ADD> struct EpiGate {
    static constexpr bool PERM = true;
    u16* mrg; const u16* z; int gcol0;
    DEVI void operator()(const f32x4 (&acc)[2][2][4][2], const Unit& u, int wr, int wc, int fr, int fq) const {
        const int row0 = u.pm * 256 + wr * 64 + fr, col0 = u.pn * 256 + wc * 32 + 8 * fq;
#pragma unroll
        for (int ai = 0; ai < 2; ++ai)
#pragma unroll
            for (int m = 0; m < 4; ++m) { const int row = row0 + ai * 128 + m * 16;
#pragma unroll
                for (int bj = 0; bj < 2; ++bj) { const int col = col0 + bj * 128;
                    float gz[8], pv[8]; unpack8(*(const u32x4*)(z + (size_t)row * NPAD + gcol0 + col), gz);
                    u16* dst = mrg + (size_t)row * D_ + col;
                    if (ADD) unpack8(*(const u32x4*)dst, pv);
                    float o[8];
#pragma unroll
                    for (int j = 0; j < 4; ++j) { o[j] = acc[ai][bj][m][0][j] * sigm(gz[j]); o[4 + j] = acc[ai][bj][m][1][j] * sigm(gz[4 + j]); }
                    if (ADD) {
#pragma unroll
                        for (int j = 0; j < 8; ++j) o[j] += pv[j]; }
                    u32x4 w; w.x = pk2(o[0], o[1]); w.y = pk2(o[2], o[3]); w.z = pk2(o[4], o[5]); w.w = pk2(o[6], o[7]);
                    *(u32x4*)dst = w; } }
    }
};
struct EpiResid {
    static constexpr bool PERM = false;
    u16* pre; const float* x; const u16* xh;
    DEVI void operator()(const f32x4 (&acc)[2][2][4][2], const Unit& u, int wr, int wc, int fr, int fq) const {
        const int row0 = u.pm * 256 + wr * 64 + fr, col0 = u.pn * 256 + wc * 32 + 4 * fq;
#pragma unroll
        for (int ai = 0; ai < 2; ++ai)
#pragma unroll
            for (int m = 0; m < 4; ++m) { const size_t off = (size_t)(row0 + ai * 128 + m * 16) * D_ + col0;
#pragma unroll
                for (int bj = 0; bj < 2; ++bj)
#pragma unroll
                    for (int n = 0; n < 2; ++n) { f32x4 xv; if (xh) { const u32x2 t_ = *(const u32x2*)(xh + off + bj * 128 + n * 16); xv = (f32x4){__uint_as_float(t_.x << 16), __uint_as_float(t_.x & 0xffff0000u), __uint_as_float(t_.y << 16), __uint_as_float(t_.y & 0xffff0000u)}; } else xv = *(const f32x4*)(x + off + bj * 128 + n * 16);
                        const f32x4 r = xv * ALPHA + acc[ai][bj][m][n];
                        u32x2 w; w.x = pk2(r[0], r[1]); w.y = pk2(r[2], r[3]); *(u32x2*)(pre + off + bj * 128 + n * 16) = w; } }
    }
};
struct EpiSwiGLU {
    static constexpr bool PERM = true;
    unsigned char* H;
    DEVI void operator()(const f32x4 (&acc)[2][2][4][2], const Unit& u, int wr, int wc, int fr, int fq) const {
        const int row0 = u.pm * 256 + wr * 64 + fr, f0 = u.pn * 128 + wc * 16 + 4 * fq;
#pragma unroll
        for (int ai = 0; ai < 2; ++ai)
#pragma unroll
            for (int m = 0; m < 4; ++m) { const int row = row0 + ai * 128 + m * 16;
#pragma unroll
                for (int bj = 0; bj < 2; ++bj) { const f32x4 a = acc[ai][bj][m][0], b = acc[ai][bj][m][1]; float o[4];
#pragma unroll
                    for (int j = 0; j < 4; ++j) o[j] = a[j] * sigm(a[j]) * b[j];
                    *(unsigned*)(H + (size_t)row * DFF + f0 + bj * 64) = pk4_fp8(o[0], o[1], o[2], o[3]); } }
    }
};
struct EpiScaleRow {
    static constexpr bool PERM = true;
    u16* Y; const float* roww;
    DEVI void operator()(const f32x4 (&acc)[2][2][4][2], const Unit& u, int wr, int wc, int fr, int fq) const {
        const int row0 = u.pm * 256 + wr * 64 + fr, col0 = u.pn * 256 + wc * 32 + 8 * fq;
#pragma unroll
        for (int ai = 0; ai < 2; ++ai)
#pragma unroll
            for (int m = 0; m < 4; ++m) { const int row = row0 + ai * 128 + m * 16; const float w_ = roww[row];
#pragma unroll
                for (int bj = 0; bj < 2; ++bj) { const f32x4 v0 = acc[ai][bj][m][0] * w_, v1 = acc[ai][bj][m][1] * w_;
                    u32x4 w; w.x = pk2(v0[0], v0[1]); w.y = pk2(v0[2], v0[3]); w.z = pk2(v1[0], v1[1]); w.w = pk2(v1[2], v1[3]);
                    *(u32x4*)(Y + (size_t)row * D_ + col0 + bj * 128) = w; } }
    }
};

struct CmpOrder {
    int G, c;
    DEVI bool next(int i, Unit& u) const { const int L = i * G + c; if (L >= 32) return false; u.pm = L; u.pn = 0; u.pb = L >> 4; return true; }
};
struct MoeOrder {
    int G, c, ntiles; const volatile LAS int* tstart;
    DEVI bool next(int i, Unit& u) const {
        const int L = i * G + c; if (L >= ntiles * 8) return false;
        const int tile = L >> 3, pn = L & 7;
        const int lk_ = (int)__builtin_amdgcn_mbcnt_hi(~0u, __builtin_amdgcn_mbcnt_lo(~0u, 0u));
        const int e = __popcll(__ballot(lk_ >= 1 && lk_ < 32 && tstart[lk_ & 31] <= tile));
        u.pm = tile; u.pn = pn; u.pb = e * 8 + pn; return true;
    }
};

struct Args { const float* in[26]; float* out; unsigned char* ws; int ph_lo, ph_hi; };
typedef const __attribute__((address_space(4))) Args* KP;
constexpr int PPL = 13;
constexpr int NPH = 1 + 2 * PPL;

DEVI int src_col(int n) {
    if (n < C_NQ) return n;
    if (n < C_KC) { const int r = n - C_NQ, hd = r >> 7, p = r & 127; return S_NQ + hd * 128 + (p >> 1) + 64 * (p & 1); }
    if (n < C_KS) return S_KC + (n - C_KC);
    if (n < C_VS) { const int r = n - C_KS, hd = r >> 7, p = r & 127; return S_KS + hd * 128 + (p >> 1) + 64 * (p & 1); }
    if (n < C_KW) return S_VS + (n - C_VS);
    if (n < C_VW) { const int r = n - C_KW, hd = r >> 7, p = r & 127; return S_KW + hd * 128 + (p >> 1) + 64 * (p & 1); }
    if (n < C_GM) return S_VW + (n - C_VW);
    if (n < C_GT) return S_GM + (n - C_GM);
    const int r = n - C_GT; if (r < 8) return S_MI + r; if (r < 56) return S_NG + (r - 8); return -1;
}

template <class ColPtr>
DEVI void tr_item32(const ColPtr& cp, size_t ldw, int K, u16* WT, int k0, int n0, float* scr, int lane) {
    const float* src = cp(n0 + (lane & 31));
#pragma unroll 8
    for (int i = 0; i < 32; ++i) { const int kk = 2 * i + (lane >> 5); scr[kk * 33 + (lane & 31)] = src ? src[(size_t)(k0 + kk) * ldw] : 0.f; }
    WAVE_SYNC();
    const int c = lane & 7;
#pragma unroll
    for (int j = 0; j < 4; ++j) { const int n = (lane >> 3) + 8 * j; const float* s = scr + (8 * c) * 33 + n;
        u32x4 o; o.x = pk2(s[0 * 33], s[1 * 33]); o.y = pk2(s[2 * 33], s[3 * 33]); o.z = pk2(s[4 * 33], s[5 * 33]); o.w = pk2(s[6 * 33], s[7 * 33]);
        *(u32x4*)(WT + (size_t)(n0 + n) * K + k0 + 8 * c) = o; }
    WAVE_SYNC();
}
template <class ColPtr>
DEVI void tr_item64(const ColPtr& cp, size_t ldw, int K, u16* WT, int k0, int n0, float* scr, int lane) {
    const int nq = lane & 15, kr = lane >> 4;
    const float* src = cp(n0 + 4 * nq);
    f32x4 v[16];
#pragma unroll
    for (int i = 0; i < 16; ++i) v[i] = src ? __builtin_nontemporal_load((const f32x4*)(src + (size_t)(k0 + kr + 4 * i) * ldw)) : (f32x4){0.f, 0.f, 0.f, 0.f};
#pragma unroll
    for (int i = 0; i < 16; ++i) { float* d = scr + (kr + 4 * i) * 65 + 4 * nq; d[0] = v[i][0]; d[1] = v[i][1]; d[2] = v[i][2]; d[3] = v[i][3]; }
    WAVE_SYNC();
    const int c = lane & 7;
#pragma unroll
    for (int j = 0; j < 8; ++j) { const int n = (lane >> 3) + 8 * j; const float* sp = scr + (8 * c) * 65 + n;
        u32x4 o; o.x = pk2(sp[0 * 65], sp[1 * 65]); o.y = pk2(sp[2 * 65], sp[3 * 65]); o.z = pk2(sp[4 * 65], sp[5 * 65]); o.w = pk2(sp[6 * 65], sp[7 * 65]);
        *(u32x4*)(WT + (size_t)(n0 + n) * K + k0 + 8 * c) = o; }
    WAVE_SYNC();
}
template <class ColPtr>
DEVI void tr_item64_f8(const ColPtr& cp, size_t ldw, int K, unsigned char* WT, int k0, int n0, float* scr, int lane, float scale) {
    const int nq = lane & 15, kr = lane >> 4;
    const float* src = cp(n0 + 4 * nq);
    f32x4 v[16];
#pragma unroll
    for (int i = 0; i < 16; ++i) v[i] = src ? __builtin_nontemporal_load((const f32x4*)(src + (size_t)(k0 + kr + 4 * i) * ldw)) : (f32x4){0.f, 0.f, 0.f, 0.f};
#pragma unroll
    for (int i = 0; i < 16; ++i) { float* d = scr + (kr + 4 * i) * 65 + 4 * nq; d[0] = v[i][0]; d[1] = v[i][1]; d[2] = v[i][2]; d[3] = v[i][3]; }
    WAVE_SYNC();
    const int c = lane & 3;
#pragma unroll
    for (int j = 0; j < 4; ++j) { const int n = (lane >> 2) + 16 * j; const float* sp = scr + (16 * c) * 65 + n;
        u32x4 o; o.x = pk4_fp8(sp[0 * 65] * scale, sp[1 * 65] * scale, sp[2 * 65] * scale, sp[3 * 65] * scale); o.y = pk4_fp8(sp[4 * 65] * scale, sp[5 * 65] * scale, sp[6 * 65] * scale, sp[7 * 65] * scale);
        o.z = pk4_fp8(sp[8 * 65] * scale, sp[9 * 65] * scale, sp[10 * 65] * scale, sp[11 * 65] * scale); o.w = pk4_fp8(sp[12 * 65] * scale, sp[13 * 65] * scale, sp[14 * 65] * scale, sp[15 * 65] * scale);
        *(u32x4*)(WT + (size_t)(n0 + n) * K + k0 + 16 * c) = o; }
    WAVE_SYNC();
}
DEVI void tr_item64_f8_rope(const float* Wh  , size_t ldw, int K, unsigned char* WT, int k0, int n0, float* scr, int lane, float scale) {
    const int nq = lane & 15, kr = lane >> 4, hf = nq >> 3, d4 = 4 * (nq & 7);
    const float* src = Wh + hf * 64 + d4;
    f32x4 v[16];
#pragma unroll
    for (int i = 0; i < 16; ++i) v[i] = __builtin_nontemporal_load((const f32x4*)(src + (size_t)(k0 + kr + 4 * i) * ldw));
#pragma unroll
    for (int i = 0; i < 16; ++i) { float* d = scr + (kr + 4 * i) * 65 + 2 * d4 + hf; d[0] = v[i][0]; d[2] = v[i][1]; d[4] = v[i][2]; d[6] = v[i][3]; }
    WAVE_SYNC();
    const int c = lane & 3;
#pragma unroll
    for (int j = 0; j < 4; ++j) { const int n = (lane >> 2) + 16 * j; const float* sp = scr + (16 * c) * 65 + n;
        u32x4 o; o.x = pk4_fp8(sp[0 * 65] * scale, sp[1 * 65] * scale, sp[2 * 65] * scale, sp[3 * 65] * scale); o.y = pk4_fp8(sp[4 * 65] * scale, sp[5 * 65] * scale, sp[6 * 65] * scale, sp[7 * 65] * scale);
        o.z = pk4_fp8(sp[8 * 65] * scale, sp[9 * 65] * scale, sp[10 * 65] * scale, sp[11 * 65] * scale); o.w = pk4_fp8(sp[12 * 65] * scale, sp[13 * 65] * scale, sp[14 * 65] * scale, sp[15 * 65] * scale);
        *(u32x4*)(WT + (size_t)(n0 + n) * K + k0 + 16 * c) = o; }
    WAVE_SYNC();
}
template <class ColPtr>
DEVI void tr_item32_f8(const ColPtr& cp, size_t ldw, int K, unsigned char* WT, int k0, int n0, float* scr, int lane, float scale) {
    const float* src = cp(n0 + (lane & 31));
#pragma unroll 8
    for (int i = 0; i < 32; ++i) { const int kk = 2 * i + (lane >> 5); scr[kk * 33 + (lane & 31)] = src ? src[(size_t)(k0 + kk) * ldw] : 0.f; }
    WAVE_SYNC();
    const int c = lane & 7;
#pragma unroll
    for (int j = 0; j < 4; ++j) { const int n = (lane >> 3) + 8 * j; const float* sp = scr + (8 * c) * 33 + n;
        u32x2 o; o.x = pk4_fp8(sp[0 * 33] * scale, sp[1 * 33] * scale, sp[2 * 33] * scale, sp[3 * 33] * scale); o.y = pk4_fp8(sp[4 * 33] * scale, sp[5 * 33] * scale, sp[6 * 33] * scale, sp[7 * 33] * scale);
        *(u32x2*)(WT + (size_t)(n0 + n) * K + k0 + 8 * c) = o; }
    WAVE_SYNC();
}
struct ColPlain { const float* W; DEVI const float* operator()(int n) const { return W + n; } };
struct ColInProj { const float* W; DEVI const float* operator()(int n) const { const int s = src_col(n); return s >= 0 ? W + s : nullptr; } };
struct ColW13 { const float* w1; const float* w3; DEVI const float* operator()(int n) const { const int f = (n >> 3) * 4 + (n & 3); return ((n >> 2) & 1) ? w3 + f : w1 + f; } };

DEVI void phase_prologue(KP a, unsigned char* lds, int tid, int lane, int wave, int G) {
    unsigned char* ws = a->ws;
    float* cosT = (float*)(ws + WS_ROPE); float* sinT = cosT + 4096 * 64;
    for (int idx = blockIdx.x * 512 + tid; idx < 4096 * 64; idx += G * 512) {
        const int pos = idx >> 6, i = idx & 63;
        const float inv = exp2f(-(float)i * (13.287712379549449f / 64.f));
        const double ang = (double)pos * (double)inv;
        const double k = __builtin_rint(ang * 0.15915494309189535);
        const float r = (float)(ang - k * 6.283185307179586);
        cosT[idx] = cosf(r); sinT[idx] = sinf(r);
    }
    { const float* x = a->in[0]; unsigned char* x8 = ws + WS_X8;
      const size_t NI = (size_t)M_ * D_ / 8, st = (size_t)G * 512; size_t i = (size_t)blockIdx.x * 512 + tid;
      for (; i + 3 * st < NI; i += 4 * st) {
          f32x4 v0[4], v1[4];
#pragma unroll
          for (int u = 0; u < 4; ++u) { v0[u] = *(const f32x4*)(x + (i + u * st) * 8); v1[u] = *(const f32x4*)(x + (i + u * st) * 8 + 4); }
#pragma unroll
          for (int u = 0; u < 4; ++u) { u32x2 w; w.x = pk4_fp8(v0[u][0], v0[u][1], v0[u][2], v0[u][3]); w.y = pk4_fp8(v1[u][0], v1[u][1], v1[u][2], v1[u][3]); *(u32x2*)(x8 + (i + u * st) * 8) = w; } }
      for (; i < NI; i += st) {
          const f32x4 v0 = *(const f32x4*)(x + i * 8), v1 = *(const f32x4*)(x + i * 8 + 4);
          u32x2 w; w.x = pk4_fp8(v0[0], v0[1], v0[2], v0[3]); w.y = pk4_fp8(v1[0], v1[1], v1[2], v1[3]);
          *(u32x2*)(x8 + i * 8) = w; } }
    { float* bp = (float*)(ws + WS_BIASP);
      for (int i = blockIdx.x * 512 + tid; i < 2 * NPAD; i += G * 512) { const int l = i / NPAD, n = i % NPAD, s = src_col(n); bp[i] = s >= 0 ? a->in[2][l * IN_W + s] : 0.f; } }
    { u16* ov = (u16*)(ws + WS_OVL);
      for (int i = blockIdx.x * 512 + tid; i < 256 * 128; i += G * 512) { const int n = i >> 7, j = i & 127;
          const bool on = j < 64 && n < 255 && (16 * n <= 64 * j + 63) && (16 * n + 31 >= 64 * j); ov[i] = on ? (u16)0x3f80 : (u16)0; } }
    { float* wT = (float*)(ws + WS_RWT); const float* rw = a->in[19];
      for (int i = blockIdx.x * 512 + tid; i < 32 * 2048; i += G * 512) { const int e = i >> 11, d = i & 2047; wT[i] = rw[d * 32 + e]; } }
    const int gw = blockIdx.x * 8 + wave, NGW = G * 8;
    { float* b1p = (float*)(ws + WS_MISC + 1536 * 1024);
      for (int task = gw; task < 512; task += NGW) { const int kc = task & 63, fh = (task >> 6) & 1, kv = (task >> 7) & 1, l = task >> 8;
          const float* pos = a->in[kv ? 9 : 4] + (size_t)l * 4096; const float* w1 = a->in[kv ? 10 : 5] + (size_t)l * 4096 * 128; const int f = fh * 64 + lane;
          float s = 0.f;
          for (int k = kc * 64; k < kc * 64 + 64; ++k) s += pos[k] * w1[(size_t)k * 128 + f];
          b1p[((l * 2 + kv) * 64 + kc) * 128 + f] = s; } }
    float* scr = (float*)(lds + wave * 16640);
    constexpr int IT_WIN = 32 * (NPAD / 64), IT_WB = 32 * 32, IT_CW = 32 * 2;
    constexpr int NIT = 2 * IT_WIN + 6 * IT_WB + 8 * IT_CW;
    for (int it = gw; it < NIT; it += NGW) {
        int r = it;
        if (r < 2 * IT_WIN) { const int l = r / IT_WIN; r %= IT_WIN; const int kb = r / (NPAD / 64), nb = r % (NPAD / 64), n0 = nb * 64;
            const ColInProj cp{a->in[1] + (size_t)l * D_ * IN_W}; unsigned char* WT = ws + WS_WIN + (size_t)l * NPAD * D_;
            const bool rope = (n0 >= C_NQ && n0 < C_KC) || (n0 >= C_KS && n0 < C_VS) || (n0 >= C_KW && n0 < C_VW);
            if (rope) { const int segd = n0 >= C_KW ? C_KW : n0 >= C_KS ? C_KS : C_NQ, segs = n0 >= C_KW ? S_KW : n0 >= C_KS ? S_KS : S_NQ;
                const int r_ = n0 - segd, hd = r_ >> 7, m32 = (r_ & 127) >> 6;
                tr_item64_f8_rope(a->in[1] + (size_t)l * D_ * IN_W + segs + hd * 128 + 32 * m32, IN_W, D_, WT, kb * 64, n0, scr, lane, 64.f); }
            else tr_item64_f8(cp, IN_W, D_, WT, kb * 64, n0, scr, lane, 64.f);
            continue; }
        r -= 2 * IT_WIN;
        if (r < 6 * IT_WB) { const int q = r / IT_WB, l = q / 3, w = q % 3; r %= IT_WB; const int kb = r / 32, nb = r % 32;
            if (w <= 1) tr_item64_f8(ColPlain{a->in[14 + w] + (size_t)l * D_ * D_}, D_, D_, ws + WS_WB + (size_t)(l * 3 + w) * D_ * D_ * 2, kb * 64, nb * 64, scr, lane, 64.f);
            else tr_item64(ColPlain{a->in[14 + w] + (size_t)l * D_ * D_}, D_, D_, (u16*)(ws + WS_WB) + (size_t)(l * 3 + w) * D_ * D_, kb * 64, nb * 64, scr, lane);
            continue; }
        r -= 6 * IT_WB;
        { const int q = r / IT_CW, l = q >> 2, kv = (q >> 1) & 1, ab = q & 1; r %= IT_CW; const int kb = r / 2, nb = r % 2;
          const float* w1 = a->in[kv ? 10 : 5] + (size_t)l * 4096 * 128 + (size_t)ab * 2048 * 128;
          tr_item64_f8(ColPlain{w1}, 128, 2048, ws + WS_CW1 + (size_t)(l * 512 + kv * 256 + ab * 128) * 2048, kb * 64, nb * 64, scr, lane, 64.f); }
    }
}
DEVI void phase_experts(KP a, unsigned char* lds, int lane, int wave, int G, int l) {
    unsigned char* ws = a->ws;
    float* scr = (float*)(lds + wave * 16640);
    const int gw = blockIdx.x * 8 + wave, NGW = G * 8;
    constexpr int IT13 = 32 * 32, IT2 = 16 * 32;
    for (int it = gw; it < NEXP * (IT13 + IT2); it += NGW) {
        const int e = it / (IT13 + IT2); int r = it % (IT13 + IT2);
        if (r < IT13) { const int kb = r / 32, nb = r % 32;
            const float* w1 = a->in[21] + ((size_t)l * NEXP + e) * D_ * DFF; const float* w3 = a->in[22] + ((size_t)l * NEXP + e) * D_ * DFF;
            tr_item64_f8(ColW13{w1, w3}, DFF, D_, ws + WS_W13 + (size_t)e * 2048 * D_, kb * 64, nb * 64, scr, lane, 64.f); }
        else { r -= IT13; const int kb = r / 32, nb = r % 32;
            const float* w2 = a->in[23] + ((size_t)l * NEXP + e) * DFF * D_;
            tr_item64_f8(ColPlain{w2}, D_, DFF, ws + WS_W2 + (size_t)e * D_ * DFF, kb * 64, nb * 64, scr, lane, 64.f); }
    }
}

namespace ml {
constexpr int QP = 272, VP = 72;
constexpr int O_Q = 0, O_K = 34816, O_CB = 69632, O_VT = 95744, O_VW = 102656, O_SP = 109568, O_SC = 118784;
constexpr int S_A = 0, S_M = 64, S_WI = 128, S_EN = 192, S_WS = 256, S_DEN = 320, S_DEC = 384;
typedef short s16x4 __attribute__((ext_vector_type(4)));
DEVI bf16x8 frag(const unsigned char* lds, int off) { return *(const bf16x8*)(lds + off); }
DEVI bf16x8 frag_tr(unsigned addr) {
    s16x4 lo, hi;
    asm volatile("ds_read_b64_tr_b16 %0, %2\n\tds_read_b64_tr_b16 %1, %2 offset:2176\n\ts_waitcnt lgkmcnt(0)" : "=&v"(lo), "=&v"(hi) : "v"(addr) : "memory");
    return (bf16x8){lo[0], lo[1], lo[2], lo[3], hi[0], hi[1], hi[2], hi[3]};
}
}
constexpr size_t WS_SP = WS_O, WS_MSC = WS_O + 16 * MiB, WS_MDEC = WS_O + 20 * MiB;
DEVI void phase_mlstm_pre(KP a, unsigned char* lds, const int tid, int G, int first_blk) {
    using namespace ml;
    unsigned char* ws = a->ws;
    const u16* z = (const u16*)(ws + WS_Z); const float* gates = (const float*)(ws + WS_GATES);
    u16* SPg = (u16*)(ws + WS_SP); float* MSC = (float*)(ws + WS_MSC); float* MDEC = (float*)(ws + WS_MDEC);
    const int lane = tid & 63, wave = __builtin_amdgcn_readfirstlane(tid >> 6), g4 = lane >> 4, l15 = lane & 15;
    float* sc = (float*)(lds + O_SC);
    const int nblk = G - first_blk, bi = (int)blockIdx.x - first_blk;
    if (bi < 0) return;
    const int u0 = (int)(((long)bi * 1024) / nblk), u1 = (int)(((long)(bi + 1) * 1024) / nblk);
    float off = 0.f, Gp = 0.f; int have = -1;
    const unsigned qkoff = (unsigned)((tid >> 5) * NPAD + (tid & 31) * 8) * 2u; const int qklds = (tid >> 5) * (QP * 2) + (tid & 31) * 16;
    for (int u = u0; u < u1; ++u) { const int bh = u >> 6, c = u & 63, b = bh >> 2, h = bh & 3;
        const char* zq = (const char*)(z + (size_t)(b * 4096 + c * 64) * NPAD + C_MQ + h * 256);
        const char* zk = (const char*)(z + (size_t)(b * 4096 + c * 64) * NPAD + C_MK + h * 256);
        const float* gp = gates + (size_t)b * 4096 * 64 + h;
#pragma unroll
        for (int k = 0; k < 4; ++k) { *(u32x4*)(lds + O_Q + qklds + k * 16 * QP * 2) = *(const u32x4*)(zq + qkoff + (size_t)k * 16 * NPAD * 2); *(u32x4*)(lds + O_K + qklds + k * 16 * QP * 2) = *(const u32x4*)(zk + qkoff + (size_t)k * 16 * NPAD * 2); }
        if (wave == 0) {
            if (have != u) { off = 0.f; Gp = 0.f;
                if (c > 0) { const float* ch = (const float*)(ws + WS_CHS) + ((size_t)(b * 64) * 4 + h) * 2;
                    float Sv = 0.f, Lv = -INFINITY; if (lane < c) { Sv = ch[lane * 8]; Lv = ch[lane * 8 + 1]; }
#pragma unroll
                    for (int cc = 0; cc < 63; ++cc) { const float s_ = __int_as_float(__builtin_amdgcn_readlane(__float_as_int(Sv), cc)), l_ = __int_as_float(__builtin_amdgcn_readlane(__float_as_int(Lv), cc));
                        Gp = fmaxf(Gp, l_ - off); off += s_; } } }
            const float fg = gp[(size_t)(c * 64 + lane) * 64 + 4], ig = gp[(size_t)(c * 64 + lane) * 64];
            float bc = fminf(fg, 0.f) - log1pf(__expf(-fabsf(fg)));
#pragma unroll
            for (int o = 1; o < 64; o <<= 1) { const float t_ = __shfl_up(bc, o); if (lane >= o) bc += t_; }
            const float Bg = off + bc, gv = ig - Bg; float pm = gv;
#pragma unroll
            for (int o = 1; o < 64; o <<= 1) { const float t_ = __shfl_up(pm, o); if (lane >= o) pm = fmaxf(pm, t_); }
            const float Gt = fmaxf(Gp, pm), Ge = __shfl(Gt, 63);
            sc[S_A + lane] = gv; sc[S_M + lane] = Gt;
            *(f32x4*)(MSC + ((size_t)bh * 4096 + c * 64 + lane) * 4) = (f32x4){__expf(Gp - Gt), __expf(-(Bg + Gt)), __expf(gv - Ge), 0.f};
            if (lane == 0) MDEC[bh * 64 + c] = __expf(Gp - Ge);
            off = __shfl(Bg, 63); Gp = Ge; have = u + 1;
            if (c == 63) have = -1;
        }
        __syncthreads();
        const int tt = wave >> 1, st0 = 2 * (wave & 1); const int t = 16 * tt + l15; const float Gt_ = sc[S_M + t];
        u16* spo = SPg + (size_t)u * 4096 + (size_t)t * 64;
#pragma unroll
        for (int si = 0; si < 2; ++si) { const int st = st0 + si; u32x2 pk_ = {0u, 0u};
            if (st <= tt) { f32x4 sacc = {0.f, 0.f, 0.f, 0.f};
#pragma unroll
                for (int ks = 0; ks < 8; ++ks) sacc = __builtin_amdgcn_mfma_f32_16x16x32_bf16(frag(lds, O_K + (16 * st + l15) * (QP * 2) + (32 * ks + 8 * g4) * 2), frag(lds, O_Q + (16 * tt + l15) * (QP * 2) + (32 * ks + 8 * g4) * 2), sacc, 0, 0, 0);
                float w_[4];
#pragma unroll
                for (int j = 0; j < 4; ++j) { const int sj = 16 * st + 4 * g4 + j; w_[j] = sj <= t ? sacc[j] * __expf(sc[S_A + sj] - Gt_) : 0.f; }
                pk_.x = pk2(w_[0], w_[1]); pk_.y = pk2(w_[2], w_[3]); }
            *(u32x2*)(spo + 16 * st + 4 * g4) = pk_; }
        __syncthreads();
    }
}
DEVI void phase_mlstm(KP a, unsigned char* lds, const int tid, int G) {
    using namespace ml;
    unsigned char* ws = a->ws;
    const u16* z = (const u16*)(ws + WS_Z); u16* hbuf = (u16*)(ws + WS_HG);
    const u16* SPg = (const u16*)(ws + WS_SP); const float* MSC = (const float*)(ws + WS_MSC); const float* MDEC = (const float*)(ws + WS_MDEC);
    const int lane = tid & 63, wave = __builtin_amdgcn_readfirstlane(tid >> 6), g4 = lane >> 4, l15 = lane & 15;
    float* sc = (float*)(lds + O_SC);
    const unsigned lds32 = (unsigned)(uintptr_t)lds;
    const unsigned qkoff = (unsigned)((tid >> 5) * NPAD + (tid & 31) * 8) * 2u;
    const int qklds = (tid >> 5) * (QP * 2) + (tid & 31) * 16;
    const int vs_ = tid >> 3, v4 = (tid & 7) * 4;
    for (int unit0 = blockIdx.x; unit0 < 256; unit0 += G) {
        const int unit = (G % 8 == 0 && G >= 256) ? (((unit0 & 7) + 8 * (unit0 >> 7)) * 16 + ((unit0 >> 3) & 15)) : unit0;
        const int b = unit >> 6, h = (unit >> 4) & 3, jv = unit & 15, bh = b * 4 + h;
        const char* zq = (const char*)(z + (size_t)b * 4096 * NPAD + C_MQ + h * 256);
        const char* zk = (const char*)(z + (size_t)b * 4096 * NPAD + C_MK + h * 256);
        const char* zv = (const char*)(z + (size_t)b * 4096 * NPAD + C_MV + h * 512 + jv * 32);
        const char* spg = (const char*)(SPg + (size_t)bh * 64 * 4096);
        const float* msc = MSC + (size_t)bh * 4096 * 4;
        for (int i = tid; i < 48 * QP / 2; i += 512) ((unsigned*)(lds + O_CB))[i] = 0u;
        for (int i = tid; i < 16 * VP / 2; i += 512) { ((unsigned*)(lds + O_VT + 32 * VP * 2))[i] = i < VP / 2 ? 0x3f803f80u : 0u; ((unsigned*)(lds + O_VW + 32 * VP * 2))[i] = 0u; }
        f32x4 Cacc[2][3];
#pragma unroll
        for (int i = 0; i < 2; ++i)
#pragma unroll
            for (int j = 0; j < 3; ++j) Cacc[i][j] = (f32x4){0.f, 0.f, 0.f, 0.f};
        u32x4 pq[4], pk[4], psp; u32x2 pv; f32x4 pms = {0.f, 0.f, 0.f, 0.f}; float pdec = 0.f, pws = 0.f;
#pragma unroll
        for (int k = 0; k < 4; ++k) { pq[k] = *(const u32x4*)(zq + qkoff + (size_t)k * 16 * NPAD * 2); pk[k] = *(const u32x4*)(zk + qkoff + (size_t)k * 16 * NPAD * 2); }
        pv = *(const u32x2*)(zv + ((size_t)vs_ * NPAD + v4) * 2); pws = msc[(size_t)vs_ * 4 + 2];
        psp = *(const u32x4*)(spg + (size_t)tid * 16);
        if (wave == 0) { pms = *(const f32x4*)(msc + (size_t)lane * 4); pdec = MDEC[bh * 64]; }
        for (int c = 0; c < 64; ++c) {
#pragma unroll
            for (int k = 0; k < 4; ++k) { *(u32x4*)(lds + O_Q + qklds + k * 16 * QP * 2) = pq[k]; *(u32x4*)(lds + O_K + qklds + k * 16 * QP * 2) = pk[k]; }
            { u16* vt = (u16*)(lds + O_VT); u16* vw = (u16*)(lds + O_VW); const unsigned short e0 = (u16)(pv.x & 0xffffu), e1 = (u16)(pv.x >> 16), e2 = (u16)(pv.y & 0xffffu), e3 = (u16)(pv.y >> 16);
              vt[(v4 + 0) * VP + vs_] = e0; vt[(v4 + 1) * VP + vs_] = e1; vt[(v4 + 2) * VP + vs_] = e2; vt[(v4 + 3) * VP + vs_] = e3;
              vw[(v4 + 0) * VP + vs_] = (u16)f2bf(bf2f(e0) * pws); vw[(v4 + 1) * VP + vs_] = (u16)f2bf(bf2f(e1) * pws); vw[(v4 + 2) * VP + vs_] = (u16)f2bf(bf2f(e2) * pws); vw[(v4 + 3) * VP + vs_] = (u16)f2bf(bf2f(e3) * pws); }
            *(u32x4*)(lds + O_SP + (tid >> 3) * (VP * 2) + (tid & 7) * 16) = psp;
            if (wave == 0) { sc[S_WI + lane] = pms[0]; sc[S_EN + lane] = pms[1]; ((u16*)(lds + O_VW))[32 * VP + lane] = (u16)f2bf(pms[2]); if (lane == 0) sc[S_DEC] = pdec; }
            __syncthreads();
            { const int cn = c < 63 ? c + 1 : 63; const size_t ro = (size_t)cn * 64 * NPAD * 2;
#pragma unroll
              for (int k = 0; k < 4; ++k) { pq[k] = *(const u32x4*)(zq + ro + qkoff + (size_t)k * 16 * NPAD * 2); pk[k] = *(const u32x4*)(zk + ro + qkoff + (size_t)k * 16 * NPAD * 2); }
              pv = *(const u32x2*)(zv + ro + ((size_t)vs_ * NPAD + v4) * 2); pws = msc[(size_t)(cn * 64 + vs_) * 4 + 2];
              psp = *(const u32x4*)(spg + (size_t)cn * 8192 + (size_t)tid * 16);
              if (wave == 0) { pms = *(const f32x4*)(msc + (size_t)(cn * 64 + lane) * 4); pdec = MDEC[bh * 64 + cn]; } }
            const int tt1 = wave & 3, vt1 = wave >> 2;
            f32x4 inter1 = {0.f, 0.f, 0.f, 0.f}, inter2 = {0.f, 0.f, 0.f, 0.f};
#pragma unroll
            for (int ks = 0; ks < 8; ++ks) { const bf16x8 aq = frag(lds, O_Q + (16 * tt1 + l15) * (QP * 2) + (32 * ks + 8 * g4) * 2);
                inter1 = __builtin_amdgcn_mfma_f32_16x16x32_bf16(aq, frag(lds, O_CB + (16 * vt1 + l15) * (QP * 2) + (32 * ks + 8 * g4) * 2), inter1, 0, 0, 0);
                inter2 = __builtin_amdgcn_mfma_f32_16x16x32_bf16(aq, frag(lds, O_CB + (32 + l15) * (QP * 2) + (32 * ks + 8 * g4) * 2), inter2, 0, 0, 0); }
            f32x4 num1 = {0.f, 0.f, 0.f, 0.f}, num2 = {0.f, 0.f, 0.f, 0.f};
#pragma unroll
            for (int ks = 0; ks < 2; ++ks) { const bf16x8 ap = frag(lds, O_SP + (16 * tt1 + l15) * (VP * 2) + (32 * ks + 8 * g4) * 2);
                num1 = __builtin_amdgcn_mfma_f32_16x16x32_bf16(ap, frag(lds, O_VT + (16 * vt1 + l15) * (VP * 2) + (32 * ks + 8 * g4) * 2), num1, 0, 0, 0);
                num2 = __builtin_amdgcn_mfma_f32_16x16x32_bf16(ap, frag(lds, O_VT + (32 + l15) * (VP * 2) + (32 * ks + 8 * g4) * 2), num2, 0, 0, 0); }
            { const int row0 = b * 4096 + c * 64;
#pragma unroll
              for (int j = 0; j < 4; ++j) { const int tj = 16 * tt1 + 4 * g4 + j; const float wi = sc[S_WI + tj];
                  float d_ = num2[j] + wi * inter2[j];
                  d_ = __shfl(d_, lane & 48);
                  const float den = fmaxf(fabsf(d_), sc[S_EN + tj]);
                  const float hv = (num1[j] + wi * inter1[j]) / den;
                  const float hn = __int_as_float(__builtin_amdgcn_mov_dpp(__float_as_int(hv), 0xB1, 0xF, 0xF, true));
                  if ((l15 & 1) == 0) *(unsigned*)(hbuf + (size_t)(row0 + tj) * D_ + h * 512 + jv * 32 + 16 * vt1 + l15) = pk2(hv, hn); } }
            { const float decay = sc[S_DEC];
#pragma unroll
              for (int di = 0; di < 2; ++di) { const int dt = 2 * wave + di;
#pragma unroll
                  for (int vt = 0; vt < 3; ++vt) Cacc[di][vt] = Cacc[di][vt] * decay;
#pragma unroll
                  for (int ks = 0; ks < 2; ++ks) { const bf16x8 ak = frag_tr(lds32 + O_K + (32 * ks + 8 * g4 + (l15 >> 2)) * (QP * 2) + (16 * dt + 4 * (lane & 3)) * 2);
#pragma unroll
                      for (int vt = 0; vt < 3; ++vt) Cacc[di][vt] = __builtin_amdgcn_mfma_f32_16x16x32_bf16(ak, frag(lds, O_VW + (16 * vt + l15) * (VP * 2) + (32 * ks + 8 * g4) * 2), Cacc[di][vt], 0, 0, 0); }
              } }
            __syncthreads();
#pragma unroll
            for (int di = 0; di < 2; ++di) { const int dt = 2 * wave + di;
#pragma unroll
                for (int vt = 0; vt < 3; ++vt) { u32x2 w_; w_.x = pk2(Cacc[di][vt][0], Cacc[di][vt][1]); w_.y = pk2(Cacc[di][vt][2], Cacc[di][vt][3]);
                    *(u32x2*)(lds + O_CB + (16 * vt + l15) * (QP * 2) + (16 * dt + 4 * g4) * 2) = w_; } }
        }
        __syncthreads();
    }
}

DEVI void phase_cmp2(KP a, unsigned char* lds, int tid, int G, int l) {
    unsigned char* ws = a->ws;
    const float* U = (const float*)(ws + WS_U); u16* kcmp = (u16*)(ws + WS_KCMP);
    const float* cosT = (const float*)(ws + WS_ROPE); const float* sinT = cosT + 4096 * 64;
    const float* b1part = (const float*)(ws + WS_MISC + 1536 * 1024);
    constexpr int HP = 132;
    float* hs = (float*)lds;
    float* os = hs + 32 * HP;
    float* b1p = os + 32 * HP;
    const int sub = tid >> 7, f = tid & 127, lane = tid & 63, wv = tid >> 6, g4 = lane >> 4, l15 = lane & 15;
    __syncthreads();
    if (tid < 256) { const int which = tid >> 7; float s = a->in[which ? 11 : 6][l * 128 + f]; float p[64];
#pragma unroll
        for (int kc = 0; kc < 64; ++kc) p[kc] = b1part[((l * 2 + which) * 64 + kc) * 128 + f];
#pragma unroll
        for (int kc = 0; kc < 64; ++kc) s += p[kc];
        b1p[tid] = s; }
    __syncthreads();
    for (int unit = blockIdx.x; unit < 256; unit += G) {
        const int which = unit >> 7, rb = which * 4096 + (unit & 127) * 32;
        const float* w2 = a->in[which ? 12 : 7] + (size_t)l * 128 * 128; const float* b2 = a->in[which ? 13 : 8] + l * 128;
        float bw[8][4];
#pragma unroll
        for (int ks = 0; ks < 8; ++ks)
#pragma unroll
            for (int u = 0; u < 4; ++u) bw[ks][u] = w2[(16 * ks + 4 * g4 + u) * 128 + wv * 16 + l15];
        float ua[8], ub[8];
#pragma unroll
        for (int j = 0; j < 8; ++j) { const int r = rb + sub + 4 * j; const bool ok = (r & 255) < 255;
            ua[j] = ok ? U[(size_t)r * 256 + f] : 0.f; ub[j] = ok ? U[(size_t)(r + 1) * 256 + 128 + f] : 0.f; }
        const float b1v = b1p[which * 128 + f];
#pragma unroll
        for (int j = 0; j < 8; ++j) { const int r = rb + sub + 4 * j; float hp = 0.f;
            if ((r & 255) < 255) { hp = ua[j] + ub[j] + b1v;
                const float u_ = 0.7978845608028654f * (hp + 0.044715f * hp * hp * hp); const float th = 1.f - 2.f / (1.f + __expf(2.f * u_)); hp = 0.5f * hp * (1.f + th); }
            hs[(sub + 4 * j) * HP + f] = hp; }
        __syncthreads();
        { f32x4 acc0 = {0.f, 0.f, 0.f, 0.f}, acc1 = {0.f, 0.f, 0.f, 0.f};
#pragma unroll
          for (int ks = 0; ks < 8; ++ks) { const f32x4 a0 = *(const f32x4*)(hs + l15 * HP + 16 * ks + 4 * g4), a1 = *(const f32x4*)(hs + (16 + l15) * HP + 16 * ks + 4 * g4);
#pragma unroll
              for (int u = 0; u < 4; ++u) { acc0 = __builtin_amdgcn_mfma_f32_16x16x4f32(a0[u], bw[ks][u], acc0, 0, 0, 0); acc1 = __builtin_amdgcn_mfma_f32_16x16x4f32(a1[u], bw[ks][u], acc1, 0, 0, 0); } }
          const float bb = b2[wv * 16 + l15];
#pragma unroll
          for (int j = 0; j < 4; ++j) { os[(4 * g4 + j) * HP + wv * 16 + l15] = acc0[j] + bb; os[(16 + 4 * g4 + j) * HP + wv * 16 + l15] = acc1[j] + bb; } }
        __syncthreads();
        if (which == 0) { const int i = f >> 1; float cs[8], sn[8];
#pragma unroll
            for (int j = 0; j < 8; ++j) { const int r = rb + sub + 4 * j, n = r & 255, pos = 16 * n + 31; cs[j] = n < 255 ? cosT[pos * 64 + i] : 1.f; sn[j] = n < 255 ? sinT[pos * 64 + i] : 0.f; }
#pragma unroll
            for (int j = 0; j < 8; ++j) { const int lr = sub + 4 * j, r = rb + lr, n = r & 255; const float x1 = os[lr * HP + i], x2 = os[lr * HP + i + 64];
                float val = (f & 1) ? x2 * cs[j] + x1 * sn[j] : x1 * cs[j] - x2 * sn[j]; if (n == 255) val = 0.f;
                kcmp[(size_t)r * 128 + f] = (u16)f2bf(val); (ws + WS_KCMP8)[(size_t)r * 128 + f] = (unsigned char)(pk4_fp8(val, 0.f, 0.f, 0.f) & 0xffu); } }
        else {
#pragma unroll
            for (int j = 0; j < 8; ++j) { const int lr = sub + 4 * j, r = rb + lr, n = r & 255; float val = os[lr * HP + f]; if (n == 255) val = 0.f;
                kcmp[(size_t)r * 128 + f] = (u16)f2bf(val); } }
        __syncthreads();
    }
}
DEVI void phase_norm(KP a, int lane, int wave, int G, int l) {
    unsigned char* ws = a->ws;
    const u16* z = (const u16*)(ws + WS_Z); u16* hg = (u16*)(ws + WS_HG); const float* mw = a->in[3] + l * 2048;
    const int gw = blockIdx.x * 8 + wave, NGW = G * 8;
    f32x4 mwq[4][2];
#pragma unroll
    for (int h = 0; h < 4; ++h) { mwq[h][0] = *(const f32x4*)(mw + h * 512 + lane * 8); mwq[h][1] = *(const f32x4*)(mw + h * 512 + lane * 8 + 4); }
    for (int row = gw; row < M_; row += NGW) {
        u32x4 hv[4], ov[4];
#pragma unroll
        for (int h = 0; h < 4; ++h) { hv[h] = *(const u32x4*)(hg + (size_t)row * D_ + h * 512 + lane * 8); ov[h] = *(const u32x4*)(z + (size_t)row * NPAD + C_MO + h * 512 + lane * 8); }
#pragma unroll
        for (int h = 0; h < 4; ++h) {
            float v[8]; unpack8(hv[h], v);
            float s = 0.f;
#pragma unroll
            for (int j = 0; j < 8; ++j) s += v[j];
            const float mean = wsum(s) * (1.f / 512.f); float q = 0.f;
#pragma unroll
            for (int j = 0; j < 8; ++j) { v[j] -= mean; q += v[j] * v[j]; }
            const float rstd = 1.f / sqrtf(wsum(q) * (1.f / 512.f) + LN_EPS);
            float og[8]; unpack8(ov[h], og);
            const f32x4 w0 = mwq[h][0], w1 = mwq[h][1];
            const float wv[8] = {w0[0], w0[1], w0[2], w0[3], w1[0], w1[1], w1[2], w1[3]};
            float o[8];
#pragma unroll
            for (int j = 0; j < 8; ++j) o[j] = v[j] * rstd * wv[j] * sigm(og[j]);
            u32x2 w8; w8.x = pk4_fp8(o[0] * 2.f, o[1] * 2.f, o[2] * 2.f, o[3] * 2.f); w8.y = pk4_fp8(o[4] * 2.f, o[5] * 2.f, o[6] * 2.f, o[7] * 2.f);
            *(u32x2*)(ws + WS_XBF + (size_t)row * D_ + h * 512 + lane * 8) = w8; }
    }
}

#ifndef GQ_CV
#define GQ_CV true
#endif
#ifndef GQ_CI
#define GQ_CI true
#endif
#ifndef GQ_W
#define GQ_W true
#endif
#ifndef GQ_S
#define GQ_S false
#endif
namespace att {
constexpr int NW = 8, QBLK = 32, KVBLK = 64, QB = 256, D = 128, WIN = 512;
constexpr int SHM_V = KVBLK * D * 2, SHM_K = KVBLK * D * 2;
constexpr float SCALE = 0.08838834764831845f, THR = 8.f;
typedef short s16x4 __attribute__((ext_vector_type(4)));
typedef float f32x16 __attribute__((ext_vector_type(16)));
enum { M_WIN = 0, M_SEL = 1, M_CMP = 2 };
enum { E_GATED = 0, E_IMP = 1, E_FINAL = 2 };
#define KSWZ8(row, colB) ((row) * 128 + ((colB) ^ (((row) & 7) << 4)))
#define SBAR() __builtin_amdgcn_sched_barrier(0)
DEVI int v_st(int k, int c) { const int kk = (k & ~0xC) | ((k & 4) << 1) | ((k & 8) >> 1); return ((kk >> 3) * 4 + (c >> 5)) * 512 + ((kk & 7) * 32 + (c & 31)) * 2; }
DEVI int v_rd_base(int lane) { return ((lane & 3) << 3) | (((lane >> 2) & 3) << 6) | (((lane >> 4) & 1) << 5) | (((lane >> 5) & 1) << 8); }
constexpr int v_rd_off(int d0, int ks, int half) { return d0 * 512 + ks * 4096 + half * 2048; }
DEVI int crow(int r, int hi) { return (r & 3) + 8 * (r >> 2) + 4 * hi; }
DEVI unsigned cvtpk(float lo, float hi) { unsigned r; asm volatile("v_cvt_pk_bf16_f32 %0, %1, %2" : "=v"(r) : "v"(lo), "v"(hi)); return r; }
DEVI bf16x8 load8(const u16* p) { return *reinterpret_cast<const bf16x8*>(p); }
DEVI int nvis(int pos) { return pos >= 31 ? ((pos - 31) >> 4) + 1 : 0; }
DEVI void mask_tile(f32x16& p0, f32x16& p1, int dq, unsigned W) {
    const float NEG = -__builtin_inff();
#pragma unroll
    for (int r = 0; r < 16; ++r) { const int c = (r & 3) + 8 * (r >> 2);
        if ((unsigned)(dq - c) >= W) p0[r] = NEG;
        if ((unsigned)(dq - c - 32) >= W) p1[r] = NEG; }
}
DEVI void mask_cmp(f32x16& p0, f32x16& p1, int lim) {
    const float NEG = -__builtin_inff();
#pragma unroll
    for (int r = 0; r < 16; ++r) { const int c = (r & 3) + 8 * (r >> 2);
        if (c >= lim) p0[r] = NEG;
        if (c + 32 >= lim) p1[r] = NEG; }
}
DEVI void mask_all(f32x16& p0, f32x16& p1, bool kill) {
    const float NEG = -__builtin_inff();
#pragma unroll
    for (int r = 0; r < 16; ++r) { if (kill) p0[r] = NEG; if (kill) p1[r] = NEG; }
}
DEVI void partialSM(f32x16& p0, f32x16& p1, float& m_reg, float& mn, float& alpha, const bool kill = false) {
    float pmax = p0[0];
#pragma unroll
    for (int r = 1; r < 16; ++r) pmax = fmaxf(pmax, p0[r]);
#pragma unroll
    for (int r = 0; r < 16; ++r) pmax = fmaxf(pmax, p1[r]);
    { auto rr = __builtin_amdgcn_permlane32_swap(__float_as_uint(pmax), __float_as_uint(pmax), false, false);
      pmax = fmaxf(__uint_as_float(rr[0]), __uint_as_float(rr[1])); }
    if (kill) pmax = -__builtin_inff();
    constexpr float C2 = 1.4426950408889634f * SCALE;
    if (__builtin_expect(__all((pmax - m_reg) * SCALE <= THR), 1)) { mn = m_reg; alpha = 1.f; }
    else { mn = fmaxf(m_reg, pmax); alpha = __builtin_amdgcn_exp2f((m_reg - mn) * C2); m_reg = mn; }
    const float mnL = kill ? -__builtin_inff() : -mn * C2;
#pragma unroll
    for (int r = 0; r < 16; ++r) p0[r] = fmaf(p0[r], C2, mnL);
#pragma unroll
    for (int r = 0; r < 16; ++r) p1[r] = fmaf(p1[r], C2, mnL);
#pragma unroll
    for (int r = 0; r < 16; ++r) p0[r] = __builtin_amdgcn_exp2f(p0[r]);
}
DEVI void finishSM(f32x16& p0, f32x16& p1, float alpha, float& l_reg, bf16x8& pa0, bf16x8& pa1, bf16x8& pa2, bf16x8& pa3) {
#pragma unroll
    for (int r = 0; r < 16; ++r) p1[r] = __builtin_amdgcn_exp2f(p1[r]);
    float ps = 0;
#pragma unroll
    for (int r = 0; r < 16; ++r) ps += p0[r];
#pragma unroll
    for (int r = 0; r < 16; ++r) ps += p1[r];
    { auto rr = __builtin_amdgcn_permlane32_swap(__float_as_uint(ps), __float_as_uint(ps), false, false);
      ps = __uint_as_float(rr[0]) + __uint_as_float(rr[1]); }
    l_reg = l_reg * alpha + ps;
#define PK4(P, B_, OUT) do { unsigned a0 = cvtpk(P[B_+0], P[B_+1]), a1 = cvtpk(P[B_+2], P[B_+3]);                          \
        unsigned b0 = cvtpk(P[B_+4], P[B_+5]), b1 = cvtpk(P[B_+6], P[B_+7]);                                             \
        auto r0 = __builtin_amdgcn_permlane32_swap(a0, b0, false, false); auto r1 = __builtin_amdgcn_permlane32_swap(a1, b1, false, false); \
        u32x4 w = {r0[0], r1[0], r0[1], r1[1]}; OUT = *reinterpret_cast<bf16x8*>(&w); } while (0)
    PK4(p0, 0, pa0); PK4(p0, 8, pa1); PK4(p1, 0, pa2); PK4(p1, 8, pa3);
#undef PK4
}
template <int KB, bool SK>
DEVI void qkt(f32x16& p0, f32x16& p1, const char* K_lds, int r32, int hi, const pg8::i32x8_* q8, bool act) {
    if (SK && !act) { const float NEG = -__builtin_inff();
#pragma unroll
        for (int r = 0; r < 16; ++r) { p0[r] = NEG; p1[r] = NEG; } return; }
    const char* kb = K_lds + KB * SHM_K;
    const int one = 0x7f7f7f7f;
    typedef int i4 __attribute__((ext_vector_type(4)));
    { const pg8::i32x8_ a00 = __builtin_shufflevector(*(const i4*)(kb + KSWZ8(r32, 32 * hi)), *(const i4*)(kb + KSWZ8(r32, 32 * hi + 16)), 0, 1, 2, 3, 4, 5, 6, 7);
      const pg8::i32x8_ a10 = __builtin_shufflevector(*(const i4*)(kb + 4096 + KSWZ8(r32, 32 * hi)), *(const i4*)(kb + 4096 + KSWZ8(r32, 32 * hi + 16)), 0, 1, 2, 3, 4, 5, 6, 7);
      asm volatile("s_waitcnt lgkmcnt(0)\n\tv_mfma_scale_f32_32x32x64_f8f6f4 %0, %2, %4, 0, %5, %5 op_sel_hi:[0,0,0]\n\tv_mfma_scale_f32_32x32x64_f8f6f4 %1, %3, %4, 0, %5, %5 op_sel_hi:[0,0,0]"
                   : "=&v"(p0), "=&v"(p1) : "v"(a00), "v"(a10), "v"(q8[0]), "v"(one) : "memory"); }
    { const pg8::i32x8_ a01 = __builtin_shufflevector(*(const i4*)(kb + KSWZ8(r32, 64 + 32 * hi)), *(const i4*)(kb + KSWZ8(r32, 64 + 32 * hi + 16)), 0, 1, 2, 3, 4, 5, 6, 7);
      const pg8::i32x8_ a11 = __builtin_shufflevector(*(const i4*)(kb + 4096 + KSWZ8(r32, 64 + 32 * hi)), *(const i4*)(kb + 4096 + KSWZ8(r32, 64 + 32 * hi + 16)), 0, 1, 2, 3, 4, 5, 6, 7);
      asm volatile("s_waitcnt lgkmcnt(0)\n\tv_mfma_scale_f32_32x32x64_f8f6f4 %0, %2, %4, %0, %5, %5 op_sel_hi:[0,0,0]\n\tv_mfma_scale_f32_32x32x64_f8f6f4 %1, %3, %4, %1, %5, %5 op_sel_hi:[0,0,0]\n\ts_nop 15\n\ts_nop 15\n\ts_nop 15\n\ts_nop 15"
                   : "+v"(p0), "+v"(p1) : "v"(a01), "v"(a11), "v"(q8[1]), "v"(one) : "memory"); }
}
template <int VB, bool SK>
DEVI void pv_tile(f32x16* o, int vb0, bf16x8 pa0, bf16x8 pa1, bf16x8 pa2, bf16x8 pa3, bool act) {
    if (SK && !act) return;
#define TRRD(dst, off) asm volatile("ds_read_b64_tr_b16 %0, %1 offset:%2" : "=&v"(dst) : "v"(vb0), "i"(off) : "memory")
#define PV_D0(d0) do { s16x4 l0, l1, l2, l3, h0, h1, h2, h3; constexpr int b_ = VB * SHM_V + v_rd_off(d0, 0, 0); \
        TRRD(l0, b_); TRRD(h0, b_ + 2048); TRRD(l1, b_ + 4096); TRRD(h1, b_ + 6144); TRRD(l2, b_ + 8192); TRRD(h2, b_ + 10240); TRRD(l3, b_ + 12288); TRRD(h3, b_ + 14336); \
        asm volatile("s_waitcnt lgkmcnt(0)" ::: "memory"); SBAR();   \
        o[d0] = __builtin_amdgcn_mfma_f32_32x32x16_bf16(pa0, (bf16x8){l0[0], l0[1], l0[2], l0[3], h0[0], h0[1], h0[2], h0[3]}, o[d0], 0, 0, 0);   \
        o[d0] = __builtin_amdgcn_mfma_f32_32x32x16_bf16(pa1, (bf16x8){l1[0], l1[1], l1[2], l1[3], h1[0], h1[1], h1[2], h1[3]}, o[d0], 0, 0, 0);   \
        o[d0] = __builtin_amdgcn_mfma_f32_32x32x16_bf16(pa2, (bf16x8){l2[0], l2[1], l2[2], l2[3], h2[0], h2[1], h2[2], h2[3]}, o[d0], 0, 0, 0);   \
        o[d0] = __builtin_amdgcn_mfma_f32_32x32x16_bf16(pa3, (bf16x8){l3[0], l3[1], l3[2], l3[3], h3[0], h3[1], h3[2], h3[3]}, o[d0], 0, 0, 0); } while (0)
    PV_D0(0); PV_D0(1); PV_D0(2); PV_D0(3);
#undef PV_D0
#undef TRRD
}
struct ABlock { const unsigned char* Q; const unsigned char* K; const u16* V; int P0, row0, b, head; };
struct Seam { pg8::i32x8_ q8[2]; u32x4 st_k; bf16x8 st_v0, st_v1; };
struct Epi { const float* gates; u16* dst; const u16* oc; const u16* ow; float* imp; const unsigned long long* sel; };
template <int MODE> DEVI int jlo(int P0) { if (MODE == M_WIN) { const int lowk = P0 - WIN + 1; return lowk > 0 ? lowk / KVBLK : 0; } return 0; }
template <int MODE, int QBE = QB> DEVI int jhi(int P0) {
    if (MODE == M_CMP) { const int n = (nvis(P0 + QBE - 1) + KVBLK - 1) / KVBLK; return n < 1 ? 1 : n; }
    return (P0 + QBE - 1) / KVBLK + 1; }
#define ROWB(p, k0) ((const char*)((p) + (size_t)(k0) * LDK))
#define VMW() asm volatile("s_waitcnt vmcnt(0)" ::: "memory")
#define VMWN(n) asm volatile("s_waitcnt vmcnt(%0)" :: "i"(n) : "memory")
#define SLOAD_H(Kp, Vp, k0) do { const char* vb_ = ROWB(Vp, k0); const char* kb__ = (const char*)(Kp) + (size_t)(k0) * LDK8;                     \
                         S.st_v0 = load8((const u16*)(vb_ + voff0)); S.st_v1 = load8((const u16*)(vb_ + voff1));              \
                         S.st_k = *(const u32x4*)(kb__ + koff8); } while (0)
#define SWRITE_HK(bf) do { *(u32x4*)(K_lds + (bf) * SHM_K + kws) = S.st_k; } while (0)
#define SWRITE_HV(bf) do { *(bf16x8*)(V_lds + (bf) * SHM_V + vst0) = S.st_v0; *(bf16x8*)(V_lds + (bf) * SHM_V + vst1) = S.st_v1; } while (0)
#define SWRITE_H(bf) do { SWRITE_HV(bf); SWRITE_HK(bf); } while (0)
template <int MODE, int LDK, int LDK8, bool GQ = false>
DEVI void prime(const ABlock& cur, char* lds, Seam& S, const int tid) {
    const int wid = __builtin_amdgcn_readfirstlane(tid >> 6), lane = tid & 63, r32 = lane & 31, hi = lane >> 5;
    const int sr = tid >> 4, sc = (tid & 15) * 8, kws = KSWZ8(tid >> 3, (tid & 7) * 16); char* K_lds = lds + 2 * SHM_V;
    const unsigned voff0 = (unsigned)(sr * LDK + sc) * 2u, voff1 = (unsigned)((32 + sr) * LDK + sc) * 2u, koff8 = (unsigned)((tid >> 3) * LDK8 + (tid & 7) * 16);
    const unsigned qoff = GQ ? (unsigned)(((wid & 1) * QBLK + r32) * 3072 + (wid >> 1) * 128 + hi * 32) : (unsigned)((wid * QBLK + r32) * 3072 + hi * 32);
    const int kb0 = jlo<MODE>(cur.P0) * KVBLK;
    { typedef int i4 __attribute__((ext_vector_type(4)));
#pragma unroll
      for (int s_ = 0; s_ < 2; ++s_) S.q8[s_] = __builtin_shufflevector(*(const i4*)(cur.Q + qoff + 64 * s_), *(const i4*)(cur.Q + qoff + 64 * s_ + 16), 0, 1, 2, 3, 4, 5, 6, 7); }
    SLOAD_H(cur.K, cur.V, kb0); VMW(); SWRITE_HK(0);
    __syncthreads();
}
template <int MODE, int EPI, int GK, int LDK, int LDK8, bool SK, bool GQ = false>
DEVI void block(const ABlock& cur, const ABlock& nxt, char* lds, Seam& S, const Epi& E, const int tid) {
    const int wid = __builtin_amdgcn_readfirstlane(tid >> 6), lane = tid & 63, r32 = lane & 31, hi = lane >> 5;
    const int wrow = GQ ? (wid & 1) * QBLK : wid * QBLK, whead = GQ ? cur.head + (wid >> 1) : cur.head;
    const int j_lo = jlo<MODE>(cur.P0), j_hi = jhi<MODE, GQ ? 64 : QB>(cur.P0);
    const int NT = j_hi - j_lo;
    const int kbn = jlo<MODE>(nxt.P0) * KVBLK;
    const int qlo = cur.P0 + wrow, qm = qlo + r32 - 4 * hi;
    char* V_lds = lds; char* K_lds = lds + 2 * SHM_V;
    float* wsl = (float*)(lds + 2 * SHM_V + 2 * SHM_K) + wid * 64; float* li_l = wsl, * al_l = wsl + 32;
    float m_reg = -1e30f, l_reg = 0; f32x16 o[4] = {};
    const int sr = tid >> 4, sc = (tid & 15) * 8, vst0 = v_st(sr, sc), vst1 = v_st(32 + sr, sc), kws = KSWZ8(tid >> 3, (tid & 7) * 16);
    const unsigned voff0 = (unsigned)(sr * LDK + sc) * 2u, voff1 = (unsigned)((32 + sr) * LDK + sc) * 2u, koff8 = (unsigned)((tid >> 3) * LDK8 + (tid & 7) * 16);
    const unsigned qoff = GQ ? (unsigned)(((wid & 1) * QBLK + r32) * 3072 + (wid >> 1) * 128 + hi * 32) : (unsigned)((wid * QBLK + r32) * 3072 + hi * 32);
    const int vb0 = (int)(uintptr_t)V_lds + v_rd_base(lane);
    const unsigned char* Kh = cur.K; const u16* Vh = cur.V;
    unsigned sello = 0u, selhi = 0u; int nvl = 0;
    if (MODE == M_SEL) { const unsigned long long sw = E.sel[(size_t)(cur.b * 4 + (cur.head >> 2)) * 4096 + qlo + r32]; sello = (unsigned)sw; selhi = (unsigned)(sw >> 32); }
    if (MODE == M_CMP) nvl = nvis(qlo + r32) - 4 * hi;
#define RESC(a) do { if (__any((a) < 1.f)) { if (hi == 0) al_l[r32] = (a); asm volatile("s_waitcnt lgkmcnt(0)" ::: "memory");              \
                     for (int d_ = 0; d_ < 4; ++d_) for (int r = 0; r < 16; ++r) o[d_][r] *= al_l[crow(r, hi)]; } } while (0)
#define KBASE(t) ((j_lo + (t)) * KVBLK)
#define ACT(t) (MODE == M_WIN ? (KBASE(t) <= qlo + QBLK - 1 && KBASE(t) + KVBLK - 1 >= qlo - WIN + 1) : MODE == M_SEL ? (KBASE(t) <= qlo + QBLK - 1) : (KBASE(t) < nvis(qlo + QBLK - 1)))
#define MASKT(P0_, P1_, t) do { const int kb_ = KBASE(t); if (!SK || ACT(t)) {                                                             \
        if (MODE == M_WIN) { if (kb_ + KVBLK - 1 > qlo || kb_ <= qlo + QBLK - 1 - WIN) mask_tile(P0_, P1_, qm - kb_, (unsigned)WIN); }       \
        else if (MODE == M_SEL) { if (kb_ + KVBLK - 1 > qlo) mask_tile(P0_, P1_, qm - kb_, 0x40000000u);                                    \
            const int jt_ = j_lo + (t); const unsigned w_ = (jt_ & 32) ? selhi : sello; killf = ((w_ >> (jt_ & 31)) & 1u) == 0u; } \
        else { mask_cmp(P0_, P1_, nvl - kb_); } } } while (0)
    constexpr int NQL = 4;
#define SEAM_K0() do { VMWN(NQL); SWRITE_HK(0); SBAR(); } while (0)
    f32x16 pA0, pA1, pB0, pB1; float mnA, mnB, alA, alB; bf16x8 pa0, pa1, pa2, pa3; bool killf = false;
    SWRITE_HV(0); SBAR();
    if (NT > 1) { SLOAD_H(Kh, Vh, KBASE(1)); }
    SBAR(); qkt<0, SK>(pA0, pA1, K_lds, r32, hi, S.q8, ACT(0));
    MASKT(pA0, pA1, 0); partialSM(pA0, pA1, m_reg, mnA, alA, MODE == M_SEL && killf);
    if (NT > 1) { VMW(); SWRITE_H(1); }
    __syncthreads();
#define HALF_STEP(PX0, PX1, mnX, alX, PY0, PY1, alY, t, KB, VB, SB) do {                                                      \
        SBAR(); qkt<KB, SK>(PX0, PX1, K_lds, r32, hi, S.q8, ACT(t));                                             \
        finishSM(PY0, PY1, alY, l_reg, pa0, pa1, pa2, pa3); SBAR();                                                           \
        if ((t) + 1 < NT) { SLOAD_H(Kh, Vh, KBASE((t) + 1)); SBAR(); }                                               \
        pv_tile<VB, SK>(o, vb0, pa0, pa1, pa2, pa3, ACT((t) - 1)); MASKT(PX0, PX1, (t)); partialSM(PX0, PX1, m_reg, mnX, alX, MODE == M_SEL && killf);                                        \
        __syncthreads();                                                                                                      \
        if ((t) + 1 < NT) { VMW(); SWRITE_H(SB); }                                                                          \
        RESC(alX); __syncthreads(); } while (0)
    for (int t = 1; t + 1 < NT; t += 2) {
        HALF_STEP(pB0, pB1, mnB, alB, pA0, pA1, alA, t, 1, 0, 0);
        HALF_STEP(pA0, pA1, mnA, alA, pB0, pB1, alB, t + 1, 0, 1, 1);
    }
    const bool even = (NT & 1) == 0;
    if (even) { SBAR(); qkt<1, SK>(pB0, pB1, K_lds, r32, hi, S.q8, ACT(NT - 1)); SBAR(); }
    { const unsigned char* nK = nxt.K; const u16* nV = nxt.V; SLOAD_H(nK, nV, kbn); SBAR();
      typedef int i4 __attribute__((ext_vector_type(4)));
#pragma unroll
      for (int s_ = 0; s_ < 2; ++s_) S.q8[s_] = __builtin_shufflevector(*(const i4*)(nxt.Q + qoff + 64 * s_), *(const i4*)(nxt.Q + qoff + 64 * s_ + 16), 0, 1, 2, 3, 4, 5, 6, 7); }
    SBAR();
    finishSM(pA0, pA1, alA, l_reg, pa0, pa1, pa2, pa3); SBAR();
    pv_tile<0, SK>(o, vb0, pa0, pa1, pa2, pa3, ACT(even ? NT - 2 : NT - 1));
    if (even) { MASKT(pB0, pB1, NT - 1); partialSM(pB0, pB1, m_reg, mnB, alB, MODE == M_SEL && killf); __syncthreads(); RESC(alB);
        finishSM(pB0, pB1, alB, l_reg, pa0, pa1, pa2, pa3); SBAR(); pv_tile<1, SK>(o, vb0, pa0, pa1, pa2, pa3, ACT(NT - 1)); }
    SBAR(); SEAM_K0();
    if (hi == 0) { li_l[r32] = l_reg; if (EPI != E_IMP && GK >= 0) al_l[r32] = sigm(E.gates[(size_t)(cur.row0 + wrow + r32) * 64 + 8 + whead * 3 + (GK < 0 ? 0 : GK)]); }
    asm volatile("s_waitcnt lgkmcnt(0)" ::: "memory");
    float rli[16];
#pragma unroll
    for (int r = 0; r < 16; ++r) { const float l_ = li_l[crow(r, hi)]; rli[r] = l_ > 0.f ? __builtin_amdgcn_rcpf(l_) : 0.f; if (EPI != E_IMP && GK >= 0) rli[r] *= al_l[crow(r, hi)]; }
    const size_t ebase = ((size_t)cur.row0 * D_ + whead * 128) * 2;
    const unsigned elane = (unsigned)((wrow + 4 * hi) * D_ + r32) * 2u;
    float* impb = E.imp + ((size_t)(cur.b * 16 + whead) * 4096 + cur.P0) * 64;
    const unsigned ilane = (unsigned)((wrow + 4 * hi) * 64 + r32) * 4u;
    const size_t frb = ((((size_t)(cur.b * 16 + whead) * 128 + ((cur.P0 + wrow) >> 5)) * 64 + lane) * 64) * 2;
    if (EPI == E_GATED) {
#pragma unroll
        for (int i = 0; i < 8; ++i) { const int r0 = 2 * i, r1 = 2 * i + 1; u32x4 w;
            w.x = cvtpk(o[0][r0] * rli[r0], o[1][r0] * rli[r0]); w.y = cvtpk(o[2][r0] * rli[r0], o[3][r0] * rli[r0]);
            w.z = cvtpk(o[0][r1] * rli[r1], o[1][r1] * rli[r1]); w.w = cvtpk(o[2][r1] * rli[r1], o[3][r1] * rli[r1]);
            *(u32x4*)((char*)E.dst + frb + i * 16) = w; }
    } else if (EPI == E_FINAL) {
        u32x4 cq[8], wq[8];
#pragma unroll
        for (int i = 0; i < 8; ++i) { cq[i] = *(const u32x4*)((const char*)E.oc + frb + i * 16); wq[i] = *(const u32x4*)((const char*)E.ow + frb + i * 16); }
#pragma unroll
        for (int r = 0; r < 16; ++r) { const int cr = (r & 3) + 8 * (r >> 2);
#pragma unroll
            for (int d0 = 0; d0 < 4; ++d0) { const float v = o[d0][r] * rli[r];
                const unsigned cw = cq[r >> 1][(r & 1) * 2 + (d0 >> 1)], ww = wq[r >> 1][(r & 1) * 2 + (d0 >> 1)];
                const float cv = __uint_as_float((d0 & 1) ? (cw & 0xffff0000u) : (cw << 16)), wv = __uint_as_float((d0 & 1) ? (ww & 0xffff0000u) : (ww << 16));
                const unsigned off = elane + (unsigned)(cr * D_ + d0 * 32) * 2u;
                const float f = (v + cv + wv) * 8.f;
                const float f1 = __int_as_float(__builtin_amdgcn_mov_dpp(__float_as_int(f), 0x55, 0xF, 0xF, true)), f2 = __int_as_float(__builtin_amdgcn_mov_dpp(__float_as_int(f), 0xAA, 0xF, 0xF, true)),
                            f3 = __int_as_float(__builtin_amdgcn_mov_dpp(__float_as_int(f), 0xFF, 0xF, 0xF, true));
                if ((r32 & 3) == 0) *(unsigned*)((char*)E.dst + (ebase >> 1) + (off >> 1)) = pk4_fp8(f, f1, f2, f3); } }
    } else {
#pragma unroll
        for (int r = 0; r < 16; ++r) { const int cr = (r & 3) + 8 * (r >> 2);
#pragma unroll
            for (int d0 = 0; d0 < 2; ++d0) *(float*)((char*)impb + ilane + (unsigned)(cr * 64 + d0 * 32) * 4u) = o[d0][r] * rli[r]; }
    }
    __syncthreads();
#undef RESC
#undef KBASE
#undef ACT
#undef MASKT
#undef SEAM_K0
#undef HALF_STEP
}
#undef ROWB
#undef VMW
#undef VMWN
#undef SLOAD_H
#undef SWRITE_HK
#undef SWRITE_HV
#undef SWRITE_H
struct Item { int b, head, qb0, qb1; };
template <bool PAIRED> DEVI Item decode(int L) {
    Item it; const int xcd = L & 7, k = L >> 3;
    if (PAIRED) { const int gi = k >> 5, r = k & 31, hl = r >> 3, x = r & 7; const int bg = gi * 8 + xcd; it.b = bg >> 2; it.head = (bg & 3) * 4 + hl; it.qb0 = x; it.qb1 = 15 - x; }
    else { const int gi = k >> 6, r = k & 63, hl = r >> 4, x = r & 15; const int bg = gi * 8 + xcd; it.b = bg >> 2; it.head = (bg & 3) * 4 + hl; it.qb0 = it.qb1 = (hl & 2) ? x : 15 - x; }
    return it;
}
template <bool PAIRED> DEVI Item decode_gq(int L) {
    Item it; const int xcd = L & 7, k = L >> 3;
    if (PAIRED) { const int gi = k >> 5, x = k & 31, bg = gi * 8 + xcd; it.b = bg >> 2; it.head = (bg & 3) * 4; it.qb0 = x; it.qb1 = 63 - x; }
    else { const int gi = k >> 6, x = k & 63, bg = gi * 8 + xcd; it.b = bg >> 2; it.head = (bg & 3) * 4; it.qb0 = it.qb1 = (x & 32) ? 63 - (x & 31) : (x & 31); }
    return it;
}
template <int MODE, bool GQ = false> DEVI ABlock mkref(const Item& it, int pass, const u16* z, const unsigned char* z8, const unsigned char* kcmp8, const u16* vcmp) {
    const int qb = pass ? it.qb1 : it.qb0; ABlock r; r.b = it.b; r.head = it.head; r.P0 = qb * (GQ ? 64 : QB); r.row0 = it.b * 4096 + r.P0;
    r.Q = z8 + (size_t)r.row0 * 3072 + it.head * 128;
    const int g = it.head >> 2;
    if (MODE == M_WIN) { r.K = z8 + (size_t)it.b * 4096 * 3072 + 2560 + g * 128; r.V = z + (size_t)it.b * 4096 * NPAD + C_VW + g * 128; }
    else if (MODE == M_SEL) { r.K = z8 + (size_t)it.b * 4096 * 3072 + 2048 + g * 128; r.V = z + (size_t)it.b * 4096 * NPAD + C_VS + g * 128; }
    else { r.K = kcmp8 + (size_t)(it.b * 4 + g) * 256 * 128; r.V = vcmp; }
    return r;
}
template <int MODE, int EPI, int GK, int LDK, int LDK8, bool SK, bool PAIRED, bool GQ = false>
DEVI void run_pass(const u16* z, const unsigned char* z8, const unsigned char* kcmp8, const u16* vcmp, size_t vcmp_stride, char* lds, const Epi& E, const int tid_in, int G) {
    int tz_ = tid_in; asm volatile("" : "+v"(tz_)); const int tid = tz_;
    constexpr int total = PAIRED ? 512 : 1024;
    int L = blockIdx.x; if (L >= total) return;
    Item it = GQ ? decode_gq<PAIRED>(L) : decode<PAIRED>(L); int pass = 0;
    ABlock cur = mkref<MODE, GQ>(it, 0, z, z8, kcmp8, vcmp + (size_t)(it.b * 4 + (it.head >> 2)) * vcmp_stride);
    Seam S;
    prime<MODE, LDK, LDK8, GQ>(cur, lds, S, tid);
    for (;;) {
        const bool more_pass = pass == 0 && it.qb1 != it.qb0, more_item = L + G < total, last = !more_pass && !more_item;
        Item itn = it; int passn = pass + 1, Ln = L;
        if (!more_pass) { passn = 0; Ln = more_item ? L + G : L; itn = GQ ? decode_gq<PAIRED>(Ln) : decode<PAIRED>(Ln); }
        const ABlock nxt = last ? cur : mkref<MODE, GQ>(itn, passn, z, z8, kcmp8, vcmp + (size_t)(itn.b * 4 + (itn.head >> 2)) * vcmp_stride);
        block<MODE, EPI, GK, LDK, LDK8, SK, GQ>(cur, nxt, lds, S, E, tid);
        if (last) break;
        cur = nxt; it = itn; pass = passn; L = Ln;
    }
}
}

DEVI void phase_nsa1(KP a, unsigned char* lds, const int tid, int G) {
    unsigned char* ws = a->ws;
    const u16* z = (const u16*)(ws + WS_Z); const u16* kcmp = (const u16*)(ws + WS_KCMP); const u16* vcmp = kcmp + (size_t)16 * 256 * 128;
    att::Epi E{(const float*)(ws + WS_GATES), (u16*)(ws + WS_OC), nullptr, nullptr, (float*)(ws + WS_IMP), nullptr};
#ifndef NSA1_PASSES
#define NSA1_PASSES 7
#endif
#ifndef WIN_SK
#define WIN_SK false
#endif
    const unsigned char* z8 = ws + WS_Z8; const unsigned char* kcmp8 = ws + WS_KCMP8;
    if (NSA1_PASSES & 1) att::run_pass<att::M_CMP, att::E_GATED, 0, 128, 128, false, false, GQ_CV>(z, z8, kcmp8, vcmp, (size_t)256 * 128, (char*)lds, E, tid, G);
    __syncthreads();
    if (NSA1_PASSES & 2) att::run_pass<att::M_CMP, att::E_IMP, 0, 128, 128, false, false, GQ_CI>(z, z8, kcmp8, (const u16*)(ws + WS_OVL), 0, (char*)lds, E, tid, G);
    __syncthreads();
    E.dst = (u16*)(ws + WS_OW);
    if (NSA1_PASSES & 4) att::run_pass<att::M_WIN, att::E_GATED, 2, NPAD, 3072, WIN_SK, false, GQ_W>(z, z8, kcmp8, nullptr, 0, (char*)lds, E, tid, G);
}
DEVI void phase_topk(KP a, int lane, int wave, int G) {
    unsigned char* ws = a->ws; const float* imp = (const float*)(ws + WS_IMP); unsigned long long* sel = (unsigned long long*)(ws + WS_SEL);
    const int gw = blockIdx.x * 8 + wave, NGW = G * 8;
    float pf0[4], pf1[4];
    { const int task = gw * 2; if (task < M_ * 4) { const int bg = task >> 12, t = task & 4095, b = bg >> 2, g = bg & 3;
#pragma unroll
        for (int h = 0; h < 4; ++h) { const float* p = imp + ((size_t)(b * 16 + g * 4 + h) * 4096 + t) * 64 + lane; pf0[h] = p[0]; pf1[h] = p[64]; } } }
    for (int task = gw * 2; task < M_ * 4; task += NGW * 2) { const int bg = task >> 12, t = task & 4095;
        const float v0 = (pf0[0] + pf0[1]) + (pf0[2] + pf0[3]), v1 = (pf1[0] + pf1[1]) + (pf1[2] + pf1[3]);
        { const int tn = task + NGW * 2; if (tn < M_ * 4) { const int bgn = tn >> 12, t2 = tn & 4095, b = bgn >> 2, g = bgn & 3;
#pragma unroll
            for (int h = 0; h < 4; ++h) { const float* p = imp + ((size_t)(b * 16 + g * 4 + h) * 4096 + t2) * 64 + lane; pf0[h] = p[0]; pf1[h] = p[64]; } } }
        const int cur0 = t >> 6, cur1 = (t + 1) >> 6;
        const float s0 = ((lane == 0) || (lane == cur0) || (lane == cur0 - 1)) ? INFINITY : (lane <= cur0 ? v0 : -INFINITY);
        const float s1 = ((lane == 0) || (lane == cur1) || (lane == cur1 - 1)) ? INFINITY : (lane <= cur1 ? v1 : -INFINITY);
        int r0 = 0, r1 = 0;
#pragma unroll
        for (int jj = 0; jj < 64; ++jj) { const float a0 = __int_as_float(__builtin_amdgcn_readlane(__float_as_int(s0), jj)), a1 = __int_as_float(__builtin_amdgcn_readlane(__float_as_int(s1), jj));
            r0 += (a0 > s0 || (a0 == s0 && jj < lane)) ? 1 : 0; r1 += (a1 > s1 || (a1 == s1 && jj < lane)) ? 1 : 0; }
        const unsigned long long m0 = __ballot(r0 < 16 && lane <= cur0), m1 = __ballot(r1 < 16 && lane <= cur1);
        if (lane == 0) { sel[(size_t)bg * 4096 + t] = m0; sel[(size_t)bg * 4096 + t + 1] = m1; } }
}
DEVI void phase_nsa2(KP a, unsigned char* lds, const int tid, int G) {
    unsigned char* ws = a->ws;
    const u16* z = (const u16*)(ws + WS_Z);
    att::Epi E{(const float*)(ws + WS_GATES), (u16*)(ws + WS_O), (const u16*)(ws + WS_OC), (const u16*)(ws + WS_OW), nullptr, (const unsigned long long*)(ws + WS_SEL)};
    att::run_pass<att::M_SEL, att::E_FINAL, 1, NPAD, 3072, false, true, GQ_S>(z, ws + WS_Z8, nullptr, nullptr, 0, (char*)lds, E, tid, G);
}

typedef float f32x4_t __attribute__((ext_vector_type(4)));
DEVI void phase_ln1_router(KP a, unsigned char* lds, int tid, int lane, int wave, int G, int l) {
    unsigned char* ws = a->ws;
    const u16* pre = (const u16*)(ws + WS_H); u16* xa = (u16*)(ws + WS_XA); unsigned char* xb = ws + WS_XBF;
    const float* g1 = a->in[17] + l * D_; const float* b1 = a->in[18] + l * D_; const float* rb = a->in[20]; const float* wT = (const float*)(ws + WS_RWT);
    int* tokinfo = (int*)(ws + WS_MISC); int* hist = (int*)(ws + WS_MISC + 1280 * 1024);
    int* be = (int*)lds;
    float* lg = (float*)(lds + 1024);
    const int g4 = lane >> 4, l15 = lane & 15;
    for (int chunk = blockIdx.x; chunk < 256; chunk += G) {
      f32x4 gq[4][2], bq[4][2];
#pragma unroll
      for (int j = 0; j < 4; ++j)
#pragma unroll
          for (int hh = 0; hh < 2; ++hh) { gq[j][hh] = *(const f32x4*)(g1 + j * 512 + lane * 8 + 4 * hh); bq[j][hh] = *(const f32x4*)(b1 + j * 512 + lane * 8 + 4 * hh); }
      u32x4 pc[4], pn[4];
#pragma unroll
      for (int j = 0; j < 4; ++j) pc[j] = *(const u32x4*)(pre + (size_t)(chunk * 64 + wave * 8) * D_ + j * 512 + lane * 8);
      for (int rr = 0; rr < 8; ++rr) {
        const int row = chunk * 64 + wave * 8 + rr;
        if (rr < 7) {
#pragma unroll
            for (int j = 0; j < 4; ++j) pn[j] = *(const u32x4*)(pre + (size_t)(row + 1) * D_ + j * 512 + lane * 8); }
        float v[4][8]; float s = 0.f;
#pragma unroll
        for (int j = 0; j < 4; ++j) { unpack8(pc[j], v[j]); s += ((v[j][0] + v[j][1]) + (v[j][2] + v[j][3])) + ((v[j][4] + v[j][5]) + (v[j][6] + v[j][7])); }
        const float mean = wsum(s) * (1.f / D_); float q = 0.f;
#pragma unroll
        for (int j = 0; j < 4; ++j)
#pragma unroll
            for (int e = 0; e < 8; ++e) { v[j][e] -= mean; q += v[j][e] * v[j][e]; }
        const float rstd = 1.f / sqrtf(wsum(q) * (1.f / D_) + LN_EPS);
#pragma unroll
        for (int j = 0; j < 4; ++j) { const int c0 = j * 512 + lane * 8; float y[8];
#pragma unroll
            for (int e = 0; e < 8; ++e) y[e] = v[j][e] * rstd * gq[j][e >> 2][e & 3] + bq[j][e >> 2][e & 3];
            u32x4 wx; wx.x = pk2(y[0], y[1]); wx.y = pk2(y[2], y[3]); wx.z = pk2(y[4], y[5]); wx.w = pk2(y[6], y[7]); *(u32x4*)(xa + (size_t)row * D_ + c0) = wx;
            u32x2 w8; w8.x = pk4_fp8(y[0], y[1], y[2], y[3]); w8.y = pk4_fp8(y[4], y[5], y[6], y[7]); *(u32x2*)(xb + (size_t)row * D_ + c0) = w8; }
#pragma unroll
        for (int j = 0; j < 4; ++j) pc[j] = pn[j];
      }
      asm volatile("s_waitcnt vmcnt(0)" ::: "memory"); __syncthreads();
      {
          f32x4 racc[4][2];
#pragma unroll
          for (int rt = 0; rt < 4; ++rt) { racc[rt][0] = (f32x4){0.f, 0.f, 0.f, 0.f}; racc[rt][1] = (f32x4){0.f, 0.f, 0.f, 0.f}; }
          const u16* ap = xa + (size_t)(chunk * 64 + l15) * D_ + wave * 256 + 8 * g4; const float* bp = wT + (size_t)l15 * D_ + wave * 256 + 8 * g4;
#pragma unroll 2
          for (int blk = 0; blk < 8; ++blk) { u32x4 ar[4]; f32x4 br[2][2];
#pragma unroll
              for (int rt = 0; rt < 4; ++rt) ar[rt] = *(const u32x4*)(ap + (size_t)rt * 16 * D_ + 32 * blk);
#pragma unroll
              for (int et = 0; et < 2; ++et) { br[et][0] = *(const f32x4*)(bp + (size_t)et * 16 * D_ + 32 * blk); br[et][1] = *(const f32x4*)(bp + (size_t)et * 16 * D_ + 32 * blk + 4); }
#pragma unroll
              for (int rt = 0; rt < 4; ++rt) { float af[8]; unpack8(ar[rt], af);
#pragma unroll
                  for (int e = 0; e < 8; ++e) { racc[rt][0] = __builtin_amdgcn_mfma_f32_16x16x4f32(af[e], br[0][e >> 2][e & 3], racc[rt][0], 0, 0, 0); racc[rt][1] = __builtin_amdgcn_mfma_f32_16x16x4f32(af[e], br[1][e >> 2][e & 3], racc[rt][1], 0, 0, 0); } } }
          f32x4* part = (f32x4*)(lds + 16384);
#pragma unroll
          for (int rt = 0; rt < 4; ++rt) { part[(wave * 8 + rt * 2) * 64 + lane] = racc[rt][0]; part[(wave * 8 + rt * 2 + 1) * 64 + lane] = racc[rt][1]; }
          __syncthreads();
          { f32x4 v = part[wave * 64 + lane];
#pragma unroll
            for (int w2 = 1; w2 < 8; ++w2) v = v + part[(w2 * 8 + wave) * 64 + lane];
#pragma unroll
            for (int j = 0; j < 4; ++j) lg[((wave >> 1) * 16 + 4 * g4 + j) * 33 + (wave & 1) * 16 + l15] = v[j]; }
      }
      __syncthreads();
      if (tid < 64) { const int row = chunk * 64 + tid;
        float aff[32], sel[32];
#pragma unroll
        for (int e = 0; e < 32; ++e) { aff[e] = sigm(lg[tid * 33 + e]); sel[e] = aff[e] + rb[e]; }
        int bg_ = 0; float bs = -INFINITY;
#pragma unroll
        for (int gq = 0; gq < 8; ++gq) { const float s0 = sel[gq * 4], s1 = sel[gq * 4 + 1], s2 = sel[gq * 4 + 2], s3 = sel[gq * 4 + 3];
            const float mx = fmaxf(fmaxf(s0, s1), fmaxf(s2, s3));
            const float m2 = fmaxf(fmaxf(fminf(s0, s1), fminf(s2, s3)), fminf(fmaxf(s0, s1), fmaxf(s2, s3)));
            const float gs = mx + m2; if (gs > bs) { bs = gs; bg_ = gq; } }
        float c0 = 0.f, c1 = 0.f, c2 = 0.f, c3 = 0.f, a0 = 0.f, a1 = 0.f, a2 = 0.f, a3 = 0.f;
#pragma unroll
        for (int gq = 0; gq < 8; ++gq) if (gq == bg_) { c0 = sel[gq * 4]; c1 = sel[gq * 4 + 1]; c2 = sel[gq * 4 + 2]; c3 = sel[gq * 4 + 3]; a0 = aff[gq * 4]; a1 = aff[gq * 4 + 1]; a2 = aff[gq * 4 + 2]; a3 = aff[gq * 4 + 3]; }
        int i1 = 0; float m1 = c0;
        if (c1 > m1) { m1 = c1; i1 = 1; } if (c2 > m1) { m1 = c2; i1 = 2; } if (c3 > m1) { m1 = c3; i1 = 3; }
        int i2 = -1; float m2v = -INFINITY;
        if (i1 != 0 && c0 > m2v) { m2v = c0; i2 = 0; } if (i1 != 1 && c1 > m2v) { m2v = c1; i2 = 1; } if (i1 != 2 && c2 > m2v) { m2v = c2; i2 = 2; } if (i1 != 3 && c3 > m2v) { m2v = c3; i2 = 3; }
        if (i2 < 0) i2 = (i1 == 0) ? 1 : 0;
        float w1 = i1 == 0 ? a0 : i1 == 1 ? a1 : i1 == 2 ? a2 : a3, w2 = i2 == 0 ? a0 : i2 == 1 ? a1 : i2 == 2 ? a2 : a3;
        const float ws_ = w1 + w2; w1 /= ws_; w2 /= ws_;
        const int e1 = bg_ * 4 + i1, e2 = bg_ * 4 + i2;
        int* ti = tokinfo + (size_t)row * 8; ti[0] = e1; ti[2] = e2; ti[4] = __float_as_int(w1); ti[5] = __float_as_int(w2);
        int r1 = 0, r2 = 0, myh = 0;
        const unsigned long long lt = (1ull << lane) - 1ull;
        for (int e = 0; e < 32; ++e) { const unsigned long long mm1 = __ballot(e1 == e), mm2 = __ballot(e2 == e);
            const int below = __popcll(mm1 & lt) + __popcll(mm2 & lt);
            if (e1 == e) r1 = below; if (e2 == e) r2 = below; if (lane == e) myh = __popcll(mm1) + __popcll(mm2); }
        ti[1] = r1; ti[3] = r2;
        if (lane < 32) hist[chunk * 32 + lane] = myh; }
      __syncthreads();
    }
    (void)be;
}
DEVI int moe_base(const unsigned* cnt, int lane, int& base_out) {
    const unsigned c = cnt[lane & 31]; const int tiles = (int)((c + 255u) >> 8); int incl = tiles;
#pragma unroll
    for (int o = 1; o < 32; o <<= 1) { const int t_ = __shfl_up(incl, o); if ((lane & 31) >= o) incl += t_; }
    base_out = (incl - tiles) * 256; return __shfl(incl, 31);
}
DEVI void phase_moe_gather(KP a, unsigned char* lds, int tid, int lane, int wave, int G, int l) {
    unsigned char* ws = a->ws;
    unsigned* cnt = (unsigned*)(ws + WS_CTL) + CW_CNT + l * 32; int* tokinfo = (int*)(ws + WS_MISC); const int* hist = (const int*)(ws + WS_MISC + 1280 * 1024);
    const unsigned char* xb = ws + WS_XBF; unsigned char* xg = ws + WS_XG; float* roww = (float*)(ws + WS_MISC + 1 * MiB);
    int* so = (int*)lds;
    for (int chunk = blockIdx.x; chunk < 256; chunk += G) {
        if (tid < 64) so[tid] = 0;
        __syncthreads();
        { const int e = tid & 31, seg = tid >> 5; int below = 0, all = 0;
          for (int b2 = seg * 16; b2 < seg * 16 + 16; ++b2) { const int h = hist[b2 * 32 + e]; all += h; if (b2 < chunk) below += h; }
          atomicAdd(&so[e], below); atomicAdd(&so[32 + e], all); }
        __syncthreads();
        if (wave == 0) { const int c = so[32 + (lane & 31)]; const int tiles = (c + 255) >> 8; int incl = tiles;
#pragma unroll
            for (int o = 1; o < 32; o <<= 1) { const int t_ = __shfl_up(incl, o); if ((lane & 31) >= o) incl += t_; }
            if (lane < 32) { so[64 + lane] = (incl - tiles) * 256; if (chunk == 0) cnt[lane] = (unsigned)c; } }
        __syncthreads();
        for (int r0 = 0; r0 < 8; r0 += 4) { u32x4 cp[4][2]; int sl0[4], sl1[4];
#pragma unroll
            for (int q = 0; q < 4; ++q) { const int row = chunk * 64 + wave * 8 + r0 + q; const int* ti = tokinfo + (size_t)row * 8;
                const int e0 = ti[0], rk0 = ti[1], e1 = ti[2], rk1 = ti[3]; sl0[q] = so[64 + e0] + so[e0] + rk0; sl1[q] = so[64 + e1] + so[e1] + rk1;
                const u32x4* src = (const u32x4*)(xb + (size_t)row * D_); cp[q][0] = src[lane]; cp[q][1] = src[64 + lane]; }
#pragma unroll
            for (int q = 0; q < 4; ++q) { const int row = chunk * 64 + wave * 8 + r0 + q; int* ti = tokinfo + (size_t)row * 8;
                u32x4* d0 = (u32x4*)(xg + (size_t)sl0[q] * D_); u32x4* d1 = (u32x4*)(xg + (size_t)sl1[q] * D_);
                d0[lane] = cp[q][0]; d0[64 + lane] = cp[q][1]; d1[lane] = cp[q][0]; d1[64 + lane] = cp[q][1];
                if (lane == 0) { roww[sl0[q]] = __int_as_float(ti[4]); roww[sl1[q]] = __int_as_float(ti[5]); ti[6] = sl0[q]; ti[7] = sl1[q]; } } }
        __syncthreads();
    }
}
DEVI void phase_ln2(KP a, int lane, int wave, int G, int l) {
    unsigned char* ws = a->ws;
    const int* tokinfo = (const int*)(ws + WS_MISC);
    const u16* xa = (const u16*)(ws + WS_XA); const u16* Y = (const u16*)(ws + WS_Y); unsigned char* x8 = ws + WS_X8;
    float* xo = a->out; u16* xoh = (u16*)(ws + WS_XB);
    const float* g2 = a->in[24] + l * D_; const float* b2 = a->in[25] + l * D_;
    const int gw = blockIdx.x * 8 + wave, NGW = G * 8;
    int row = gw; if (row >= M_) return;
    f32x4 gq[4][2], bq[4][2];
#pragma unroll
    for (int j = 0; j < 4; ++j)
#pragma unroll
        for (int hh = 0; hh < 2; ++hh) { gq[j][hh] = *(const f32x4*)(g2 + j * 512 + lane * 8 + 4 * hh); bq[j][hh] = *(const f32x4*)(b2 + j * 512 + lane * 8 + 4 * hh); }
    u32x4 cx[4], c1[4], c2[4], nx[4], n1[4], n2[4];
    int s1 = tokinfo[(size_t)row * 8 + 6], s2 = tokinfo[(size_t)row * 8 + 7];
#pragma unroll
    for (int j = 0; j < 4; ++j) { const int c0 = j * 512 + lane * 8; cx[j] = *(const u32x4*)(xa + (size_t)row * D_ + c0); c1[j] = *(const u32x4*)(Y + (size_t)s1 * D_ + c0); c2[j] = *(const u32x4*)(Y + (size_t)s2 * D_ + c0); }
    int rn = row + NGW, t1 = 0, t2 = 0;
    if (rn < M_) { t1 = tokinfo[(size_t)rn * 8 + 6]; t2 = tokinfo[(size_t)rn * 8 + 7]; }
    for (;;) {
        const bool more = rn < M_;
        if (more) {
#pragma unroll
            for (int j = 0; j < 4; ++j) { const int c0 = j * 512 + lane * 8; nx[j] = *(const u32x4*)(xa + (size_t)rn * D_ + c0); n1[j] = *(const u32x4*)(Y + (size_t)t1 * D_ + c0); n2[j] = *(const u32x4*)(Y + (size_t)t2 * D_ + c0); } }
        const int rnn = rn + NGW; int u1 = 0, u2 = 0;
        if (rnn < M_) { u1 = tokinfo[(size_t)rnn * 8 + 6]; u2 = tokinfo[(size_t)rnn * 8 + 7]; }
        float v[4][8]; float s = 0.f;
#pragma unroll
        for (int j = 0; j < 4; ++j) { float xv[8], y1[8], y2[8]; unpack8(cx[j], xv); unpack8(c1[j], y1); unpack8(c2[j], y2);
#pragma unroll
            for (int e = 0; e < 8; ++e) { v[j][e] = xv[e] * ALPHA + (y1[e] + y2[e]); }
            s += ((v[j][0] + v[j][1]) + (v[j][2] + v[j][3])) + ((v[j][4] + v[j][5]) + (v[j][6] + v[j][7])); }
        const float mean = wsum(s) * (1.f / D_); float q = 0.f;
#pragma unroll
        for (int j = 0; j < 4; ++j)
#pragma unroll
            for (int e = 0; e < 8; ++e) { v[j][e] -= mean; q += v[j][e] * v[j][e]; }
        const float rstd = 1.f / sqrtf(wsum(q) * (1.f / D_) + LN_EPS);
#pragma unroll
        for (int j = 0; j < 4; ++j) { const int c0 = j * 512 + lane * 8; float y[8];
#pragma unroll
            for (int e = 0; e < 8; ++e) y[e] = v[j][e] * rstd * gq[j][e >> 2][e & 3] + bq[j][e >> 2][e & 3];
            if (l == 0) { u32x4 wo; wo.x = pk2(y[0], y[1]); wo.y = pk2(y[2], y[3]); wo.z = pk2(y[4], y[5]); wo.w = pk2(y[6], y[7]); *(u32x4*)(xoh + (size_t)row * D_ + c0) = wo;
                u32x2 w8; w8.x = pk4_fp8(y[0], y[1], y[2], y[3]); w8.y = pk4_fp8(y[4], y[5], y[6], y[7]); *(u32x2*)(x8 + (size_t)row * D_ + c0) = w8; }
            else { *(f32x4*)(xo + (size_t)row * D_ + c0) = (f32x4){y[0], y[1], y[2], y[3]}; *(f32x4*)(xo + (size_t)row * D_ + c0 + 4) = (f32x4){y[4], y[5], y[6], y[7]}; } }
        if (!more) break;
        row = rn; rn = rnn; t1 = u1; t2 = u2;
#pragma unroll
        for (int j = 0; j < 4; ++j) { cx[j] = nx[j]; c1[j] = n1[j]; c2[j] = n2[j]; }
    }
}

constexpr int NGEMM = 15360;
DEVI void phase_gates(KP a, unsigned char* lds, int tid, int G, int l) {
    using pg8::i32x8_; using pg8::i32x4_;
    unsigned char* ws = a->ws;
    const unsigned char* X = ws + WS_X8; const unsigned char* W = ws + WS_WIN + (size_t)l * NPAD * D_ + (size_t)NGEMM * D_;
    const float* bias = (const float*)(ws + WS_BIASP) + l * NPAD + NGEMM; float* gates = (float*)(ws + WS_GATES);
    const int lane = tid & 63, wave = tid >> 6, g4 = lane >> 4, l15 = lane & 15;
    f32x4* red = (f32x4*)lds;
    float* gl = (float*)(lds + 131072);
    const int sclW = 0x79797979, sclA = 0x7f7f7f7f;
    for (int unit = blockIdx.x; unit < M_ / 64; unit += G) {
        const unsigned char* ap = X + (size_t)(unit * 64 + l15) * D_ + wave * 256 + 32 * g4;
        const unsigned char* bp = W + (size_t)l15 * D_ + wave * 256 + 32 * g4;
        i32x8_ af[4][2], bf[4][2];
#pragma unroll
        for (int t = 0; t < 4; ++t)
#pragma unroll
            for (int ks = 0; ks < 2; ++ks) {
                af[t][ks] = __builtin_shufflevector(*(const i32x4_*)(ap + (size_t)t * 16 * D_ + 128 * ks), *(const i32x4_*)(ap + (size_t)t * 16 * D_ + 128 * ks + 16), 0, 1, 2, 3, 4, 5, 6, 7);
                bf[t][ks] = __builtin_shufflevector(*(const i32x4_*)(bp + (size_t)t * 16 * D_ + 128 * ks), *(const i32x4_*)(bp + (size_t)t * 16 * D_ + 128 * ks + 16), 0, 1, 2, 3, 4, 5, 6, 7); }
        f32x4 acc[4][4];
#pragma unroll
        for (int rt = 0; rt < 4; ++rt)
#pragma unroll
            for (int ct = 0; ct < 4; ++ct) acc[rt][ct] = (f32x4){0.f, 0.f, 0.f, 0.f};
#pragma unroll
        for (int ks = 0; ks < 2; ++ks)
#pragma unroll
            for (int rt = 0; rt < 4; ++rt)
#pragma unroll
                for (int ct = 0; ct < 4; ++ct) asm volatile("v_mfma_scale_f32_16x16x128_f8f6f4 %0, %1, %2, %0, %3, %4 op_sel_hi:[0,0,0]" : "+v"(acc[rt][ct]) : "v"(bf[ct][ks]), "v"(af[rt][ks]), "v"(sclW), "v"(sclA));
        asm volatile("s_nop 15\n\ts_nop 15\n\ts_nop 15\n\ts_nop 15" ::: "memory");
#pragma unroll
        for (int rt = 0; rt < 4; ++rt)
#pragma unroll
            for (int ct = 0; ct < 4; ++ct) red[(wave * 16 + rt * 4 + ct) * 64 + lane] = acc[rt][ct];
        __syncthreads();
#pragma unroll
        for (int q = 0; q < 2; ++q) { const int tile = 2 * wave + q, rt = tile >> 2, ct = tile & 3, row = unit * 64 + rt * 16 + l15, col = ct * 16 + 4 * g4;
            f32x4 v = red[tile * 64 + lane];
#pragma unroll
            for (int w = 1; w < 8; ++w) v = v + red[(w * 16 + tile) * 64 + lane];
            if (col < 56) { const f32x4 gv_ = v + *(const f32x4*)(bias + col); *(f32x4*)(gates + (size_t)row * 64 + col) = gv_;
                if (col < 8) *(f32x4*)(gl + (rt * 16 + l15) * 8 + col) = gv_; } }
        __syncthreads();
        if (wave < 4) {
            const float ig = gl[lane * 8 + wave], fg = gl[lane * 8 + 4 + wave];
            float bc = fminf(fg, 0.f) - log1pf(__expf(-fabsf(fg)));
#pragma unroll
            for (int o = 1; o < 64; o <<= 1) { const float t_ = __shfl_up(bc, o); if (lane >= o) bc += t_; }
            const float L_ = wmax(ig - bc), S_ = __shfl(bc, 63);
            if (lane == 0) { float* ch = (float*)(ws + WS_CHS) + ((size_t)unit * 4 + wave) * 2; ch[0] = S_; ch[1] = L_; } }
        __syncthreads();
    }
}
__global__ void __launch_bounds__(512, 2) fwd_kernel(Args args) {
    extern __shared__ __attribute__((aligned(16))) unsigned char lds_raw[];
    LAS unsigned char* ldsl = (LAS unsigned char*)lds_raw;
    unsigned char* lds = lds_raw;
    const int G = gridDim.x;
    const int wave_sg = __builtin_amdgcn_readfirstlane(threadIdx.x >> 6);
    unsigned char* ws = args.ws;
    volatile LAS unsigned* lctl = (volatile LAS unsigned*)(ldsl + LDSCTL_OFF);
    if (wave_sg == 0) { const int l_ = (int)__builtin_amdgcn_mbcnt_hi(~0u, __builtin_amdgcn_mbcnt_lo(~0u, 0u)); for (int u = l_; u < 256; u += 64) lctl[u] = 0u; }
    __syncthreads();
    const int lo = args.ph_lo, hi = args.ph_hi;
    const bool one = (hi - lo) > 1;
    XcdBarrier bar; bar.bar = (unsigned*)(ws + WS_CTL) + CW_BAR; bar.x = 0; bar.st = lctl; bar.wv = wave_sg;
    if (one) bar = xcd_barrier_post((unsigned*)(ws + WS_CTL) + CW_BAR, lctl, wave_sg);
#ifndef ONLY_PHASE
#define ONLY_PHASE -1
#endif
#define LAUNDER() int wv_ = wave_sg; asm volatile("" : "+s"(wv_)); int tz_ = wv_ * 64 + (int)__builtin_amdgcn_mbcnt_hi(~0u, __builtin_amdgcn_mbcnt_lo(~0u, 0u)); asm volatile("" : "+v"(tz_)); const int tid = tz_, lane = tz_ & 63, wave = wv_; (void)tid; (void)lane; (void)wave; \
    unsigned long long kp_ = (unsigned long long)__builtin_amdgcn_kernarg_segment_ptr(); asm volatile("" : "+s"(kp_)); \
    const KP la = (KP)kp_; unsigned char* const ws = la->ws; (void)ws
#define INR(k) (lo <= (k) && (k) < hi)
#define IN0 ((ONLY_PHASE < 0 || ONLY_PHASE == 0) && INR(0))
#define INL(j) ((ONLY_PHASE < 0 || ONLY_PHASE == 1 + (j)) && INR(pb + (j)))
#define SEAM(k) do { if (INR(k) && INR((k) + 1)) xcd_barrier(bar); else __syncthreads(); } while (0)

    if (IN0) { LAUNDER(); phase_prologue(la, lds, tid, lane, wave, G); phase_experts(la, lds, lane, wave, G, 0); SEAM(0); }

    for (int l = 0; l < 2; ++l) {
        const int pb = 1 + l * PPL;
        if (INL(0)) { LAUNDER();
            pg8::Gemm g{(const u16*)(ws + WS_X8), (const u16*)(ws + WS_WIN + (size_t)l * NPAD * D_), D_ / 2, D_ / 2, 0x79797979, 0x7f7f7f7f};
            pg8::StaticOrder S; S.init(M_, NGEMM, G, (int)blockIdx.x);
            EpiInProj E{(u16*)(ws + WS_Z), (const float*)(ws + WS_BIASP) + l * NPAD, (float*)(ws + WS_GATES), (u16*)(ws + WS_KC), (const float*)(ws + WS_ROPE), (const float*)(ws + WS_ROPE) + 4096 * 64, ws + WS_Z8};
            pg8::gemm_phase<EpiInProj, pg8::StaticOrder, true>(ldsl, g, S, E, tid);
            __syncthreads();
            phase_gates(la, lds, tid, G, l);
            SEAM(pb + 0);
        }
        if (INL(1)) { LAUNDER();
            pg8::Gemm g{(const u16*)(ws + WS_KC), (const u16*)(ws + WS_CW1 + (size_t)l * 512 * 2048), 1024, 1024, 0x79797979, 0x7f7f7f7f};
            CmpOrder S{G, (int)blockIdx.x};
            EpiF32Tile E{(float*)(ws + WS_U), 256};
            pg8::gemm_phase<EpiF32Tile, CmpOrder, true>(ldsl, g, S, E, tid);
            phase_mlstm_pre(la, lds, tid, G, G >= 64 ? 32 : 0);
            SEAM(pb + 1);
        }
        if (INL(2)) { LAUNDER(); phase_mlstm(la, lds, tid, G); phase_cmp2(la, lds, tid, G, l); SEAM(pb + 2); }
        if (INL(3)) { LAUNDER(); phase_nsa1(la, lds, tid, G); phase_norm(la, lane, wave, G, l); SEAM(pb + 3); }
        if (INL(4)) { LAUNDER(); phase_topk(la, lane, wave, G); SEAM(pb + 4); }
        if (INL(5)) { LAUNDER(); phase_nsa2(la, lds, tid, G); __syncthreads();
            {
            pg8::Gemm g{(const u16*)(ws + WS_XBF), (const u16*)(ws + WS_WB) + (size_t)(l * 3 + 0) * D_ * D_, D_ / 2, D_ / 2, 0x79797979, 0x7e7e7e7e};
            pg8::StaticOrder S; S.init(M_, D_, G, (int)blockIdx.x);
            EpiGate<false> E{(u16*)(ws + WS_MRG), (const u16*)(ws + WS_Z), C_GM};
            pg8::gemm_phase<EpiGate<false>, pg8::StaticOrder, true>(ldsl, g, S, E, tid);
            }
            SEAM(pb + 5);
        }
        if (INL(6)) { LAUNDER();
            pg8::Gemm g{(const u16*)(ws + WS_O), (const u16*)(ws + WS_WB) + (size_t)(l * 3 + 1) * D_ * D_, D_ / 2, D_ / 2, 0x79797979, 0x7c7c7c7c};
            pg8::StaticOrder S; S.init(M_, D_, G, (int)blockIdx.x);
            EpiGate<true> E{(u16*)(ws + WS_MRG), (const u16*)(ws + WS_Z), C_GM + 2048};
            pg8::gemm_phase<EpiGate<true>, pg8::StaticOrder, true>(ldsl, g, S, E, tid);
            SEAM(pb + 6);
        }
        if (INL(7)) { LAUNDER();
            pg8::Gemm g{(const u16*)(ws + WS_MRG), (const u16*)(ws + WS_WB) + (size_t)(l * 3 + 2) * D_ * D_, D_, D_};
            pg8::StaticOrder S; S.init(M_, D_, G, (int)blockIdx.x);
            EpiResid E{(u16*)(ws + WS_H), la->in[0], l == 0 ? (const u16*)nullptr : (const u16*)(ws + WS_XB)};
            pg8::gemm_phase(ldsl, g, S, E, tid);
            SEAM(pb + 7);
        }
        if (INL(8)) { LAUNDER(); phase_ln1_router(la, lds, tid, lane, wave, G, l); SEAM(pb + 8); }
        if (INL(9)) { LAUNDER(); phase_moe_gather(la, lds, tid, lane, wave, G, l); SEAM(pb + 9); }
        if (INL(10) || INL(11)) { LAUNDER();
            const unsigned* cnt = (const unsigned*)(ws + WS_CTL) + CW_CNT + l * 32;
            volatile LAS int* tstart = (volatile LAS int*)(lctl + 16);
            if (wave == 0) { int mybase; const int nt_ = moe_base(cnt, lane, mybase); if (lane < 32) tstart[lane] = mybase >> 8; if (lane == 32) tstart[32] = nt_; }
            __syncthreads();
            const int ntiles = tstart[32];
            if (INL(10)) { LAUNDER();
                pg8::Gemm g{(const u16*)(ws + WS_XG), (const u16*)(ws + WS_W13), D_ / 2, D_ / 2, 0x79797979, 0x7f7f7f7f};
                MoeOrder S{G, (int)blockIdx.x, ntiles, tstart};
                EpiSwiGLU E{ws + WS_HB};
                pg8::gemm_phase<EpiSwiGLU, MoeOrder, true>(ldsl, g, S, E, tid);
                SEAM(pb + 10);
            }
            if (INL(11)) { LAUNDER();
                pg8::Gemm g{(const u16*)(ws + WS_HB), (const u16*)(ws + WS_W2), DFF / 2, DFF / 2, 0x79797979, 0x7f7f7f7f};
                MoeOrder S{G, (int)blockIdx.x, ntiles, tstart};
                EpiScaleRow E{(u16*)(ws + WS_Y), (const float*)(ws + WS_MISC + 1 * MiB)};
                pg8::gemm_phase<EpiScaleRow, MoeOrder, true>(ldsl, g, S, E, tid);
                SEAM(pb + 11);
            }
        }
        if (INL(12)) { LAUNDER(); phase_ln2(la, lane, wave, G, l); if (l == 0) phase_experts(la, lds, lane, wave, G, 1); SEAM(pb + 12); }
    }
#undef INR
#undef IN0
#undef INL
#undef SEAM
}

extern "C" void kernel_launch(void* const* d_in, const int* in_sizes, int n_in, void* d_out, int out_size, void* d_ws, size_t ws_size, hipStream_t stream) {
    static int grid = 0;
    if (grid == 0) {
        if (n_in != 26 || out_size != M_ * D_ || ws_size < WS_END5) { fprintf(stderr, "kernel_launch: unexpected problem (n_in %d out %d ws %zu need %zu)\n", n_in, out_size, ws_size, (size_t)WS_END); grid = -1; return; }
        int dev = 0, cus = 0;
        if (hipGetDevice(&dev) != hipSuccess || hipDeviceGetAttribute(&cus, hipDeviceAttributeMultiprocessorCount, dev) != hipSuccess) { grid = -1; return; }
        if (hipFuncSetAttribute((const void*)fwd_kernel, hipFuncAttributeMaxDynamicSharedMemorySize, LDS_BYTES) != hipSuccess) { fprintf(stderr, "kernel_launch: hipFuncSetAttribute failed\n"); grid = -1; return; }
        int per_cu = 0;
        if (hipOccupancyMaxActiveBlocksPerMultiprocessor(&per_cu, (const void*)fwd_kernel, 512, LDS_BYTES) != hipSuccess || per_cu < 1) fprintf(stderr, "kernel_launch: occupancy query reports %d\n", per_cu);
        (void)hipGetLastError();
        grid = cus;
    }
    if (grid < 0) return;
    (void)hipMemsetAsync((char*)d_ws + WS_CTL, 0, CTL_BYTES, stream);
    Args a{};
    for (int i = 0; i < 26; ++i) a.in[i] = (const float*)d_in[i];
    a.out = (float*)d_out; a.ws = (unsigned char*)d_ws;
#if MK_ONE_LAUNCH
    a.ph_lo = 0; a.ph_hi = NPH;
    hipLaunchKernelGGL(fwd_kernel, dim3(grid), dim3(512), LDS_BYTES, stream, a);
#else
#ifdef DBG_STOP
    for (int p = 0; p < DBG_STOP; ++p) { a.ph_lo = p; a.ph_hi = p + 1; hipLaunchKernelGGL(fwd_kernel, dim3(grid), dim3(512), LDS_BYTES, stream, a); }
    (void)hipMemcpyAsync(d_out, (char*)d_ws + DBG_SRC, (size_t)M_ * D_ * 4, hipMemcpyDeviceToDevice, stream);
#else
#ifndef REP_N
#define REP_N 1
#define REP_LO 99
#define REP_HI 99
#endif
    for (int p = 0; p < NPH; ++p) {
        const int j = p == 0 ? -1 : (p - 1) % PPL;
        if (j == REP_LO) { for (int r = 0; r < REP_N; ++r) for (int q = p; q <= p + (REP_HI - REP_LO); ++q) { a.ph_lo = q; a.ph_hi = q + 1; hipLaunchKernelGGL(fwd_kernel, dim3(grid), dim3(512), LDS_BYTES, stream, a); } p += REP_HI - REP_LO; continue; }
        a.ph_lo = p; a.ph_hi = p + 1; hipLaunchKernelGGL(fwd_kernel, dim3(grid), dim3(512), LDS_BYTES, stream, a); }
#endif
#endif
}
```

```cpp
#include <hip/hip_runtime.h>
#include <cstdio>
#include <cstdint>

#ifndef MK_ONE_LAUNCH
#define MK_ONE_LAUNCH 1
#endif

#define LAS __attribute__((address_space(3)))
#define DEVI __device__ __forceinline__
typedef unsigned short u16;
typedef short bf16x8 __attribute__((ext_vector_type(8)));
typedef float f32x4 __attribute__((ext_vector_type(4)));
typedef float f32x2 __attribute__((ext_vector_type(2)));
typedef unsigned u32x4 __attribute__((ext_vector_type(4)));
typedef unsigned u32x2 __attribute__((ext_vector_type(2)));

constexpr int T_ = 4096, D_ = 2048, M_ = 16384;
constexpr int NPAD = 15616, IN_W = 15416;
constexpr int C_MQ = 0, C_MK = 1024, C_MV = 2048, C_MO = 4096, C_NQ = 6144, C_KC = 8192, C_VC = 8704, C_KS = 9216, C_VS = 9728, C_KW = 10240,
              C_VW = 10752, C_GM = 11264, C_GT = 15360;
constexpr int S_MI = 6144, S_NQ = 6152, S_KC = 8200, S_KS = 9224, S_VS = 9736, S_KW = 10248, S_VW = 10760, S_NG = 11272, S_GM = 11320;
constexpr float ALPHA = 1.4142135623730951f;
constexpr float LN_EPS = 1e-5f;
constexpr int NEXP = 32, DFF = 1024;
constexpr int MOE_ROWS = 40960;

constexpr size_t MiB = 1u << 20;
constexpr size_t WS_CTL = 0, CTL_BYTES = 1 * MiB;
constexpr size_t WS_ROPE = 1 * MiB;
constexpr size_t WS_BIASP = 3 * MiB;
constexpr size_t WS_WIN = 4 * MiB;
constexpr size_t WS_WB = 126 * MiB;
constexpr size_t WS_CW1 = 174 * MiB;
constexpr size_t WS_W13 = 178 * MiB;
constexpr size_t WS_W2 = 434 * MiB;
constexpr size_t WS_XBF = 562 * MiB;
constexpr size_t WS_XA = 626 * MiB;
constexpr size_t WS_XB = 754 * MiB;
constexpr size_t WS_Z = 882 * MiB;
constexpr size_t WS_GATES = 1370 * MiB;
constexpr size_t WS_KC = 1374 * MiB;
constexpr size_t WS_U = 1406 * MiB;
constexpr size_t WS_KCMP = 1414 * MiB;
constexpr size_t WS_MISC = 1416 * MiB;
constexpr size_t WS_CHS = WS_MISC + 1800 * 1024;
constexpr size_t WS_H = 1418 * MiB;
constexpr size_t WS_HG = 1546 * MiB;
constexpr size_t WS_O = 1610 * MiB;
constexpr size_t WS_MRG = 1674 * MiB;
constexpr size_t WS_END = 1738 * MiB, WS_END2 = 1739 * MiB;
constexpr size_t WS_OC = WS_H, WS_OW = WS_H + 64 * MiB, WS_IMP = WS_MRG, WS_OVL = WS_MISC + 1728 * 1024, WS_SEL = WS_END;
constexpr size_t WS_RWT = WS_MISC + 512 * 1024;
constexpr size_t WS_X8 = 1739 * MiB, WS_END3 = 1771 * MiB;
constexpr size_t WS_Z8 = 1771 * MiB, WS_KCMP8 = 1819 * MiB, WS_END4 = 1820 * MiB;
constexpr size_t WS_OCG = 1820 * MiB, WS_END5 = 1884 * MiB;
constexpr size_t WS_XG = WS_Z, WS_HB = WS_Z + 160 * MiB, WS_Y = WS_Z + 240 * MiB;
constexpr int CW_BAR = 4096;
constexpr int CW_CNT = 16384;
constexpr int CW_B1P = 16640;

constexpr int RING_BYTES = 131072;
constexpr int LDSCTL_OFF = 143360;
constexpr int LDS_BYTES = 147456;

DEVI float bf2f(unsigned h) { return __uint_as_float(h << 16); }
DEVI unsigned f2bf(float f) { unsigned u = __float_as_uint(f); return (u + 0x7fffu + ((u >> 16) & 1u)) >> 16; }
DEVI unsigned pk2(float lo, float hi) { unsigned r; asm("v_cvt_pk_bf16_f32 %0, %1, %2" : "=v"(r) : "v"(lo), "v"(hi)); return r; }
DEVI unsigned pk4_fp8(float a, float b, float c, float d) {
    a = __builtin_amdgcn_fmed3f(a, 448.f, -448.f); b = __builtin_amdgcn_fmed3f(b, 448.f, -448.f); c = __builtin_amdgcn_fmed3f(c, 448.f, -448.f); d = __builtin_amdgcn_fmed3f(d, 448.f, -448.f);
    int w = __builtin_amdgcn_cvt_pk_fp8_f32(a, b, 0, false); w = __builtin_amdgcn_cvt_pk_fp8_f32(c, d, w, true); return (unsigned)w; }
DEVI float sigm(float x) { return 1.f / (1.f + __expf(-x)); }
DEVI float wsum(float v) {
#pragma unroll
    for (int o = 32; o; o >>= 1) v += __shfl_xor(v, o);
    return v; }
DEVI float wmax(float v) {
#pragma unroll
    for (int o = 32; o; o >>= 1) v = fmaxf(v, __shfl_xor(v, o));
    return v; }
#define WAVE_SYNC() asm volatile("s_waitcnt lgkmcnt(0)" ::: "memory")
DEVI void unpack8(u32x4 v, float* f) {
    f[0] = __uint_as_float(v.x << 16); f[1] = __uint_as_float(v.x & 0xffff0000u); f[2] = __uint_as_float(v.y << 16); f[3] = __uint_as_float(v.y & 0xffff0000u);
    f[4] = __uint_as_float(v.z << 16); f[5] = __uint_as_float(v.z & 0xffff0000u); f[6] = __uint_as_float(v.w << 16); f[7] = __uint_as_float(v.w & 0xffff0000u); }

#define XB_TMO      128
#define XB_XCNT(j)  (256  + 64 * (j))
#define XB_XSUB(j)  (1280 + 64 * (j))
#define XB_XGEN(j)  (2304 + 64 * (j))
#define XB_TOP      3328
#define XB_TOPGEN   3392
#define XCD_BAR_WORDS 3456
#define XB_SPIN_CAP (1u << 21)
DEVI unsigned xb_ld(unsigned* p)              { return __hip_atomic_load(p, __ATOMIC_RELAXED, __HIP_MEMORY_SCOPE_AGENT); }
DEVI unsigned xb_add(unsigned* p, unsigned v) { return __hip_atomic_fetch_add(p, v, __ATOMIC_RELAXED, __HIP_MEMORY_SCOPE_AGENT); }
DEVI unsigned xb_xcc_id() { return (unsigned)__builtin_amdgcn_s_getreg((3 << 11) | 20) & 0xFu; }
#define XB_SPIN(cond, bar) do { unsigned _sp = 0; while (cond) { __builtin_amdgcn_s_sleep(1); \
    if ((++_sp & 255u) == 0u) { if (xb_ld(&(bar)[XB_TMO])) break; if (_sp > XB_SPIN_CAP) { atomicAdd(&(bar)[XB_TMO], 1u); break; } } } } while (0)
struct XcdBarrier { unsigned* bar; unsigned x; volatile LAS unsigned* st; int wv; };
DEVI bool xb_leader(int wv) { return wv == 0 && __builtin_amdgcn_mbcnt_hi(~0u, __builtin_amdgcn_mbcnt_lo(~0u, 0u)) == 0u; }
DEVI XcdBarrier xcd_barrier_post(unsigned* bar, volatile LAS unsigned* st, int wv) {
    XcdBarrier b; b.bar = bar; b.x = xb_xcc_id(); b.st = st; b.wv = wv;
    if (xb_leader(wv)) (void)xb_add(&bar[XB_XCNT(b.x)], 1u);
    return b;
}
DEVI void xcd_barrier_complete(unsigned* bar, unsigned x, unsigned& nloc, unsigned& nx) {
    const unsigned G = gridDim.x * gridDim.y * gridDim.z;
    unsigned sum, cnt, mine, sp = 0u;
    for (;;) {
        sum = 0u; cnt = 0u; mine = 0u;
#pragma unroll
        for (unsigned j = 0; j < 16; ++j) { const unsigned c = xb_ld(&bar[XB_XCNT(j)]); sum += c; cnt += (c > 0u) ? 1u : 0u; mine = (j == x) ? c : mine; }
        if (sum == G) break;
        __builtin_amdgcn_s_sleep(1);
        if ((++sp & 255u) == 0u) { if (xb_ld(&bar[XB_TMO])) break; if (sp > XB_SPIN_CAP) { atomicAdd(&bar[XB_TMO], 1u); break; } }
    }
    nloc = mine > 0u ? mine : 1u; nx = cnt > 0u ? cnt : 1u;
}
__device__ __noinline__ void xcd_barrier_impl(unsigned* bar_, unsigned x_, volatile LAS unsigned* st_, int wv_) {
    XcdBarrier b; b.bar = bar_; b.x = x_; b.st = st_; b.wv = wv_;
    asm volatile("s_waitcnt vmcnt(0)" ::: "memory");
    __syncthreads();
    if (xb_leader(b.wv)) {
        unsigned* bar = b.bar;
        __builtin_amdgcn_s_waitcnt(0);
        unsigned nloc = b.st[0], nx = b.st[1];
        if (nloc == 0u) { xcd_barrier_complete(bar, b.x, nloc, nx); b.st[0] = nloc; b.st[1] = nx; }
        const unsigned old = xb_add(&bar[XB_XSUB(b.x)], 1u);
        const unsigned gen = old / nloc;
        if (old + 1u == (gen + 1u) * nloc) {
            __builtin_amdgcn_fence(__ATOMIC_RELEASE, "agent");
            asm volatile("s_waitcnt vmcnt(0)" ::: "memory");
            const unsigned og = xb_add(&bar[XB_TOP], 1u);
            const unsigned tg = og / nx;
            if (og + 1u == (tg + 1u) * nx) xb_add(&bar[XB_TOPGEN], 1u);
            else XB_SPIN(xb_ld(&bar[XB_TOPGEN]) == tg, bar);
            __builtin_amdgcn_fence(__ATOMIC_ACQUIRE, "agent");
            xb_add(&bar[XB_XGEN(b.x)], 1u);
            asm volatile("s_waitcnt vmcnt(0)" ::: "memory");
        } else {
            XB_SPIN(xb_ld(&bar[XB_XGEN(b.x)]) == gen, bar);
            __builtin_amdgcn_fence(__ATOMIC_ACQUIRE, "agent");
            asm volatile("s_waitcnt vmcnt(0)" ::: "memory");
        }
    }
    __syncthreads();
}

DEVI void xcd_barrier(const XcdBarrier& b) { xcd_barrier_impl(b.bar, b.x, b.st, b.wv); }

namespace pg8 {
constexpr int BM = 256, BK = 64, HALF = 128, HTB = HALF * BK * 2, STAGE_BYTES = 8 * HTB, NXCD = 8, WGM = 4;
__host__ __device__ __forceinline__ int lds_byte(int r, int c) { const int st = (r >> 4) * 2 + (c >> 5), rr = r & 15, cc = c & 31, ob = rr * 64 + cc * 2; return st * 1024 + (ob ^ (((ob >> 9) & 1) << 5)); }
__host__ __device__ __forceinline__ void stage_rc(int b, int& R, int& C) { const int st = b / 1024, sb = b % 1024, swz = sb ^ (((sb >> 9) & 1) << 5); R = (st >> 1) * 16 + swz / 64; C = (st & 1) * 32 + (swz % 64) / 2; }
__host__ __device__ __forceinline__ int perm32(int rho) { const int n = rho >> 4, i = rho & 15; return 8 * (i >> 2) + 4 * n + (i & 3); }

struct Unit { int pm, pn, pb; };
struct Gemm { const u16* A; const u16* Bt; int lda, K; int sclW = 0x7f7f7f7f, sclA = 0x7f7f7f7f; };

struct StaticOrder {
    int nM, nN, nwg, G, c;
    DEVI void init(int M, int N, int G_, int c_) { nM = M / BM; nN = N / BM; nwg = nM * nN; G = G_; c = c_; }
    DEVI bool next(int i, Unit& u) const {
        const long L = (long)i * G + c; if (L >= nwg) return false;
        int wgid = (int)L; { const int q = nwg / NXCD, r = nwg % NXCD, xcd = wgid % NXCD, off = wgid / NXCD; wgid = (xcd < r ? xcd * (q + 1) : r * (q + 1) + (xcd - r) * q) + off; }
        const int nig = WGM * nN, gid = wgid / nig, fm = gid * WGM, gsz = (nM - fm) < WGM ? (nM - fm) : WGM;
        u.pm = fm + ((wgid % nig) % gsz); u.pn = (wgid % nig) / gsz; u.pb = u.pn; return true;
    }
};

typedef int i32x4_ __attribute__((ext_vector_type(4)));
typedef int i32x8_ __attribute__((ext_vector_type(8)));
template <class Epi, class Sched, bool FP8 = false>
DEVI void gemm_phase(LAS unsigned char* lds, const Gemm g, const Sched& S, const Epi& E, const int tid) {
    const int wid = __builtin_amdgcn_readfirstlane(tid >> 6), lane = tid & 63, wr = wid >> 2, wc = wid & 3, fr = lane & 15, fq = lane >> 4;
    const int K = g.K, nt = K / BK, lda = g.lda; const int sclW = g.sclW, sclA = g.sclA; (void)sclW; (void)sclA;
    unsigned voffA[2], voffB[2];
#pragma unroll
    for (int i = 0; i < 2; ++i) { int R, C; stage_rc(tid * 16 + i * 8192, R, C); const int Rb = Epi::PERM ? ((R & ~31) + perm32(R & 31)) : R;
        voffA[i] = (unsigned)(R * lda + C) * 2u; voffB[i] = (unsigned)(Rb * K + C) * 2u; }
    const size_t kstep = (size_t)(BK * 2);
    const size_t hstepA = (size_t)HALF * lda * 2, tstepA = 2 * hstepA;
    const size_t hstepB = (size_t)HALF * K * 2, tstepB = 2 * hstepB;
    const unsigned ldsw = (unsigned)wid * 1024u;
    const int aoff = lds_byte(wr * 64 + fr, fq * 8), boff = lds_byte(wc * 32 + fr, fq * 8);
#define PG8_SA(b, h) (((b) * 2 + (h)) * HTB)
#define PG8_SB(b, h) ((4 + (b) * 2 + (h)) * HTB)
#define PG8_STAGE(bufoff, gbase, voff) do { _Pragma("unroll") for (int _i = 0; _i < 2; ++_i) \
        __builtin_amdgcn_global_load_lds((const unsigned*)((const char*)(gbase) + (voff)[_i]), (LAS unsigned*)(lds + (bufoff) + ldsw + _i * 8192), 16, 0, 0); } while (0)
#define PG8_LD2(addr) __builtin_shufflevector(*(const LAS i32x4_*)(addr), *(const LAS i32x4_*)((addr) + 1024), 0, 1, 2, 3, 4, 5, 6, 7)
#define PG8_LDA(dst, b, h) do { _Pragma("unroll") for (int m = 0; m < 4; ++m) dst[m] = PG8_LD2(lds + PG8_SA(b, h) + aoff + m * 2048); } while (0)
#define PG8_LDB(dst, b, h) do { _Pragma("unroll") for (int n = 0; n < 2; ++n) dst[n] = PG8_LD2(lds + PG8_SB(b, h) + boff + n * 2048); } while (0)
#define PG8_HALF(v, k) ((k) == 0 ? (bf16x8)__builtin_shufflevector(v, v, 0, 1, 2, 3) : (bf16x8)__builtin_shufflevector(v, v, 4, 5, 6, 7))
#define PG8_MMA(ai, bj, At, Bt) do { __builtin_amdgcn_s_setprio(1); _Pragma("unroll") for (int m = 0; m < 4; ++m) _Pragma("unroll") for (int n = 0; n < 2; ++n) { \
        if constexpr (FP8) { asm volatile("v_mfma_scale_f32_16x16x128_f8f6f4 %0, %1, %2, %0, %3, %4 op_sel_hi:[0,0,0]" : "+v"(acc[ai][bj][m][n]) : "v"(Bt[n]), "v"(At[m]), "v"(sclW), "v"(sclA)); } \
        else { _Pragma("unroll") for (int k = 0; k < 2; ++k) acc[ai][bj][m][n] = __builtin_amdgcn_mfma_f32_16x16x32_bf16(PG8_HALF(Bt[n], k), PG8_HALF(At[m], k), acc[ai][bj][m][n], 0, 0, 0); } } \
        __builtin_amdgcn_s_setprio(0); } while (0)
#define PG8_WAIT_V(n) asm volatile("s_waitcnt vmcnt(" #n ")" ::: "memory")
#define PG8_WAIT_L(n) asm volatile("s_waitcnt lgkmcnt(" #n ")" ::: "memory")
#define PG8_BAR __builtin_amdgcn_s_barrier()
#define PG8_SCHED __builtin_amdgcn_sched_barrier(0)
    Unit cur, nxt; int ui = 0;
    if (!S.next(0, cur)) return;
    f32x4 acc[2][2][4][2];
#pragma unroll
    for (int a = 0; a < 2; ++a)
#pragma unroll
        for (int b = 0; b < 2; ++b)
#pragma unroll
            for (int m = 0; m < 4; ++m)
#pragma unroll
                for (int n = 0; n < 2; ++n) acc[a][b][m][n] = (f32x4){0.f, 0.f, 0.f, 0.f};
    i32x8_ At[4], B0[2], B1[2];
    const char* cA = (const char*)g.A + (size_t)cur.pm * tstepA; const char* cB = (const char*)g.Bt + (size_t)cur.pb * tstepB;
    PG8_STAGE(PG8_SB(0, 0), cB, voffB); PG8_STAGE(PG8_SB(0, 1), cB + hstepB, voffB); PG8_STAGE(PG8_SA(0, 0), cA, voffA); PG8_STAGE(PG8_SA(0, 1), cA + hstepA, voffA);
    if (wr == 1) PG8_BAR;
    PG8_WAIT_V(2); PG8_BAR;
    PG8_STAGE(PG8_SB(1, 0), cB + kstep, voffB); PG8_STAGE(PG8_SA(1, 0), cA + kstep, voffA); PG8_STAGE(PG8_SB(1, 1), cB + hstepB + kstep, voffB);
    PG8_WAIT_V(6); PG8_BAR;
    for (;;) {
        const bool has_next = S.next(ui + 1, nxt);
        const char* nA = has_next ? (const char*)g.A + (size_t)nxt.pm * tstepA : cA; const char* nB = has_next ? (const char*)g.Bt + (size_t)nxt.pb * tstepB : cB;
        for (int t = 0; t < nt; t += 2) {
            const bool last = (t == nt - 2);
            const char* a1 = cA + (size_t)(t + 1) * kstep;
            const char* a2 = last ? nA : cA + (size_t)(t + 2) * kstep; const char* b2 = last ? nB : cB + (size_t)(t + 2) * kstep;
            const char* a3 = a2 + kstep; const char* b3 = b2 + kstep;
            PG8_LDB(B0, 0, 0); PG8_LDB(B1, 0, 1); PG8_SCHED; PG8_LDA(At, 0, 0); PG8_STAGE(PG8_SA(1, 1), a1 + hstepA, voffA);
            PG8_WAIT_V(8); PG8_WAIT_L(0); PG8_BAR; PG8_MMA(0, 0, At, B0); PG8_MMA(0, 1, At, B1); PG8_BAR; PG8_SCHED;
            PG8_LDA(At, 0, 1); PG8_STAGE(PG8_SB(0, 0), b2, voffB); PG8_STAGE(PG8_SB(0, 1), b2 + hstepB, voffB); PG8_STAGE(PG8_SA(0, 0), a2, voffA);
            PG8_WAIT_V(8); PG8_WAIT_L(0); PG8_BAR; PG8_MMA(1, 0, At, B0); PG8_MMA(1, 1, At, B1); PG8_BAR; PG8_SCHED;
            PG8_LDB(B0, 1, 0); PG8_LDB(B1, 1, 1); PG8_SCHED; PG8_LDA(At, 1, 0); PG8_STAGE(PG8_SA(0, 1), a2 + hstepA, voffA);
            PG8_WAIT_V(8); PG8_WAIT_L(0); PG8_BAR; PG8_MMA(0, 0, At, B0); PG8_MMA(0, 1, At, B1); PG8_BAR; PG8_SCHED;
            PG8_LDA(At, 1, 1); PG8_STAGE(PG8_SB(1, 0), b3, voffB); PG8_STAGE(PG8_SB(1, 1), b3 + hstepB, voffB); PG8_STAGE(PG8_SA(1, 0), a3, voffA);
            PG8_WAIT_V(8); PG8_WAIT_L(0); PG8_BAR; PG8_MMA(1, 0, At, B0); PG8_MMA(1, 1, At, B1); PG8_BAR; PG8_SCHED;
        }
        if (wr == 0) PG8_BAR;
        if constexpr (FP8) asm volatile("s_nop 15\n\ts_nop 15\n\ts_nop 15\n\ts_nop 15" ::: "memory");
        E(acc, cur, wr, wc, fr, fq);
        if (!has_next) break;
#pragma unroll
        for (int a = 0; a < 2; ++a)
#pragma unroll
            for (int b = 0; b < 2; ++b)
#pragma unroll
                for (int m = 0; m < 4; ++m)
#pragma unroll
                    for (int n = 0; n < 2; ++n) acc[a][b][m][n] = (f32x4){0.f, 0.f, 0.f, 0.f};
        cur = nxt; cA = nA; cB = nB; ++ui;
        if (wr == 1) PG8_BAR;
    }
    PG8_WAIT_V(0);
    PG8_BAR;
#undef PG8_SA
#undef PG8_SB
#undef PG8_STAGE
#undef PG8_LDA
#undef PG8_LD2
#undef PG8_HALF
#undef PG8_LDB
#undef PG8_MMA
#undef PG8_WAIT_V
#undef PG8_WAIT_L
#undef PG8_BAR
#undef PG8_SCHED
}
}
using pg8::Unit;

struct EpiInProj {
    static constexpr bool PERM = true;
    u16* z; const float* bias; float* gates; u16* kc; const float* cosT; const float* sinT; unsigned char* z8;
    DEVI void operator()(const f32x4 (&acc)[2][2][4][2], const Unit& u, int wr, int wc, int fr, int fq) const {
        const int pn = u.pn, row0 = u.pm * 256 + wr * 64 + fr, colt = pn * 256, cl0 = wc * 32 + 8 * fq;
        f32x4 bv[2][2];
#pragma unroll
        for (int bj = 0; bj < 2; ++bj)
#pragma unroll
            for (int n = 0; n < 2; ++n) bv[bj][n] = *(const f32x4*)(bias + colt + cl0 + bj * 128 + 4 * n);
        const float scale = pn < 4 ? 0.0625f : 1.f;
        const bool rope = (pn >= 24 && pn < 32) || pn == 36 || pn == 37 || pn == 40 || pn == 41;
        const bool kcv = pn >= 32 && pn < 36;
#pragma unroll
        for (int ai = 0; ai < 2; ++ai)
#pragma unroll
            for (int m = 0; m < 4; ++m) { const int row = row0 + ai * 128 + m * 16, t = row & 4095;
                f32x4 cs = {1.f, 1.f, 1.f, 1.f}, sn = {0.f, 0.f, 0.f, 0.f};
                if (rope) { cs = *(const f32x4*)(cosT + t * 64 + (cl0 >> 1)); sn = *(const f32x4*)(sinT + t * 64 + (cl0 >> 1)); }
#pragma unroll
                for (int bj = 0; bj < 2; ++bj) {
                    f32x4 v0 = (acc[ai][bj][m][0] + bv[bj][0]) * scale, v1 = (acc[ai][bj][m][1] + bv[bj][1]) * scale;
                    if (rope) {
                        const f32x4 a0 = v0, a1 = v1;
                        v0[0] = a0[0] * cs[0] - a0[1] * sn[0]; v0[1] = a0[1] * cs[0] + a0[0] * sn[0];
                        v0[2] = a0[2] * cs[1] - a0[3] * sn[1]; v0[3] = a0[3] * cs[1] + a0[2] * sn[1];
                        v1[0] = a1[0] * cs[2] - a1[1] * sn[2]; v1[1] = a1[1] * cs[2] + a1[0] * sn[2];
                        v1[2] = a1[2] * cs[3] - a1[3] * sn[3]; v1[3] = a1[3] * cs[3] + a1[2] * sn[3];
                    }
                    u32x4 w; w.x = pk2(v0[0], v0[1]); w.y = pk2(v0[2], v0[3]); w.z = pk2(v1[0], v1[1]); w.w = pk2(v1[2], v1[3]);
                    if (rope) { const int c8 = (pn < 32 ? (pn - 24) * 256 : pn < 38 ? 2048 + (pn - 36) * 256 : 2560 + (pn - 40) * 256) + bj * 128 + cl0;
                        u32x2 w8; w8.x = pk4_fp8(v0[0], v0[1], v0[2], v0[3]); w8.y = pk4_fp8(v1[0], v1[1], v1[2], v1[3]); *(u32x2*)(z8 + (size_t)row * 3072 + c8) = w8; }
                    if (rope) { }
                    else if (kcv) { const int cs_ = (pn - 32) * 256 + bj * 128 + cl0, which = cs_ >> 9, gg = (cs_ >> 7) & 3, dd = cs_ & 127, b = row >> 12;
                        u32x2 w8; w8.x = pk4_fp8(v0[0], v0[1], v0[2], v0[3]); w8.y = pk4_fp8(v1[0], v1[1], v1[2], v1[3]);
                        *(u32x2*)((unsigned char*)kc + ((size_t)((which * 16 + b * 4 + gg) * 4096 + t) * 128 + dd)) = w8; }
                    else *(u32x4*)(z + (size_t)row * NPAD + colt + bj * 128 + cl0) = w;
                }
            }
    }
};
struct EpiF32Tile {
    static constexpr bool PERM = false;
    float* C; int ldc;
    DEVI void operator()(const f32x4 (&acc)[2][2][4][2], const Unit& u, int wr, int wc, int fr, int fq) const {
        const int row0 = u.pm * 256 + wr * 64 + fr, col0 = u.pn * 256 + wc * 32 + 4 * fq;
#pragma unroll
        for (int ai = 0; ai < 2; ++ai)
#pragma unroll
            for (int m = 0; m < 4; ++m) { float* rowp = C + (size_t)(row0 + ai * 128 + m * 16) * ldc + col0;
#pragma unroll
                for (int bj = 0; bj < 2; ++bj)
#pragma unroll
                    for (int n = 0; n < 2; ++n) *(f32x4*)(rowp + bj * 128 + n * 16) = acc[ai][bj][m][n]; }
    }
};
template <bool ADD> struct EpiGate {
    static constexpr bool PERM = true;
    u16* mrg; const u16* z; int gcol0;
    DEVI void operator()(const f32x4 (&acc)[2][2][4][2], const Unit& u, int wr, int wc, int fr, int fq) const {
        const int row0 = u.pm * 256 + wr * 64 + fr, col0 = u.pn * 256 + wc * 32 + 8 * fq;
#pragma unroll
        for (int ai = 0; ai < 2; ++ai)
#pragma unroll
            for (int m = 0; m < 4; ++m) { const int row = row0 + ai * 128 + m * 16;
#pragma unroll
                for (int bj = 0; bj < 2; ++bj) { const int col = col0 + bj * 128;
                    float gz[8], pv[8]; unpack8(*(const u32x4*)(z + (size_t)row * NPAD + gcol0 + col), gz);
                    u16* dst = mrg + (size_t)row * D_ + col;
                    if (ADD) unpack8(*(const u32x4*)dst, pv);
                    float o[8];
#pragma unroll
                    for (int j = 0; j < 4; ++j) { o[j] = acc[ai][bj][m][0][j] * sigm(gz[j]); o[4 + j] = acc[ai][bj][m][1][j] * sigm(gz[4 + j]); }
                    if (ADD) {
#pragma unroll
                        for (int j = 0; j < 8; ++j) o[j] += pv[j]; }
                    u32x4 w; w.x = pk2(o[0], o[1]); w.y = pk2(o[2], o[3]); w.z = pk2(o[4], o[5]); w.w = pk2(o[6], o[7]);
                    *(u32x4*)dst = w; } }
    }
};
struct EpiResid {
    static constexpr bool PERM = true;
    u16* pre; const float* x; const u16* xh;
    DEVI void operator()(const f32x4 (&acc)[2][2][4][2], const Unit& u, int wr, int wc, int fr, int fq) const {
        const int row0 = u.pm * 256 + wr * 64 + fr, col0 = u.pn * 256 + wc * 32 + 8 * fq;
#pragma unroll
        for (int ai = 0; ai < 2; ++ai)
#pragma unroll
            for (int m = 0; m < 4; ++m) { const size_t off = (size_t)(row0 + ai * 128 + m * 16) * D_ + col0;
#pragma unroll
                for (int bj = 0; bj < 2; ++bj) { float xv[8];
                    if (xh) unpack8(*(const u32x4*)(xh + off + bj * 128), xv);
                    else { const f32x4 x0 = *(const f32x4*)(x + off + bj * 128), x1 = *(const f32x4*)(x + off + bj * 128 + 4); xv[0] = x0[0]; xv[1] = x0[1]; xv[2] = x0[2]; xv[3] = x0[3]; xv[4] = x1[0]; xv[5] = x1[1]; xv[6] = x1[2]; xv[7] = x1[3]; }
                    float r[8];
#pragma unroll
                    for (int j = 0; j < 4; ++j) { r[j] = xv[j] * ALPHA + acc[ai][bj][m][0][j]; r[4 + j] = xv[4 + j] * ALPHA + acc[ai][bj][m][1][j]; }
                    u32x4 w; w.x = pk2(r[0], r[1]); w.y = pk2(r[2], r[3]); w.z = pk2(r[4], r[5]); w.w = pk2(r[6], r[7]);
                    *(u32x4*)(pre + off + bj * 128) = w; } }
    }
};
struct EpiSwiGLU {
    static constexpr bool PERM = true;
    unsigned char* H;
    DEVI void operator()(const f32x4 (&acc)[2][2][4][2], const Unit& u, int wr, int wc, int fr, int fq) const {
        const int row0 = u.pm * 256 + wr * 64 + fr, f0 = u.pn * 128 + wc * 16 + 4 * fq;
#pragma unroll
        for (int ai = 0; ai < 2; ++ai)
#pragma unroll
            for (int m = 0; m < 4; ++m) { const int row = row0 + ai * 128 + m * 16;
#pragma unroll
                for (int bj = 0; bj < 2; ++bj) { const f32x4 a = acc[ai][bj][m][0], b = acc[ai][bj][m][1]; float o[4];
#pragma unroll
                    for (int j = 0; j < 4; ++j) o[j] = a[j] * sigm(a[j]) * b[j];
                    *(unsigned*)(H + (size_t)row * DFF + f0 + bj * 64) = pk4_fp8(o[0], o[1], o[2], o[3]); } }
    }
};
struct EpiScaleRow {
    static constexpr bool PERM = true;
    u16* Y; const float* roww;
    DEVI void operator()(const f32x4 (&acc)[2][2][4][2], const Unit& u, int wr, int wc, int fr, int fq) const {
        const int row0 = u.pm * 256 + wr * 64 + fr, col0 = u.pn * 256 + wc * 32 + 8 * fq;
#pragma unroll
        for (int ai = 0; ai < 2; ++ai)
#pragma unroll
            for (int m = 0; m < 4; ++m) { const int row = row0 + ai * 128 + m * 16; const float w_ = roww[row];
#pragma unroll
                for (int bj = 0; bj < 2; ++bj) { const f32x4 v0 = acc[ai][bj][m][0] * w_, v1 = acc[ai][bj][m][1] * w_;
                    u32x4 w; w.x = pk2(v0[0], v0[1]); w.y = pk2(v0[2], v0[3]); w.z = pk2(v1[0], v1[1]); w.w = pk2(v1[2], v1[3]);
                    *(u32x4*)(Y + (size_t)row * D_ + col0 + bj * 128) = w; } }
    }
};

struct CmpOrder {
    int G, c;
    DEVI bool next(int i, Unit& u) const { const int L = i * G + c; if (L >= 32) return false; u.pm = L; u.pn = 0; u.pb = L >> 4; return true; }
};
struct MoeOrder {
    int G, c, ntiles; const volatile LAS int* tstart;
    DEVI bool next(int i, Unit& u) const {
        const int L = i * G + c; if (L >= ntiles * 8) return false;
        const int tile = L >> 3, pn = L & 7;
        const int lk_ = (int)__builtin_amdgcn_mbcnt_hi(~0u, __builtin_amdgcn_mbcnt_lo(~0u, 0u));
        const int e = __popcll(__ballot(lk_ >= 1 && lk_ < 32 && tstart[lk_ & 31] <= tile));
        u.pm = tile; u.pn = pn; u.pb = e * 8 + pn; return true;
    }
};

struct Args { const float* in[26]; float* out; unsigned char* ws; int ph_lo, ph_hi; };
typedef const __attribute__((address_space(4))) Args* KP;
constexpr int PPL = 13;
constexpr int NPH = 1 + 2 * PPL;

DEVI int src_col(int n) {
    if (n < C_NQ) return n;
    if (n < C_KC) { const int r = n - C_NQ, hd = r >> 7, p = r & 127; return S_NQ + hd * 128 + (p >> 1) + 64 * (p & 1); }
    if (n < C_KS) return S_KC + (n - C_KC);
    if (n < C_VS) { const int r = n - C_KS, hd = r >> 7, p = r & 127; return S_KS + hd * 128 + (p >> 1) + 64 * (p & 1); }
    if (n < C_KW) return S_VS + (n - C_VS);
    if (n < C_VW) { const int r = n - C_KW, hd = r >> 7, p = r & 127; return S_KW + hd * 128 + (p >> 1) + 64 * (p & 1); }
    if (n < C_GM) return S_VW + (n - C_VW);
    if (n < C_GT) return S_GM + (n - C_GM);
    const int r = n - C_GT; if (r < 8) return S_MI + r; if (r < 56) return S_NG + (r - 8); return -1;
}

template <class ColPtr>
DEVI void tr_item32(const ColPtr& cp, size_t ldw, int K, u16* WT, int k0, int n0, float* scr, int lane) {
    const float* src = cp(n0 + (lane & 31));
#pragma unroll 8
    for (int i = 0; i < 32; ++i) { const int kk = 2 * i + (lane >> 5); scr[kk * 33 + (lane & 31)] = src ? src[(size_t)(k0 + kk) * ldw] : 0.f; }
    WAVE_SYNC();
    const int c = lane & 7;
#pragma unroll
    for (int j = 0; j < 4; ++j) { const int n = (lane >> 3) + 8 * j; const float* s = scr + (8 * c) * 33 + n;
        u32x4 o; o.x = pk2(s[0 * 33], s[1 * 33]); o.y = pk2(s[2 * 33], s[3 * 33]); o.z = pk2(s[4 * 33], s[5 * 33]); o.w = pk2(s[6 * 33], s[7 * 33]);
        *(u32x4*)(WT + (size_t)(n0 + n) * K + k0 + 8 * c) = o; }
    WAVE_SYNC();
}
template <class ColPtr>
DEVI void tr_item64(const ColPtr& cp, size_t ldw, int K, u16* WT, int k0, int n0, float* scr, int lane) {
    const int nq = lane & 15, kr = lane >> 4;
    const float* src = cp(n0 + 4 * nq);
    f32x4 v[16];
#pragma unroll
    for (int i = 0; i < 16; ++i) v[i] = src ? __builtin_nontemporal_load((const f32x4*)(src + (size_t)(k0 + kr + 4 * i) * ldw)) : (f32x4){0.f, 0.f, 0.f, 0.f};
#pragma unroll
    for (int i = 0; i < 16; ++i) { float* d = scr + (kr + 4 * i) * 65 + 4 * nq; d[0] = v[i][0]; d[1] = v[i][1]; d[2] = v[i][2]; d[3] = v[i][3]; }
    WAVE_SYNC();
    const int c = lane & 7;
#pragma unroll
    for (int j = 0; j < 8; ++j) { const int n = (lane >> 3) + 8 * j; const float* sp = scr + (8 * c) * 65 + n;
        u32x4 o; o.x = pk2(sp[0 * 65], sp[1 * 65]); o.y = pk2(sp[2 * 65], sp[3 * 65]); o.z = pk2(sp[4 * 65], sp[5 * 65]); o.w = pk2(sp[6 * 65], sp[7 * 65]);
        *(u32x4*)(WT + (size_t)(n0 + n) * K + k0 + 8 * c) = o; }
    WAVE_SYNC();
}
template <class ColPtr>
DEVI void tr_item64_f8(const ColPtr& cp, size_t ldw, int K, unsigned char* WT, int k0, int n0, float* scr, int lane, float scale) {
    const int nq = lane & 15, kr = lane >> 4;
    const float* src = cp(n0 + 4 * nq);
    f32x4 v[16];
#pragma unroll
    for (int i = 0; i < 16; ++i) v[i] = src ? __builtin_nontemporal_load((const f32x4*)(src + (size_t)(k0 + kr + 4 * i) * ldw)) : (f32x4){0.f, 0.f, 0.f, 0.f};
#pragma unroll
    for (int i = 0; i < 16; ++i) { float* d = scr + (kr + 4 * i) * 65 + 4 * nq; d[0] = v[i][0]; d[1] = v[i][1]; d[2] = v[i][2]; d[3] = v[i][3]; }
    WAVE_SYNC();
    const int c = lane & 3;
#pragma unroll
    for (int j = 0; j < 4; ++j) { const int n = (lane >> 2) + 16 * j; const float* sp = scr + (16 * c) * 65 + n;
        u32x4 o; o.x = pk4_fp8(sp[0 * 65] * scale, sp[1 * 65] * scale, sp[2 * 65] * scale, sp[3 * 65] * scale); o.y = pk4_fp8(sp[4 * 65] * scale, sp[5 * 65] * scale, sp[6 * 65] * scale, sp[7 * 65] * scale);
        o.z = pk4_fp8(sp[8 * 65] * scale, sp[9 * 65] * scale, sp[10 * 65] * scale, sp[11 * 65] * scale); o.w = pk4_fp8(sp[12 * 65] * scale, sp[13 * 65] * scale, sp[14 * 65] * scale, sp[15 * 65] * scale);
        *(u32x4*)(WT + (size_t)(n0 + n) * K + k0 + 16 * c) = o; }
    WAVE_SYNC();
}
DEVI void tr_item64_f8_rope(const float* Wh  , size_t ldw, int K, unsigned char* WT, int k0, int n0, float* scr, int lane, float scale) {
    const int nq = lane & 15, kr = lane >> 4, hf = nq >> 3, d4 = 4 * (nq & 7);
    const float* src = Wh + hf * 64 + d4;
    f32x4 v[16];
#pragma unroll
    for (int i = 0; i < 16; ++i) v[i] = __builtin_nontemporal_load((const f32x4*)(src + (size_t)(k0 + kr + 4 * i) * ldw));
#pragma unroll
    for (int i = 0; i < 16; ++i) { float* d = scr + (kr + 4 * i) * 65 + 2 * d4 + hf; d[0] = v[i][0]; d[2] = v[i][1]; d[4] = v[i][2]; d[6] = v[i][3]; }
    WAVE_SYNC();
    const int c = lane & 3;
#pragma unroll
    for (int j = 0; j < 4; ++j) { const int n = (lane >> 2) + 16 * j; const float* sp = scr + (16 * c) * 65 + n;
        u32x4 o; o.x = pk4_fp8(sp[0 * 65] * scale, sp[1 * 65] * scale, sp[2 * 65] * scale, sp[3 * 65] * scale); o.y = pk4_fp8(sp[4 * 65] * scale, sp[5 * 65] * scale, sp[6 * 65] * scale, sp[7 * 65] * scale);
        o.z = pk4_fp8(sp[8 * 65] * scale, sp[9 * 65] * scale, sp[10 * 65] * scale, sp[11 * 65] * scale); o.w = pk4_fp8(sp[12 * 65] * scale, sp[13 * 65] * scale, sp[14 * 65] * scale, sp[15 * 65] * scale);
        *(u32x4*)(WT + (size_t)(n0 + n) * K + k0 + 16 * c) = o; }
    WAVE_SYNC();
}
template <class ColPtr>
DEVI void tr_item32_f8(const ColPtr& cp, size_t ldw, int K, unsigned char* WT, int k0, int n0, float* scr, int lane, float scale) {
    const float* src = cp(n0 + (lane & 31));
#pragma unroll 8
    for (int i = 0; i < 32; ++i) { const int kk = 2 * i + (lane >> 5); scr[kk * 33 + (lane & 31)] = src ? src[(size_t)(k0 + kk) * ldw] : 0.f; }
    WAVE_SYNC();
    const int c = lane & 7;
#pragma unroll
    for (int j = 0; j < 4; ++j) { const int n = (lane >> 3) + 8 * j; const float* sp = scr + (8 * c) * 33 + n;
        u32x2 o; o.x = pk4_fp8(sp[0 * 33] * scale, sp[1 * 33] * scale, sp[2 * 33] * scale, sp[3 * 33] * scale); o.y = pk4_fp8(sp[4 * 33] * scale, sp[5 * 33] * scale, sp[6 * 33] * scale, sp[7 * 33] * scale);
        *(u32x2*)(WT + (size_t)(n0 + n) * K + k0 + 8 * c) = o; }
    WAVE_SYNC();
}
struct ColPlain { const float* W; DEVI const float* operator()(int n) const { return W + n; } };
struct ColInProj { const float* W; DEVI const float* operator()(int n) const { const int s = src_col(n); return s >= 0 ? W + s : nullptr; } };
struct ColW13 { const float* w1; const float* w3; DEVI const float* operator()(int n) const { const int f = (n >> 3) * 4 + (n & 3); return ((n >> 2) & 1) ? w3 + f : w1 + f; } };

DEVI void phase_prologue(KP a, unsigned char* lds, int tid, int lane, int wave, int G) {
    unsigned char* ws = a->ws;
    float* cosT = (float*)(ws + WS_ROPE); float* sinT = cosT + 4096 * 64;
    for (int idx = blockIdx.x * 512 + tid; idx < 4096 * 64; idx += G * 512) {
        const int pos = idx >> 6, i = idx & 63;
        const float inv = exp2f(-(float)i * (13.287712379549449f / 64.f));
        const double ang = (double)pos * (double)inv;
        const double k = __builtin_rint(ang * 0.15915494309189535);
        const float r = (float)(ang - k * 6.283185307179586);
        cosT[idx] = cosf(r); sinT[idx] = sinf(r);
    }
    { const float* x = a->in[0]; unsigned char* x8 = ws + WS_X8;
      const size_t NI = (size_t)M_ * D_ / 8, st = (size_t)G * 512; size_t i = (size_t)blockIdx.x * 512 + tid;
      for (; i + 3 * st < NI; i += 4 * st) {
          f32x4 v0[4], v1[4];
#pragma unroll
          for (int u = 0; u < 4; ++u) { v0[u] = *(const f32x4*)(x + (i + u * st) * 8); v1[u] = *(const f32x4*)(x + (i + u * st) * 8 + 4); }
#pragma unroll
          for (int u = 0; u < 4; ++u) { u32x2 w; w.x = pk4_fp8(v0[u][0], v0[u][1], v0[u][2], v0[u][3]); w.y = pk4_fp8(v1[u][0], v1[u][1], v1[u][2], v1[u][3]); *(u32x2*)(x8 + (i + u * st) * 8) = w; } }
      for (; i < NI; i += st) {
          const f32x4 v0 = *(const f32x4*)(x + i * 8), v1 = *(const f32x4*)(x + i * 8 + 4);
          u32x2 w; w.x = pk4_fp8(v0[0], v0[1], v0[2], v0[3]); w.y = pk4_fp8(v1[0], v1[1], v1[2], v1[3]);
          *(u32x2*)(x8 + i * 8) = w; } }
    { float* bp = (float*)(ws + WS_BIASP);
      for (int i = blockIdx.x * 512 + tid; i < 2 * NPAD; i += G * 512) { const int l = i / NPAD, n = i % NPAD, s = src_col(n); bp[i] = s >= 0 ? a->in[2][l * IN_W + s] : 0.f; } }
    { u16* ov = (u16*)(ws + WS_OVL);
      for (int i = blockIdx.x * 512 + tid; i < 256 * 128; i += G * 512) { const int n = i >> 7, j = i & 127;
          const bool on = j < 64 && n < 255 && (16 * n <= 64 * j + 63) && (16 * n + 31 >= 64 * j); ov[i] = on ? (u16)0x3f80 : (u16)0; } }
    { float* wT = (float*)(ws + WS_RWT); const float* rw = a->in[19];
      for (int i = blockIdx.x * 512 + tid; i < 32 * 2048; i += G * 512) { const int e = i >> 11, d = i & 2047; wT[i] = rw[d * 32 + e]; } }
    const int gw = blockIdx.x * 8 + wave, NGW = G * 8;
    { float* b1p = (float*)(ws + WS_MISC + 1536 * 1024);
      for (int task = gw; task < 512; task += NGW) { const int kc = task & 63, fh = (task >> 6) & 1, kv = (task >> 7) & 1, l = task >> 8;
          const float* pos = a->in[kv ? 9 : 4] + (size_t)l * 4096; const float* w1 = a->in[kv ? 10 : 5] + (size_t)l * 4096 * 128; const int f = fh * 64 + lane;
          float s = 0.f;
          for (int k = kc * 64; k < kc * 64 + 64; ++k) s += pos[k] * w1[(size_t)k * 128 + f];
          b1p[((l * 2 + kv) * 64 + kc) * 128 + f] = s; } }
    float* scr = (float*)(lds + wave * 16640);
    constexpr int IT_WIN = 32 * (NPAD / 64), IT_WB = 32 * 32, IT_CW = 32 * 2;
    constexpr int NIT = 2 * IT_WIN + 6 * IT_WB + 8 * IT_CW;
    for (int it = gw; it < NIT; it += NGW) {
        int r = it;
        if (r < 2 * IT_WIN) { const int l = r / IT_WIN; r %= IT_WIN; const int kb = r / (NPAD / 64), nb = r % (NPAD / 64), n0 = nb * 64;
            const ColInProj cp{a->in[1] + (size_t)l * D_ * IN_W}; unsigned char* WT = ws + WS_WIN + (size_t)l * NPAD * D_;
            const bool rope = (n0 >= C_NQ && n0 < C_KC) || (n0 >= C_KS && n0 < C_VS) || (n0 >= C_KW && n0 < C_VW);
            if (rope) { const int segd = n0 >= C_KW ? C_KW : n0 >= C_KS ? C_KS : C_NQ, segs = n0 >= C_KW ? S_KW : n0 >= C_KS ? S_KS : S_NQ;
                const int r_ = n0 - segd, hd = r_ >> 7, m32 = (r_ & 127) >> 6;
                tr_item64_f8_rope(a->in[1] + (size_t)l * D_ * IN_W + segs + hd * 128 + 32 * m32, IN_W, D_, WT, kb * 64, n0, scr, lane, 64.f); }
            else tr_item64_f8(cp, IN_W, D_, WT, kb * 64, n0, scr, lane, 64.f);
            continue; }
        r -= 2 * IT_WIN;
        if (r < 6 * IT_WB) { const int q = r / IT_WB, l = q / 3, w = q % 3; r %= IT_WB; const int kb = r / 32, nb = r % 32;
            if (w <= 1) tr_item64_f8(ColPlain{a->in[14 + w] + (size_t)l * D_ * D_}, D_, D_, ws + WS_WB + (size_t)(l * 3 + w) * D_ * D_ * 2, kb * 64, nb * 64, scr, lane, 64.f);
            else tr_item64(ColPlain{a->in[14 + w] + (size_t)l * D_ * D_}, D_, D_, (u16*)(ws + WS_WB) + (size_t)(l * 3 + w) * D_ * D_, kb * 64, nb * 64, scr, lane);
            continue; }
        r -= 6 * IT_WB;
        { const int q = r / IT_CW, l = q >> 2, kv = (q >> 1) & 1, ab = q & 1; r %= IT_CW; const int kb = r / 2, nb = r % 2;
          const float* w1 = a->in[kv ? 10 : 5] + (size_t)l * 4096 * 128 + (size_t)ab * 2048 * 128;
          tr_item64_f8(ColPlain{w1}, 128, 2048, ws + WS_CW1 + (size_t)(l * 512 + kv * 256 + ab * 128) * 2048, kb * 64, nb * 64, scr, lane, 64.f); }
    }
}
DEVI void phase_experts(KP a, unsigned char* lds, int lane, int wave, int G, int l) {
    unsigned char* ws = a->ws;
    float* scr = (float*)(lds + wave * 16640);
    const int gw = blockIdx.x * 8 + wave, NGW = G * 8;
    constexpr int IT13 = 32 * 32, IT2 = 16 * 32;
    for (int it = gw; it < NEXP * (IT13 + IT2); it += NGW) {
        const int e = it / (IT13 + IT2); int r = it % (IT13 + IT2);
        if (r < IT13) { const int kb = r / 32, nb = r % 32;
            const float* w1 = a->in[21] + ((size_t)l * NEXP + e) * D_ * DFF; const float* w3 = a->in[22] + ((size_t)l * NEXP + e) * D_ * DFF;
            tr_item64_f8(ColW13{w1, w3}, DFF, D_, ws + WS_W13 + (size_t)e * 2048 * D_, kb * 64, nb * 64, scr, lane, 64.f); }
        else { r -= IT13; const int kb = r / 32, nb = r % 32;
            const float* w2 = a->in[23] + ((size_t)l * NEXP + e) * DFF * D_;
            tr_item64_f8(ColPlain{w2}, D_, DFF, ws + WS_W2 + (size_t)e * D_ * DFF, kb * 64, nb * 64, scr, lane, 64.f); }
    }
}

namespace ml {
constexpr int QP = 272, VP = 72;
constexpr int O_Q = 0, O_K = 34816, O_CB = 69632, O_VT = 95744, O_VW = 102656, O_SP = 109568, O_SC = 118784;
constexpr int S_A = 0, S_M = 64, S_WI = 128, S_EN = 192, S_WS = 256, S_DEN = 320, S_DEC = 384;
typedef short s16x4 __attribute__((ext_vector_type(4)));
DEVI bf16x8 frag(const unsigned char* lds, int off) { return *(const bf16x8*)(lds + off); }
DEVI bf16x8 frag_tr(unsigned addr) {
    s16x4 lo, hi;
    asm volatile("ds_read_b64_tr_b16 %0, %2\n\tds_read_b64_tr_b16 %1, %2 offset:2176\n\ts_waitcnt lgkmcnt(0)" : "=&v"(lo), "=&v"(hi) : "v"(addr) : "memory");
    return (bf16x8){lo[0], lo[1], lo[2], lo[3], hi[0], hi[1], hi[2], hi[3]};
}
}
constexpr size_t WS_SP = WS_O, WS_MSC = WS_O + 16 * MiB, WS_MDEC = WS_O + 20 * MiB;
DEVI void phase_mlstm_pre(KP a, unsigned char* lds, const int tid, int G, int first_blk) {
    using namespace ml;
    unsigned char* ws = a->ws;
    const u16* z = (const u16*)(ws + WS_Z); const float* gates = (const float*)(ws + WS_GATES);
    u16* SPg = (u16*)(ws + WS_SP); float* MSC = (float*)(ws + WS_MSC); float* MDEC = (float*)(ws + WS_MDEC);
    const int lane = tid & 63, wave = __builtin_amdgcn_readfirstlane(tid >> 6), g4 = lane >> 4, l15 = lane & 15;
    float* sc = (float*)(lds + O_SC);
    const int nblk = G - first_blk, bi = (int)blockIdx.x - first_blk;
    if (bi < 0) return;
    const int u0 = (int)(((long)bi * 1024) / nblk), u1 = (int)(((long)(bi + 1) * 1024) / nblk);
    float off = 0.f, Gp = 0.f; int have = -1;
    const unsigned qkoff = (unsigned)((tid >> 5) * NPAD + (tid & 31) * 8) * 2u; const int qklds = (tid >> 5) * (QP * 2) + (tid & 31) * 16;
    for (int u = u0; u < u1; ++u) { const int bh = u >> 6, c = u & 63, b = bh >> 2, h = bh & 3;
        const char* zq = (const char*)(z + (size_t)(b * 4096 + c * 64) * NPAD + C_MQ + h * 256);
        const char* zk = (const char*)(z + (size_t)(b * 4096 + c * 64) * NPAD + C_MK + h * 256);
        const float* gp = gates + (size_t)b * 4096 * 64 + h;
#pragma unroll
        for (int k = 0; k < 4; ++k) { *(u32x4*)(lds + O_Q + qklds + k * 16 * QP * 2) = *(const u32x4*)(zq + qkoff + (size_t)k * 16 * NPAD * 2); *(u32x4*)(lds + O_K + qklds + k * 16 * QP * 2) = *(const u32x4*)(zk + qkoff + (size_t)k * 16 * NPAD * 2); }
        if (wave == 0) {
            if (have != u) { off = 0.f; Gp = 0.f;
                if (c > 0) { const float* ch = (const float*)(ws + WS_CHS) + ((size_t)(b * 64) * 4 + h) * 2;
                    float Sv = 0.f, Lv = -INFINITY; if (lane < c) { Sv = ch[lane * 8]; Lv = ch[lane * 8 + 1]; }
#pragma unroll
                    for (int cc = 0; cc < 63; ++cc) { const float s_ = __int_as_float(__builtin_amdgcn_readlane(__float_as_int(Sv), cc)), l_ = __int_as_float(__builtin_amdgcn_readlane(__float_as_int(Lv), cc));
                        Gp = fmaxf(Gp, l_ - off); off += s_; } } }
            const float fg = gp[(size_t)(c * 64 + lane) * 64 + 4], ig = gp[(size_t)(c * 64 + lane) * 64];
            float bc = fminf(fg, 0.f) - log1pf(__expf(-fabsf(fg)));
#pragma unroll
            for (int o = 1; o < 64; o <<= 1) { const float t_ = __shfl_up(bc, o); if (lane >= o) bc += t_; }
            const float Bg = off + bc, gv = ig - Bg; float pm = gv;
#pragma unroll
            for (int o = 1; o < 64; o <<= 1) { const float t_ = __shfl_up(pm, o); if (lane >= o) pm = fmaxf(pm, t_); }
            const float Gt = fmaxf(Gp, pm), Ge = __shfl(Gt, 63);
            sc[S_A + lane] = gv; sc[S_M + lane] = Gt;
            *(f32x4*)(MSC + ((size_t)bh * 4096 + c * 64 + lane) * 4) = (f32x4){__expf(Gp - Gt), __expf(-(Bg + Gt)), __expf(gv - Ge), 0.f};
            if (lane == 0) MDEC[bh * 64 + c] = __expf(Gp - Ge);
            off = __shfl(Bg, 63); Gp = Ge; have = u + 1;
            if (c == 63) have = -1;
        }
        __syncthreads();
        const int tt = wave >> 1, st0 = 2 * (wave & 1); const int t = 16 * tt + l15; const float Gt_ = sc[S_M + t];
        u16* spo = SPg + (size_t)u * 4096 + (size_t)t * 64;
#pragma unroll
        for (int si = 0; si < 2; ++si) { const int st = st0 + si; u32x2 pk_ = {0u, 0u};
            if (st <= tt) { f32x4 sacc = {0.f, 0.f, 0.f, 0.f};
#pragma unroll
                for (int ks = 0; ks < 8; ++ks) sacc = __builtin_amdgcn_mfma_f32_16x16x32_bf16(frag(lds, O_K + (16 * st + l15) * (QP * 2) + (32 * ks + 8 * g4) * 2), frag(lds, O_Q + (16 * tt + l15) * (QP * 2) + (32 * ks + 8 * g4) * 2), sacc, 0, 0, 0);
                float w_[4];
#pragma unroll
                for (int j = 0; j < 4; ++j) { const int sj = 16 * st + 4 * g4 + j; w_[j] = sj <= t ? sacc[j] * __expf(sc[S_A + sj] - Gt_) : 0.f; }
                pk_.x = pk2(w_[0], w_[1]); pk_.y = pk2(w_[2], w_[3]); }
            *(u32x2*)(spo + 16 * st + 4 * g4) = pk_; }
        __syncthreads();
    }
}
DEVI void phase_mlstm(KP a, unsigned char* lds, const int tid, int G) {
    using namespace ml;
    unsigned char* ws = a->ws;
    const u16* z = (const u16*)(ws + WS_Z); u16* hbuf = (u16*)(ws + WS_HG);
    const u16* SPg = (const u16*)(ws + WS_SP); const float* MSC = (const float*)(ws + WS_MSC); const float* MDEC = (const float*)(ws + WS_MDEC);
    const int lane = tid & 63, wave = __builtin_amdgcn_readfirstlane(tid >> 6), g4 = lane >> 4, l15 = lane & 15;
    float* sc = (float*)(lds + O_SC);
    const unsigned lds32 = (unsigned)(uintptr_t)lds;
    const unsigned qkoff = (unsigned)((tid >> 5) * NPAD + (tid & 31) * 8) * 2u;
    const int qklds = (tid >> 5) * (QP * 2) + (tid & 31) * 16;
    const int vs_ = tid >> 3, v4 = (tid & 7) * 4;
    for (int unit0 = blockIdx.x; unit0 < 256; unit0 += G) {
        const int unit = (G % 8 == 0 && G >= 256) ? (((unit0 & 7) + 8 * (unit0 >> 7)) * 16 + ((unit0 >> 3) & 15)) : unit0;
        const int b = unit >> 6, h = (unit >> 4) & 3, jv = unit & 15, bh = b * 4 + h;
        const char* zq = (const char*)(z + (size_t)b * 4096 * NPAD + C_MQ + h * 256);
        const char* zk = (const char*)(z + (size_t)b * 4096 * NPAD + C_MK + h * 256);
        const char* zv = (const char*)(z + (size_t)b * 4096 * NPAD + C_MV + h * 512 + jv * 32);
        const char* spg = (const char*)(SPg + (size_t)bh * 64 * 4096);
        const float* msc = MSC + (size_t)bh * 4096 * 4;
        for (int i = tid; i < 48 * QP / 2; i += 512) ((unsigned*)(lds + O_CB))[i] = 0u;
        for (int i = tid; i < 16 * VP / 2; i += 512) { ((unsigned*)(lds + O_VT + 32 * VP * 2))[i] = i < VP / 2 ? 0x3f803f80u : 0u; ((unsigned*)(lds + O_VW + 32 * VP * 2))[i] = 0u; }
        f32x4 Cacc[2][3];
#pragma unroll
        for (int i = 0; i < 2; ++i)
#pragma unroll
            for (int j = 0; j < 3; ++j) Cacc[i][j] = (f32x4){0.f, 0.f, 0.f, 0.f};
        u32x4 pq[4], pk[4], psp; u32x2 pv; f32x4 pms = {0.f, 0.f, 0.f, 0.f}; float pdec = 0.f, pws = 0.f;
#pragma unroll
        for (int k = 0; k < 4; ++k) { pq[k] = *(const u32x4*)(zq + qkoff + (size_t)k * 16 * NPAD * 2); pk[k] = *(const u32x4*)(zk + qkoff + (size_t)k * 16 * NPAD * 2); }
        pv = *(const u32x2*)(zv + ((size_t)vs_ * NPAD + v4) * 2); pws = msc[(size_t)vs_ * 4 + 2];
        psp = *(const u32x4*)(spg + (size_t)tid * 16);
        if (wave == 0) { pms = *(const f32x4*)(msc + (size_t)lane * 4); pdec = MDEC[bh * 64]; }
        for (int c = 0; c < 64; ++c) {
#pragma unroll
            for (int k = 0; k < 4; ++k) { *(u32x4*)(lds + O_Q + qklds + k * 16 * QP * 2) = pq[k]; *(u32x4*)(lds + O_K + qklds + k * 16 * QP * 2) = pk[k]; }
            { u16* vt = (u16*)(lds + O_VT); u16* vw = (u16*)(lds + O_VW); const unsigned short e0 = (u16)(pv.x & 0xffffu), e1 = (u16)(pv.x >> 16), e2 = (u16)(pv.y & 0xffffu), e3 = (u16)(pv.y >> 16);
              vt[(v4 + 0) * VP + vs_] = e0; vt[(v4 + 1) * VP + vs_] = e1; vt[(v4 + 2) * VP + vs_] = e2; vt[(v4 + 3) * VP + vs_] = e3;
              vw[(v4 + 0) * VP + vs_] = (u16)f2bf(bf2f(e0) * pws); vw[(v4 + 1) * VP + vs_] = (u16)f2bf(bf2f(e1) * pws); vw[(v4 + 2) * VP + vs_] = (u16)f2bf(bf2f(e2) * pws); vw[(v4 + 3) * VP + vs_] = (u16)f2bf(bf2f(e3) * pws); }
            *(u32x4*)(lds + O_SP + (tid >> 3) * (VP * 2) + (tid & 7) * 16) = psp;
            if (wave == 0) { sc[S_WI + lane] = pms[0]; sc[S_EN + lane] = pms[1]; ((u16*)(lds + O_VW))[32 * VP + lane] = (u16)f2bf(pms[2]); if (lane == 0) sc[S_DEC] = pdec; }
            __syncthreads();
            { const int cn = c < 63 ? c + 1 : 63; const size_t ro = (size_t)cn * 64 * NPAD * 2;
#pragma unroll
              for (int k = 0; k < 4; ++k) { pq[k] = *(const u32x4*)(zq + ro + qkoff + (size_t)k * 16 * NPAD * 2); pk[k] = *(const u32x4*)(zk + ro + qkoff + (size_t)k * 16 * NPAD * 2); }
              pv = *(const u32x2*)(zv + ro + ((size_t)vs_ * NPAD + v4) * 2); pws = msc[(size_t)(cn * 64 + vs_) * 4 + 2];
              psp = *(const u32x4*)(spg + (size_t)cn * 8192 + (size_t)tid * 16);
              if (wave == 0) { pms = *(const f32x4*)(msc + (size_t)(cn * 64 + lane) * 4); pdec = MDEC[bh * 64 + cn]; } }
            const int tt1 = wave & 3, vt1 = wave >> 2;
            f32x4 inter1 = {0.f, 0.f, 0.f, 0.f}, inter2 = {0.f, 0.f, 0.f, 0.f};
#pragma unroll
            for (int ks = 0; ks < 8; ++ks) { const bf16x8 aq = frag(lds, O_Q + (16 * tt1 + l15) * (QP * 2) + (32 * ks + 8 * g4) * 2);
                inter1 = __builtin_amdgcn_mfma_f32_16x16x32_bf16(aq, frag(lds, O_CB + (16 * vt1 + l15) * (QP * 2) + (32 * ks + 8 * g4) * 2), inter1, 0, 0, 0);
                inter2 = __builtin_amdgcn_mfma_f32_16x16x32_bf16(aq, frag(lds, O_CB + (32 + l15) * (QP * 2) + (32 * ks + 8 * g4) * 2), inter2, 0, 0, 0); }
            f32x4 num1 = {0.f, 0.f, 0.f, 0.f}, num2 = {0.f, 0.f, 0.f, 0.f};
#pragma unroll
            for (int ks = 0; ks < 2; ++ks) { const bf16x8 ap = frag(lds, O_SP + (16 * tt1 + l15) * (VP * 2) + (32 * ks + 8 * g4) * 2);
                num1 = __builtin_amdgcn_mfma_f32_16x16x32_bf16(ap, frag(lds, O_VT + (16 * vt1 + l15) * (VP * 2) + (32 * ks + 8 * g4) * 2), num1, 0, 0, 0);
                num2 = __builtin_amdgcn_mfma_f32_16x16x32_bf16(ap, frag(lds, O_VT + (32 + l15) * (VP * 2) + (32 * ks + 8 * g4) * 2), num2, 0, 0, 0); }
            { const int row0 = b * 4096 + c * 64;
#pragma unroll
              for (int j = 0; j < 4; ++j) { const int tj = 16 * tt1 + 4 * g4 + j; const float wi = sc[S_WI + tj];
                  float d_ = num2[j] + wi * inter2[j];
                  d_ = __shfl(d_, lane & 48);
                  const float den = fmaxf(fabsf(d_), sc[S_EN + tj]);
                  const float hv = (num1[j] + wi * inter1[j]) / den;
                  const float hn = __int_as_float(__builtin_amdgcn_mov_dpp(__float_as_int(hv), 0xB1, 0xF, 0xF, true));
                  if ((l15 & 1) == 0) *(unsigned*)(hbuf + (size_t)(row0 + tj) * D_ + h * 512 + jv * 32 + 16 * vt1 + l15) = pk2(hv, hn); } }
            { const float decay = sc[S_DEC];
#pragma unroll
              for (int di = 0; di < 2; ++di) { const int dt = 2 * wave + di;
#pragma unroll
                  for (int vt = 0; vt < 3; ++vt) Cacc[di][vt] = Cacc[di][vt] * decay;
#pragma unroll
                  for (int ks = 0; ks < 2; ++ks) { const bf16x8 ak = frag_tr(lds32 + O_K + (32 * ks + 8 * g4 + (l15 >> 2)) * (QP * 2) + (16 * dt + 4 * (lane & 3)) * 2);
#pragma unroll
                      for (int vt = 0; vt < 3; ++vt) Cacc[di][vt] = __builtin_amdgcn_mfma_f32_16x16x32_bf16(ak, frag(lds, O_VW + (16 * vt + l15) * (VP * 2) + (32 * ks + 8 * g4) * 2), Cacc[di][vt], 0, 0, 0); }
              } }
            __syncthreads();
#pragma unroll
            for (int di = 0; di < 2; ++di) { const int dt = 2 * wave + di;
#pragma unroll
                for (int vt = 0; vt < 3; ++vt) { u32x2 w_; w_.x = pk2(Cacc[di][vt][0], Cacc[di][vt][1]); w_.y = pk2(Cacc[di][vt][2], Cacc[di][vt][3]);
                    *(u32x2*)(lds + O_CB + (16 * vt + l15) * (QP * 2) + (16 * dt + 4 * g4) * 2) = w_; } }
        }
        __syncthreads();
    }
}

DEVI void phase_cmp2(KP a, unsigned char* lds, int tid, int G, int l) {
    unsigned char* ws = a->ws;
    const float* U = (const float*)(ws + WS_U); u16* kcmp = (u16*)(ws + WS_KCMP);
    const float* cosT = (const float*)(ws + WS_ROPE); const float* sinT = cosT + 4096 * 64;
    const float* b1part = (const float*)(ws + WS_MISC + 1536 * 1024);
    constexpr int HP = 132;
    float* hs = (float*)lds;
    float* os = hs + 32 * HP;
    float* b1p = os + 32 * HP;
    const int sub = tid >> 7, f = tid & 127, lane = tid & 63, wv = tid >> 6, g4 = lane >> 4, l15 = lane & 15;
    __syncthreads();
    if (tid < 256) { const int which = tid >> 7; float s = a->in[which ? 11 : 6][l * 128 + f]; float p[64];
#pragma unroll
        for (int kc = 0; kc < 64; ++kc) p[kc] = b1part[((l * 2 + which) * 64 + kc) * 128 + f];
#pragma unroll
        for (int kc = 0; kc < 64; ++kc) s += p[kc];
        b1p[tid] = s; }
    __syncthreads();
    for (int unit = blockIdx.x; unit < 256; unit += G) {
        const int which = unit >> 7, rb = which * 4096 + (unit & 127) * 32;
        const float* w2 = a->in[which ? 12 : 7] + (size_t)l * 128 * 128; const float* b2 = a->in[which ? 13 : 8] + l * 128;
        float bw[8][4];
#pragma unroll
        for (int ks = 0; ks < 8; ++ks)
#pragma unroll
            for (int u = 0; u < 4; ++u) bw[ks][u] = w2[(16 * ks + 4 * g4 + u) * 128 + wv * 16 + l15];
        float ua[8], ub[8];
#pragma unroll
        for (int j = 0; j < 8; ++j) { const int r = rb + sub + 4 * j; const bool ok = (r & 255) < 255;
            ua[j] = ok ? U[(size_t)r * 256 + f] : 0.f; ub[j] = ok ? U[(size_t)(r + 1) * 256 + 128 + f] : 0.f; }
        const float b1v = b1p[which * 128 + f];
#pragma unroll
        for (int j = 0; j < 8; ++j) { const int r = rb + sub + 4 * j; float hp = 0.f;
            if ((r & 255) < 255) { hp = ua[j] + ub[j] + b1v;
                const float u_ = 0.7978845608028654f * (hp + 0.044715f * hp * hp * hp); const float th = 1.f - 2.f / (1.f + __expf(2.f * u_)); hp = 0.5f * hp * (1.f + th); }
            hs[(sub + 4 * j) * HP + f] = hp; }
        __syncthreads();
        { f32x4 acc0 = {0.f, 0.f, 0.f, 0.f}, acc1 = {0.f, 0.f, 0.f, 0.f};
#pragma unroll
          for (int ks = 0; ks < 8; ++ks) { const f32x4 a0 = *(const f32x4*)(hs + l15 * HP + 16 * ks + 4 * g4), a1 = *(const f32x4*)(hs + (16 + l15) * HP + 16 * ks + 4 * g4);
#pragma unroll
              for (int u = 0; u < 4; ++u) { acc0 = __builtin_amdgcn_mfma_f32_16x16x4f32(a0[u], bw[ks][u], acc0, 0, 0, 0); acc1 = __builtin_amdgcn_mfma_f32_16x16x4f32(a1[u], bw[ks][u], acc1, 0, 0, 0); } }
          const float bb = b2[wv * 16 + l15];
#pragma unroll
          for (int j = 0; j < 4; ++j) { os[(4 * g4 + j) * HP + wv * 16 + l15] = acc0[j] + bb; os[(16 + 4 * g4 + j) * HP + wv * 16 + l15] = acc1[j] + bb; } }
        __syncthreads();
        if (which == 0) { const int i = f >> 1; float cs[8], sn[8];
#pragma unroll
            for (int j = 0; j < 8; ++j) { const int r = rb + sub + 4 * j, n = r & 255, pos = 16 * n + 31; cs[j] = n < 255 ? cosT[pos * 64 + i] : 1.f; sn[j] = n < 255 ? sinT[pos * 64 + i] : 0.f; }
#pragma unroll
            for (int j = 0; j < 8; ++j) { const int lr = sub + 4 * j, r = rb + lr, n = r & 255; const float x1 = os[lr * HP + i], x2 = os[lr * HP + i + 64];
                float val = (f & 1) ? x2 * cs[j] + x1 * sn[j] : x1 * cs[j] - x2 * sn[j]; if (n == 255) val = 0.f;
                kcmp[(size_t)r * 128 + f] = (u16)f2bf(val); (ws + WS_KCMP8)[(size_t)r * 128 + f] = (unsigned char)(pk4_fp8(val, 0.f, 0.f, 0.f) & 0xffu); } }
        else {
#pragma unroll
            for (int j = 0; j < 8; ++j) { const int lr = sub + 4 * j, r = rb + lr, n = r & 255; float val = os[lr * HP + f]; if (n == 255) val = 0.f;
                kcmp[(size_t)r * 128 + f] = (u16)f2bf(val); } }
        __syncthreads();
    }
}
DEVI void phase_norm(KP a, int lane, int wave, int G, int l) {
    unsigned char* ws = a->ws;
    const u16* z = (const u16*)(ws + WS_Z); u16* hg = (u16*)(ws + WS_HG); const float* mw = a->in[3] + l * 2048;
    const int gw = blockIdx.x * 8 + wave, NGW = G * 8;
    f32x4 mwq[4][2];
#pragma unroll
    for (int h = 0; h < 4; ++h) { mwq[h][0] = *(const f32x4*)(mw + h * 512 + lane * 8); mwq[h][1] = *(const f32x4*)(mw + h * 512 + lane * 8 + 4); }
    for (int row = gw; row < M_; row += NGW) {
        u32x4 hv[4], ov[4];
#pragma unroll
        for (int h = 0; h < 4; ++h) { hv[h] = *(const u32x4*)(hg + (size_t)row * D_ + h * 512 + lane * 8); ov[h] = *(const u32x4*)(z + (size_t)row * NPAD + C_MO + h * 512 + lane * 8); }
#pragma unroll
        for (int h = 0; h < 4; ++h) {
            float v[8]; unpack8(hv[h], v);
            float s = 0.f;
#pragma unroll
            for (int j = 0; j < 8; ++j) s += v[j];
            const float mean = wsum(s) * (1.f / 512.f); float q = 0.f;
#pragma unroll
            for (int j = 0; j < 8; ++j) { v[j] -= mean; q += v[j] * v[j]; }
            const float rstd = 1.f / sqrtf(wsum(q) * (1.f / 512.f) + LN_EPS);
            float og[8]; unpack8(ov[h], og);
            const f32x4 w0 = mwq[h][0], w1 = mwq[h][1];
            const float wv[8] = {w0[0], w0[1], w0[2], w0[3], w1[0], w1[1], w1[2], w1[3]};
            float o[8];
#pragma unroll
            for (int j = 0; j < 8; ++j) o[j] = v[j] * rstd * wv[j] * sigm(og[j]);
            u32x2 w8; w8.x = pk4_fp8(o[0] * 2.f, o[1] * 2.f, o[2] * 2.f, o[3] * 2.f); w8.y = pk4_fp8(o[4] * 2.f, o[5] * 2.f, o[6] * 2.f, o[7] * 2.f);
            *(u32x2*)(ws + WS_XBF + (size_t)row * D_ + h * 512 + lane * 8) = w8; }
    }
}

#ifndef GQ_CV
#define GQ_CV true
#endif
#ifndef GQ_CI
#define GQ_CI true
#endif
#ifndef GQ_W
#define GQ_W true
#endif
#ifndef GQ_S
#define GQ_S false
#endif
namespace att {
constexpr int NW = 8, QBLK = 32, KVBLK = 64, QB = 256, D = 128, WIN = 512;
constexpr int SHM_V = KVBLK * D * 2, SHM_K = KVBLK * D * 2;
constexpr float SCALE = 0.08838834764831845f, THR = 8.f;
typedef short s16x4 __attribute__((ext_vector_type(4)));
typedef float f32x16 __attribute__((ext_vector_type(16)));
enum { M_WIN = 0, M_SEL = 1, M_CMP = 2 };
enum { E_GATED = 0, E_IMP = 1, E_FINAL = 2 };
#define KSWZ8(row, colB) ((row) * 128 + ((colB) ^ (((row) & 7) << 4)))
#define SBAR() __builtin_amdgcn_sched_barrier(0)
DEVI int v_st(int k, int c) { const int kk = (k & ~0xC) | ((k & 4) << 1) | ((k & 8) >> 1); return ((kk >> 3) * 4 + (c >> 5)) * 512 + ((kk & 7) * 32 + (c & 31)) * 2; }
DEVI int v_rd_base(int lane) { return ((lane & 3) << 3) | (((lane >> 2) & 3) << 6) | (((lane >> 4) & 1) << 5) | (((lane >> 5) & 1) << 8); }
constexpr int v_rd_off(int d0, int ks, int half) { return d0 * 512 + ks * 4096 + half * 2048; }
DEVI int crow(int r, int hi) { return (r & 3) + 8 * (r >> 2) + 4 * hi; }
DEVI unsigned cvtpk(float lo, float hi) { unsigned r; asm volatile("v_cvt_pk_bf16_f32 %0, %1, %2" : "=v"(r) : "v"(lo), "v"(hi)); return r; }
DEVI bf16x8 load8(const u16* p) { return *reinterpret_cast<const bf16x8*>(p); }
DEVI int nvis(int pos) { return pos >= 31 ? ((pos - 31) >> 4) + 1 : 0; }
DEVI void mask_tile(f32x16& p0, f32x16& p1, int dq, unsigned W) {
    const float NEG = -__builtin_inff();
#pragma unroll
    for (int r = 0; r < 16; ++r) { const int c = (r & 3) + 8 * (r >> 2);
        if ((unsigned)(dq - c) >= W) p0[r] = NEG;
        if ((unsigned)(dq - c - 32) >= W) p1[r] = NEG; }
}
DEVI void mask_cmp(f32x16& p0, f32x16& p1, int lim) {
    const float NEG = -__builtin_inff();
#pragma unroll
    for (int r = 0; r < 16; ++r) { const int c = (r & 3) + 8 * (r >> 2);
        if (c >= lim) p0[r] = NEG;
        if (c + 32 >= lim) p1[r] = NEG; }
}
DEVI void mask_all(f32x16& p0, f32x16& p1, bool kill) {
    const float NEG = -__builtin_inff();
#pragma unroll
    for (int r = 0; r < 16; ++r) { if (kill) p0[r] = NEG; if (kill) p1[r] = NEG; }
}
DEVI void partialSM(f32x16& p0, f32x16& p1, float& m_reg, float& mn, float& alpha, const bool kill = false) {
    float pmax = p0[0];
#pragma unroll
    for (int r = 1; r < 16; ++r) pmax = fmaxf(pmax, p0[r]);
#pragma unroll
    for (int r = 0; r < 16; ++r) pmax = fmaxf(pmax, p1[r]);
    { auto rr = __builtin_amdgcn_permlane32_swap(__float_as_uint(pmax), __float_as_uint(pmax), false, false);
      pmax = fmaxf(__uint_as_float(rr[0]), __uint_as_float(rr[1])); }
    if (kill) pmax = -__builtin_inff();
    constexpr float C2 = 1.4426950408889634f * SCALE;
    if (__builtin_expect(__all((pmax - m_reg) * SCALE <= THR), 1)) { mn = m_reg; alpha = 1.f; }
    else { mn = fmaxf(m_reg, pmax); alpha = __builtin_amdgcn_exp2f((m_reg - mn) * C2); m_reg = mn; }
    const float mnL = kill ? -__builtin_inff() : -mn * C2;
#pragma unroll
    for (int r = 0; r < 16; ++r) p0[r] = fmaf(p0[r], C2, mnL);
#pragma unroll
    for (int r = 0; r < 16; ++r) p1[r] = fmaf(p1[r], C2, mnL);
#pragma unroll
    for (int r = 0; r < 16; ++r) p0[r] = __builtin_amdgcn_exp2f(p0[r]);
}
DEVI void finishSM(f32x16& p0, f32x16& p1, float alpha, float& l_reg, bf16x8& pa0, bf16x8& pa1, bf16x8& pa2, bf16x8& pa3) {
#pragma unroll
    for (int r = 0; r < 16; ++r) p1[r] = __builtin_amdgcn_exp2f(p1[r]);
    float ps = 0;
#pragma unroll
    for (int r = 0; r < 16; ++r) ps += p0[r];
#pragma unroll
    for (int r = 0; r < 16; ++r) ps += p1[r];
    { auto rr = __builtin_amdgcn_permlane32_swap(__float_as_uint(ps), __float_as_uint(ps), false, false);
      ps = __uint_as_float(rr[0]) + __uint_as_float(rr[1]); }
    l_reg = l_reg * alpha + ps;
#define PK4(P, B_, OUT) do { unsigned a0 = cvtpk(P[B_+0], P[B_+1]), a1 = cvtpk(P[B_+2], P[B_+3]);                          \
        unsigned b0 = cvtpk(P[B_+4], P[B_+5]), b1 = cvtpk(P[B_+6], P[B_+7]);                                             \
        auto r0 = __builtin_amdgcn_permlane32_swap(a0, b0, false, false); auto r1 = __builtin_amdgcn_permlane32_swap(a1, b1, false, false); \
        u32x4 w = {r0[0], r1[0], r0[1], r1[1]}; OUT = *reinterpret_cast<bf16x8*>(&w); } while (0)
    PK4(p0, 0, pa0); PK4(p0, 8, pa1); PK4(p1, 0, pa2); PK4(p1, 8, pa3);
#undef PK4
}
template <int KB, bool SK>
DEVI void qkt(f32x16& p0, f32x16& p1, const char* K_lds, int r32, int hi, const pg8::i32x8_* q8, bool act) {
    if (SK && !act) { const float NEG = -__builtin_inff();
#pragma unroll
        for (int r = 0; r < 16; ++r) { p0[r] = NEG; p1[r] = NEG; } return; }
    const char* kb = K_lds + KB * SHM_K;
    const int one = 0x7f7f7f7f;
    typedef int i4 __attribute__((ext_vector_type(4)));
    { const pg8::i32x8_ a00 = __builtin_shufflevector(*(const i4*)(kb + KSWZ8(r32, 32 * hi)), *(const i4*)(kb + KSWZ8(r32, 32 * hi + 16)), 0, 1, 2, 3, 4, 5, 6, 7);
      const pg8::i32x8_ a10 = __builtin_shufflevector(*(const i4*)(kb + 4096 + KSWZ8(r32, 32 * hi)), *(const i4*)(kb + 4096 + KSWZ8(r32, 32 * hi + 16)), 0, 1, 2, 3, 4, 5, 6, 7);
      asm volatile("s_waitcnt lgkmcnt(0)\n\tv_mfma_scale_f32_32x32x64_f8f6f4 %0, %2, %4, 0, %5, %5 op_sel_hi:[0,0,0]\n\tv_mfma_scale_f32_32x32x64_f8f6f4 %1, %3, %4, 0, %5, %5 op_sel_hi:[0,0,0]"
                   : "=&v"(p0), "=&v"(p1) : "v"(a00), "v"(a10), "v"(q8[0]), "v"(one) : "memory"); }
    { const pg8::i32x8_ a01 = __builtin_shufflevector(*(const i4*)(kb + KSWZ8(r32, 64 + 32 * hi)), *(const i4*)(kb + KSWZ8(r32, 64 + 32 * hi + 16)), 0, 1, 2, 3, 4, 5, 6, 7);
      const pg8::i32x8_ a11 = __builtin_shufflevector(*(const i4*)(kb + 4096 + KSWZ8(r32, 64 + 32 * hi)), *(const i4*)(kb + 4096 + KSWZ8(r32, 64 + 32 * hi + 16)), 0, 1, 2, 3, 4, 5, 6, 7);
      asm volatile("s_waitcnt lgkmcnt(0)\n\tv_mfma_scale_f32_32x32x64_f8f6f4 %0, %2, %4, %0, %5, %5 op_sel_hi:[0,0,0]\n\tv_mfma_scale_f32_32x32x64_f8f6f4 %1, %3, %4, %1, %5, %5 op_sel_hi:[0,0,0]\n\ts_nop 15\n\ts_nop 15\n\ts_nop 15\n\ts_nop 15"
                   : "+v"(p0), "+v"(p1) : "v"(a01), "v"(a11), "v"(q8[1]), "v"(one) : "memory"); }
}
template <int VB, bool SK>
DEVI void pv_tile(f32x16* o, int vb0, bf16x8 pa0, bf16x8 pa1, bf16x8 pa2, bf16x8 pa3, bool act) {
    if (SK && !act) return;
#define TRRD(dst, off) asm volatile("ds_read_b64_tr_b16 %0, %1 offset:%2" : "=&v"(dst) : "v"(vb0), "i"(off) : "memory")
#define PV_D0(d0) do { s16x4 l0, l1, l2, l3, h0, h1, h2, h3; constexpr int b_ = VB * SHM_V + v_rd_off(d0, 0, 0); \
        TRRD(l0, b_); TRRD(h0, b_ + 2048); TRRD(l1, b_ + 4096); TRRD(h1, b_ + 6144); TRRD(l2, b_ + 8192); TRRD(h2, b_ + 10240); TRRD(l3, b_ + 12288); TRRD(h3, b_ + 14336); \
        asm volatile("s_waitcnt lgkmcnt(0)" ::: "memory"); SBAR();   \
        o[d0] = __builtin_amdgcn_mfma_f32_32x32x16_bf16(pa0, (bf16x8){l0[0], l0[1], l0[2], l0[3], h0[0], h0[1], h0[2], h0[3]}, o[d0], 0, 0, 0);   \
        o[d0] = __builtin_amdgcn_mfma_f32_32x32x16_bf16(pa1, (bf16x8){l1[0], l1[1], l1[2], l1[3], h1[0], h1[1], h1[2], h1[3]}, o[d0], 0, 0, 0);   \
        o[d0] = __builtin_amdgcn_mfma_f32_32x32x16_bf16(pa2, (bf16x8){l2[0], l2[1], l2[2], l2[3], h2[0], h2[1], h2[2], h2[3]}, o[d0], 0, 0, 0);   \
        o[d0] = __builtin_amdgcn_mfma_f32_32x32x16_bf16(pa3, (bf16x8){l3[0], l3[1], l3[2], l3[3], h3[0], h3[1], h3[2], h3[3]}, o[d0], 0, 0, 0); } while (0)
    PV_D0(0); PV_D0(1); PV_D0(2); PV_D0(3);
#undef PV_D0
#undef TRRD
}
struct ABlock { const unsigned char* Q; const unsigned char* K; const u16* V; int P0, row0, b, head; };
struct Seam { pg8::i32x8_ q8[2]; u32x4 st_k; bf16x8 st_v0, st_v1; };
struct Epi { const float* gates; u16* dst; const u16* oc; const u16* ow; float* imp; const unsigned long long* sel; };
template <int MODE> DEVI int jlo(int P0) { if (MODE == M_WIN) { const int lowk = P0 - WIN + 1; return lowk > 0 ? lowk / KVBLK : 0; } return 0; }
template <int MODE, int QBE = QB> DEVI int jhi(int P0) {
    if (MODE == M_CMP) { const int n = (nvis(P0 + QBE - 1) + KVBLK - 1) / KVBLK; return n < 1 ? 1 : n; }
    return (P0 + QBE - 1) / KVBLK + 1; }
#define ROWB(p, k0) ((const char*)((p) + (size_t)(k0) * LDK))
#define VMW() asm volatile("s_waitcnt vmcnt(0)" ::: "memory")
#define VMWN(n) asm volatile("s_waitcnt vmcnt(%0)" :: "i"(n) : "memory")
#define SLOAD_H(Kp, Vp, k0) do { const char* vb_ = ROWB(Vp, k0); const char* kb__ = (const char*)(Kp) + (size_t)(k0) * LDK8;                     \
                         S.st_v0 = load8((const u16*)(vb_ + voff0)); S.st_v1 = load8((const u16*)(vb_ + voff1));              \
                         S.st_k = *(const u32x4*)(kb__ + koff8); } while (0)
#define SWRITE_HK(bf) do { *(u32x4*)(K_lds + (bf) * SHM_K + kws) = S.st_k; } while (0)
#define SWRITE_HV(bf) do { *(bf16x8*)(V_lds + (bf) * SHM_V + vst0) = S.st_v0; *(bf16x8*)(V_lds + (bf) * SHM_V + vst1) = S.st_v1; } while (0)
#define SWRITE_H(bf) do { SWRITE_HV(bf); SWRITE_HK(bf); } while (0)
template <int MODE, int LDK, int LDK8, bool GQ = false>
DEVI void prime(const ABlock& cur, char* lds, Seam& S, const int tid) {
    const int wid = __builtin_amdgcn_readfirstlane(tid >> 6), lane = tid & 63, r32 = lane & 31, hi = lane >> 5;
    const int sr = tid >> 4, sc = (tid & 15) * 8, kws = KSWZ8(tid >> 3, (tid & 7) * 16); char* K_lds = lds + 2 * SHM_V;
    const unsigned voff0 = (unsigned)(sr * LDK + sc) * 2u, voff1 = (unsigned)((32 + sr) * LDK + sc) * 2u, koff8 = (unsigned)((tid >> 3) * LDK8 + (tid & 7) * 16);
    const unsigned qoff = GQ ? (unsigned)(((wid & 1) * QBLK + r32) * 3072 + (wid >> 1) * 128 + hi * 32) : (unsigned)((wid * QBLK + r32) * 3072 + hi * 32);
    const int kb0 = jlo<MODE>(cur.P0) * KVBLK;
    { typedef int i4 __attribute__((ext_vector_type(4)));
#pragma unroll
      for (int s_ = 0; s_ < 2; ++s_) S.q8[s_] = __builtin_shufflevector(*(const i4*)(cur.Q + qoff + 64 * s_), *(const i4*)(cur.Q + qoff + 64 * s_ + 16), 0, 1, 2, 3, 4, 5, 6, 7); }
    SLOAD_H(cur.K, cur.V, kb0); VMW(); SWRITE_HK(0);
    __syncthreads();
}
template <int MODE, int EPI, int GK, int LDK, int LDK8, bool SK, bool GQ = false>
DEVI void block(const ABlock& cur, const ABlock& nxt, char* lds, Seam& S, const Epi& E, const int tid) {
    const int wid = __builtin_amdgcn_readfirstlane(tid >> 6), lane = tid & 63, r32 = lane & 31, hi = lane >> 5;
    const int wrow = GQ ? (wid & 1) * QBLK : wid * QBLK, whead = GQ ? cur.head + (wid >> 1) : cur.head;
    const int j_lo = jlo<MODE>(cur.P0), j_hi = jhi<MODE, GQ ? 64 : QB>(cur.P0);
    const int NT = j_hi - j_lo;
    const int kbn = jlo<MODE>(nxt.P0) * KVBLK;
    const int qlo = cur.P0 + wrow, qm = qlo + r32 - 4 * hi;
    char* V_lds = lds; char* K_lds = lds + 2 * SHM_V;
    float* wsl = (float*)(lds + 2 * SHM_V + 2 * SHM_K) + wid * 64; float* li_l = wsl, * al_l = wsl + 32;
    float m_reg = -1e30f, l_reg = 0; f32x16 o[4] = {};
    const int sr = tid >> 4, sc = (tid & 15) * 8, vst0 = v_st(sr, sc), vst1 = v_st(32 + sr, sc), kws = KSWZ8(tid >> 3, (tid & 7) * 16);
    const unsigned voff0 = (unsigned)(sr * LDK + sc) * 2u, voff1 = (unsigned)((32 + sr) * LDK + sc) * 2u, koff8 = (unsigned)((tid >> 3) * LDK8 + (tid & 7) * 16);
    const unsigned qoff = GQ ? (unsigned)(((wid & 1) * QBLK + r32) * 3072 + (wid >> 1) * 128 + hi * 32) : (unsigned)((wid * QBLK + r32) * 3072 + hi * 32);
    const int vb0 = (int)(uintptr_t)V_lds + v_rd_base(lane);
    const unsigned char* Kh = cur.K; const u16* Vh = cur.V;
    unsigned sello = 0u, selhi = 0u; int nvl = 0;
    if (MODE == M_SEL) { const unsigned long long sw = E.sel[(size_t)(cur.b * 4 + (cur.head >> 2)) * 4096 + qlo + r32]; sello = (unsigned)sw; selhi = (unsigned)(sw >> 32); }
    if (MODE == M_CMP) nvl = nvis(qlo + r32) - 4 * hi;
#define RESC(a) do { if (__any((a) < 1.f)) { if (hi == 0) al_l[r32] = (a); asm volatile("s_waitcnt lgkmcnt(0)" ::: "memory");              \
                     for (int d_ = 0; d_ < 4; ++d_) for (int r = 0; r < 16; ++r) o[d_][r] *= al_l[crow(r, hi)]; } } while (0)
#define KBASE(t) ((j_lo + (t)) * KVBLK)
#define ACT(t) (MODE == M_WIN ? (KBASE(t) <= qlo + QBLK - 1 && KBASE(t) + KVBLK - 1 >= qlo - WIN + 1) : MODE == M_SEL ? (KBASE(t) <= qlo + QBLK - 1) : (KBASE(t) < nvis(qlo + QBLK - 1)))
#define MASKT(P0_, P1_, t) do { const int kb_ = KBASE(t); if (!SK || ACT(t)) {                                                             \
        if (MODE == M_WIN) { if (kb_ + KVBLK - 1 > qlo || kb_ <= qlo + QBLK - 1 - WIN) mask_tile(P0_, P1_, qm - kb_, (unsigned)WIN); }       \
        else if (MODE == M_SEL) { if (kb_ + KVBLK - 1 > qlo) mask_tile(P0_, P1_, qm - kb_, 0x40000000u);                                    \
            const int jt_ = j_lo + (t); const unsigned w_ = (jt_ & 32) ? selhi : sello; killf = ((w_ >> (jt_ & 31)) & 1u) == 0u; } \
        else { mask_cmp(P0_, P1_, nvl - kb_); } } } while (0)
    constexpr int NQL = 4;
#define SEAM_K0() do { VMWN(NQL); SWRITE_HK(0); SBAR(); } while (0)
    f32x16 pA0, pA1, pB0, pB1; float mnA, mnB, alA, alB; bf16x8 pa0, pa1, pa2, pa3; bool killf = false;
    SWRITE_HV(0); SBAR();
    if (NT > 1) { SLOAD_H(Kh, Vh, KBASE(1)); }
    SBAR(); qkt<0, SK>(pA0, pA1, K_lds, r32, hi, S.q8, ACT(0));
    MASKT(pA0, pA1, 0); partialSM(pA0, pA1, m_reg, mnA, alA, MODE == M_SEL && killf);
    if (NT > 1) { VMW(); SWRITE_H(1); }
    __syncthreads();
#define HALF_STEP(PX0, PX1, mnX, alX, PY0, PY1, alY, t, KB, VB, SB) do {                                                      \
        SBAR(); qkt<KB, SK>(PX0, PX1, K_lds, r32, hi, S.q8, ACT(t));                                             \
        finishSM(PY0, PY1, alY, l_reg, pa0, pa1, pa2, pa3); SBAR();                                                           \
        if ((t) + 1 < NT) { SLOAD_H(Kh, Vh, KBASE((t) + 1)); SBAR(); }                                               \
        pv_tile<VB, SK>(o, vb0, pa0, pa1, pa2, pa3, ACT((t) - 1)); MASKT(PX0, PX1, (t)); partialSM(PX0, PX1, m_reg, mnX, alX, MODE == M_SEL && killf);                                        \
        __syncthreads();                                                                                                      \
        if ((t) + 1 < NT) { VMW(); SWRITE_H(SB); }                                                                          \
        RESC(alX); __syncthreads(); } while (0)
    for (int t = 1; t + 1 < NT; t += 2) {
        HALF_STEP(pB0, pB1, mnB, alB, pA0, pA1, alA, t, 1, 0, 0);
        HALF_STEP(pA0, pA1, mnA, alA, pB0, pB1, alB, t + 1, 0, 1, 1);
    }
    const bool even = (NT & 1) == 0;
    if (even) { SBAR(); qkt<1, SK>(pB0, pB1, K_lds, r32, hi, S.q8, ACT(NT - 1)); SBAR(); }
    { const unsigned char* nK = nxt.K; const u16* nV = nxt.V; SLOAD_H(nK, nV, kbn); SBAR();
      typedef int i4 __attribute__((ext_vector_type(4)));
#pragma unroll
      for (int s_ = 0; s_ < 2; ++s_) S.q8[s_] = __builtin_shufflevector(*(const i4*)(nxt.Q + qoff + 64 * s_), *(const i4*)(nxt.Q + qoff + 64 * s_ + 16), 0, 1, 2, 3, 4, 5, 6, 7); }
    SBAR();
    finishSM(pA0, pA1, alA, l_reg, pa0, pa1, pa2, pa3); SBAR();
    pv_tile<0, SK>(o, vb0, pa0, pa1, pa2, pa3, ACT(even ? NT - 2 : NT - 1));
    if (even) { MASKT(pB0, pB1, NT - 1); partialSM(pB0, pB1, m_reg, mnB, alB, MODE == M_SEL && killf); __syncthreads(); RESC(alB);
        finishSM(pB0, pB1, alB, l_reg, pa0, pa1, pa2, pa3); SBAR(); pv_tile<1, SK>(o, vb0, pa0, pa1, pa2, pa3, ACT(NT - 1)); }
    SBAR(); SEAM_K0();
    if (hi == 0) { li_l[r32] = l_reg; if (EPI != E_IMP && GK >= 0) al_l[r32] = sigm(E.gates[(size_t)(cur.row0 + wrow + r32) * 64 + 8 + whead * 3 + (GK < 0 ? 0 : GK)]); }
    asm volatile("s_waitcnt lgkmcnt(0)" ::: "memory");
    float rli[16];
#pragma unroll
    for (int r = 0; r < 16; ++r) { const float l_ = li_l[crow(r, hi)]; rli[r] = l_ > 0.f ? __builtin_amdgcn_rcpf(l_) : 0.f; if (EPI != E_IMP && GK >= 0) rli[r] *= al_l[crow(r, hi)]; }
    const size_t ebase = ((size_t)cur.row0 * D_ + whead * 128) * 2;
    const unsigned elane = (unsigned)((wrow + 4 * hi) * D_ + r32) * 2u;
    float* impb = E.imp + ((size_t)(cur.b * 16 + whead) * 4096 + cur.P0) * 64;
    const unsigned ilane = (unsigned)((wrow + 4 * hi) * 64 + r32) * 4u;
    const size_t frb = ((((size_t)(cur.b * 16 + whead) * 128 + ((cur.P0 + wrow) >> 5)) * 64 + lane) * 64) * 2;
    if (EPI == E_GATED) {
#pragma unroll
        for (int i = 0; i < 8; ++i) { const int r0 = 2 * i, r1 = 2 * i + 1; u32x4 w;
            w.x = cvtpk(o[0][r0] * rli[r0], o[1][r0] * rli[r0]); w.y = cvtpk(o[2][r0] * rli[r0], o[3][r0] * rli[r0]);
            w.z = cvtpk(o[0][r1] * rli[r1], o[1][r1] * rli[r1]); w.w = cvtpk(o[2][r1] * rli[r1], o[3][r1] * rli[r1]);
            *(u32x4*)((char*)E.dst + frb + i * 16) = w; }
    } else if (EPI == E_FINAL) {
        u32x4 cq[8], wq[8];
#pragma unroll
        for (int i = 0; i < 8; ++i) { cq[i] = *(const u32x4*)((const char*)E.oc + frb + i * 16); wq[i] = *(const u32x4*)((const char*)E.ow + frb + i * 16); }
#pragma unroll
        for (int r = 0; r < 16; ++r) { const int cr = (r & 3) + 8 * (r >> 2);
#pragma unroll
            for (int d0 = 0; d0 < 4; ++d0) { const float v = o[d0][r] * rli[r];
                const unsigned cw = cq[r >> 1][(r & 1) * 2 + (d0 >> 1)], ww = wq[r >> 1][(r & 1) * 2 + (d0 >> 1)];
                const float cv = __uint_as_float((d0 & 1) ? (cw & 0xffff0000u) : (cw << 16)), wv = __uint_as_float((d0 & 1) ? (ww & 0xffff0000u) : (ww << 16));
                const unsigned off = elane + (unsigned)(cr * D_ + d0 * 32) * 2u;
                const float f = (v + cv + wv) * 8.f;
                const float f1 = __int_as_float(__builtin_amdgcn_mov_dpp(__float_as_int(f), 0x55, 0xF, 0xF, true)), f2 = __int_as_float(__builtin_amdgcn_mov_dpp(__float_as_int(f), 0xAA, 0xF, 0xF, true)),
                            f3 = __int_as_float(__builtin_amdgcn_mov_dpp(__float_as_int(f), 0xFF, 0xF, 0xF, true));
                if ((r32 & 3) == 0) *(unsigned*)((char*)E.dst + (ebase >> 1) + (off >> 1)) = pk4_fp8(f, f1, f2, f3); } }
    } else {
#pragma unroll
        for (int r = 0; r < 16; ++r) { const int cr = (r & 3) + 8 * (r >> 2);
#pragma unroll
            for (int d0 = 0; d0 < 2; ++d0) *(float*)((char*)impb + ilane + (unsigned)(cr * 64 + d0 * 32) * 4u) = o[d0][r] * rli[r]; }
    }
    __syncthreads();
#undef RESC
#undef KBASE
#undef ACT
#undef MASKT
#undef SEAM_K0
#undef HALF_STEP
}
#undef ROWB
#undef VMW
#undef VMWN
#undef SLOAD_H
#undef SWRITE_HK
#undef SWRITE_HV
#undef SWRITE_H
struct Item { int b, head, qb0, qb1; };
template <bool PAIRED> DEVI Item decode(int L) {
    Item it; const int xcd = L & 7, k = L >> 3;
    if (PAIRED) { const int gi = k >> 5, r = k & 31, hl = r >> 3, x = r & 7; const int bg = gi * 8 + xcd; it.b = bg >> 2; it.head = (bg & 3) * 4 + hl; it.qb0 = x; it.qb1 = 15 - x; }
    else { const int gi = k >> 6, r = k & 63, hl = r >> 4, x = r & 15; const int bg = gi * 8 + xcd; it.b = bg >> 2; it.head = (bg & 3) * 4 + hl; it.qb0 = it.qb1 = (hl & 2) ? x : 15 - x; }
    return it;
}
template <bool PAIRED> DEVI Item decode_gq(int L) {
    Item it; const int xcd = L & 7, k = L >> 3;
    if (PAIRED) { const int gi = k >> 5, x = k & 31, bg = gi * 8 + xcd; it.b = bg >> 2; it.head = (bg & 3) * 4; it.qb0 = x; it.qb1 = 63 - x; }
    else { const int gi = k >> 6, x = k & 63, bg = gi * 8 + xcd; it.b = bg >> 2; it.head = (bg & 3) * 4; it.qb0 = it.qb1 = (x & 32) ? 63 - (x & 31) : (x & 31); }
    return it;
}
template <int MODE, bool GQ = false> DEVI ABlock mkref(const Item& it, int pass, const u16* z, const unsigned char* z8, const unsigned char* kcmp8, const u16* vcmp) {
    const int qb = pass ? it.qb1 : it.qb0; ABlock r; r.b = it.b; r.head = it.head; r.P0 = qb * (GQ ? 64 : QB); r.row0 = it.b * 4096 + r.P0;
    r.Q = z8 + (size_t)r.row0 * 3072 + it.head * 128;
    const int g = it.head >> 2;
    if (MODE == M_WIN) { r.K = z8 + (size_t)it.b * 4096 * 3072 + 2560 + g * 128; r.V = z + (size_t)it.b * 4096 * NPAD + C_VW + g * 128; }
    else if (MODE == M_SEL) { r.K = z8 + (size_t)it.b * 4096 * 3072 + 2048 + g * 128; r.V = z + (size_t)it.b * 4096 * NPAD + C_VS + g * 128; }
    else { r.K = kcmp8 + (size_t)(it.b * 4 + g) * 256 * 128; r.V = vcmp; }
    return r;
}
template <int MODE, int EPI, int GK, int LDK, int LDK8, bool SK, bool PAIRED, bool GQ = false>
DEVI void run_pass(const u16* z, const unsigned char* z8, const unsigned char* kcmp8, const u16* vcmp, size_t vcmp_stride, char* lds, const Epi& E, const int tid_in, int G) {
    int tz_ = tid_in; asm volatile("" : "+v"(tz_)); const int tid = tz_;
    constexpr int total = PAIRED ? 512 : 1024;
    int L = blockIdx.x; if (L >= total) return;
    Item it = GQ ? decode_gq<PAIRED>(L) : decode<PAIRED>(L); int pass = 0;
    ABlock cur = mkref<MODE, GQ>(it, 0, z, z8, kcmp8, vcmp + (size_t)(it.b * 4 + (it.head >> 2)) * vcmp_stride);
    Seam S;
    prime<MODE, LDK, LDK8, GQ>(cur, lds, S, tid);
    for (;;) {
        const bool more_pass = pass == 0 && it.qb1 != it.qb0, more_item = L + G < total, last = !more_pass && !more_item;
        Item itn = it; int passn = pass + 1, Ln = L;
        if (!more_pass) { passn = 0; Ln = more_item ? L + G : L; itn = GQ ? decode_gq<PAIRED>(Ln) : decode<PAIRED>(Ln); }
        const ABlock nxt = last ? cur : mkref<MODE, GQ>(itn, passn, z, z8, kcmp8, vcmp + (size_t)(itn.b * 4 + (itn.head >> 2)) * vcmp_stride);
        block<MODE, EPI, GK, LDK, LDK8, SK, GQ>(cur, nxt, lds, S, E, tid);
        if (last) break;
        cur = nxt; it = itn; pass = passn; L = Ln;
    }
}
}

DEVI void phase_nsa1(KP a, unsigned char* lds, const int tid, int G) {
    unsigned char* ws = a->ws;
    const u16* z = (const u16*)(ws + WS_Z); const u16* kcmp = (const u16*)(ws + WS_KCMP); const u16* vcmp = kcmp + (size_t)16 * 256 * 128;
    att::Epi E{(const float*)(ws + WS_GATES), (u16*)(ws + WS_OC), nullptr, nullptr, (float*)(ws + WS_IMP), nullptr};
#ifndef NSA1_PASSES
#define NSA1_PASSES 7
#endif
#ifndef WIN_SK
#define WIN_SK false
#endif
    const unsigned char* z8 = ws + WS_Z8; const unsigned char* kcmp8 = ws + WS_KCMP8;
    if (NSA1_PASSES & 1) att::run_pass<att::M_CMP, att::E_GATED, 0, 128, 128, false, false, GQ_CV>(z, z8, kcmp8, vcmp, (size_t)256 * 128, (char*)lds, E, tid, G);
    __syncthreads();
    if (NSA1_PASSES & 2) att::run_pass<att::M_CMP, att::E_IMP, 0, 128, 128, false, false, GQ_CI>(z, z8, kcmp8, (const u16*)(ws + WS_OVL), 0, (char*)lds, E, tid, G);
    __syncthreads();
    E.dst = (u16*)(ws + WS_OW);
    if (NSA1_PASSES & 4) att::run_pass<att::M_WIN, att::E_GATED, 2, NPAD, 3072, WIN_SK, false, GQ_W>(z, z8, kcmp8, nullptr, 0, (char*)lds, E, tid, G);
}
DEVI void phase_topk(KP a, int lane, int wave, int G) {
    unsigned char* ws = a->ws; const float* imp = (const float*)(ws + WS_IMP); unsigned long long* sel = (unsigned long long*)(ws + WS_SEL);
    const int gw = blockIdx.x * 8 + wave, NGW = G * 8;
    float pf0[4], pf1[4];
    { const int task = gw * 2; if (task < M_ * 4) { const int bg = task >> 12, t = task & 4095, b = bg >> 2, g = bg & 3;
#pragma unroll
        for (int h = 0; h < 4; ++h) { const float* p = imp + ((size_t)(b * 16 + g * 4 + h) * 4096 + t) * 64 + lane; pf0[h] = p[0]; pf1[h] = p[64]; } } }
    for (int task = gw * 2; task < M_ * 4; task += NGW * 2) { const int bg = task >> 12, t = task & 4095;
        const float v0 = (pf0[0] + pf0[1]) + (pf0[2] + pf0[3]), v1 = (pf1[0] + pf1[1]) + (pf1[2] + pf1[3]);
        { const int tn = task + NGW * 2; if (tn < M_ * 4) { const int bgn = tn >> 12, t2 = tn & 4095, b = bgn >> 2, g = bgn & 3;
#pragma unroll
            for (int h = 0; h < 4; ++h) { const float* p = imp + ((size_t)(b * 16 + g * 4 + h) * 4096 + t2) * 64 + lane; pf0[h] = p[0]; pf1[h] = p[64]; } } }
        const int cur0 = t >> 6, cur1 = (t + 1) >> 6;
        const float s0 = ((lane == 0) || (lane == cur0) || (lane == cur0 - 1)) ? INFINITY : (lane <= cur0 ? v0 : -INFINITY);
        const float s1 = ((lane == 0) || (lane == cur1) || (lane == cur1 - 1)) ? INFINITY : (lane <= cur1 ? v1 : -INFINITY);
        int r0 = 0, r1 = 0;
#pragma unroll
        for (int jj = 0; jj < 64; ++jj) { const float a0 = __int_as_float(__builtin_amdgcn_readlane(__float_as_int(s0), jj)), a1 = __int_as_float(__builtin_amdgcn_readlane(__float_as_int(s1), jj));
            r0 += (a0 > s0 || (a0 == s0 && jj < lane)) ? 1 : 0; r1 += (a1 > s1 || (a1 == s1 && jj < lane)) ? 1 : 0; }
        const unsigned long long m0 = __ballot(r0 < 16 && lane <= cur0), m1 = __ballot(r1 < 16 && lane <= cur1);
        if (lane == 0) { sel[(size_t)bg * 4096 + t] = m0; sel[(size_t)bg * 4096 + t + 1] = m1; } }
}
DEVI void phase_nsa2(KP a, unsigned char* lds, const int tid, int G) {
    unsigned char* ws = a->ws;
    const u16* z = (const u16*)(ws + WS_Z);
    att::Epi E{(const float*)(ws + WS_GATES), (u16*)(ws + WS_O), (const u16*)(ws + WS_OC), (const u16*)(ws + WS_OW), nullptr, (const unsigned long long*)(ws + WS_SEL)};
    att::run_pass<att::M_SEL, att::E_FINAL, 1, NPAD, 3072, false, true, GQ_S>(z, ws + WS_Z8, nullptr, nullptr, 0, (char*)lds, E, tid, G);
}

typedef float f32x4_t __attribute__((ext_vector_type(4)));
DEVI void phase_ln1_router(KP a, unsigned char* lds, int tid, int lane, int wave, int G, int l) {
    unsigned char* ws = a->ws;
    const u16* pre = (const u16*)(ws + WS_H); u16* xa = (u16*)(ws + WS_XA); unsigned char* xb = ws + WS_XBF;
    const float* g1 = a->in[17] + l * D_; const float* b1 = a->in[18] + l * D_; const float* rb = a->in[20]; const float* wT = (const float*)(ws + WS_RWT);
    int* tokinfo = (int*)(ws + WS_MISC); int* hist = (int*)(ws + WS_MISC + 1280 * 1024);
    int* be = (int*)lds;
    float* lg = (float*)(lds + 1024);
    const int g4 = lane >> 4, l15 = lane & 15;
    for (int chunk = blockIdx.x; chunk < 256; chunk += G) {
      f32x4 gq[4][2], bq[4][2];
#pragma unroll
      for (int j = 0; j < 4; ++j)
#pragma unroll
          for (int hh = 0; hh < 2; ++hh) { gq[j][hh] = *(const f32x4*)(g1 + j * 512 + lane * 8 + 4 * hh); bq[j][hh] = *(const f32x4*)(b1 + j * 512 + lane * 8 + 4 * hh); }
      u32x4 pc[4], pn[4];
#pragma unroll
      for (int j = 0; j < 4; ++j) pc[j] = *(const u32x4*)(pre + (size_t)(chunk * 64 + wave * 8) * D_ + j * 512 + lane * 8);
      for (int rr = 0; rr < 8; ++rr) {
        const int row = chunk * 64 + wave * 8 + rr;
        if (rr < 7) {
#pragma unroll
            for (int j = 0; j < 4; ++j) pn[j] = *(const u32x4*)(pre + (size_t)(row + 1) * D_ + j * 512 + lane * 8); }
        float v[4][8]; float s = 0.f;
#pragma unroll
        for (int j = 0; j < 4; ++j) { unpack8(pc[j], v[j]); s += ((v[j][0] + v[j][1]) + (v[j][2] + v[j][3])) + ((v[j][4] + v[j][5]) + (v[j][6] + v[j][7])); }
        const float mean = wsum(s) * (1.f / D_); float q = 0.f;
#pragma unroll
        for (int j = 0; j < 4; ++j)
#pragma unroll
            for (int e = 0; e < 8; ++e) { v[j][e] -= mean; q += v[j][e] * v[j][e]; }
        const float rstd = 1.f / sqrtf(wsum(q) * (1.f / D_) + LN_EPS);
#pragma unroll
        for (int j = 0; j < 4; ++j) { const int c0 = j * 512 + lane * 8; float y[8];
#pragma unroll
            for (int e = 0; e < 8; ++e) y[e] = v[j][e] * rstd * gq[j][e >> 2][e & 3] + bq[j][e >> 2][e & 3];
            u32x4 wx; wx.x = pk2(y[0], y[1]); wx.y = pk2(y[2], y[3]); wx.z = pk2(y[4], y[5]); wx.w = pk2(y[6], y[7]); *(u32x4*)(xa + (size_t)row * D_ + c0) = wx;
            u32x2 w8; w8.x = pk4_fp8(y[0], y[1], y[2], y[3]); w8.y = pk4_fp8(y[4], y[5], y[6], y[7]); *(u32x2*)(xb + (size_t)row * D_ + c0) = w8; }
#pragma unroll
        for (int j = 0; j < 4; ++j) pc[j] = pn[j];
      }
      asm volatile("s_waitcnt vmcnt(0)" ::: "memory"); __syncthreads();
      {
          f32x4 racc[4][2];
#pragma unroll
          for (int rt = 0; rt < 4; ++rt) { racc[rt][0] = (f32x4){0.f, 0.f, 0.f, 0.f}; racc[rt][1] = (f32x4){0.f, 0.f, 0.f, 0.f}; }
          const u16* ap = xa + (size_t)(chunk * 64 + l15) * D_ + wave * 256 + 8 * g4; const float* bp = wT + (size_t)l15 * D_ + wave * 256 + 8 * g4;
#pragma unroll 2
          for (int blk = 0; blk < 8; ++blk) { u32x4 ar[4]; f32x4 br[2][2];
#pragma unroll
              for (int rt = 0; rt < 4; ++rt) ar[rt] = *(const u32x4*)(ap + (size_t)rt * 16 * D_ + 32 * blk);
#pragma unroll
              for (int et = 0; et < 2; ++et) { br[et][0] = *(const f32x4*)(bp + (size_t)et * 16 * D_ + 32 * blk); br[et][1] = *(const f32x4*)(bp + (size_t)et * 16 * D_ + 32 * blk + 4); }
#pragma unroll
              for (int rt = 0; rt < 4; ++rt) { float af[8]; unpack8(ar[rt], af);
#pragma unroll
                  for (int e = 0; e < 8; ++e) { racc[rt][0] = __builtin_amdgcn_mfma_f32_16x16x4f32(af[e], br[0][e >> 2][e & 3], racc[rt][0], 0, 0, 0); racc[rt][1] = __builtin_amdgcn_mfma_f32_16x16x4f32(af[e], br[1][e >> 2][e & 3], racc[rt][1], 0, 0, 0); } } }
          f32x4* part = (f32x4*)(lds + 16384);
#pragma unroll
          for (int rt = 0; rt < 4; ++rt) { part[(wave * 8 + rt * 2) * 64 + lane] = racc[rt][0]; part[(wave * 8 + rt * 2 + 1) * 64 + lane] = racc[rt][1]; }
          __syncthreads();
          { f32x4 v = part[wave * 64 + lane];
#pragma unroll
            for (int w2 = 1; w2 < 8; ++w2) v = v + part[(w2 * 8 + wave) * 64 + lane];
#pragma unroll
            for (int j = 0; j < 4; ++j) lg[((wave >> 1) * 16 + 4 * g4 + j) * 33 + (wave & 1) * 16 + l15] = v[j]; }
      }
      __syncthreads();
      if (tid < 64) { const int row = chunk * 64 + tid;
        float aff[32], sel[32];
#pragma unroll
        for (int e = 0; e < 32; ++e) { aff[e] = sigm(lg[tid * 33 + e]); sel[e] = aff[e] + rb[e]; }
        int bg_ = 0; float bs = -INFINITY;
#pragma unroll
        for (int gq = 0; gq < 8; ++gq) { const float s0 = sel[gq * 4], s1 = sel[gq * 4 + 1], s2 = sel[gq * 4 + 2], s3 = sel[gq * 4 + 3];
            const float mx = fmaxf(fmaxf(s0, s1), fmaxf(s2, s3));
            const float m2 = fmaxf(fmaxf(fminf(s0, s1), fminf(s2, s3)), fminf(fmaxf(s0, s1), fmaxf(s2, s3)));
            const float gs = mx + m2; if (gs > bs) { bs = gs; bg_ = gq; } }
        float c0 = 0.f, c1 = 0.f, c2 = 0.f, c3 = 0.f, a0 = 0.f, a1 = 0.f, a2 = 0.f, a3 = 0.f;
#pragma unroll
        for (int gq = 0; gq < 8; ++gq) if (gq == bg_) { c0 = sel[gq * 4]; c1 = sel[gq * 4 + 1]; c2 = sel[gq * 4 + 2]; c3 = sel[gq * 4 + 3]; a0 = aff[gq * 4]; a1 = aff[gq * 4 + 1]; a2 = aff[gq * 4 + 2]; a3 = aff[gq * 4 + 3]; }
        int i1 = 0; float m1 = c0;
        if (c1 > m1) { m1 = c1; i1 = 1; } if (c2 > m1) { m1 = c2; i1 = 2; } if (c3 > m1) { m1 = c3; i1 = 3; }
        int i2 = -1; float m2v = -INFINITY;
        if (i1 != 0 && c0 > m2v) { m2v = c0; i2 = 0; } if (i1 != 1 && c1 > m2v) { m2v = c1; i2 = 1; } if (i1 != 2 && c2 > m2v) { m2v = c2; i2 = 2; } if (i1 != 3 && c3 > m2v) { m2v = c3; i2 = 3; }
        if (i2 < 0) i2 = (i1 == 0) ? 1 : 0;
        float w1 = i1 == 0 ? a0 : i1 == 1 ? a1 : i1 == 2 ? a2 : a3, w2 = i2 == 0 ? a0 : i2 == 1 ? a1 : i2 == 2 ? a2 : a3;
        const float ws_ = w1 + w2; w1 /= ws_; w2 /= ws_;
        const int e1 = bg_ * 4 + i1, e2 = bg_ * 4 + i2;
        int* ti = tokinfo + (size_t)row * 8; ti[0] = e1; ti[2] = e2; ti[4] = __float_as_int(w1); ti[5] = __float_as_int(w2);
        int r1 = 0, r2 = 0, myh = 0;
        const unsigned long long lt = (1ull << lane) - 1ull;
        for (int e = 0; e < 32; ++e) { const unsigned long long mm1 = __ballot(e1 == e), mm2 = __ballot(e2 == e);
            const int below = __popcll(mm1 & lt) + __popcll(mm2 & lt);
            if (e1 == e) r1 = below; if (e2 == e) r2 = below; if (lane == e) myh = __popcll(mm1) + __popcll(mm2); }
        ti[1] = r1; ti[3] = r2;
        if (lane < 32) hist[chunk * 32 + lane] = myh; }
      __syncthreads();
    }
    (void)be;
}
DEVI int moe_base(const unsigned* cnt, int lane, int& base_out) {
    const unsigned c = cnt[lane & 31]; const int tiles = (int)((c + 255u) >> 8); int incl = tiles;
#pragma unroll
    for (int o = 1; o < 32; o <<= 1) { const int t_ = __shfl_up(incl, o); if ((lane & 31) >= o) incl += t_; }
    base_out = (incl - tiles) * 256; return __shfl(incl, 31);
}
DEVI void phase_moe_gather(KP a, unsigned char* lds, int tid, int lane, int wave, int G, int l) {
    unsigned char* ws = a->ws;
    unsigned* cnt = (unsigned*)(ws + WS_CTL) + CW_CNT + l * 32; int* tokinfo = (int*)(ws + WS_MISC); const int* hist = (const int*)(ws + WS_MISC + 1280 * 1024);
    const unsigned char* xb = ws + WS_XBF; unsigned char* xg = ws + WS_XG; float* roww = (float*)(ws + WS_MISC + 1 * MiB);
    int* so = (int*)lds;
    for (int chunk = blockIdx.x; chunk < 256; chunk += G) {
        if (tid < 64) so[tid] = 0;
        __syncthreads();
        { const int e = tid & 31, seg = tid >> 5; int below = 0, all = 0;
          for (int b2 = seg * 16; b2 < seg * 16 + 16; ++b2) { const int h = hist[b2 * 32 + e]; all += h; if (b2 < chunk) below += h; }
          atomicAdd(&so[e], below); atomicAdd(&so[32 + e], all); }
        __syncthreads();
        if (wave == 0) { const int c = so[32 + (lane & 31)]; const int tiles = (c + 255) >> 8; int incl = tiles;
#pragma unroll
            for (int o = 1; o < 32; o <<= 1) { const int t_ = __shfl_up(incl, o); if ((lane & 31) >= o) incl += t_; }
            if (lane < 32) { so[64 + lane] = (incl - tiles) * 256; if (chunk == 0) cnt[lane] = (unsigned)c; } }
        __syncthreads();
        for (int r0 = 0; r0 < 8; r0 += 4) { u32x4 cp[4][2]; int sl0[4], sl1[4];
#pragma unroll
            for (int q = 0; q < 4; ++q) { const int row = chunk * 64 + wave * 8 + r0 + q; const int* ti = tokinfo + (size_t)row * 8;
                const int e0 = ti[0], rk0 = ti[1], e1 = ti[2], rk1 = ti[3]; sl0[q] = so[64 + e0] + so[e0] + rk0; sl1[q] = so[64 + e1] + so[e1] + rk1;
                const u32x4* src = (const u32x4*)(xb + (size_t)row * D_); cp[q][0] = src[lane]; cp[q][1] = src[64 + lane]; }
#pragma unroll
            for (int q = 0; q < 4; ++q) { const int row = chunk * 64 + wave * 8 + r0 + q; int* ti = tokinfo + (size_t)row * 8;
                u32x4* d0 = (u32x4*)(xg + (size_t)sl0[q] * D_); u32x4* d1 = (u32x4*)(xg + (size_t)sl1[q] * D_);
                d0[lane] = cp[q][0]; d0[64 + lane] = cp[q][1]; d1[lane] = cp[q][0]; d1[64 + lane] = cp[q][1];
                if (lane == 0) { roww[sl0[q]] = __int_as_float(ti[4]); roww[sl1[q]] = __int_as_float(ti[5]); ti[6] = sl0[q]; ti[7] = sl1[q]; } } }
        __syncthreads();
    }
}
DEVI void phase_ln2(KP a, int lane, int wave, int G, int l) {
    unsigned char* ws = a->ws;
    const int* tokinfo = (const int*)(ws + WS_MISC);
    const u16* xa = (const u16*)(ws + WS_XA); const u16* Y = (const u16*)(ws + WS_Y); unsigned char* x8 = ws + WS_X8;
    float* xo = a->out; u16* xoh = (u16*)(ws + WS_XB);
    const float* g2 = a->in[24] + l * D_; const float* b2 = a->in[25] + l * D_;
    const int gw = blockIdx.x * 8 + wave, NGW = G * 8;
    int row = gw; if (row >= M_) return;
    f32x4 gq[4][2], bq[4][2];
#pragma unroll
    for (int j = 0; j < 4; ++j)
#pragma unroll
        for (int hh = 0; hh < 2; ++hh) { gq[j][hh] = *(const f32x4*)(g2 + j * 512 + lane * 8 + 4 * hh); bq[j][hh] = *(const f32x4*)(b2 + j * 512 + lane * 8 + 4 * hh); }
    u32x4 cx[4], c1[4], c2[4], nx[4], n1[4], n2[4];
    int s1 = tokinfo[(size_t)row * 8 + 6], s2 = tokinfo[(size_t)row * 8 + 7];
#pragma unroll
    for (int j = 0; j < 4; ++j) { const int c0 = j * 512 + lane * 8; cx[j] = *(const u32x4*)(xa + (size_t)row * D_ + c0); c1[j] = *(const u32x4*)(Y + (size_t)s1 * D_ + c0); c2[j] = *(const u32x4*)(Y + (size_t)s2 * D_ + c0); }
    int rn = row + NGW, t1 = 0, t2 = 0;
    if (rn < M_) { t1 = tokinfo[(size_t)rn * 8 + 6]; t2 = tokinfo[(size_t)rn * 8 + 7]; }
    for (;;) {
        const bool more = rn < M_;
        if (more) {
#pragma unroll
            for (int j = 0; j < 4; ++j) { const int c0 = j * 512 + lane * 8; nx[j] = *(const u32x4*)(xa + (size_t)rn * D_ + c0); n1[j] = *(const u32x4*)(Y + (size_t)t1 * D_ + c0); n2[j] = *(const u32x4*)(Y + (size_t)t2 * D_ + c0); } }
        const int rnn = rn + NGW; int u1 = 0, u2 = 0;
        if (rnn < M_) { u1 = tokinfo[(size_t)rnn * 8 + 6]; u2 = tokinfo[(size_t)rnn * 8 + 7]; }
        float v[4][8]; float s = 0.f;
#pragma unroll
        for (int j = 0; j < 4; ++j) { float xv[8], y1[8], y2[8]; unpack8(cx[j], xv); unpack8(c1[j], y1); unpack8(c2[j], y2);
#pragma unroll
            for (int e = 0; e < 8; ++e) { v[j][e] = xv[e] * ALPHA + (y1[e] + y2[e]); }
            s += ((v[j][0] + v[j][1]) + (v[j][2] + v[j][3])) + ((v[j][4] + v[j][5]) + (v[j][6] + v[j][7])); }
        const float mean = wsum(s) * (1.f / D_); float q = 0.f;
#pragma unroll
        for (int j = 0; j < 4; ++j)
#pragma unroll
            for (int e = 0; e < 8; ++e) { v[j][e] -= mean; q += v[j][e] * v[j][e]; }
        const float rstd = 1.f / sqrtf(wsum(q) * (1.f / D_) + LN_EPS);
#pragma unroll
        for (int j = 0; j < 4; ++j) { const int c0 = j * 512 + lane * 8; float y[8];
#pragma unroll
            for (int e = 0; e < 8; ++e) y[e] = v[j][e] * rstd * gq[j][e >> 2][e & 3] + bq[j][e >> 2][e & 3];
            if (l == 0) { u32x4 wo; wo.x = pk2(y[0], y[1]); wo.y = pk2(y[2], y[3]); wo.z = pk2(y[4], y[5]); wo.w = pk2(y[6], y[7]); *(u32x4*)(xoh + (size_t)row * D_ + c0) = wo;
                u32x2 w8; w8.x = pk4_fp8(y[0], y[1], y[2], y[3]); w8.y = pk4_fp8(y[4], y[5], y[6], y[7]); *(u32x2*)(x8 + (size_t)row * D_ + c0) = w8; }
            else { *(f32x4*)(xo + (size_t)row * D_ + c0) = (f32x4){y[0], y[1], y[2], y[3]}; *(f32x4*)(xo + (size_t)row * D_ + c0 + 4) = (f32x4){y[4], y[5], y[6], y[7]}; } }
        if (!more) break;
        row = rn; rn = rnn; t1 = u1; t2 = u2;
#pragma unroll
        for (int j = 0; j < 4; ++j) { cx[j] = nx[j]; c1[j] = n1[j]; c2[j] = n2[j]; }
    }
}

constexpr int NGEMM = 15360;
DEVI void phase_gates(KP a, unsigned char* lds, int tid, int G, int l) {
    using pg8::i32x8_; using pg8::i32x4_;
    unsigned char* ws = a->ws;
    const unsigned char* X = ws + WS_X8; const unsigned char* W = ws + WS_WIN + (size_t)l * NPAD * D_ + (size_t)NGEMM * D_;
    const float* bias = (const float*)(ws + WS_BIASP) + l * NPAD + NGEMM; float* gates = (float*)(ws + WS_GATES);
    const int lane = tid & 63, wave = tid >> 6, g4 = lane >> 4, l15 = lane & 15;
    f32x4* red = (f32x4*)lds;
    float* gl = (float*)(lds + 131072);
    const int sclW = 0x79797979, sclA = 0x7f7f7f7f;
    for (int unit = blockIdx.x; unit < M_ / 64; unit += G) {
        const unsigned char* ap = X + (size_t)(unit * 64 + l15) * D_ + wave * 256 + 32 * g4;
        const unsigned char* bp = W + (size_t)l15 * D_ + wave * 256 + 32 * g4;
        i32x8_ af[4][2], bf[4][2];
#pragma unroll
        for (int t = 0; t < 4; ++t)
#pragma unroll
            for (int ks = 0; ks < 2; ++ks) {
                af[t][ks] = __builtin_shufflevector(*(const i32x4_*)(ap + (size_t)t * 16 * D_ + 128 * ks), *(const i32x4_*)(ap + (size_t)t * 16 * D_ + 128 * ks + 16), 0, 1, 2, 3, 4, 5, 6, 7);
                bf[t][ks] = __builtin_shufflevector(*(const i32x4_*)(bp + (size_t)t * 16 * D_ + 128 * ks), *(const i32x4_*)(bp + (size_t)t * 16 * D_ + 128 * ks + 16), 0, 1, 2, 3, 4, 5, 6, 7); }
        f32x4 acc[4][4];
#pragma unroll
        for (int rt = 0; rt < 4; ++rt)
#pragma unroll
            for (int ct = 0; ct < 4; ++ct) acc[rt][ct] = (f32x4){0.f, 0.f, 0.f, 0.f};
#pragma unroll
        for (int ks = 0; ks < 2; ++ks)
#pragma unroll
            for (int rt = 0; rt < 4; ++rt)
#pragma unroll
                for (int ct = 0; ct < 4; ++ct) asm volatile("v_mfma_scale_f32_16x16x128_f8f6f4 %0, %1, %2, %0, %3, %4 op_sel_hi:[0,0,0]" : "+v"(acc[rt][ct]) : "v"(bf[ct][ks]), "v"(af[rt][ks]), "v"(sclW), "v"(sclA));
        asm volatile("s_nop 15\n\ts_nop 15\n\ts_nop 15\n\ts_nop 15" ::: "memory");
#pragma unroll
        for (int rt = 0; rt < 4; ++rt)
#pragma unroll
            for (int ct = 0; ct < 4; ++ct) red[(wave * 16 + rt * 4 + ct) * 64 + lane] = acc[rt][ct];
        __syncthreads();
#pragma unroll
        for (int q = 0; q < 2; ++q) { const int tile = 2 * wave + q, rt = tile >> 2, ct = tile & 3, row = unit * 64 + rt * 16 + l15, col = ct * 16 + 4 * g4;
            f32x4 v = red[tile * 64 + lane];
#pragma unroll
            for (int w = 1; w < 8; ++w) v = v + red[(w * 16 + tile) * 64 + lane];
            if (col < 56) { const f32x4 gv_ = v + *(const f32x4*)(bias + col); *(f32x4*)(gates + (size_t)row * 64 + col) = gv_;
                if (col < 8) *(f32x4*)(gl + (rt * 16 + l15) * 8 + col) = gv_; } }
        __syncthreads();
        if (wave < 4) {
            const float ig = gl[lane * 8 + wave], fg = gl[lane * 8 + 4 + wave];
            float bc = fminf(fg, 0.f) - log1pf(__expf(-fabsf(fg)));
#pragma unroll
            for (int o = 1; o < 64; o <<= 1) { const float t_ = __shfl_up(bc, o); if (lane >= o) bc += t_; }
            const float L_ = wmax(ig - bc), S_ = __shfl(bc, 63);
            if (lane == 0) { float* ch = (float*)(ws + WS_CHS) + ((size_t)unit * 4 + wave) * 2; ch[0] = S_; ch[1] = L_; } }
        __syncthreads();
    }
}
__global__ void __launch_bounds__(512, 2) fwd_kernel(Args args) {
    extern __shared__ __attribute__((aligned(16))) unsigned char lds_raw[];
    LAS unsigned char* ldsl = (LAS unsigned char*)lds_raw;
    unsigned char* lds = lds_raw;
    const int G = gridDim.x;
    const int wave_sg = __builtin_amdgcn_readfirstlane(threadIdx.x >> 6);
    unsigned char* ws = args.ws;
    volatile LAS unsigned* lctl = (volatile LAS unsigned*)(ldsl + LDSCTL_OFF);
    if (wave_sg == 0) { const int l_ = (int)__builtin_amdgcn_mbcnt_hi(~0u, __builtin_amdgcn_mbcnt_lo(~0u, 0u)); for (int u = l_; u < 256; u += 64) lctl[u] = 0u; }
    __syncthreads();
    const int lo = args.ph_lo, hi = args.ph_hi;
    const bool one = (hi - lo) > 1;
    XcdBarrier bar; bar.bar = (unsigned*)(ws + WS_CTL) + CW_BAR; bar.x = 0; bar.st = lctl; bar.wv = wave_sg;
    if (one) bar = xcd_barrier_post((unsigned*)(ws + WS_CTL) + CW_BAR, lctl, wave_sg);
#ifndef ONLY_PHASE
#define ONLY_PHASE -1
#endif
#define LAUNDER() int wv_ = wave_sg; asm volatile("" : "+s"(wv_)); int tz_ = wv_ * 64 + (int)__builtin_amdgcn_mbcnt_hi(~0u, __builtin_amdgcn_mbcnt_lo(~0u, 0u)); asm volatile("" : "+v"(tz_)); const int tid = tz_, lane = tz_ & 63, wave = wv_; (void)tid; (void)lane; (void)wave; \
    unsigned long long kp_ = (unsigned long long)__builtin_amdgcn_kernarg_segment_ptr(); asm volatile("" : "+s"(kp_)); \
    const KP la = (KP)kp_; unsigned char* const ws = la->ws; (void)ws
#define INR(k) (lo <= (k) && (k) < hi)
#define IN0 ((ONLY_PHASE < 0 || ONLY_PHASE == 0) && INR(0))
#define INL(j) ((ONLY_PHASE < 0 || ONLY_PHASE == 1 + (j)) && INR(pb + (j)))
#define SEAM(k) do { if (INR(k) && INR((k) + 1)) xcd_barrier(bar); else __syncthreads(); } while (0)

    if (IN0) { LAUNDER(); phase_prologue(la, lds, tid, lane, wave, G); phase_experts(la, lds, lane, wave, G, 0); SEAM(0); }

    for (int l = 0; l < 2; ++l) {
        const int pb = 1 + l * PPL;
        if (INL(0)) { LAUNDER();
            pg8::Gemm g{(const u16*)(ws + WS_X8), (const u16*)(ws + WS_WIN + (size_t)l * NPAD * D_), D_ / 2, D_ / 2, 0x79797979, 0x7f7f7f7f};
            pg8::StaticOrder S; S.init(M_, NGEMM, G, (int)blockIdx.x);
            EpiInProj E{(u16*)(ws + WS_Z), (const float*)(ws + WS_BIASP) + l * NPAD, (float*)(ws + WS_GATES), (u16*)(ws + WS_KC), (const float*)(ws + WS_ROPE), (const float*)(ws + WS_ROPE) + 4096 * 64, ws + WS_Z8};
            pg8::gemm_phase<EpiInProj, pg8::StaticOrder, true>(ldsl, g, S, E, tid);
            __syncthreads();
            phase_gates(la, lds, tid, G, l);
            SEAM(pb + 0);
        }
        if (INL(1)) { LAUNDER();
            pg8::Gemm g{(const u16*)(ws + WS_KC), (const u16*)(ws + WS_CW1 + (size_t)l * 512 * 2048), 1024, 1024, 0x79797979, 0x7f7f7f7f};
            CmpOrder S{G, (int)blockIdx.x};
            EpiF32Tile E{(float*)(ws + WS_U), 256};
            pg8::gemm_phase<EpiF32Tile, CmpOrder, true>(ldsl, g, S, E, tid);
            phase_mlstm_pre(la, lds, tid, G, G >= 64 ? 32 : 0);
            SEAM(pb + 1);
        }
        if (INL(2)) { LAUNDER(); phase_mlstm(la, lds, tid, G); phase_cmp2(la, lds, tid, G, l); SEAM(pb + 2); }
        if (INL(3)) { LAUNDER(); phase_nsa1(la, lds, tid, G); phase_norm(la, lane, wave, G, l); SEAM(pb + 3); }
        if (INL(4)) { LAUNDER(); phase_topk(la, lane, wave, G); SEAM(pb + 4); }
        if (INL(5)) { LAUNDER(); phase_nsa2(la, lds, tid, G); __syncthreads();
            {
            pg8::Gemm g{(const u16*)(ws + WS_XBF), (const u16*)(ws + WS_WB) + (size_t)(l * 3 + 0) * D_ * D_, D_ / 2, D_ / 2, 0x79797979, 0x7e7e7e7e};
            pg8::StaticOrder S; S.init(M_, D_, G, (int)blockIdx.x);
            EpiGate<false> E{(u16*)(ws + WS_MRG), (const u16*)(ws + WS_Z), C_GM};
            pg8::gemm_phase<EpiGate<false>, pg8::StaticOrder, true>(ldsl, g, S, E, tid);
            }
            SEAM(pb + 5);
        }
        if (INL(6)) { LAUNDER();
            pg8::Gemm g{(const u16*)(ws + WS_O), (const u16*)(ws + WS_WB) + (size_t)(l * 3 + 1) * D_ * D_, D_ / 2, D_ / 2, 0x79797979, 0x7c7c7c7c};
            pg8::StaticOrder S; S.init(M_, D_, G, (int)blockIdx.x);
            EpiGate<true> E{(u16*)(ws + WS_MRG), (const u16*)(ws + WS_Z), C_GM + 2048};
            pg8::gemm_phase<EpiGate<true>, pg8::StaticOrder, true>(ldsl, g, S, E, tid);
            SEAM(pb + 6);
        }
        if (INL(7)) { LAUNDER();
            pg8::Gemm g{(const u16*)(ws + WS_MRG), (const u16*)(ws + WS_WB) + (size_t)(l * 3 + 2) * D_ * D_, D_, D_};
            pg8::StaticOrder S; S.init(M_, D_, G, (int)blockIdx.x);
            EpiResid E{(u16*)(ws + WS_H), la->in[0], l == 0 ? (const u16*)nullptr : (const u16*)(ws + WS_XB)};
            pg8::gemm_phase(ldsl, g, S, E, tid);
            SEAM(pb + 7);
        }
        if (INL(8)) { LAUNDER(); phase_ln1_router(la, lds, tid, lane, wave, G, l); SEAM(pb + 8); }
        if (INL(9)) { LAUNDER(); phase_moe_gather(la, lds, tid, lane, wave, G, l); SEAM(pb + 9); }
        if (INL(10) || INL(11)) { LAUNDER();
            const unsigned* cnt = (const unsigned*)(ws + WS_CTL) + CW_CNT + l * 32;
            volatile LAS int* tstart = (volatile LAS int*)(lctl + 16);
            if (wave == 0) { int mybase; const int nt_ = moe_base(cnt, lane, mybase); if (lane < 32) tstart[lane] = mybase >> 8; if (lane == 32) tstart[32] = nt_; }
            __syncthreads();
            const int ntiles = tstart[32];
            if (INL(10)) { LAUNDER();
                pg8::Gemm g{(const u16*)(ws + WS_XG), (const u16*)(ws + WS_W13), D_ / 2, D_ / 2, 0x79797979, 0x7f7f7f7f};
                MoeOrder S{G, (int)blockIdx.x, ntiles, tstart};
                EpiSwiGLU E{ws + WS_HB};
                pg8::gemm_phase<EpiSwiGLU, MoeOrder, true>(ldsl, g, S, E, tid);
                SEAM(pb + 10);
            }
            if (INL(11)) { LAUNDER();
                pg8::Gemm g{(const u16*)(ws + WS_HB), (const u16*)(ws + WS_W2), DFF / 2, DFF / 2, 0x79797979, 0x7f7f7f7f};
                MoeOrder S{G, (int)blockIdx.x, ntiles, tstart};
                EpiScaleRow E{(u16*)(ws + WS_Y), (const float*)(ws + WS_MISC + 1 * MiB)};
                pg8::gemm_phase<EpiScaleRow, MoeOrder, true>(ldsl, g, S, E, tid);
                SEAM(pb + 11);
            }
        }
        if (INL(12)) { LAUNDER(); phase_ln2(la, lane, wave, G, l); if (l == 0) phase_experts(la, lds, lane, wave, G, 1); SEAM(pb + 12); }
    }
#undef INR
#undef IN0
#undef INL
#undef SEAM
}

extern "C" void kernel_launch(void* const* d_in, const int* in_sizes, int n_in, void* d_out, int out_size, void* d_ws, size_t ws_size, hipStream_t stream) {
    static int grid = 0;
    if (grid == 0) {
        if (n_in != 26 || out_size != M_ * D_ || ws_size < WS_END5) { fprintf(stderr, "kernel_launch: unexpected problem (n_in %d out %d ws %zu need %zu)\n", n_in, out_size, ws_size, (size_t)WS_END); grid = -1; return; }
        int dev = 0, cus = 0;
        if (hipGetDevice(&dev) != hipSuccess || hipDeviceGetAttribute(&cus, hipDeviceAttributeMultiprocessorCount, dev) != hipSuccess) { grid = -1; return; }
        if (hipFuncSetAttribute((const void*)fwd_kernel, hipFuncAttributeMaxDynamicSharedMemorySize, LDS_BYTES) != hipSuccess) { fprintf(stderr, "kernel_launch: hipFuncSetAttribute failed\n"); grid = -1; return; }
        int per_cu = 0;
        if (hipOccupancyMaxActiveBlocksPerMultiprocessor(&per_cu, (const void*)fwd_kernel, 512, LDS_BYTES) != hipSuccess || per_cu < 1) fprintf(stderr, "kernel_launch: occupancy query reports %d\n", per_cu);
        (void)hipGetLastError();
        grid = cus;
    }
    if (grid < 0) return;
    (void)hipMemsetAsync((char*)d_ws + WS_CTL, 0, CTL_BYTES, stream);
    Args a{};
    for (int i = 0; i < 26; ++i) a.in[i] = (const float*)d_in[i];
    a.out = (float*)d_out; a.ws = (unsigned char*)d_ws;
#if MK_ONE_LAUNCH
    a.ph_lo = 0; a.ph_hi = NPH;
    hipLaunchKernelGGL(fwd_kernel, dim3(grid), dim3(512), LDS_BYTES, stream, a);
#else
#ifdef DBG_STOP
    for (int p = 0; p < DBG_STOP; ++p) { a.ph_lo = p; a.ph_hi = p + 1; hipLaunchKernelGGL(fwd_kernel, dim3(grid), dim3(512), LDS_BYTES, stream, a); }
    (void)hipMemcpyAsync(d_out, (char*)d_ws + DBG_SRC, (size_t)M_ * D_ * 4, hipMemcpyDeviceToDevice, stream);
#else
#ifndef REP_N
#define REP_N 1
#define REP_LO 99
#define REP_HI 99
#endif
    for (int p = 0; p < NPH; ++p) {
        const int j = p == 0 ? -1 : (p - 1) % PPL;
        if (j == REP_LO) { for (int r = 0; r < REP_N; ++r) for (int q = p; q <= p + (REP_HI - REP_LO); ++q) { a.ph_lo = q; a.ph_hi = q + 1; hipLaunchKernelGGL(fwd_kernel, dim3(grid), dim3(512), LDS_BYTES, stream, a); } p += REP_HI - REP_LO; continue; }
        a.ph_lo = p; a.ph_hi = p + 1; hipLaunchKernelGGL(fwd_kernel, dim3(grid), dim3(512), LDS_BYTES, stream, a); }
#endif
#endif
}
```

```cpp
#include <hip/hip_runtime.h>
#include <cstdio>
#include <cstdint>

#ifndef MK_ONE_LAUNCH
#define MK_ONE_LAUNCH 1
#endif

#define LAS __attribute__((address_space(3)))
#define DEVI __device__ __forceinline__
typedef unsigned short u16;
typedef short bf16x8 __attribute__((ext_vector_type(8)));
typedef float f32x4 __attribute__((ext_vector_type(4)));
typedef float f32x2 __attribute__((ext_vector_type(2)));
typedef unsigned u32x4 __attribute__((ext_vector_type(4)));
typedef unsigned u32x2 __attribute__((ext_vector_type(2)));

constexpr int T_ = 4096, D_ = 2048, M_ = 16384;
constexpr int NPAD = 15616, IN_W = 15416;
constexpr int C_MQ = 0, C_MK = 1024, C_MV = 2048, C_MO = 4096, C_NQ = 6144, C_KC = 8192, C_VC = 8704, C_KS = 9216, C_VS = 9728, C_KW = 10240,
              C_VW = 10752, C_GM = 11264, C_GT = 15360;
constexpr int S_MI = 6144, S_NQ = 6152, S_KC = 8200, S_KS = 9224, S_VS = 9736, S_KW = 10248, S_VW = 10760, S_NG = 11272, S_GM = 11320;
constexpr float ALPHA = 1.4142135623730951f;
constexpr float LN_EPS = 1e-5f;
constexpr int NEXP = 32, DFF = 1024;
constexpr int MOE_ROWS = 40960;

constexpr size_t MiB = 1u << 20;
constexpr size_t WS_CTL = 0, CTL_BYTES = 1 * MiB;
constexpr size_t WS_ROPE = 1 * MiB;
constexpr size_t WS_BIASP = 3 * MiB;
constexpr size_t WS_WIN = 4 * MiB;
constexpr size_t WS_WB = 126 * MiB;
constexpr size_t WS_CW1 = 174 * MiB;
constexpr size_t WS_W13 = 178 * MiB;
constexpr size_t WS_W2 = 434 * MiB;
constexpr size_t WS_XBF = 562 * MiB;
constexpr size_t WS_XA = 626 * MiB;
constexpr size_t WS_XB = 754 * MiB;
constexpr size_t WS_Z = 882 * MiB;
constexpr size_t WS_GATES = 1370 * MiB;
constexpr size_t WS_KC = 1374 * MiB;
constexpr size_t WS_U = 1406 * MiB;
constexpr size_t WS_KCMP = 1414 * MiB;
constexpr size_t WS_MISC = 1416 * MiB;
constexpr size_t WS_CHS = WS_MISC + 1800 * 1024;
constexpr size_t WS_H = 1418 * MiB;
constexpr size_t WS_HG = 1546 * MiB;
constexpr size_t WS_O = 1610 * MiB;
constexpr size_t WS_MRG = 1674 * MiB;
constexpr size_t WS_END = 1738 * MiB, WS_END2 = 1739 * MiB;
constexpr size_t WS_OC = WS_H, WS_OW = WS_H + 64 * MiB, WS_IMP = WS_MRG, WS_OVL = WS_MISC + 1728 * 1024, WS_SEL = WS_END;
constexpr size_t WS_RWT = WS_MISC + 512 * 1024;
constexpr size_t WS_X8 = 1739 * MiB, WS_END3 = 1771 * MiB;
constexpr size_t WS_Z8 = 1771 * MiB, WS_KCMP8 = 1819 * MiB, WS_END4 = 1820 * MiB;
constexpr size_t WS_OCG = 1820 * MiB, WS_END5 = 1884 * MiB;
constexpr size_t WS_XG = WS_Z, WS_HB = WS_Z + 160 * MiB, WS_Y = WS_Z + 240 * MiB;
constexpr int CW_BAR = 4096;
constexpr int CW_CNT = 16384;
constexpr int CW_B1P = 16640;

constexpr int RING_BYTES = 131072;
constexpr int LDSCTL_OFF = 143360;
constexpr int LDS_BYTES = 147456;

DEVI float bf2f(unsigned h) { return __uint_as_float(h << 16); }
DEVI unsigned f2bf(float f) { unsigned u = __float_as_uint(f); return (u + 0x7fffu + ((u >> 16) & 1u)) >> 16; }
DEVI unsigned pk2(float lo, float hi) { unsigned r; asm("v_cvt_pk_bf16_f32 %0, %1, %2" : "=v"(r) : "v"(lo), "v"(hi)); return r; }
DEVI unsigned pk4_fp8(float a, float b, float c, float d) {
    a = __builtin_amdgcn_fmed3f(a, 448.f, -448.f); b = __builtin_amdgcn_fmed3f(b, 448.f, -448.f); c = __builtin_amdgcn_fmed3f(c, 448.f, -448.f); d = __builtin_amdgcn_fmed3f(d, 448.f, -448.f);
    int w = __builtin_amdgcn_cvt_pk_fp8_f32(a, b, 0, false); w = __builtin_amdgcn_cvt_pk_fp8_f32(c, d, w, true); return (unsigned)w; }
DEVI float sigm(float x) { return 1.f / (1.f + __expf(-x)); }
DEVI float wsum(float v) {
#pragma unroll
    for (int o = 32; o; o >>= 1) v += __shfl_xor(v, o);
    return v; }
DEVI float wmax(float v) {
#pragma unroll
    for (int o = 32; o; o >>= 1) v = fmaxf(v, __shfl_xor(v, o));
    return v; }
#define WAVE_SYNC() asm volatile("s_waitcnt lgkmcnt(0)" ::: "memory")
DEVI void unpack8(u32x4 v, float* f) {
    f[0] = __uint_as_float(v.x << 16); f[1] = __uint_as_float(v.x & 0xffff0000u); f[2] = __uint_as_float(v.y << 16); f[3] = __uint_as_float(v.y & 0xffff0000u);
    f[4] = __uint_as_float(v.z << 16); f[5] = __uint_as_float(v.z & 0xffff0000u); f[6] = __uint_as_float(v.w << 16); f[7] = __uint_as_float(v.w & 0xffff0000u); }

#define XB_TMO      128
#define XB_XCNT(j)  (256  + 64 * (j))
#define XB_XSUB(j)  (1280 + 64 * (j))
#define XB_XGEN(j)  (2304 + 64 * (j))
#define XB_TOP      3328
#define XB_TOPGEN   3392
#define XCD_BAR_WORDS 3456
#define XB_SPIN_CAP (1u << 21)
DEVI unsigned xb_ld(unsigned* p)              { return __hip_atomic_load(p, __ATOMIC_RELAXED, __HIP_MEMORY_SCOPE_AGENT); }
DEVI unsigned xb_add(unsigned* p, unsigned v) { return __hip_atomic_fetch_add(p, v, __ATOMIC_RELAXED, __HIP_MEMORY_SCOPE_AGENT); }
DEVI unsigned xb_xcc_id() { return (unsigned)__builtin_amdgcn_s_getreg((3 << 11) | 20) & 0xFu; }
#define XB_SPIN(cond, bar) do { unsigned _sp = 0; while (cond) { __builtin_amdgcn_s_sleep(1); \
    if ((++_sp & 255u) == 0u) { if (xb_ld(&(bar)[XB_TMO])) break; if (_sp > XB_SPIN_CAP) { atomicAdd(&(bar)[XB_TMO], 1u); break; } } } } while (0)
struct XcdBarrier { unsigned* bar; unsigned x; volatile LAS unsigned* st; int wv; };
DEVI bool xb_leader(int wv) { return wv == 0 && __builtin_amdgcn_mbcnt_hi(~0u, __builtin_amdgcn_mbcnt_lo(~0u, 0u)) == 0u; }
DEVI XcdBarrier xcd_barrier_post(unsigned* bar, volatile LAS unsigned* st, int wv) {
    XcdBarrier b; b.bar = bar; b.x = xb_xcc_id(); b.st = st; b.wv = wv;
    if (xb_leader(wv)) (void)xb_add(&bar[XB_XCNT(b.x)], 1u);
    return b;
}
DEVI void xcd_barrier_complete(unsigned* bar, unsigned x, unsigned& nloc, unsigned& nx) {
    const unsigned G = gridDim.x * gridDim.y * gridDim.z;
    unsigned sum, cnt, mine, sp = 0u;
    for (;;) {
        sum = 0u; cnt = 0u; mine = 0u;
#pragma unroll
        for (unsigned j = 0; j < 16; ++j) { const unsigned c = xb_ld(&bar[XB_XCNT(j)]); sum += c; cnt += (c > 0u) ? 1u : 0u; mine = (j == x) ? c : mine; }
        if (sum == G) break;
        __builtin_amdgcn_s_sleep(1);
        if ((++sp & 255u) == 0u) { if (xb_ld(&bar[XB_TMO])) break; if (sp > XB_SPIN_CAP) { atomicAdd(&bar[XB_TMO], 1u); break; } }
    }
    nloc = mine > 0u ? mine : 1u; nx = cnt > 0u ? cnt : 1u;
}
__device__ __noinline__ void xcd_barrier_impl(unsigned* bar_, unsigned x_, volatile LAS unsigned* st_, int wv_) {
    XcdBarrier b; b.bar = bar_; b.x = x_; b.st = st_; b.wv = wv_;
    asm volatile("s_waitcnt vmcnt(0)" ::: "memory");
    __syncthreads();
    if (xb_leader(b.wv)) {
        unsigned* bar = b.bar;
        __builtin_amdgcn_s_waitcnt(0);
        unsigned nloc = b.st[0], nx = b.st[1];
        if (nloc == 0u) { xcd_barrier_complete(bar, b.x, nloc, nx); b.st[0] = nloc; b.st[1] = nx; }
        const unsigned old = xb_add(&bar[XB_XSUB(b.x)], 1u);
        const unsigned gen = old / nloc;
        if (old + 1u == (gen + 1u) * nloc) {
            __builtin_amdgcn_fence(__ATOMIC_RELEASE, "agent");
            asm volatile("s_waitcnt vmcnt(0)" ::: "memory");
            const unsigned og = xb_add(&bar[XB_TOP], 1u);
            const unsigned tg = og / nx;
            if (og + 1u == (tg + 1u) * nx) xb_add(&bar[XB_TOPGEN], 1u);
            else XB_SPIN(xb_ld(&bar[XB_TOPGEN]) == tg, bar);
            __builtin_amdgcn_fence(__ATOMIC_ACQUIRE, "agent");
            xb_add(&bar[XB_XGEN(b.x)], 1u);
            asm volatile("s_waitcnt vmcnt(0)" ::: "memory");
        } else {
            XB_SPIN(xb_ld(&bar[XB_XGEN(b.x)]) == gen, bar);
            __builtin_amdgcn_fence(__ATOMIC_ACQUIRE, "agent");
            asm volatile("s_waitcnt vmcnt(0)" ::: "memory");
        }
    }
    __syncthreads();
}

DEVI void xcd_barrier(const XcdBarrier& b) { xcd_barrier_impl(b.bar, b.x, b.st, b.wv); }

namespace pg8 {
constexpr int BM = 256, BK = 64, HALF = 128, HTB = HALF * BK * 2, STAGE_BYTES = 8 * HTB, NXCD = 8, WGM = 4;
__host__ __device__ __forceinline__ int lds_byte(int r, int c) { const int st = (r >> 4) * 2 + (c >> 5), rr = r & 15, cc = c & 31, ob = rr * 64 + cc * 2; return st * 1024 + (ob ^ (((ob >> 9) & 1) << 5)); }
__host__ __device__ __forceinline__ void stage_rc(int b, int& R, int& C) { const int st = b / 1024, sb = b % 1024, swz = sb ^ (((sb >> 9) & 1) << 5); R = (st >> 1) * 16 + swz / 64; C = (st & 1) * 32 + (swz % 64) / 2; }
__host__ __device__ __forceinline__ int perm32(int rho) { const int n = rho >> 4, i = rho & 15; return 8 * (i >> 2) + 4 * n + (i & 3); }

struct Unit { int pm, pn, pb; };
struct Gemm { const u16* A; const u16* Bt; int lda, K; int sclW = 0x7f7f7f7f, sclA = 0x7f7f7f7f; };

struct StaticOrder {
    int nM, nN, nwg, G, c;
    DEVI void init(int M, int N, int G_, int c_) { nM = M / BM; nN = N / BM; nwg = nM * nN; G = G_; c = c_; }
    DEVI bool next(int i, Unit& u) const {
        const long L = (long)i * G + c; if (L >= nwg) return false;
        int wgid = (int)L; { const int q = nwg / NXCD, r = nwg % NXCD, xcd = wgid % NXCD, off = wgid / NXCD; wgid = (xcd < r ? xcd * (q + 1) : r * (q + 1) + (xcd - r) * q) + off; }
        const int nig = WGM * nN, gid = wgid / nig, fm = gid * WGM, gsz = (nM - fm) < WGM ? (nM - fm) : WGM;
        u.pm = fm + ((wgid % nig) % gsz); u.pn = (wgid % nig) / gsz; u.pb = u.pn; return true;
    }
};

typedef int i32x4_ __attribute__((ext_vector_type(4)));
typedef int i32x8_ __attribute__((ext_vector_type(8)));
template <class Epi, class Sched, bool FP8 = false>
DEVI void gemm_phase(LAS unsigned char* lds, const Gemm g, const Sched& S, const Epi& E, const int tid) {
    const int wid = __builtin_amdgcn_readfirstlane(tid >> 6), lane = tid & 63, wr = wid >> 2, wc = wid & 3, fr = lane & 15, fq = lane >> 4;
    const int K = g.K, nt = K / BK, lda = g.lda; const int sclW = g.sclW, sclA = g.sclA; (void)sclW; (void)sclA;
    unsigned voffA[2], voffB[2];
#pragma unroll
    for (int i = 0; i < 2; ++i) { int R, C; stage_rc(tid * 16 + i * 8192, R, C); const int Rb = Epi::PERM ? ((R & ~31) + perm32(R & 31)) : R;
        voffA[i] = (unsigned)(R * lda + C) * 2u; voffB[i] = (unsigned)(Rb * K + C) * 2u; }
    const size_t kstep = (size_t)(BK * 2);
    const size_t hstepA = (size_t)HALF * lda * 2, tstepA = 2 * hstepA;
    const size_t hstepB = (size_t)HALF * K * 2, tstepB = 2 * hstepB;
    const unsigned ldsw = (unsigned)wid * 1024u;
    const int aoff = lds_byte(wr * 64 + fr, fq * 8), boff = lds_byte(wc * 32 + fr, fq * 8);
#define PG8_SA(b, h) (((b) * 2 + (h)) * HTB)
#define PG8_SB(b, h) ((4 + (b) * 2 + (h)) * HTB)
#define PG8_STAGE(bufoff, gbase, voff) do { _Pragma("unroll") for (int _i = 0; _i < 2; ++_i) \
        __builtin_amdgcn_global_load_lds((const unsigned*)((const char*)(gbase) + (voff)[_i]), (LAS unsigned*)(lds + (bufoff) + ldsw + _i * 8192), 16, 0, 0); } while (0)
#define PG8_LD2(addr) __builtin_shufflevector(*(const LAS i32x4_*)(addr), *(const LAS i32x4_*)((addr) + 1024), 0, 1, 2, 3, 4, 5, 6, 7)
#define PG8_LDA(dst, b, h) do { _Pragma("unroll") for (int m = 0; m < 4; ++m) dst[m] = PG8_LD2(lds + PG8_SA(b, h) + aoff + m * 2048); } while (0)
#define PG8_LDB(dst, b, h) do { _Pragma("unroll") for (int n = 0; n < 2; ++n) dst[n] = PG8_LD2(lds + PG8_SB(b, h) + boff + n * 2048); } while (0)
#define PG8_HALF(v, k) ((k) == 0 ? (bf16x8)__builtin_shufflevector(v, v, 0, 1, 2, 3) : (bf16x8)__builtin_shufflevector(v, v, 4, 5, 6, 7))
#define PG8_MMA(ai, bj, At, Bt) do { __builtin_amdgcn_s_setprio(1); _Pragma("unroll") for (int m = 0; m < 4; ++m) _Pragma("unroll") for (int n = 0; n < 2; ++n) { \
        if constexpr (FP8) { asm volatile("v_mfma_scale_f32_16x16x128_f8f6f4 %0, %1, %2, %0, %3, %4 op_sel_hi:[0,0,0]" : "+v"(acc[ai][bj][m][n]) : "v"(Bt[n]), "v"(At[m]), "v"(sclW), "v"(sclA)); } \
        else { _Pragma("unroll") for (int k = 0; k < 2; ++k) acc[ai][bj][m][n] = __builtin_amdgcn_mfma_f32_16x16x32_bf16(PG8_HALF(Bt[n], k), PG8_HALF(At[m], k), acc[ai][bj][m][n], 0, 0, 0); } } \
        __builtin_amdgcn_s_setprio(0); } while (0)
#define PG8_WAIT_V(n) asm volatile("s_waitcnt vmcnt(" #n ")" ::: "memory")
#define PG8_WAIT_L(n) asm volatile("s_waitcnt lgkmcnt(" #n ")" ::: "memory")
#define PG8_BAR __builtin_amdgcn_s_barrier()
#define PG8_SCHED __builtin_amdgcn_sched_barrier(0)
    Unit cur, nxt; int ui = 0;
    if (!S.next(0, cur)) return;
    f32x4 acc[2][2][4][2];
#pragma unroll
    for (int a = 0; a < 2; ++a)
#pragma unroll
        for (int b = 0; b < 2; ++b)
#pragma unroll
            for (int m = 0; m < 4; ++m)
#pragma unroll
                for (int n = 0; n < 2; ++n) acc[a][b][m][n] = (f32x4){0.f, 0.f, 0.f, 0.f};
    i32x8_ At[4], B0[2], B1[2];
    const char* cA = (const char*)g.A + (size_t)cur.pm * tstepA; const char* cB = (const char*)g.Bt + (size_t)cur.pb * tstepB;
    PG8_STAGE(PG8_SB(0, 0), cB, voffB); PG8_STAGE(PG8_SB(0, 1), cB + hstepB, voffB); PG8_STAGE(PG8_SA(0, 0), cA, voffA); PG8_STAGE(PG8_SA(0, 1), cA + hstepA, voffA);
    if (wr == 1) PG8_BAR;
    PG8_WAIT_V(2); PG8_BAR;
    PG8_STAGE(PG8_SB(1, 0), cB + kstep, voffB); PG8_STAGE(PG8_SA(1, 0), cA + kstep, voffA); PG8_STAGE(PG8_SB(1, 1), cB + hstepB + kstep, voffB);
    PG8_WAIT_V(6); PG8_BAR;
    for (;;) {
        const bool has_next = S.next(ui + 1, nxt);
        const char* nA = has_next ? (const char*)g.A + (size_t)nxt.pm * tstepA : cA; const char* nB = has_next ? (const char*)g.Bt + (size_t)nxt.pb * tstepB : cB;
        for (int t = 0; t < nt; t += 2) {
            const bool last = (t == nt - 2);
            const char* a1 = cA + (size_t)(t + 1) * kstep;
            const char* a2 = last ? nA : cA + (size_t)(t + 2) * kstep; const char* b2 = last ? nB : cB + (size_t)(t + 2) * kstep;
            const char* a3 = a2 + kstep; const char* b3 = b2 + kstep;
            PG8_LDB(B0, 0, 0); PG8_LDB(B1, 0, 1); PG8_SCHED; PG8_LDA(At, 0, 0); PG8_STAGE(PG8_SA(1, 1), a1 + hstepA, voffA);
            PG8_WAIT_V(8); PG8_WAIT_L(0); PG8_BAR; PG8_MMA(0, 0, At, B0); PG8_MMA(0, 1, At, B1); PG8_BAR; PG8_SCHED;
            PG8_LDA(At, 0, 1); PG8_STAGE(PG8_SB(0, 0), b2, voffB); PG8_STAGE(PG8_SB(0, 1), b2 + hstepB, voffB); PG8_STAGE(PG8_SA(0, 0), a2, voffA);
            PG8_WAIT_V(8); PG8_WAIT_L(0); PG8_BAR; PG8_MMA(1, 0, At, B0); PG8_MMA(1, 1, At, B1); PG8_BAR; PG8_SCHED;
            PG8_LDB(B0, 1, 0); PG8_LDB(B1, 1, 1); PG8_SCHED; PG8_LDA(At, 1, 0); PG8_STAGE(PG8_SA(0, 1), a2 + hstepA, voffA);
            PG8_WAIT_V(8); PG8_WAIT_L(0); PG8_BAR; PG8_MMA(0, 0, At, B0); PG8_MMA(0, 1, At, B1); PG8_BAR; PG8_SCHED;
            PG8_LDA(At, 1, 1); PG8_STAGE(PG8_SB(1, 0), b3, voffB); PG8_STAGE(PG8_SB(1, 1), b3 + hstepB, voffB); PG8_STAGE(PG8_SA(1, 0), a3, voffA);
            PG8_WAIT_V(8); PG8_WAIT_L(0); PG8_BAR; PG8_MMA(1, 0, At, B0); PG8_MMA(1, 1, At, B1); PG8_BAR; PG8_SCHED;
        }
        if (wr == 0) PG8_BAR;
        if constexpr (FP8) asm volatile("s_nop 15\n\ts_nop 15\n\ts_nop 15\n\ts_nop 15" ::: "memory");
        E(acc, cur, wr, wc, fr, fq);
        if (!has_next) break;
#pragma unroll
        for (int a = 0; a < 2; ++a)
#pragma unroll
            for (int b = 0; b < 2; ++b)
#pragma unroll
                for (int m = 0; m < 4; ++m)
#pragma unroll
                    for (int n = 0; n < 2; ++n) acc[a][b][m][n] = (f32x4){0.f, 0.f, 0.f, 0.f};
        cur = nxt; cA = nA; cB = nB; ++ui;
        if (wr == 1) PG8_BAR;
    }
    PG8_WAIT_V(0);
    PG8_BAR;
#undef PG8_SA
#undef PG8_SB
#undef PG8_STAGE
#undef PG8_LDA
#undef PG8_LD2
#undef PG8_HALF
#undef PG8_LDB
#undef PG8_MMA
#undef PG8_WAIT_V
#undef PG8_WAIT_L
#undef PG8_BAR
#undef PG8_SCHED
}
}
using pg8::Unit;

struct EpiInProj {
    static constexpr bool PERM = true;
    u16* z; const float* bias; float* gates; u16* kc; const float* cosT; const float* sinT; unsigned char* z8;
    DEVI void operator()(const f32x4 (&acc)[2][2][4][2], const Unit& u, int wr, int wc, int fr, int fq) const {
        const int pn = u.pn, row0 = u.pm * 256 + wr * 64 + fr, colt = pn * 256, cl0 = wc * 32 + 8 * fq;
        f32x4 bv[2][2];
#pragma unroll
        for (int bj = 0; bj < 2; ++bj)
#pragma unroll
            for (int n = 0; n < 2; ++n) bv[bj][n] = *(const f32x4*)(bias + colt + cl0 + bj * 128 + 4 * n);
        const float scale = pn < 4 ? 0.0625f : 1.f;
        const bool rope = (pn >= 24 && pn < 32) || pn == 36 || pn == 37 || pn == 40 || pn == 41;
        const bool kcv = pn >= 32 && pn < 36;
#pragma unroll
        for (int am = 0; am < 4; ++am) { const int ai = am >> 1, m0 = (am & 1) * 2;
            f32x4 csq[4], snq[4];
#pragma unroll
            for (int m = m0; m < m0 + 2; ++m) { csq[m] = (f32x4){1.f, 1.f, 1.f, 1.f}; snq[m] = (f32x4){0.f, 0.f, 0.f, 0.f};
                if (rope) { const int t_ = (row0 + ai * 128 + m * 16) & 4095; csq[m] = *(const f32x4*)(cosT + t_ * 64 + (cl0 >> 1)); snq[m] = *(const f32x4*)(sinT + t_ * 64 + (cl0 >> 1)); } }
#pragma unroll
            for (int m = m0; m < m0 + 2; ++m) { const int row = row0 + ai * 128 + m * 16, t = row & 4095;
                const f32x4 cs = csq[m], sn = snq[m];
#pragma unroll
                for (int bj = 0; bj < 2; ++bj) {
                    f32x4 v0 = (acc[ai][bj][m][0] + bv[bj][0]) * scale, v1 = (acc[ai][bj][m][1] + bv[bj][1]) * scale;
                    if (rope) {
                        const f32x4 a0 = v0, a1 = v1;
                        v0[0] = a0[0] * cs[0] - a0[1] * sn[0]; v0[1] = a0[1] * cs[0] + a0[0] * sn[0];
                        v0[2] = a0[2] * cs[1] - a0[3] * sn[1]; v0[3] = a0[3] * cs[1] + a0[2] * sn[1];
                        v1[0] = a1[0] * cs[2] - a1[1] * sn[2]; v1[1] = a1[1] * cs[2] + a1[0] * sn[2];
                        v1[2] = a1[2] * cs[3] - a1[3] * sn[3]; v1[3] = a1[3] * cs[3] + a1[2] * sn[3];
                    }
                    u32x4 w; w.x = pk2(v0[0], v0[1]); w.y = pk2(v0[2], v0[3]); w.z = pk2(v1[0], v1[1]); w.w = pk2(v1[2], v1[3]);
                    if (rope) { const int c8 = (pn < 32 ? (pn - 24) * 256 : pn < 38 ? 2048 + (pn - 36) * 256 : 2560 + (pn - 40) * 256) + bj * 128 + cl0;
                        u32x2 w8; w8.x = pk4_fp8(v0[0], v0[1], v0[2], v0[3]); w8.y = pk4_fp8(v1[0], v1[1], v1[2], v1[3]); *(u32x2*)(z8 + (size_t)row * 3072 + c8) = w8; }
                    if (rope) { }
                    else if (kcv) { const int cs_ = (pn - 32) * 256 + bj * 128 + cl0, which = cs_ >> 9, gg = (cs_ >> 7) & 3, dd = cs_ & 127, b = row >> 12;
                        u32x2 w8; w8.x = pk4_fp8(v0[0], v0[1], v0[2], v0[3]); w8.y = pk4_fp8(v1[0], v1[1], v1[2], v1[3]);
                        *(u32x2*)((unsigned char*)kc + ((size_t)((which * 16 + b * 4 + gg) * 4096 + t) * 128 + dd)) = w8; }
                    else *(u32x4*)(z + (size_t)row * NPAD + colt + bj * 128 + cl0) = w;
                }
            } }
    }
};
struct EpiF32Tile {
    static constexpr bool PERM = false;
    float* C; int ldc;
    DEVI void operator()(const f32x4 (&acc)[2][2][4][2], const Unit& u, int wr, int wc, int fr, int fq) const {
        const int row0 = u.pm * 256 + wr * 64 + fr, col0 = u.pn * 256 + wc * 32 + 4 * fq;
#pragma unroll
        for (int ai = 0; ai < 2; ++ai)
#pragma unroll
            for (int m = 0; m < 4; ++m) { float* rowp = C + (size_t)(row0 + ai * 128 + m * 16) * ldc + col0;
#pragma unroll
                for (int bj = 0; bj < 2; ++bj)
#pragma unroll
                    for (int n = 0; n < 2; ++n) *(f32x4*)(rowp + bj * 128 + n * 16) = acc[ai][bj][m][n]; }
    }
};
template <bool ADD> struct EpiGate {
    static constexpr bool PERM = true;
    u16* mrg; const u16* z; int gcol0;
    DEVI void operator()(const f32x4 (&acc)[2][2][4][2], const Unit& u, int wr, int wc, int fr, int fq) const {
        const int row0 = u.pm * 256 + wr * 64 + fr, col0 = u.pn * 256 + wc * 32 + 8 * fq;
#pragma unroll
        for (int am = 0; am < 4; ++am) { const int ai = am >> 1, m0 = (am & 1) * 2;
            u32x4 gq[4][2], pq[4][2];
#pragma unroll
            for (int m = m0; m < m0 + 2; ++m)
#pragma unroll
                for (int bj = 0; bj < 2; ++bj) { const int row = row0 + ai * 128 + m * 16, col = col0 + bj * 128;
                    gq[m][bj] = *(const u32x4*)(z + (size_t)row * NPAD + gcol0 + col); if (ADD) pq[m][bj] = *(const u32x4*)(mrg + (size_t)row * D_ + col); }
#pragma unroll
            for (int m = m0; m < m0 + 2; ++m) { const int row = row0 + ai * 128 + m * 16;
#pragma unroll
                for (int bj = 0; bj < 2; ++bj) { const int col = col0 + bj * 128;
                    float gz[8], pv[8]; unpack8(gq[m][bj], gz);
                    u16* dst = mrg + (size_t)row * D_ + col;
                    if (ADD) unpack8(pq[m][bj], pv);
                    float o[8];
#pragma unroll
                    for (int j = 0; j < 4; ++j) { o[j] = acc[ai][bj][m][0][j] * sigm(gz[j]); o[4 + j] = acc[ai][bj][m][1][j] * sigm(gz[4 + j]); }
                    if (ADD) {
#pragma unroll
                        for (int j = 0; j < 8; ++j) o[j] += pv[j]; }
                    u32x4 w; w.x = pk2(o[0], o[1]); w.y = pk2(o[2], o[3]); w.z = pk2(o[4], o[5]); w.w = pk2(o[6], o[7]);
                    *(u32x4*)dst = w; } } }
    }
};
struct EpiResid {
    static constexpr bool PERM = true;
    u16* pre; const float* x; const u16* xh;
    DEVI void operator()(const f32x4 (&acc)[2][2][4][2], const Unit& u, int wr, int wc, int fr, int fq) const {
        const int row0 = u.pm * 256 + wr * 64 + fr, col0 = u.pn * 256 + wc * 32 + 8 * fq;
#pragma unroll
        for (int am = 0; am < 4; ++am) { const int ai = am >> 1, m0 = (am & 1) * 2;
            u32x4 hq[4][2]; f32x4 xq[4][2][2];
#pragma unroll
            for (int m = m0; m < m0 + 2; ++m)
#pragma unroll
                for (int bj = 0; bj < 2; ++bj) { const size_t off = (size_t)(row0 + ai * 128 + m * 16) * D_ + col0 + bj * 128;
                    if (xh) hq[m][bj] = *(const u32x4*)(xh + off); else { xq[m][bj][0] = *(const f32x4*)(x + off); xq[m][bj][1] = *(const f32x4*)(x + off + 4); } }
#pragma unroll
            for (int m = m0; m < m0 + 2; ++m)
#pragma unroll
                for (int bj = 0; bj < 2; ++bj) { const size_t off = (size_t)(row0 + ai * 128 + m * 16) * D_ + col0 + bj * 128; float xv[8];
                    if (xh) unpack8(hq[m][bj], xv);
                    else { const f32x4 x0 = xq[m][bj][0], x1 = xq[m][bj][1]; xv[0] = x0[0]; xv[1] = x0[1]; xv[2] = x0[2]; xv[3] = x0[3]; xv[4] = x1[0]; xv[5] = x1[1]; xv[6] = x1[2]; xv[7] = x1[3]; }
                    float r[8];
#pragma unroll
                    for (int j = 0; j < 4; ++j) { r[j] = xv[j] * ALPHA + acc[ai][bj][m][0][j]; r[4 + j] = xv[4 + j] * ALPHA + acc[ai][bj][m][1][j]; }
                    u32x4 w; w.x = pk2(r[0], r[1]); w.y = pk2(r[2], r[3]); w.z = pk2(r[4], r[5]); w.w = pk2(r[6], r[7]);
                    *(u32x4*)(pre + off) = w; } }
    }
};
struct EpiSwiGLU {
    static constexpr bool PERM = true;
    unsigned char* H;
    DEVI void operator()(const f32x4 (&acc)[2][2][4][2], const Unit& u, int wr, int wc, int fr, int fq) const {
        const int row0 = u.pm * 256 + wr * 64 + fr, f0 = u.pn * 128 + wc * 16 + 4 * fq;
#pragma unroll
        for (int ai = 0; ai < 2; ++ai)
#pragma unroll
            for (int m = 0; m < 4; ++m) { const int row = row0 + ai * 128 + m * 16;
#pragma unroll
                for (int bj = 0; bj < 2; ++bj) { const f32x4 a = acc[ai][bj][m][0], b = acc[ai][bj][m][1]; float o[4];
#pragma unroll
                    for (int j = 0; j < 4; ++j) o[j] = a[j] * sigm(a[j]) * b[j];
                    *(unsigned*)(H + (size_t)row * DFF + f0 + bj * 64) = pk4_fp8(o[0], o[1], o[2], o[3]); } }
    }
};
struct EpiScaleRow {
    static constexpr bool PERM = true;
    u16* Y; const float* roww;
    DEVI void operator()(const f32x4 (&acc)[2][2][4][2], const Unit& u, int wr, int wc, int fr, int fq) const {
        const int row0 = u.pm * 256 + wr * 64 + fr, col0 = u.pn * 256 + wc * 32 + 8 * fq;
        float rwq[2][4];
#pragma unroll
        for (int ai = 0; ai < 2; ++ai)
#pragma unroll
            for (int m = 0; m < 4; ++m) rwq[ai][m] = roww[row0 + ai * 128 + m * 16];
#pragma unroll
        for (int ai = 0; ai < 2; ++ai)
#pragma unroll
            for (int m = 0; m < 4; ++m) { const int row = row0 + ai * 128 + m * 16; const float w_ = rwq[ai][m];
#pragma unroll
                for (int bj = 0; bj < 2; ++bj) { const f32x4 v0 = acc[ai][bj][m][0] * w_, v1 = acc[ai][bj][m][1] * w_;
                    u32x4 w; w.x = pk2(v0[0], v0[1]); w.y = pk2(v0[2], v0[3]); w.z = pk2(v1[0], v1[1]); w.w = pk2(v1[2], v1[3]);
                    *(u32x4*)(Y + (size_t)row * D_ + col0 + bj * 128) = w; } }
    }
};

struct CmpOrder {
    int G, c;
    DEVI bool next(int i, Unit& u) const { const int L = i * G + c; if (L >= 32) return false; u.pm = L; u.pn = 0; u.pb = L >> 4; return true; }
};
struct MoeOrder {
    int G, c, ntiles; const volatile LAS int* tstart;
    DEVI bool next(int i, Unit& u) const {
        const int L = i * G + c; if (L >= ntiles * 8) return false;
        const int tile = L >> 3, pn = L & 7;
        const int lk_ = (int)__builtin_amdgcn_mbcnt_hi(~0u, __builtin_amdgcn_mbcnt_lo(~0u, 0u));
        const int e = __popcll(__ballot(lk_ >= 1 && lk_ < 32 && tstart[lk_ & 31] <= tile));
        u.pm = tile; u.pn = pn; u.pb = e * 8 + pn; return true;
    }
};

struct Args { const float* in[26]; float* out; unsigned char* ws; int ph_lo, ph_hi; };
typedef const __attribute__((address_space(4))) Args* KP;
constexpr int PPL = 13;
constexpr int NPH = 1 + 2 * PPL;

DEVI int src_col(int n) {
    if (n < C_NQ) return n;
    if (n < C_KC) { const int r = n - C_NQ, hd = r >> 7, p = r & 127; return S_NQ + hd * 128 + (p >> 1) + 64 * (p & 1); }
    if (n < C_KS) return S_KC + (n - C_KC);
    if (n < C_VS) { const int r = n - C_KS, hd = r >> 7, p = r & 127; return S_KS + hd * 128 + (p >> 1) + 64 * (p & 1); }
    if (n < C_KW) return S_VS + (n - C_VS);
    if (n < C_VW) { const int r = n - C_KW, hd = r >> 7, p = r & 127; return S_KW + hd * 128 + (p >> 1) + 64 * (p & 1); }
    if (n < C_GM) return S_VW + (n - C_VW);
    if (n < C_GT) return S_GM + (n - C_GM);
    const int r = n - C_GT; if (r < 8) return S_MI + r; if (r < 56) return S_NG + (r - 8); return -1;
}

template <class ColPtr>
DEVI void tr_item32(const ColPtr& cp, size_t ldw, int K, u16* WT, int k0, int n0, float* scr, int lane) {
    const float* src = cp(n0 + (lane & 31));
#pragma unroll 8
    for (int i = 0; i < 32; ++i) { const int kk = 2 * i + (lane >> 5); scr[kk * 33 + (lane & 31)] = src ? src[(size_t)(k0 + kk) * ldw] : 0.f; }
    WAVE_SYNC();
    const int c = lane & 7;
#pragma unroll
    for (int j = 0; j < 4; ++j) { const int n = (lane >> 3) + 8 * j; const float* s = scr + (8 * c) * 33 + n;
        u32x4 o; o.x = pk2(s[0 * 33], s[1 * 33]); o.y = pk2(s[2 * 33], s[3 * 33]); o.z = pk2(s[4 * 33], s[5 * 33]); o.w = pk2(s[6 * 33], s[7 * 33]);
        *(u32x4*)(WT + (size_t)(n0 + n) * K + k0 + 8 * c) = o; }
    WAVE_SYNC();
}
template <class ColPtr>
DEVI void tr_item64(const ColPtr& cp, size_t ldw, int K, u16* WT, int k0, int n0, float* scr, int lane) {
    const int nq = lane & 15, kr = lane >> 4;
    const float* src = cp(n0 + 4 * nq);
    f32x4 v[16];
#pragma unroll
    for (int i = 0; i < 16; ++i) v[i] = src ? __builtin_nontemporal_load((const f32x4*)(src + (size_t)(k0 + kr + 4 * i) * ldw)) : (f32x4){0.f, 0.f, 0.f, 0.f};
#pragma unroll
    for (int i = 0; i < 16; ++i) { float* d = scr + (kr + 4 * i) * 65 + 4 * nq; d[0] = v[i][0]; d[1] = v[i][1]; d[2] = v[i][2]; d[3] = v[i][3]; }
    WAVE_SYNC();
    const int c = lane & 7;
#pragma unroll
    for (int j = 0; j < 8; ++j) { const int n = (lane >> 3) + 8 * j; const float* sp = scr + (8 * c) * 65 + n;
        u32x4 o; o.x = pk2(sp[0 * 65], sp[1 * 65]); o.y = pk2(sp[2 * 65], sp[3 * 65]); o.z = pk2(sp[4 * 65], sp[5 * 65]); o.w = pk2(sp[6 * 65], sp[7 * 65]);
        *(u32x4*)(WT + (size_t)(n0 + n) * K + k0 + 8 * c) = o; }
    WAVE_SYNC();
}
template <class ColPtr>
DEVI void tr_item64_f8(const ColPtr& cp, size_t ldw, int K, unsigned char* WT, int k0, int n0, float* scr, int lane, float scale) {
    const int nq = lane & 15, kr = lane >> 4;
    const float* src = cp(n0 + 4 * nq);
    f32x4 v[16];
#pragma unroll
    for (int i = 0; i < 16; ++i) v[i] = src ? __builtin_nontemporal_load((const f32x4*)(src + (size_t)(k0 + kr + 4 * i) * ldw)) : (f32x4){0.f, 0.f, 0.f, 0.f};
#pragma unroll
    for (int i = 0; i < 16; ++i) { float* d = scr + (kr + 4 * i) * 65 + 4 * nq; d[0] = v[i][0]; d[1] = v[i][1]; d[2] = v[i][2]; d[3] = v[i][3]; }
    WAVE_SYNC();
    const int c = lane & 3;
#pragma unroll
    for (int j = 0; j < 4; ++j) { const int n = (lane >> 2) + 16 * j; const float* sp = scr + (16 * c) * 65 + n;
        u32x4 o; o.x = pk4_fp8(sp[0 * 65] * scale, sp[1 * 65] * scale, sp[2 * 65] * scale, sp[3 * 65] * scale); o.y = pk4_fp8(sp[4 * 65] * scale, sp[5 * 65] * scale, sp[6 * 65] * scale, sp[7 * 65] * scale);
        o.z = pk4_fp8(sp[8 * 65] * scale, sp[9 * 65] * scale, sp[10 * 65] * scale, sp[11 * 65] * scale); o.w = pk4_fp8(sp[12 * 65] * scale, sp[13 * 65] * scale, sp[14 * 65] * scale, sp[15 * 65] * scale);
        *(u32x4*)(WT + (size_t)(n0 + n) * K + k0 + 16 * c) = o; }
    WAVE_SYNC();
}
DEVI void tr_item64_f8_rope(const float* Wh  , size_t ldw, int K, unsigned char* WT, int k0, int n0, float* scr, int lane, float scale) {
    const int nq = lane & 15, kr = lane >> 4, hf = nq >> 3, d4 = 4 * (nq & 7);
    const float* src = Wh + hf * 64 + d4;
    f32x4 v[16];
#pragma unroll
    for (int i = 0; i < 16; ++i) v[i] = __builtin_nontemporal_load((const f32x4*)(src + (size_t)(k0 + kr + 4 * i) * ldw));
#pragma unroll
    for (int i = 0; i < 16; ++i) { float* d = scr + (kr + 4 * i) * 65 + 2 * d4 + hf; d[0] = v[i][0]; d[2] = v[i][1]; d[4] = v[i][2]; d[6] = v[i][3]; }
    WAVE_SYNC();
    const int c = lane & 3;
#pragma unroll
    for (int j = 0; j < 4; ++j) { const int n = (lane >> 2) + 16 * j; const float* sp = scr + (16 * c) * 65 + n;
        u32x4 o; o.x = pk4_fp8(sp[0 * 65] * scale, sp[1 * 65] * scale, sp[2 * 65] * scale, sp[3 * 65] * scale); o.y = pk4_fp8(sp[4 * 65] * scale, sp[5 * 65] * scale, sp[6 * 65] * scale, sp[7 * 65] * scale);
        o.z = pk4_fp8(sp[8 * 65] * scale, sp[9 * 65] * scale, sp[10 * 65] * scale, sp[11 * 65] * scale); o.w = pk4_fp8(sp[12 * 65] * scale, sp[13 * 65] * scale, sp[14 * 65] * scale, sp[15 * 65] * scale);
        *(u32x4*)(WT + (size_t)(n0 + n) * K + k0 + 16 * c) = o; }
    WAVE_SYNC();
}
template <class ColPtr>
DEVI void tr_item32_f8(const ColPtr& cp, size_t ldw, int K, unsigned char* WT, int k0, int n0, float* scr, int lane, float scale) {
    const float* src = cp(n0 + (lane & 31));
#pragma unroll 8
    for (int i = 0; i < 32; ++i) { const int kk = 2 * i + (lane >> 5); scr[kk * 33 + (lane & 31)] = src ? src[(size_t)(k0 + kk) * ldw] : 0.f; }
    WAVE_SYNC();
    const int c = lane & 7;
#pragma unroll
    for (int j = 0; j < 4; ++j) { const int n = (lane >> 3) + 8 * j; const float* sp = scr + (8 * c) * 33 + n;
        u32x2 o; o.x = pk4_fp8(sp[0 * 33] * scale, sp[1 * 33] * scale, sp[2 * 33] * scale, sp[3 * 33] * scale); o.y = pk4_fp8(sp[4 * 33] * scale, sp[5 * 33] * scale, sp[6 * 33] * scale, sp[7 * 33] * scale);
        *(u32x2*)(WT + (size_t)(n0 + n) * K + k0 + 8 * c) = o; }
    WAVE_SYNC();
}
struct ColPlain { const float* W; DEVI const float* operator()(int n) const { return W + n; } };
struct ColInProj { const float* W; DEVI const float* operator()(int n) const { const int s = src_col(n); return s >= 0 ? W + s : nullptr; } };
struct ColW13 { const float* w1; const float* w3; DEVI const float* operator()(int n) const { const int f = (n >> 3) * 4 + (n & 3); return ((n >> 2) & 1) ? w3 + f : w1 + f; } };

DEVI void phase_prologue(KP a, unsigned char* lds, int tid, int lane, int wave, int G) {
    unsigned char* ws = a->ws;
    float* cosT = (float*)(ws + WS_ROPE); float* sinT = cosT + 4096 * 64;
    for (int idx = blockIdx.x * 512 + tid; idx < 4096 * 64; idx += G * 512) {
        const int pos = idx >> 6, i = idx & 63;
        const float inv = exp2f(-(float)i * (13.287712379549449f / 64.f));
        const double ang = (double)pos * (double)inv;
        const double k = __builtin_rint(ang * 0.15915494309189535);
        const float r = (float)(ang - k * 6.283185307179586);
        cosT[idx] = cosf(r); sinT[idx] = sinf(r);
    }
    { const float* x = a->in[0]; unsigned char* x8 = ws + WS_X8;
      const size_t NI = (size_t)M_ * D_ / 8, st = (size_t)G * 512; size_t i = (size_t)blockIdx.x * 512 + tid;
      for (; i + 3 * st < NI; i += 4 * st) {
          f32x4 v0[4], v1[4];
#pragma unroll
          for (int u = 0; u < 4; ++u) { v0[u] = *(const f32x4*)(x + (i + u * st) * 8); v1[u] = *(const f32x4*)(x + (i + u * st) * 8 + 4); }
#pragma unroll
          for (int u = 0; u < 4; ++u) { u32x2 w; w.x = pk4_fp8(v0[u][0], v0[u][1], v0[u][2], v0[u][3]); w.y = pk4_fp8(v1[u][0], v1[u][1], v1[u][2], v1[u][3]); *(u32x2*)(x8 + (i + u * st) * 8) = w; } }
      for (; i < NI; i += st) {
          const f32x4 v0 = *(const f32x4*)(x + i * 8), v1 = *(const f32x4*)(x + i * 8 + 4);
          u32x2 w; w.x = pk4_fp8(v0[0], v0[1], v0[2], v0[3]); w.y = pk4_fp8(v1[0], v1[1], v1[2], v1[3]);
          *(u32x2*)(x8 + i * 8) = w; } }
    { float* bp = (float*)(ws + WS_BIASP);
      for (int i = blockIdx.x * 512 + tid; i < 2 * NPAD; i += G * 512) { const int l = i / NPAD, n = i % NPAD, s = src_col(n); bp[i] = s >= 0 ? a->in[2][l * IN_W + s] : 0.f; } }
    { u16* ov = (u16*)(ws + WS_OVL);
      for (int i = blockIdx.x * 512 + tid; i < 256 * 128; i += G * 512) { const int n = i >> 7, j = i & 127;
          const bool on = j < 64 && n < 255 && (16 * n <= 64 * j + 63) && (16 * n + 31 >= 64 * j); ov[i] = on ? (u16)0x3f80 : (u16)0; } }
    { float* wT = (float*)(ws + WS_RWT); const float* rw = a->in[19];
      for (int i = blockIdx.x * 512 + tid; i < 32 * 2048; i += G * 512) { const int e = i >> 11, d = i & 2047; wT[i] = rw[d * 32 + e]; } }
    const int gw = blockIdx.x * 8 + wave, NGW = G * 8;
    { float* b1p = (float*)(ws + WS_MISC + 1536 * 1024);
      for (int task = gw; task < 512; task += NGW) { const int kc = task & 63, fh = (task >> 6) & 1, kv = (task >> 7) & 1, l = task >> 8;
          const float* pos = a->in[kv ? 9 : 4] + (size_t)l * 4096; const float* w1 = a->in[kv ? 10 : 5] + (size_t)l * 4096 * 128; const int f = fh * 64 + lane;
          float s = 0.f;
          for (int k = kc * 64; k < kc * 64 + 64; ++k) s += pos[k] * w1[(size_t)k * 128 + f];
          b1p[((l * 2 + kv) * 64 + kc) * 128 + f] = s; } }
    float* scr = (float*)(lds + wave * 16640);
    constexpr int IT_WIN = 32 * (NPAD / 64), IT_WB = 32 * 32, IT_CW = 32 * 2;
    constexpr int NIT = 2 * IT_WIN + 6 * IT_WB + 8 * IT_CW;
    for (int it = gw; it < NIT; it += NGW) {
        int r = it;
        if (r < 2 * IT_WIN) { const int l = r / IT_WIN; r %= IT_WIN; const int kb = r / (NPAD / 64), nb = r % (NPAD / 64), n0 = nb * 64;
            const ColInProj cp{a->in[1] + (size_t)l * D_ * IN_W}; unsigned char* WT = ws + WS_WIN + (size_t)l * NPAD * D_;
            const bool rope = (n0 >= C_NQ && n0 < C_KC) || (n0 >= C_KS && n0 < C_VS) || (n0 >= C_KW && n0 < C_VW);
            if (rope) { const int segd = n0 >= C_KW ? C_KW : n0 >= C_KS ? C_KS : C_NQ, segs = n0 >= C_KW ? S_KW : n0 >= C_KS ? S_KS : S_NQ;
                const int r_ = n0 - segd, hd = r_ >> 7, m32 = (r_ & 127) >> 6;
                tr_item64_f8_rope(a->in[1] + (size_t)l * D_ * IN_W + segs + hd * 128 + 32 * m32, IN_W, D_, WT, kb * 64, n0, scr, lane, 64.f); }
            else tr_item64_f8(cp, IN_W, D_, WT, kb * 64, n0, scr, lane, 64.f);
            continue; }
        r -= 2 * IT_WIN;
        if (r < 6 * IT_WB) { const int q = r / IT_WB, l = q / 3, w = q % 3; r %= IT_WB; const int kb = r / 32, nb = r % 32;
            if (w <= 1) tr_item64_f8(ColPlain{a->in[14 + w] + (size_t)l * D_ * D_}, D_, D_, ws + WS_WB + (size_t)(l * 3 + w) * D_ * D_ * 2, kb * 64, nb * 64, scr, lane, 64.f);
            else tr_item64(ColPlain{a->in[14 + w] + (size_t)l * D_ * D_}, D_, D_, (u16*)(ws + WS_WB) + (size_t)(l * 3 + w) * D_ * D_, kb * 64, nb * 64, scr, lane);
            continue; }
        r -= 6 * IT_WB;
        { const int q = r / IT_CW, l = q >> 2, kv = (q >> 1) & 1, ab = q & 1; r %= IT_CW; const int kb = r / 2, nb = r % 2;
          const float* w1 = a->in[kv ? 10 : 5] + (size_t)l * 4096 * 128 + (size_t)ab * 2048 * 128;
          tr_item64_f8(ColPlain{w1}, 128, 2048, ws + WS_CW1 + (size_t)(l * 512 + kv * 256 + ab * 128) * 2048, kb * 64, nb * 64, scr, lane, 64.f); }
    }
}
DEVI void phase_experts(KP a, unsigned char* lds, int lane, int wave, int G, int l) {
    unsigned char* ws = a->ws;
    float* scr = (float*)(lds + wave * 16640);
    const int gw = blockIdx.x * 8 + wave, NGW = G * 8;
    constexpr int IT13 = 32 * 32, IT2 = 16 * 32;
    for (int it = gw; it < NEXP * (IT13 + IT2); it += NGW) {
        const int e = it / (IT13 + IT2); int r = it % (IT13 + IT2);
        if (r < IT13) { const int kb = r / 32, nb = r % 32;
            const float* w1 = a->in[21] + ((size_t)l * NEXP + e) * D_ * DFF; const float* w3 = a->in[22] + ((size_t)l * NEXP + e) * D_ * DFF;
            tr_item64_f8(ColW13{w1, w3}, DFF, D_, ws + WS_W13 + (size_t)e * 2048 * D_, kb * 64, nb * 64, scr, lane, 64.f); }
        else { r -= IT13; const int kb = r / 32, nb = r % 32;
            const float* w2 = a->in[23] + ((size_t)l * NEXP + e) * DFF * D_;
            tr_item64_f8(ColPlain{w2}, D_, DFF, ws + WS_W2 + (size_t)e * D_ * DFF, kb * 64, nb * 64, scr, lane, 64.f); }
    }
}

namespace ml {
constexpr int QP = 272, VP = 72;
constexpr int O_Q = 0, O_K = 34816, O_CB = 69632, O_VT = 95744, O_VW = 102656, O_SP = 109568, O_SC = 118784;
constexpr int S_A = 0, S_M = 64, S_WI = 128, S_EN = 192, S_WS = 256, S_DEN = 320, S_DEC = 384;
typedef short s16x4 __attribute__((ext_vector_type(4)));
DEVI bf16x8 frag(const unsigned char* lds, int off) { return *(const bf16x8*)(lds + off); }
DEVI bf16x8 frag_tr(unsigned addr) {
    s16x4 lo, hi;
    asm volatile("ds_read_b64_tr_b16 %0, %2\n\tds_read_b64_tr_b16 %1, %2 offset:2176\n\ts_waitcnt lgkmcnt(0)" : "=&v"(lo), "=&v"(hi) : "v"(addr) : "memory");
    return (bf16x8){lo[0], lo[1], lo[2], lo[3], hi[0], hi[1], hi[2], hi[3]};
}
}
constexpr size_t WS_SP = WS_O, WS_MSC = WS_O + 16 * MiB, WS_MDEC = WS_O + 20 * MiB;
DEVI void phase_mlstm_pre(KP a, unsigned char* lds, const int tid, int G, int first_blk) {
    using namespace ml;
    unsigned char* ws = a->ws;
    const u16* z = (const u16*)(ws + WS_Z); const float* gates = (const float*)(ws + WS_GATES);
    u16* SPg = (u16*)(ws + WS_SP); float* MSC = (float*)(ws + WS_MSC); float* MDEC = (float*)(ws + WS_MDEC);
    const int lane = tid & 63, wave = __builtin_amdgcn_readfirstlane(tid >> 6), g4 = lane >> 4, l15 = lane & 15;
    float* sc = (float*)(lds + O_SC);
    const int nblk = G - first_blk, bi = (int)blockIdx.x - first_blk;
    if (bi < 0) return;
    const int u0 = (int)(((long)bi * 1024) / nblk), u1 = (int)(((long)(bi + 1) * 1024) / nblk);
    float off = 0.f, Gp = 0.f; int have = -1;
    const unsigned qkoff = (unsigned)((tid >> 5) * NPAD + (tid & 31) * 8) * 2u; const int qklds = (tid >> 5) * (QP * 2) + (tid & 31) * 16;
    for (int u = u0; u < u1; ++u) { const int bh = u >> 6, c = u & 63, b = bh >> 2, h = bh & 3;
        const char* zq = (const char*)(z + (size_t)(b * 4096 + c * 64) * NPAD + C_MQ + h * 256);
        const char* zk = (const char*)(z + (size_t)(b * 4096 + c * 64) * NPAD + C_MK + h * 256);
        const float* gp = gates + (size_t)b * 4096 * 64 + h;
#pragma unroll
        for (int k = 0; k < 4; ++k) { *(u32x4*)(lds + O_Q + qklds + k * 16 * QP * 2) = *(const u32x4*)(zq + qkoff + (size_t)k * 16 * NPAD * 2); *(u32x4*)(lds + O_K + qklds + k * 16 * QP * 2) = *(const u32x4*)(zk + qkoff + (size_t)k * 16 * NPAD * 2); }
        if (wave == 0) {
            if (have != u) { off = 0.f; Gp = 0.f;
                if (c > 0) { const float* ch = (const float*)(ws + WS_CHS) + ((size_t)(b * 64) * 4 + h) * 2;
                    float Sv = 0.f, Lv = -INFINITY; if (lane < c) { Sv = ch[lane * 8]; Lv = ch[lane * 8 + 1]; }
#pragma unroll
                    for (int cc = 0; cc < 63; ++cc) { const float s_ = __int_as_float(__builtin_amdgcn_readlane(__float_as_int(Sv), cc)), l_ = __int_as_float(__builtin_amdgcn_readlane(__float_as_int(Lv), cc));
                        Gp = fmaxf(Gp, l_ - off); off += s_; } } }
            const float fg = gp[(size_t)(c * 64 + lane) * 64 + 4], ig = gp[(size_t)(c * 64 + lane) * 64];
            float bc = fminf(fg, 0.f) - log1pf(__expf(-fabsf(fg)));
#pragma unroll
            for (int o = 1; o < 64; o <<= 1) { const float t_ = __shfl_up(bc, o); if (lane >= o) bc += t_; }
            const float Bg = off + bc, gv = ig - Bg; float pm = gv;
#pragma unroll
            for (int o = 1; o < 64; o <<= 1) { const float t_ = __shfl_up(pm, o); if (lane >= o) pm = fmaxf(pm, t_); }
            const float Gt = fmaxf(Gp, pm), Ge = __shfl(Gt, 63);
            sc[S_A + lane] = gv; sc[S_M + lane] = Gt;
            *(f32x4*)(MSC + ((size_t)bh * 4096 + c * 64 + lane) * 4) = (f32x4){__expf(Gp - Gt), __expf(-(Bg + Gt)), __expf(gv - Ge), 0.f};
            if (lane == 0) MDEC[bh * 64 + c] = __expf(Gp - Ge);
            off = __shfl(Bg, 63); Gp = Ge; have = u + 1;
            if (c == 63) have = -1;
        }
        __syncthreads();
        const int tt = wave >> 1, st0 = 2 * (wave & 1); const int t = 16 * tt + l15; const float Gt_ = sc[S_M + t];
        u16* spo = SPg + (size_t)u * 4096 + (size_t)t * 64;
#pragma unroll
        for (int si = 0; si < 2; ++si) { const int st = st0 + si; u32x2 pk_ = {0u, 0u};
            if (st <= tt) { f32x4 sacc = {0.f, 0.f, 0.f, 0.f};
#pragma unroll
                for (int ks = 0; ks < 8; ++ks) sacc = __builtin_amdgcn_mfma_f32_16x16x32_bf16(frag(lds, O_K + (16 * st + l15) * (QP * 2) + (32 * ks + 8 * g4) * 2), frag(lds, O_Q + (16 * tt + l15) * (QP * 2) + (32 * ks + 8 * g4) * 2), sacc, 0, 0, 0);
                float w_[4];
#pragma unroll
                for (int j = 0; j < 4; ++j) { const int sj = 16 * st + 4 * g4 + j; w_[j] = sj <= t ? sacc[j] * __expf(sc[S_A + sj] - Gt_) : 0.f; }
                pk_.x = pk2(w_[0], w_[1]); pk_.y = pk2(w_[2], w_[3]); }
            *(u32x2*)(spo + 16 * st + 4 * g4) = pk_; }
        __syncthreads();
    }
}
DEVI void phase_mlstm(KP a, unsigned char* lds, const int tid, int G) {
    using namespace ml;
    unsigned char* ws = a->ws;
    const u16* z = (const u16*)(ws + WS_Z); u16* hbuf = (u16*)(ws + WS_HG);
    const u16* SPg = (const u16*)(ws + WS_SP); const float* MSC = (const float*)(ws + WS_MSC); const float* MDEC = (const float*)(ws + WS_MDEC);
    const int lane = tid & 63, wave = __builtin_amdgcn_readfirstlane(tid >> 6), g4 = lane >> 4, l15 = lane & 15;
    float* sc = (float*)(lds + O_SC);
    const unsigned lds32 = (unsigned)(uintptr_t)lds;
    const unsigned qkoff = (unsigned)((tid >> 5) * NPAD + (tid & 31) * 8) * 2u;
    const int qklds = (tid >> 5) * (QP * 2) + (tid & 31) * 16;
    const int vs_ = tid >> 3, v4 = (tid & 7) * 4;
    for (int unit0 = blockIdx.x; unit0 < 256; unit0 += G) {
        const int unit = (G % 8 == 0 && G >= 256) ? (((unit0 & 7) + 8 * (unit0 >> 7)) * 16 + ((unit0 >> 3) & 15)) : unit0;
        const int b = unit >> 6, h = (unit >> 4) & 3, jv = unit & 15, bh = b * 4 + h;
        const char* zq = (const char*)(z + (size_t)b * 4096 * NPAD + C_MQ + h * 256);
        const char* zk = (const char*)(z + (size_t)b * 4096 * NPAD + C_MK + h * 256);
        const char* zv = (const char*)(z + (size_t)b * 4096 * NPAD + C_MV + h * 512 + jv * 32);
        const char* spg = (const char*)(SPg + (size_t)bh * 64 * 4096);
        const float* msc = MSC + (size_t)bh * 4096 * 4;
        for (int i = tid; i < 48 * QP / 2; i += 512) ((unsigned*)(lds + O_CB))[i] = 0u;
        for (int i = tid; i < 16 * VP / 2; i += 512) { ((unsigned*)(lds + O_VT + 32 * VP * 2))[i] = i < VP / 2 ? 0x3f803f80u : 0u; ((unsigned*)(lds + O_VW + 32 * VP * 2))[i] = 0u; }
        f32x4 Cacc[2][3];
#pragma unroll
        for (int i = 0; i < 2; ++i)
#pragma unroll
            for (int j = 0; j < 3; ++j) Cacc[i][j] = (f32x4){0.f, 0.f, 0.f, 0.f};
        u32x4 pq[4], pk[4], psp; u32x2 pv; f32x4 pms = {0.f, 0.f, 0.f, 0.f}; float pdec = 0.f, pws = 0.f;
#pragma unroll
        for (int k = 0; k < 4; ++k) { pq[k] = *(const u32x4*)(zq + qkoff + (size_t)k * 16 * NPAD * 2); pk[k] = *(const u32x4*)(zk + qkoff + (size_t)k * 16 * NPAD * 2); }
        pv = *(const u32x2*)(zv + ((size_t)vs_ * NPAD + v4) * 2); pws = msc[(size_t)vs_ * 4 + 2];
        psp = *(const u32x4*)(spg + (size_t)tid * 16);
        if (wave == 0) { pms = *(const f32x4*)(msc + (size_t)lane * 4); pdec = MDEC[bh * 64]; }
        for (int c = 0; c < 64; ++c) {
#pragma unroll
            for (int k = 0; k < 4; ++k) { *(u32x4*)(lds + O_Q + qklds + k * 16 * QP * 2) = pq[k]; *(u32x4*)(lds + O_K + qklds + k * 16 * QP * 2) = pk[k]; }
            { u16* vt = (u16*)(lds + O_VT); u16* vw = (u16*)(lds + O_VW); const unsigned short e0 = (u16)(pv.x & 0xffffu), e1 = (u16)(pv.x >> 16), e2 = (u16)(pv.y & 0xffffu), e3 = (u16)(pv.y >> 16);
              vt[(v4 + 0) * VP + vs_] = e0; vt[(v4 + 1) * VP + vs_] = e1; vt[(v4 + 2) * VP + vs_] = e2; vt[(v4 + 3) * VP + vs_] = e3;
              vw[(v4 + 0) * VP + vs_] = (u16)f2bf(bf2f(e0) * pws); vw[(v4 + 1) * VP + vs_] = (u16)f2bf(bf2f(e1) * pws); vw[(v4 + 2) * VP + vs_] = (u16)f2bf(bf2f(e2) * pws); vw[(v4 + 3) * VP + vs_] = (u16)f2bf(bf2f(e3) * pws); }
            *(u32x4*)(lds + O_SP + (tid >> 3) * (VP * 2) + (tid & 7) * 16) = psp;
            if (wave == 0) { sc[S_WI + lane] = pms[0]; sc[S_EN + lane] = pms[1]; ((u16*)(lds + O_VW))[32 * VP + lane] = (u16)f2bf(pms[2]); if (lane == 0) sc[S_DEC] = pdec; }
            __syncthreads();
            { const int cn = c < 63 ? c + 1 : 63; const size_t ro = (size_t)cn * 64 * NPAD * 2;
#pragma unroll
              for (int k = 0; k < 4; ++k) { pq[k] = *(const u32x4*)(zq + ro + qkoff + (size_t)k * 16 * NPAD * 2); pk[k] = *(const u32x4*)(zk + ro + qkoff + (size_t)k * 16 * NPAD * 2); }
              pv = *(const u32x2*)(zv + ro + ((size_t)vs_ * NPAD + v4) * 2); pws = msc[(size_t)(cn * 64 + vs_) * 4 + 2];
              psp = *(const u32x4*)(spg + (size_t)cn * 8192 + (size_t)tid * 16);
              if (wave == 0) { pms = *(const f32x4*)(msc + (size_t)(cn * 64 + lane) * 4); pdec = MDEC[bh * 64 + cn]; } }
            const int tt1 = wave & 3, vt1 = wave >> 2;
            f32x4 inter1 = {0.f, 0.f, 0.f, 0.f}, inter2 = {0.f, 0.f, 0.f, 0.f};
#pragma unroll
            for (int ks = 0; ks < 8; ++ks) { const bf16x8 aq = frag(lds, O_Q + (16 * tt1 + l15) * (QP * 2) + (32 * ks + 8 * g4) * 2);
                inter1 = __builtin_amdgcn_mfma_f32_16x16x32_bf16(aq, frag(lds, O_CB + (16 * vt1 + l15) * (QP * 2) + (32 * ks + 8 * g4) * 2), inter1, 0, 0, 0);
                inter2 = __builtin_amdgcn_mfma_f32_16x16x32_bf16(aq, frag(lds, O_CB + (32 + l15) * (QP * 2) + (32 * ks + 8 * g4) * 2), inter2, 0, 0, 0); }
            f32x4 num1 = {0.f, 0.f, 0.f, 0.f}, num2 = {0.f, 0.f, 0.f, 0.f};
#pragma unroll
            for (int ks = 0; ks < 2; ++ks) { const bf16x8 ap = frag(lds, O_SP + (16 * tt1 + l15) * (VP * 2) + (32 * ks + 8 * g4) * 2);
                num1 = __builtin_amdgcn_mfma_f32_16x16x32_bf16(ap, frag(lds, O_VT + (16 * vt1 + l15) * (VP * 2) + (32 * ks + 8 * g4) * 2), num1, 0, 0, 0);
                num2 = __builtin_amdgcn_mfma_f32_16x16x32_bf16(ap, frag(lds, O_VT + (32 + l15) * (VP * 2) + (32 * ks + 8 * g4) * 2), num2, 0, 0, 0); }
            { const int row0 = b * 4096 + c * 64;
#pragma unroll
              for (int j = 0; j < 4; ++j) { const int tj = 16 * tt1 + 4 * g4 + j; const float wi = sc[S_WI + tj];
                  float d_ = num2[j] + wi * inter2[j];
                  d_ = __shfl(d_, lane & 48);
                  const float den = fmaxf(fabsf(d_), sc[S_EN + tj]);
                  const float hv = (num1[j] + wi * inter1[j]) / den;
                  const float hn = __int_as_float(__builtin_amdgcn_mov_dpp(__float_as_int(hv), 0xB1, 0xF, 0xF, true));
                  if ((l15 & 1) == 0) *(unsigned*)(hbuf + (size_t)(row0 + tj) * D_ + h * 512 + jv * 32 + 16 * vt1 + l15) = pk2(hv, hn); } }
            { const float decay = sc[S_DEC];
#pragma unroll
              for (int di = 0; di < 2; ++di) { const int dt = 2 * wave + di;
#pragma unroll
                  for (int vt = 0; vt < 3; ++vt) Cacc[di][vt] = Cacc[di][vt] * decay;
#pragma unroll
                  for (int ks = 0; ks < 2; ++ks) { const bf16x8 ak = frag_tr(lds32 + O_K + (32 * ks + 8 * g4 + (l15 >> 2)) * (QP * 2) + (16 * dt + 4 * (lane & 3)) * 2);
#pragma unroll
                      for (int vt = 0; vt < 3; ++vt) Cacc[di][vt] = __builtin_amdgcn_mfma_f32_16x16x32_bf16(ak, frag(lds, O_VW + (16 * vt + l15) * (VP * 2) + (32 * ks + 8 * g4) * 2), Cacc[di][vt], 0, 0, 0); }
              } }
            __syncthreads();
#pragma unroll
            for (int di = 0; di < 2; ++di) { const int dt = 2 * wave + di;
#pragma unroll
                for (int vt = 0; vt < 3; ++vt) { u32x2 w_; w_.x = pk2(Cacc[di][vt][0], Cacc[di][vt][1]); w_.y = pk2(Cacc[di][vt][2], Cacc[di][vt][3]);
                    *(u32x2*)(lds + O_CB + (16 * vt + l15) * (QP * 2) + (16 * dt + 4 * g4) * 2) = w_; } }
        }
        __syncthreads();
    }
}

DEVI void phase_cmp2(KP a, unsigned char* lds, int tid, int G, int l) {
    unsigned char* ws = a->ws;
    const float* U = (const float*)(ws + WS_U); u16* kcmp = (u16*)(ws + WS_KCMP);
    const float* cosT = (const float*)(ws + WS_ROPE); const float* sinT = cosT + 4096 * 64;
    const float* b1part = (const float*)(ws + WS_MISC + 1536 * 1024);
    constexpr int HP = 132;
    float* hs = (float*)lds;
    float* os = hs + 32 * HP;
    float* b1p = os + 32 * HP;
    const int sub = tid >> 7, f = tid & 127, lane = tid & 63, wv = tid >> 6, g4 = lane >> 4, l15 = lane & 15;
    __syncthreads();
    if (tid < 256) { const int which = tid >> 7; float s = a->in[which ? 11 : 6][l * 128 + f]; float p[64];
#pragma unroll
        for (int kc = 0; kc < 64; ++kc) p[kc] = b1part[((l * 2 + which) * 64 + kc) * 128 + f];
#pragma unroll
        for (int kc = 0; kc < 64; ++kc) s += p[kc];
        b1p[tid] = s; }
    __syncthreads();
    for (int unit = blockIdx.x; unit < 256; unit += G) {
        const int which = unit >> 7, rb = which * 4096 + (unit & 127) * 32;
        const float* w2 = a->in[which ? 12 : 7] + (size_t)l * 128 * 128; const float* b2 = a->in[which ? 13 : 8] + l * 128;
        float bw[8][4];
#pragma unroll
        for (int ks = 0; ks < 8; ++ks)
#pragma unroll
            for (int u = 0; u < 4; ++u) bw[ks][u] = w2[(16 * ks + 4 * g4 + u) * 128 + wv * 16 + l15];
        float ua[8], ub[8];
#pragma unroll
        for (int j = 0; j < 8; ++j) { const int r = rb + sub + 4 * j; const bool ok = (r & 255) < 255;
            ua[j] = ok ? U[(size_t)r * 256 + f] : 0.f; ub[j] = ok ? U[(size_t)(r + 1) * 256 + 128 + f] : 0.f; }
        const float b1v = b1p[which * 128 + f];
#pragma unroll
        for (int j = 0; j < 8; ++j) { const int r = rb + sub + 4 * j; float hp = 0.f;
            if ((r & 255) < 255) { hp = ua[j] + ub[j] + b1v;
                const float u_ = 0.7978845608028654f * (hp + 0.044715f * hp * hp * hp); const float th = 1.f - 2.f / (1.f + __expf(2.f * u_)); hp = 0.5f * hp * (1.f + th); }
            hs[(sub + 4 * j) * HP + f] = hp; }
        __syncthreads();
        { f32x4 acc0 = {0.f, 0.f, 0.f, 0.f}, acc1 = {0.f, 0.f, 0.f, 0.f};
#pragma unroll
          for (int ks = 0; ks < 8; ++ks) { const f32x4 a0 = *(const f32x4*)(hs + l15 * HP + 16 * ks + 4 * g4), a1 = *(const f32x4*)(hs + (16 + l15) * HP + 16 * ks + 4 * g4);
#pragma unroll
              for (int u = 0; u < 4; ++u) { acc0 = __builtin_amdgcn_mfma_f32_16x16x4f32(a0[u], bw[ks][u], acc0, 0, 0, 0); acc1 = __builtin_amdgcn_mfma_f32_16x16x4f32(a1[u], bw[ks][u], acc1, 0, 0, 0); } }
          const float bb = b2[wv * 16 + l15];
#pragma unroll
          for (int j = 0; j < 4; ++j) { os[(4 * g4 + j) * HP + wv * 16 + l15] = acc0[j] + bb; os[(16 + 4 * g4 + j) * HP + wv * 16 + l15] = acc1[j] + bb; } }
        __syncthreads();
        if (which == 0) { const int i = f >> 1; float cs[8], sn[8];
#pragma unroll
            for (int j = 0; j < 8; ++j) { const int r = rb + sub + 4 * j, n = r & 255, pos = 16 * n + 31; cs[j] = n < 255 ? cosT[pos * 64 + i] : 1.f; sn[j] = n < 255 ? sinT[pos * 64 + i] : 0.f; }
#pragma unroll
            for (int j = 0; j < 8; ++j) { const int lr = sub + 4 * j, r = rb + lr, n = r & 255; const float x1 = os[lr * HP + i], x2 = os[lr * HP + i + 64];
                float val = (f & 1) ? x2 * cs[j] + x1 * sn[j] : x1 * cs[j] - x2 * sn[j]; if (n == 255) val = 0.f;
                kcmp[(size_t)r * 128 + f] = (u16)f2bf(val); (ws + WS_KCMP8)[(size_t)r * 128 + f] = (unsigned char)(pk4_fp8(val, 0.f, 0.f, 0.f) & 0xffu); } }
        else {
#pragma unroll
            for (int j = 0; j < 8; ++j) { const int lr = sub + 4 * j, r = rb + lr, n = r & 255; float val = os[lr * HP + f]; if (n == 255) val = 0.f;
                kcmp[(size_t)r * 128 + f] = (u16)f2bf(val); } }
        __syncthreads();
    }
}
DEVI void phase_norm(KP a, int lane, int wave, int G, int l) {
    unsigned char* ws = a->ws;
    const u16* z = (const u16*)(ws + WS_Z); u16* hg = (u16*)(ws + WS_HG); const float* mw = a->in[3] + l * 2048;
    const int gw = blockIdx.x * 8 + wave, NGW = G * 8;
    f32x4 mwq[4][2];
#pragma unroll
    for (int h = 0; h < 4; ++h) { mwq[h][0] = *(const f32x4*)(mw + h * 512 + lane * 8); mwq[h][1] = *(const f32x4*)(mw + h * 512 + lane * 8 + 4); }
    for (int row = gw; row < M_; row += NGW) {
        u32x4 hv[4], ov[4];
#pragma unroll
        for (int h = 0; h < 4; ++h) { hv[h] = *(const u32x4*)(hg + (size_t)row * D_ + h * 512 + lane * 8); ov[h] = *(const u32x4*)(z + (size_t)row * NPAD + C_MO + h * 512 + lane * 8); }
#pragma unroll
        for (int h = 0; h < 4; ++h) {
            float v[8]; unpack8(hv[h], v);
            float s = 0.f;
#pragma unroll
            for (int j = 0; j < 8; ++j) s += v[j];
            const float mean = wsum(s) * (1.f / 512.f); float q = 0.f;
#pragma unroll
            for (int j = 0; j < 8; ++j) { v[j] -= mean; q += v[j] * v[j]; }
            const float rstd = 1.f / sqrtf(wsum(q) * (1.f / 512.f) + LN_EPS);
            float og[8]; unpack8(ov[h], og);
            const f32x4 w0 = mwq[h][0], w1 = mwq[h][1];
            const float wv[8] = {w0[0], w0[1], w0[2], w0[3], w1[0], w1[1], w1[2], w1[3]};
            float o[8];
#pragma unroll
            for (int j = 0; j < 8; ++j) o[j] = v[j] * rstd * wv[j] * sigm(og[j]);
            u32x2 w8; w8.x = pk4_fp8(o[0] * 2.f, o[1] * 2.f, o[2] * 2.f, o[3] * 2.f); w8.y = pk4_fp8(o[4] * 2.f, o[5] * 2.f, o[6] * 2.f, o[7] * 2.f);
            *(u32x2*)(ws + WS_XBF + (size_t)row * D_ + h * 512 + lane * 8) = w8; }
    }
}

#ifndef GQ_CV
#define GQ_CV true
#endif
#ifndef GQ_CI
#define GQ_CI true
#endif
#ifndef GQ_W
#define GQ_W true
#endif
#ifndef GQ_S
#define GQ_S false
#endif
namespace att {
constexpr int NW = 8, QBLK = 32, KVBLK = 64, QB = 256, D = 128, WIN = 512;
constexpr int SHM_V = KVBLK * D * 2, SHM_K = KVBLK * D * 2;
constexpr float SCALE = 0.08838834764831845f, THR = 8.f;
typedef short s16x4 __attribute__((ext_vector_type(4)));
typedef float f32x16 __attribute__((ext_vector_type(16)));
enum { M_WIN = 0, M_SEL = 1, M_CMP = 2 };
enum { E_GATED = 0, E_IMP = 1, E_FINAL = 2 };
#define KSWZ8(row, colB) ((row) * 128 + ((colB) ^ (((row) & 7) << 4)))
#define SBAR() __builtin_amdgcn_sched_barrier(0)
DEVI int v_st(int k, int c) { const int kk = (k & ~0xC) | ((k & 4) << 1) | ((k & 8) >> 1); return ((kk >> 3) * 4 + (c >> 5)) * 512 + ((kk & 7) * 32 + (c & 31)) * 2; }
DEVI int v_rd_base(int lane) { return ((lane & 3) << 3) | (((lane >> 2) & 3) << 6) | (((lane >> 4) & 1) << 5) | (((lane >> 5) & 1) << 8); }
constexpr int v_rd_off(int d0, int ks, int half) { return d0 * 512 + ks * 4096 + half * 2048; }
DEVI int crow(int r, int hi) { return (r & 3) + 8 * (r >> 2) + 4 * hi; }
DEVI unsigned cvtpk(float lo, float hi) { unsigned r; asm volatile("v_cvt_pk_bf16_f32 %0, %1, %2" : "=v"(r) : "v"(lo), "v"(hi)); return r; }
DEVI bf16x8 load8(const u16* p) { return *reinterpret_cast<const bf16x8*>(p); }
DEVI int nvis(int pos) { return pos >= 31 ? ((pos - 31) >> 4) + 1 : 0; }
DEVI void mask_tile(f32x16& p0, f32x16& p1, int dq, unsigned W) {
    const float NEG = -__builtin_inff();
#pragma unroll
    for (int r = 0; r < 16; ++r) { const int c = (r & 3) + 8 * (r >> 2);
        if ((unsigned)(dq - c) >= W) p0[r] = NEG;
        if ((unsigned)(dq - c - 32) >= W) p1[r] = NEG; }
}
DEVI void mask_cmp(f32x16& p0, f32x16& p1, int lim) {
    const float NEG = -__builtin_inff();
#pragma unroll
    for (int r = 0; r < 16; ++r) { const int c = (r & 3) + 8 * (r >> 2);
        if (c >= lim) p0[r] = NEG;
        if (c + 32 >= lim) p1[r] = NEG; }
}
DEVI void mask_all(f32x16& p0, f32x16& p1, bool kill) {
    const float NEG = -__builtin_inff();
#pragma unroll
    for (int r = 0; r < 16; ++r) { if (kill) p0[r] = NEG; if (kill) p1[r] = NEG; }
}
DEVI void partialSM(f32x16& p0, f32x16& p1, float& m_reg, float& mn, float& alpha, const bool kill = false) {
    float pmax = p0[0];
#pragma unroll
    for (int r = 1; r < 16; ++r) pmax = fmaxf(pmax, p0[r]);
#pragma unroll
    for (int r = 0; r < 16; ++r) pmax = fmaxf(pmax, p1[r]);
    { auto rr = __builtin_amdgcn_permlane32_swap(__float_as_uint(pmax), __float_as_uint(pmax), false, false);
      pmax = fmaxf(__uint_as_float(rr[0]), __uint_as_float(rr[1])); }
    if (kill) pmax = -__builtin_inff();
    constexpr float C2 = 1.4426950408889634f * SCALE;
    if (__builtin_expect(__all((pmax - m_reg) * SCALE <= THR), 1)) { mn = m_reg; alpha = 1.f; }
    else { mn = fmaxf(m_reg, pmax); alpha = __builtin_amdgcn_exp2f((m_reg - mn) * C2); m_reg = mn; }
    const float mnL = kill ? -__builtin_inff() : -mn * C2;
#pragma unroll
    for (int r = 0; r < 16; ++r) p0[r] = fmaf(p0[r], C2, mnL);
#pragma unroll
    for (int r = 0; r < 16; ++r) p1[r] = fmaf(p1[r], C2, mnL);
#pragma unroll
    for (int r = 0; r < 16; ++r) p0[r] = __builtin_amdgcn_exp2f(p0[r]);
}
DEVI void finishSM(f32x16& p0, f32x16& p1, float alpha, float& l_reg, bf16x8& pa0, bf16x8& pa1, bf16x8& pa2, bf16x8& pa3) {
#pragma unroll
    for (int r = 0; r < 16; ++r) p1[r] = __builtin_amdgcn_exp2f(p1[r]);
    float ps = 0;
#pragma unroll
    for (int r = 0; r < 16; ++r) ps += p0[r];
#pragma unroll
    for (int r = 0; r < 16; ++r) ps += p1[r];
    { auto rr = __builtin_amdgcn_permlane32_swap(__float_as_uint(ps), __float_as_uint(ps), false, false);
      ps = __uint_as_float(rr[0]) + __uint_as_float(rr[1]); }
    l_reg = l_reg * alpha + ps;
#define PK4(P, B_, OUT) do { unsigned a0 = cvtpk(P[B_+0], P[B_+1]), a1 = cvtpk(P[B_+2], P[B_+3]);                          \
        unsigned b0 = cvtpk(P[B_+4], P[B_+5]), b1 = cvtpk(P[B_+6], P[B_+7]);                                             \
        auto r0 = __builtin_amdgcn_permlane32_swap(a0, b0, false, false); auto r1 = __builtin_amdgcn_permlane32_swap(a1, b1, false, false); \
        u32x4 w = {r0[0], r1[0], r0[1], r1[1]}; OUT = *reinterpret_cast<bf16x8*>(&w); } while (0)
    PK4(p0, 0, pa0); PK4(p0, 8, pa1); PK4(p1, 0, pa2); PK4(p1, 8, pa3);
#undef PK4
}
template <int KB, bool SK>
DEVI void qkt(f32x16& p0, f32x16& p1, const char* K_lds, int r32, int hi, const pg8::i32x8_* q8, bool act) {
    if (SK && !act) { const float NEG = -__builtin_inff();
#pragma unroll
        for (int r = 0; r < 16; ++r) { p0[r] = NEG; p1[r] = NEG; } return; }
    const char* kb = K_lds + KB * SHM_K;
    const int one = 0x7f7f7f7f;
    typedef int i4 __attribute__((ext_vector_type(4)));
    { const pg8::i32x8_ a00 = __builtin_shufflevector(*(const i4*)(kb + KSWZ8(r32, 32 * hi)), *(const i4*)(kb + KSWZ8(r32, 32 * hi + 16)), 0, 1, 2, 3, 4, 5, 6, 7);
      const pg8::i32x8_ a10 = __builtin_shufflevector(*(const i4*)(kb + 4096 + KSWZ8(r32, 32 * hi)), *(const i4*)(kb + 4096 + KSWZ8(r32, 32 * hi + 16)), 0, 1, 2, 3, 4, 5, 6, 7);
      asm volatile("s_waitcnt lgkmcnt(0)\n\tv_mfma_scale_f32_32x32x64_f8f6f4 %0, %2, %4, 0, %5, %5 op_sel_hi:[0,0,0]\n\tv_mfma_scale_f32_32x32x64_f8f6f4 %1, %3, %4, 0, %5, %5 op_sel_hi:[0,0,0]"
                   : "=&v"(p0), "=&v"(p1) : "v"(a00), "v"(a10), "v"(q8[0]), "v"(one) : "memory"); }
    { const pg8::i32x8_ a01 = __builtin_shufflevector(*(const i4*)(kb + KSWZ8(r32, 64 + 32 * hi)), *(const i4*)(kb + KSWZ8(r32, 64 + 32 * hi + 16)), 0, 1, 2, 3, 4, 5, 6, 7);
      const pg8::i32x8_ a11 = __builtin_shufflevector(*(const i4*)(kb + 4096 + KSWZ8(r32, 64 + 32 * hi)), *(const i4*)(kb + 4096 + KSWZ8(r32, 64 + 32 * hi + 16)), 0, 1, 2, 3, 4, 5, 6, 7);
      asm volatile("s_waitcnt lgkmcnt(0)\n\tv_mfma_scale_f32_32x32x64_f8f6f4 %0, %2, %4, %0, %5, %5 op_sel_hi:[0,0,0]\n\tv_mfma_scale_f32_32x32x64_f8f6f4 %1, %3, %4, %1, %5, %5 op_sel_hi:[0,0,0]\n\ts_nop 15\n\ts_nop 15\n\ts_nop 15\n\ts_nop 15"
                   : "+v"(p0), "+v"(p1) : "v"(a01), "v"(a11), "v"(q8[1]), "v"(one) : "memory"); }
}
template <int VB, bool SK>
DEVI void pv_tile(f32x16* o, int vb0, bf16x8 pa0, bf16x8 pa1, bf16x8 pa2, bf16x8 pa3, bool act) {
    if (SK && !act) return;
#define TRRD(dst, off) asm volatile("ds_read_b64_tr_b16 %0, %1 offset:%2" : "=&v"(dst) : "v"(vb0), "i"(off) : "memory")
#define PV_D0(d0) do { s16x4 l0, l1, l2, l3, h0, h1, h2, h3; constexpr int b_ = VB * SHM_V + v_rd_off(d0, 0, 0); \
        TRRD(l0, b_); TRRD(h0, b_ + 2048); TRRD(l1, b_ + 4096); TRRD(h1, b_ + 6144); TRRD(l2, b_ + 8192); TRRD(h2, b_ + 10240); TRRD(l3, b_ + 12288); TRRD(h3, b_ + 14336); \
        asm volatile("s_waitcnt lgkmcnt(0)" ::: "memory"); SBAR();   \
        o[d0] = __builtin_amdgcn_mfma_f32_32x32x16_bf16(pa0, (bf16x8){l0[0], l0[1], l0[2], l0[3], h0[0], h0[1], h0[2], h0[3]}, o[d0], 0, 0, 0);   \
        o[d0] = __builtin_amdgcn_mfma_f32_32x32x16_bf16(pa1, (bf16x8){l1[0], l1[1], l1[2], l1[3], h1[0], h1[1], h1[2], h1[3]}, o[d0], 0, 0, 0);   \
        o[d0] = __builtin_amdgcn_mfma_f32_32x32x16_bf16(pa2, (bf16x8){l2[0], l2[1], l2[2], l2[3], h2[0], h2[1], h2[2], h2[3]}, o[d0], 0, 0, 0);   \
        o[d0] = __builtin_amdgcn_mfma_f32_32x32x16_bf16(pa3, (bf16x8){l3[0], l3[1], l3[2], l3[3], h3[0], h3[1], h3[2], h3[3]}, o[d0], 0, 0, 0); } while (0)
    PV_D0(0); PV_D0(1); PV_D0(2); PV_D0(3);
#undef PV_D0
#undef TRRD
}
struct ABlock { const unsigned char* Q; const unsigned char* K; const u16* V; int P0, row0, b, head; };
struct Seam { pg8::i32x8_ q8[2]; u32x4 st_k; bf16x8 st_v0, st_v1; };
struct Epi { const float* gates; u16* dst; const u16* oc; const u16* ow; float* imp; const unsigned long long* sel; };
template <int MODE> DEVI int jlo(int P0) { if (MODE == M_WIN) { const int lowk = P0 - WIN + 1; return lowk > 0 ? lowk / KVBLK : 0; } return 0; }
template <int MODE, int QBE = QB> DEVI int jhi(int P0) {
    if (MODE == M_CMP) { const int n = (nvis(P0 + QBE - 1) + KVBLK - 1) / KVBLK; return n < 1 ? 1 : n; }
    return (P0 + QBE - 1) / KVBLK + 1; }
#define ROWB(p, k0) ((const char*)((p) + (size_t)(k0) * LDK))
#define VMW() asm volatile("s_waitcnt vmcnt(0)" ::: "memory")
#define VMWN(n) asm volatile("s_waitcnt vmcnt(%0)" :: "i"(n) : "memory")
#define SLOAD_H(Kp, Vp, k0) do { const char* vb_ = ROWB(Vp, k0); const char* kb__ = (const char*)(Kp) + (size_t)(k0) * LDK8;                     \
                         S.st_v0 = load8((const u16*)(vb_ + voff0)); S.st_v1 = load8((const u16*)(vb_ + voff1));              \
                         S.st_k = *(const u32x4*)(kb__ + koff8); } while (0)
#define SWRITE_HK(bf) do { *(u32x4*)(K_lds + (bf) * SHM_K + kws) = S.st_k; } while (0)
#define SWRITE_HV(bf) do { *(bf16x8*)(V_lds + (bf) * SHM_V + vst0) = S.st_v0; *(bf16x8*)(V_lds + (bf) * SHM_V + vst1) = S.st_v1; } while (0)
#define SWRITE_H(bf) do { SWRITE_HV(bf); SWRITE_HK(bf); } while (0)
template <int MODE, int LDK, int LDK8, bool GQ = false>
DEVI void prime(const ABlock& cur, char* lds, Seam& S, const int tid) {
    const int wid = __builtin_amdgcn_readfirstlane(tid >> 6), lane = tid & 63, r32 = lane & 31, hi = lane >> 5;
    const int sr = tid >> 4, sc = (tid & 15) * 8, kws = KSWZ8(tid >> 3, (tid & 7) * 16); char* K_lds = lds + 2 * SHM_V;
    const unsigned voff0 = (unsigned)(sr * LDK + sc) * 2u, voff1 = (unsigned)((32 + sr) * LDK + sc) * 2u, koff8 = (unsigned)((tid >> 3) * LDK8 + (tid & 7) * 16);
    const unsigned qoff = GQ ? (unsigned)(((wid & 1) * QBLK + r32) * 3072 + (wid >> 1) * 128 + hi * 32) : (unsigned)((wid * QBLK + r32) * 3072 + hi * 32);
    const int kb0 = jlo<MODE>(cur.P0) * KVBLK;
    { typedef int i4 __attribute__((ext_vector_type(4)));
#pragma unroll
      for (int s_ = 0; s_ < 2; ++s_) S.q8[s_] = __builtin_shufflevector(*(const i4*)(cur.Q + qoff + 64 * s_), *(const i4*)(cur.Q + qoff + 64 * s_ + 16), 0, 1, 2, 3, 4, 5, 6, 7); }
    SLOAD_H(cur.K, cur.V, kb0); VMW(); SWRITE_HK(0);
    __syncthreads();
}
template <int MODE, int EPI, int GK, int LDK, int LDK8, bool SK, bool GQ = false>
DEVI void block(const ABlock& cur, const ABlock& nxt, char* lds, Seam& S, const Epi& E, const int tid) {
    const int wid = __builtin_amdgcn_readfirstlane(tid >> 6), lane = tid & 63, r32 = lane & 31, hi = lane >> 5;
    const int wrow = GQ ? (wid & 1) * QBLK : wid * QBLK, whead = GQ ? cur.head + (wid >> 1) : cur.head;
    const int j_lo = jlo<MODE>(cur.P0), j_hi = jhi<MODE, GQ ? 64 : QB>(cur.P0);
    const int NT = j_hi - j_lo;
    const int kbn = jlo<MODE>(nxt.P0) * KVBLK;
    const int qlo = cur.P0 + wrow, qm = qlo + r32 - 4 * hi;
    char* V_lds = lds; char* K_lds = lds + 2 * SHM_V;
    float* wsl = (float*)(lds + 2 * SHM_V + 2 * SHM_K) + wid * 64; float* li_l = wsl, * al_l = wsl + 32;
    float m_reg = -1e30f, l_reg = 0; f32x16 o[4] = {};
    const int sr = tid >> 4, sc = (tid & 15) * 8, vst0 = v_st(sr, sc), vst1 = v_st(32 + sr, sc), kws = KSWZ8(tid >> 3, (tid & 7) * 16);
    const unsigned voff0 = (unsigned)(sr * LDK + sc) * 2u, voff1 = (unsigned)((32 + sr) * LDK + sc) * 2u, koff8 = (unsigned)((tid >> 3) * LDK8 + (tid & 7) * 16);
    const unsigned qoff = GQ ? (unsigned)(((wid & 1) * QBLK + r32) * 3072 + (wid >> 1) * 128 + hi * 32) : (unsigned)((wid * QBLK + r32) * 3072 + hi * 32);
    const int vb0 = (int)(uintptr_t)V_lds + v_rd_base(lane);
    const unsigned char* Kh = cur.K; const u16* Vh = cur.V;
    unsigned sello = 0u, selhi = 0u; int nvl = 0;
    if (MODE == M_SEL) { const unsigned long long sw = E.sel[(size_t)(cur.b * 4 + (cur.head >> 2)) * 4096 + qlo + r32]; sello = (unsigned)sw; selhi = (unsigned)(sw >> 32); }
    if (MODE == M_CMP) nvl = nvis(qlo + r32) - 4 * hi;
#define RESC(a) do { if (__any((a) < 1.f)) { if (hi == 0) al_l[r32] = (a); asm volatile("s_waitcnt lgkmcnt(0)" ::: "memory");              \
                     for (int d_ = 0; d_ < 4; ++d_) for (int r = 0; r < 16; ++r) o[d_][r] *= al_l[crow(r, hi)]; } } while (0)
#define KBASE(t) ((j_lo + (t)) * KVBLK)
#define ACT(t) (MODE == M_WIN ? (KBASE(t) <= qlo + QBLK - 1 && KBASE(t) + KVBLK - 1 >= qlo - WIN + 1) : MODE == M_SEL ? (KBASE(t) <= qlo + QBLK - 1) : (KBASE(t) < nvis(qlo + QBLK - 1)))
#define MASKT(P0_, P1_, t) do { const int kb_ = KBASE(t); if (!SK || ACT(t)) {                                                             \
        if (MODE == M_WIN) { if (kb_ + KVBLK - 1 > qlo || kb_ <= qlo + QBLK - 1 - WIN) mask_tile(P0_, P1_, qm - kb_, (unsigned)WIN); }       \
        else if (MODE == M_SEL) { if (kb_ + KVBLK - 1 > qlo) mask_tile(P0_, P1_, qm - kb_, 0x40000000u);                                    \
            const int jt_ = j_lo + (t); const unsigned w_ = (jt_ & 32) ? selhi : sello; killf = ((w_ >> (jt_ & 31)) & 1u) == 0u; } \
        else { mask_cmp(P0_, P1_, nvl - kb_); } } } while (0)
    constexpr int NQL = 4;
#define SEAM_K0() do { VMWN(NQL); SWRITE_HK(0); SBAR(); } while (0)
    f32x16 pA0, pA1, pB0, pB1; float mnA, mnB, alA, alB; bf16x8 pa0, pa1, pa2, pa3; bool killf = false;
    SWRITE_HV(0); SBAR();
    if (NT > 1) { SLOAD_H(Kh, Vh, KBASE(1)); }
    SBAR(); qkt<0, SK>(pA0, pA1, K_lds, r32, hi, S.q8, ACT(0));
    MASKT(pA0, pA1, 0); partialSM(pA0, pA1, m_reg, mnA, alA, MODE == M_SEL && killf);
    if (NT > 1) { VMW(); SWRITE_H(1); }
    __syncthreads();
#define HALF_STEP(PX0, PX1, mnX, alX, PY0, PY1, alY, t, KB, VB, SB) do {                                                      \
        SBAR(); qkt<KB, SK>(PX0, PX1, K_lds, r32, hi, S.q8, ACT(t));                                             \
        finishSM(PY0, PY1, alY, l_reg, pa0, pa1, pa2, pa3); SBAR();                                                           \
        if ((t) + 1 < NT) { SLOAD_H(Kh, Vh, KBASE((t) + 1)); SBAR(); }                                               \
        pv_tile<VB, SK>(o, vb0, pa0, pa1, pa2, pa3, ACT((t) - 1)); MASKT(PX0, PX1, (t)); partialSM(PX0, PX1, m_reg, mnX, alX, MODE == M_SEL && killf);                                        \
        __syncthreads();                                                                                                      \
        if ((t) + 1 < NT) { VMW(); SWRITE_H(SB); }                                                                          \
        RESC(alX); __syncthreads(); } while (0)
    for (int t = 1; t + 1 < NT; t += 2) {
        HALF_STEP(pB0, pB1, mnB, alB, pA0, pA1, alA, t, 1, 0, 0);
        HALF_STEP(pA0, pA1, mnA, alA, pB0, pB1, alB, t + 1, 0, 1, 1);
    }
    const bool even = (NT & 1) == 0;
    if (even) { SBAR(); qkt<1, SK>(pB0, pB1, K_lds, r32, hi, S.q8, ACT(NT - 1)); SBAR(); }
    { const unsigned char* nK = nxt.K; const u16* nV = nxt.V; SLOAD_H(nK, nV, kbn); SBAR();
      typedef int i4 __attribute__((ext_vector_type(4)));
#pragma unroll
      for (int s_ = 0; s_ < 2; ++s_) S.q8[s_] = __builtin_shufflevector(*(const i4*)(nxt.Q + qoff + 64 * s_), *(const i4*)(nxt.Q + qoff + 64 * s_ + 16), 0, 1, 2, 3, 4, 5, 6, 7); }
    SBAR();
    finishSM(pA0, pA1, alA, l_reg, pa0, pa1, pa2, pa3); SBAR();
    pv_tile<0, SK>(o, vb0, pa0, pa1, pa2, pa3, ACT(even ? NT - 2 : NT - 1));
    if (even) { MASKT(pB0, pB1, NT - 1); partialSM(pB0, pB1, m_reg, mnB, alB, MODE == M_SEL && killf); __syncthreads(); RESC(alB);
        finishSM(pB0, pB1, alB, l_reg, pa0, pa1, pa2, pa3); SBAR(); pv_tile<1, SK>(o, vb0, pa0, pa1, pa2, pa3, ACT(NT - 1)); }
    SBAR(); SEAM_K0();
    if (hi == 0) { li_l[r32] = l_reg; if (EPI != E_IMP && GK >= 0) al_l[r32] = sigm(E.gates[(size_t)(cur.row0 + wrow + r32) * 64 + 8 + whead * 3 + (GK < 0 ? 0 : GK)]); }
    asm volatile("s_waitcnt lgkmcnt(0)" ::: "memory");
    float rli[16];
#pragma unroll
    for (int r = 0; r < 16; ++r) { const float l_ = li_l[crow(r, hi)]; rli[r] = l_ > 0.f ? __builtin_amdgcn_rcpf(l_) : 0.f; if (EPI != E_IMP && GK >= 0) rli[r] *= al_l[crow(r, hi)]; }
    const size_t ebase = ((size_t)cur.row0 * D_ + whead * 128) * 2;
    const unsigned elane = (unsigned)((wrow + 4 * hi) * D_ + r32) * 2u;
    float* impb = E.imp + ((size_t)(cur.b * 16 + whead) * 4096 + cur.P0) * 64;
    const unsigned ilane = (unsigned)((wrow + 4 * hi) * 64 + r32) * 4u;
    const size_t frb = ((((size_t)(cur.b * 16 + whead) * 128 + ((cur.P0 + wrow) >> 5)) * 64 + lane) * 64) * 2;
    if (EPI == E_GATED) {
#pragma unroll
        for (int i = 0; i < 8; ++i) { const int r0 = 2 * i, r1 = 2 * i + 1; u32x4 w;
            w.x = cvtpk(o[0][r0] * rli[r0], o[1][r0] * rli[r0]); w.y = cvtpk(o[2][r0] * rli[r0], o[3][r0] * rli[r0]);
            w.z = cvtpk(o[0][r1] * rli[r1], o[1][r1] * rli[r1]); w.w = cvtpk(o[2][r1] * rli[r1], o[3][r1] * rli[r1]);
            *(u32x4*)((char*)E.dst + frb + i * 16) = w; }
    } else if (EPI == E_FINAL) {
        u32x4 cq[8], wq[8];
#pragma unroll
        for (int i = 0; i < 8; ++i) { cq[i] = *(const u32x4*)((const char*)E.oc + frb + i * 16); wq[i] = *(const u32x4*)((const char*)E.ow + frb + i * 16); }
#pragma unroll
        for (int r = 0; r < 16; ++r) { const int cr = (r & 3) + 8 * (r >> 2);
#pragma unroll
            for (int d0 = 0; d0 < 4; ++d0) { const float v = o[d0][r] * rli[r];
                const unsigned cw = cq[r >> 1][(r & 1) * 2 + (d0 >> 1)], ww = wq[r >> 1][(r & 1) * 2 + (d0 >> 1)];
                const float cv = __uint_as_float((d0 & 1) ? (cw & 0xffff0000u) : (cw << 16)), wv = __uint_as_float((d0 & 1) ? (ww & 0xffff0000u) : (ww << 16));
                const unsigned off = elane + (unsigned)(cr * D_ + d0 * 32) * 2u;
                const float f = (v + cv + wv) * 8.f;
                const float f1 = __int_as_float(__builtin_amdgcn_mov_dpp(__float_as_int(f), 0x55, 0xF, 0xF, true)), f2 = __int_as_float(__builtin_amdgcn_mov_dpp(__float_as_int(f), 0xAA, 0xF, 0xF, true)),
                            f3 = __int_as_float(__builtin_amdgcn_mov_dpp(__float_as_int(f), 0xFF, 0xF, 0xF, true));
                if ((r32 & 3) == 0) *(unsigned*)((char*)E.dst + (ebase >> 1) + (off >> 1)) = pk4_fp8(f, f1, f2, f3); } }
    } else {
#pragma unroll
        for (int r = 0; r < 16; ++r) { const int cr = (r & 3) + 8 * (r >> 2);
#pragma unroll
            for (int d0 = 0; d0 < 2; ++d0) *(float*)((char*)impb + ilane + (unsigned)(cr * 64 + d0 * 32) * 4u) = o[d0][r] * rli[r]; }
    }
    __syncthreads();
#undef RESC
#undef KBASE
#undef ACT
#undef MASKT
#undef SEAM_K0
#undef HALF_STEP
}
#undef ROWB
#undef VMW
#undef VMWN
#undef SLOAD_H
#undef SWRITE_HK
#undef SWRITE_HV
#undef SWRITE_H
struct Item { int b, head, qb0, qb1; };
template <bool PAIRED> DEVI Item decode(int L) {
    Item it; const int xcd = L & 7, k = L >> 3;
    if (PAIRED) { const int gi = k >> 5, r = k & 31, hl = r >> 3, x = r & 7; const int bg = gi * 8 + xcd; it.b = bg >> 2; it.head = (bg & 3) * 4 + hl; it.qb0 = x; it.qb1 = 15 - x; }
    else { const int gi = k >> 6, r = k & 63, hl = r >> 4, x = r & 15; const int bg = gi * 8 + xcd; it.b = bg >> 2; it.head = (bg & 3) * 4 + hl; it.qb0 = it.qb1 = (hl & 2) ? x : 15 - x; }
    return it;
}
template <bool PAIRED> DEVI Item decode_gq(int L) {
    Item it; const int xcd = L & 7, k = L >> 3;
    if (PAIRED) { const int gi = k >> 5, x = k & 31, bg = gi * 8 + xcd; it.b = bg >> 2; it.head = (bg & 3) * 4; it.qb0 = x; it.qb1 = 63 - x; }
    else { const int gi = k >> 6, x = k & 63, bg = gi * 8 + xcd; it.b = bg >> 2; it.head = (bg & 3) * 4; it.qb0 = it.qb1 = (x & 32) ? 63 - (x & 31) : (x & 31); }
    return it;
}
template <int MODE, bool GQ = false> DEVI ABlock mkref(const Item& it, int pass, const u16* z, const unsigned char* z8, const unsigned char* kcmp8, const u16* vcmp) {
    const int qb = pass ? it.qb1 : it.qb0; ABlock r; r.b = it.b; r.head = it.head; r.P0 = qb * (GQ ? 64 : QB); r.row0 = it.b * 4096 + r.P0;
    r.Q = z8 + (size_t)r.row0 * 3072 + it.head * 128;
    const int g = it.head >> 2;
    if (MODE == M_WIN) { r.K = z8 + (size_t)it.b * 4096 * 3072 + 2560 + g * 128; r.V = z + (size_t)it.b * 4096 * NPAD + C_VW + g * 128; }
    else if (MODE == M_SEL) { r.K = z8 + (size_t)it.b * 4096 * 3072 + 2048 + g * 128; r.V = z + (size_t)it.b * 4096 * NPAD + C_VS + g * 128; }
    else { r.K = kcmp8 + (size_t)(it.b * 4 + g) * 256 * 128; r.V = vcmp; }
    return r;
}
template <int MODE, int EPI, int GK, int LDK, int LDK8, bool SK, bool PAIRED, bool GQ = false>
DEVI void run_pass(const u16* z, const unsigned char* z8, const unsigned char* kcmp8, const u16* vcmp, size_t vcmp_stride, char* lds, const Epi& E, const int tid_in, int G) {
    int tz_ = tid_in; asm volatile("" : "+v"(tz_)); const int tid = tz_;
    constexpr int total = PAIRED ? 512 : 1024;
    int L = blockIdx.x; if (L >= total) return;
    Item it = GQ ? decode_gq<PAIRED>(L) : decode<PAIRED>(L); int pass = 0;
    ABlock cur = mkref<MODE, GQ>(it, 0, z, z8, kcmp8, vcmp + (size_t)(it.b * 4 + (it.head >> 2)) * vcmp_stride);
    Seam S;
    prime<MODE, LDK, LDK8, GQ>(cur, lds, S, tid);
    for (;;) {
        const bool more_pass = pass == 0 && it.qb1 != it.qb0, more_item = L + G < total, last = !more_pass && !more_item;
        Item itn = it; int passn = pass + 1, Ln = L;
        if (!more_pass) { passn = 0; Ln = more_item ? L + G : L; itn = GQ ? decode_gq<PAIRED>(Ln) : decode<PAIRED>(Ln); }
        const ABlock nxt = last ? cur : mkref<MODE, GQ>(itn, passn, z, z8, kcmp8, vcmp + (size_t)(itn.b * 4 + (itn.head >> 2)) * vcmp_stride);
        block<MODE, EPI, GK, LDK, LDK8, SK, GQ>(cur, nxt, lds, S, E, tid);
        if (last) break;
        cur = nxt; it = itn; pass = passn; L = Ln;
    }
}
}

DEVI void phase_nsa1(KP a, unsigned char* lds, const int tid, int G) {
    unsigned char* ws = a->ws;
    const u16* z = (const u16*)(ws + WS_Z); const u16* kcmp = (const u16*)(ws + WS_KCMP); const u16* vcmp = kcmp + (size_t)16 * 256 * 128;
    att::Epi E{(const float*)(ws + WS_GATES), (u16*)(ws + WS_OC), nullptr, nullptr, (float*)(ws + WS_IMP), nullptr};
#ifndef NSA1_PASSES
#define NSA1_PASSES 7
#endif
#ifndef WIN_SK
#define WIN_SK false
#endif
    const unsigned char* z8 = ws + WS_Z8; const unsigned char* kcmp8 = ws + WS_KCMP8;
    if (NSA1_PASSES & 1) att::run_pass<att::M_CMP, att::E_GATED, 0, 128, 128, false, false, GQ_CV>(z, z8, kcmp8, vcmp, (size_t)256 * 128, (char*)lds, E, tid, G);
    __syncthreads();
    if (NSA1_PASSES & 2) att::run_pass<att::M_CMP, att::E_IMP, 0, 128, 128, false, false, GQ_CI>(z, z8, kcmp8, (const u16*)(ws + WS_OVL), 0, (char*)lds, E, tid, G);
    __syncthreads();
    E.dst = (u16*)(ws + WS_OW);
    if (NSA1_PASSES & 4) att::run_pass<att::M_WIN, att::E_GATED, 2, NPAD, 3072, WIN_SK, false, GQ_W>(z, z8, kcmp8, nullptr, 0, (char*)lds, E, tid, G);
}
DEVI void phase_topk(KP a, int lane, int wave, int G) {
    unsigned char* ws = a->ws; const float* imp = (const float*)(ws + WS_IMP); unsigned long long* sel = (unsigned long long*)(ws + WS_SEL);
    const int gw = blockIdx.x * 8 + wave, NGW = G * 8;
    float pf0[4], pf1[4];
    { const int task = gw * 2; if (task < M_ * 4) { const int bg = task >> 12, t = task & 4095, b = bg >> 2, g = bg & 3;
#pragma unroll
        for (int h = 0; h < 4; ++h) { const float* p = imp + ((size_t)(b * 16 + g * 4 + h) * 4096 + t) * 64 + lane; pf0[h] = p[0]; pf1[h] = p[64]; } } }
    for (int task = gw * 2; task < M_ * 4; task += NGW * 2) { const int bg = task >> 12, t = task & 4095;
        const float v0 = (pf0[0] + pf0[1]) + (pf0[2] + pf0[3]), v1 = (pf1[0] + pf1[1]) + (pf1[2] + pf1[3]);
        { const int tn = task + NGW * 2; if (tn < M_ * 4) { const int bgn = tn >> 12, t2 = tn & 4095, b = bgn >> 2, g = bgn & 3;
#pragma unroll
            for (int h = 0; h < 4; ++h) { const float* p = imp + ((size_t)(b * 16 + g * 4 + h) * 4096 + t2) * 64 + lane; pf0[h] = p[0]; pf1[h] = p[64]; } } }
        const int cur0 = t >> 6, cur1 = (t + 1) >> 6;
        const float s0 = ((lane == 0) || (lane == cur0) || (lane == cur0 - 1)) ? INFINITY : (lane <= cur0 ? v0 : -INFINITY);
        const float s1 = ((lane == 0) || (lane == cur1) || (lane == cur1 - 1)) ? INFINITY : (lane <= cur1 ? v1 : -INFINITY);
        int r0 = 0, r1 = 0;
#pragma unroll
        for (int jj = 0; jj < 64; ++jj) { const float a0 = __int_as_float(__builtin_amdgcn_readlane(__float_as_int(s0), jj)), a1 = __int_as_float(__builtin_amdgcn_readlane(__float_as_int(s1), jj));
            r0 += (a0 > s0 || (a0 == s0 && jj < lane)) ? 1 : 0; r1 += (a1 > s1 || (a1 == s1 && jj < lane)) ? 1 : 0; }
        const unsigned long long m0 = __ballot(r0 < 16 && lane <= cur0), m1 = __ballot(r1 < 16 && lane <= cur1);
        if (lane == 0) { sel[(size_t)bg * 4096 + t] = m0; sel[(size_t)bg * 4096 + t + 1] = m1; } }
}
DEVI void phase_nsa2(KP a, unsigned char* lds, const int tid, int G) {
    unsigned char* ws = a->ws;
    const u16* z = (const u16*)(ws + WS_Z);
    att::Epi E{(const float*)(ws + WS_GATES), (u16*)(ws + WS_O), (const u16*)(ws + WS_OC), (const u16*)(ws + WS_OW), nullptr, (const unsigned long long*)(ws + WS_SEL)};
    att::run_pass<att::M_SEL, att::E_FINAL, 1, NPAD, 3072, false, true, GQ_S>(z, ws + WS_Z8, nullptr, nullptr, 0, (char*)lds, E, tid, G);
}

typedef float f32x4_t __attribute__((ext_vector_type(4)));
DEVI void phase_ln1_router(KP a, unsigned char* lds, int tid, int lane, int wave, int G, int l) {
    unsigned char* ws = a->ws;
    const u16* pre = (const u16*)(ws + WS_H); u16* xa = (u16*)(ws + WS_XA); unsigned char* xb = ws + WS_XBF;
    const float* g1 = a->in[17] + l * D_; const float* b1 = a->in[18] + l * D_; const float* rb = a->in[20]; const float* wT = (const float*)(ws + WS_RWT);
    int* tokinfo = (int*)(ws + WS_MISC); int* hist = (int*)(ws + WS_MISC + 1280 * 1024);
    int* be = (int*)lds;
    float* lg = (float*)(lds + 1024);
    const int g4 = lane >> 4, l15 = lane & 15;
    for (int chunk = blockIdx.x; chunk < 256; chunk += G) {
      f32x4 gq[4][2], bq[4][2];
#pragma unroll
      for (int j = 0; j < 4; ++j)
#pragma unroll
          for (int hh = 0; hh < 2; ++hh) { gq[j][hh] = *(const f32x4*)(g1 + j * 512 + lane * 8 + 4 * hh); bq[j][hh] = *(const f32x4*)(b1 + j * 512 + lane * 8 + 4 * hh); }
      u32x4 pc[4], pn[4];
#pragma unroll
      for (int j = 0; j < 4; ++j) pc[j] = *(const u32x4*)(pre + (size_t)(chunk * 64 + wave * 8) * D_ + j * 512 + lane * 8);
      for (int rr = 0; rr < 8; ++rr) {
        const int row = chunk * 64 + wave * 8 + rr;
        if (rr < 7) {
#pragma unroll
            for (int j = 0; j < 4; ++j) pn[j] = *(const u32x4*)(pre + (size_t)(row + 1) * D_ + j * 512 + lane * 8); }
        float v[4][8]; float s = 0.f;
#pragma unroll
        for (int j = 0; j < 4; ++j) { unpack8(pc[j], v[j]); s += ((v[j][0] + v[j][1]) + (v[j][2] + v[j][3])) + ((v[j][4] + v[j][5]) + (v[j][6] + v[j][7])); }
        const float mean = wsum(s) * (1.f / D_); float q = 0.f;
#pragma unroll
        for (int j = 0; j < 4; ++j)
#pragma unroll
            for (int e = 0; e < 8; ++e) { v[j][e] -= mean; q += v[j][e] * v[j][e]; }
        const float rstd = 1.f / sqrtf(wsum(q) * (1.f / D_) + LN_EPS);
#pragma unroll
        for (int j = 0; j < 4; ++j) { const int c0 = j * 512 + lane * 8; float y[8];
#pragma unroll
            for (int e = 0; e < 8; ++e) y[e] = v[j][e] * rstd * gq[j][e >> 2][e & 3] + bq[j][e >> 2][e & 3];
            u32x4 wx; wx.x = pk2(y[0], y[1]); wx.y = pk2(y[2], y[3]); wx.z = pk2(y[4], y[5]); wx.w = pk2(y[6], y[7]); *(u32x4*)(xa + (size_t)row * D_ + c0) = wx;
            u32x2 w8; w8.x = pk4_fp8(y[0], y[1], y[2], y[3]); w8.y = pk4_fp8(y[4], y[5], y[6], y[7]); *(u32x2*)(xb + (size_t)row * D_ + c0) = w8; }
#pragma unroll
        for (int j = 0; j < 4; ++j) pc[j] = pn[j];
      }
      asm volatile("s_waitcnt vmcnt(0)" ::: "memory"); __syncthreads();
      {
          f32x4 racc[4][2];
#pragma unroll
          for (int rt = 0; rt < 4; ++rt) { racc[rt][0] = (f32x4){0.f, 0.f, 0.f, 0.f}; racc[rt][1] = (f32x4){0.f, 0.f, 0.f, 0.f}; }
          const u16* ap = xa + (size_t)(chunk * 64 + l15) * D_ + wave * 256 + 8 * g4; const float* bp = wT + (size_t)l15 * D_ + wave * 256 + 8 * g4;
#pragma unroll 2
          for (int blk = 0; blk < 8; ++blk) { u32x4 ar[4]; f32x4 br[2][2];
#pragma unroll
              for (int rt = 0; rt < 4; ++rt) ar[rt] = *(const u32x4*)(ap + (size_t)rt * 16 * D_ + 32 * blk);
#pragma unroll
              for (int et = 0; et < 2; ++et) { br[et][0] = *(const f32x4*)(bp + (size_t)et * 16 * D_ + 32 * blk); br[et][1] = *(const f32x4*)(bp + (size_t)et * 16 * D_ + 32 * blk + 4); }
#pragma unroll
              for (int rt = 0; rt < 4; ++rt) { float af[8]; unpack8(ar[rt], af);
#pragma unroll
                  for (int e = 0; e < 8; ++e) { racc[rt][0] = __builtin_amdgcn_mfma_f32_16x16x4f32(af[e], br[0][e >> 2][e & 3], racc[rt][0], 0, 0, 0); racc[rt][1] = __builtin_amdgcn_mfma_f32_16x16x4f32(af[e], br[1][e >> 2][e & 3], racc[rt][1], 0, 0, 0); } } }
          f32x4* part = (f32x4*)(lds + 16384);
#pragma unroll
          for (int rt = 0; rt < 4; ++rt) { part[(wave * 8 + rt * 2) * 64 + lane] = racc[rt][0]; part[(wave * 8 + rt * 2 + 1) * 64 + lane] = racc[rt][1]; }
          __syncthreads();
          { f32x4 v = part[wave * 64 + lane];
#pragma unroll
            for (int w2 = 1; w2 < 8; ++w2) v = v + part[(w2 * 8 + wave) * 64 + lane];
#pragma unroll
            for (int j = 0; j < 4; ++j) lg[((wave >> 1) * 16 + 4 * g4 + j) * 33 + (wave & 1) * 16 + l15] = v[j]; }
      }
      __syncthreads();
      if (tid < 64) { const int row = chunk * 64 + tid;
        float aff[32], sel[32];
#pragma unroll
        for (int e = 0; e < 32; ++e) { aff[e] = sigm(lg[tid * 33 + e]); sel[e] = aff[e] + rb[e]; }
        int bg_ = 0; float bs = -INFINITY;
#pragma unroll
        for (int gq = 0; gq < 8; ++gq) { const float s0 = sel[gq * 4], s1 = sel[gq * 4 + 1], s2 = sel[gq * 4 + 2], s3 = sel[gq * 4 + 3];
            const float mx = fmaxf(fmaxf(s0, s1), fmaxf(s2, s3));
            const float m2 = fmaxf(fmaxf(fminf(s0, s1), fminf(s2, s3)), fminf(fmaxf(s0, s1), fmaxf(s2, s3)));
            const float gs = mx + m2; if (gs > bs) { bs = gs; bg_ = gq; } }
        float c0 = 0.f, c1 = 0.f, c2 = 0.f, c3 = 0.f, a0 = 0.f, a1 = 0.f, a2 = 0.f, a3 = 0.f;
#pragma unroll
        for (int gq = 0; gq < 8; ++gq) if (gq == bg_) { c0 = sel[gq * 4]; c1 = sel[gq * 4 + 1]; c2 = sel[gq * 4 + 2]; c3 = sel[gq * 4 + 3]; a0 = aff[gq * 4]; a1 = aff[gq * 4 + 1]; a2 = aff[gq * 4 + 2]; a3 = aff[gq * 4 + 3]; }
        int i1 = 0; float m1 = c0;
        if (c1 > m1) { m1 = c1; i1 = 1; } if (c2 > m1) { m1 = c2; i1 = 2; } if (c3 > m1) { m1 = c3; i1 = 3; }
        int i2 = -1; float m2v = -INFINITY;
        if (i1 != 0 && c0 > m2v) { m2v = c0; i2 = 0; } if (i1 != 1 && c1 > m2v) { m2v = c1; i2 = 1; } if (i1 != 2 && c2 > m2v) { m2v = c2; i2 = 2; } if (i1 != 3 && c3 > m2v) { m2v = c3; i2 = 3; }
        if (i2 < 0) i2 = (i1 == 0) ? 1 : 0;
        float w1 = i1 == 0 ? a0 : i1 == 1 ? a1 : i1 == 2 ? a2 : a3, w2 = i2 == 0 ? a0 : i2 == 1 ? a1 : i2 == 2 ? a2 : a3;
        const float ws_ = w1 + w2; w1 /= ws_; w2 /= ws_;
        const int e1 = bg_ * 4 + i1, e2 = bg_ * 4 + i2;
        int* ti = tokinfo + (size_t)row * 8; ti[0] = e1; ti[2] = e2; ti[4] = __float_as_int(w1); ti[5] = __float_as_int(w2);
        int r1 = 0, r2 = 0, myh = 0;
        const unsigned long long lt = (1ull << lane) - 1ull;
        for (int e = 0; e < 32; ++e) { const unsigned long long mm1 = __ballot(e1 == e), mm2 = __ballot(e2 == e);
            const int below = __popcll(mm1 & lt) + __popcll(mm2 & lt);
            if (e1 == e) r1 = below; if (e2 == e) r2 = below; if (lane == e) myh = __popcll(mm1) + __popcll(mm2); }
        ti[1] = r1; ti[3] = r2;
        if (lane < 32) hist[chunk * 32 + lane] = myh; }
      __syncthreads();
    }
    (void)be;
}
DEVI int moe_base(const unsigned* cnt, int lane, int& base_out) {
    const unsigned c = cnt[lane & 31]; const int tiles = (int)((c + 255u) >> 8); int incl = tiles;
#pragma unroll
    for (int o = 1; o < 32; o <<= 1) { const int t_ = __shfl_up(incl, o); if ((lane & 31) >= o) incl += t_; }
    base_out = (incl - tiles) * 256; return __shfl(incl, 31);
}
DEVI void phase_moe_gather(KP a, unsigned char* lds, int tid, int lane, int wave, int G, int l) {
    unsigned char* ws = a->ws;
    unsigned* cnt = (unsigned*)(ws + WS_CTL) + CW_CNT + l * 32; int* tokinfo = (int*)(ws + WS_MISC); const int* hist = (const int*)(ws + WS_MISC + 1280 * 1024);
    const unsigned char* xb = ws + WS_XBF; unsigned char* xg = ws + WS_XG; float* roww = (float*)(ws + WS_MISC + 1 * MiB);
    int* so = (int*)lds;
    for (int chunk = blockIdx.x; chunk < 256; chunk += G) {
        if (tid < 64) so[tid] = 0;
        __syncthreads();
        { const int e = tid & 31, seg = tid >> 5; int below = 0, all = 0;
          for (int b2 = seg * 16; b2 < seg * 16 + 16; ++b2) { const int h = hist[b2 * 32 + e]; all += h; if (b2 < chunk) below += h; }
          atomicAdd(&so[e], below); atomicAdd(&so[32 + e], all); }
        __syncthreads();
        if (wave == 0) { const int c = so[32 + (lane & 31)]; const int tiles = (c + 255) >> 8; int incl = tiles;
#pragma unroll
            for (int o = 1; o < 32; o <<= 1) { const int t_ = __shfl_up(incl, o); if ((lane & 31) >= o) incl += t_; }
            if (lane < 32) { so[64 + lane] = (incl - tiles) * 256; if (chunk == 0) cnt[lane] = (unsigned)c; } }
        __syncthreads();
        for (int r0 = 0; r0 < 8; r0 += 4) { u32x4 cp[4][2]; int sl0[4], sl1[4];
#pragma unroll
            for (int q = 0; q < 4; ++q) { const int row = chunk * 64 + wave * 8 + r0 + q; const int* ti = tokinfo + (size_t)row * 8;
                const int e0 = ti[0], rk0 = ti[1], e1 = ti[2], rk1 = ti[3]; sl0[q] = so[64 + e0] + so[e0] + rk0; sl1[q] = so[64 + e1] + so[e1] + rk1;
                const u32x4* src = (const u32x4*)(xb + (size_t)row * D_); cp[q][0] = src[lane]; cp[q][1] = src[64 + lane]; }
#pragma unroll
            for (int q = 0; q < 4; ++q) { const int row = chunk * 64 + wave * 8 + r0 + q; int* ti = tokinfo + (size_t)row * 8;
                u32x4* d0 = (u32x4*)(xg + (size_t)sl0[q] * D_); u32x4* d1 = (u32x4*)(xg + (size_t)sl1[q] * D_);
                d0[lane] = cp[q][0]; d0[64 + lane] = cp[q][1]; d1[lane] = cp[q][0]; d1[64 + lane] = cp[q][1];
                if (lane == 0) { roww[sl0[q]] = __int_as_float(ti[4]); roww[sl1[q]] = __int_as_float(ti[5]); ti[6] = sl0[q]; ti[7] = sl1[q]; } } }
        __syncthreads();
    }
}
DEVI void phase_ln2(KP a, int lane, int wave, int G, int l) {
    unsigned char* ws = a->ws;
    const int* tokinfo = (const int*)(ws + WS_MISC);
    const u16* xa = (const u16*)(ws + WS_XA); const u16* Y = (const u16*)(ws + WS_Y); unsigned char* x8 = ws + WS_X8;
    float* xo = a->out; u16* xoh = (u16*)(ws + WS_XB);
    const float* g2 = a->in[24] + l * D_; const float* b2 = a->in[25] + l * D_;
    const int gw = blockIdx.x * 8 + wave, NGW = G * 8;
    int row = gw; if (row >= M_) return;
    f32x4 gq[4][2], bq[4][2];
#pragma unroll
    for (int j = 0; j < 4; ++j)
#pragma unroll
        for (int hh = 0; hh < 2; ++hh) { gq[j][hh] = *(const f32x4*)(g2 + j * 512 + lane * 8 + 4 * hh); bq[j][hh] = *(const f32x4*)(b2 + j * 512 + lane * 8 + 4 * hh); }
    u32x4 cx[4], c1[4], c2[4], nx[4], n1[4], n2[4];
    int s1 = tokinfo[(size_t)row * 8 + 6], s2 = tokinfo[(size_t)row * 8 + 7];
#pragma unroll
    for (int j = 0; j < 4; ++j) { const int c0 = j * 512 + lane * 8; cx[j] = *(const u32x4*)(xa + (size_t)row * D_ + c0); c1[j] = *(const u32x4*)(Y + (size_t)s1 * D_ + c0); c2[j] = *(const u32x4*)(Y + (size_t)s2 * D_ + c0); }
    int rn = row + NGW, t1 = 0, t2 = 0;
    if (rn < M_) { t1 = tokinfo[(size_t)rn * 8 + 6]; t2 = tokinfo[(size_t)rn * 8 + 7]; }
    for (;;) {
        const bool more = rn < M_;
        if (more) {
#pragma unroll
            for (int j = 0; j < 4; ++j) { const int c0 = j * 512 + lane * 8; nx[j] = *(const u32x4*)(xa + (size_t)rn * D_ + c0); n1[j] = *(const u32x4*)(Y + (size_t)t1 * D_ + c0); n2[j] = *(const u32x4*)(Y + (size_t)t2 * D_ + c0); } }
        const int rnn = rn + NGW; int u1 = 0, u2 = 0;
        if (rnn < M_) { u1 = tokinfo[(size_t)rnn * 8 + 6]; u2 = tokinfo[(size_t)rnn * 8 + 7]; }
        float v[4][8]; float s = 0.f;
#pragma unroll
        for (int j = 0; j < 4; ++j) { float xv[8], y1[8], y2[8]; unpack8(cx[j], xv); unpack8(c1[j], y1); unpack8(c2[j], y2);
#pragma unroll
            for (int e = 0; e < 8; ++e) { v[j][e] = xv[e] * ALPHA + (y1[e] + y2[e]); }
            s += ((v[j][0] + v[j][1]) + (v[j][2] + v[j][3])) + ((v[j][4] + v[j][5]) + (v[j][6] + v[j][7])); }
        const float mean = wsum(s) * (1.f / D_); float q = 0.f;
#pragma unroll
        for (int j = 0; j < 4; ++j)
#pragma unroll
            for (int e = 0; e < 8; ++e) { v[j][e] -= mean; q += v[j][e] * v[j][e]; }
        const float rstd = 1.f / sqrtf(wsum(q) * (1.f / D_) + LN_EPS);
#pragma unroll
        for (int j = 0; j < 4; ++j) { const int c0 = j * 512 + lane * 8; float y[8];
#pragma unroll
            for (int e = 0; e < 8; ++e) y[e] = v[j][e] * rstd * gq[j][e >> 2][e & 3] + bq[j][e >> 2][e & 3];
            if (l == 0) { u32x4 wo; wo.x = pk2(y[0], y[1]); wo.y = pk2(y[2], y[3]); wo.z = pk2(y[4], y[5]); wo.w = pk2(y[6], y[7]); *(u32x4*)(xoh + (size_t)row * D_ + c0) = wo;
                u32x2 w8; w8.x = pk4_fp8(y[0], y[1], y[2], y[3]); w8.y = pk4_fp8(y[4], y[5], y[6], y[7]); *(u32x2*)(x8 + (size_t)row * D_ + c0) = w8; }
            else { *(f32x4*)(xo + (size_t)row * D_ + c0) = (f32x4){y[0], y[1], y[2], y[3]}; *(f32x4*)(xo + (size_t)row * D_ + c0 + 4) = (f32x4){y[4], y[5], y[6], y[7]}; } }
        if (!more) break;
        row = rn; rn = rnn; t1 = u1; t2 = u2;
#pragma unroll
        for (int j = 0; j < 4; ++j) { cx[j] = nx[j]; c1[j] = n1[j]; c2[j] = n2[j]; }
    }
}

constexpr int NGEMM = 15360;
DEVI void phase_gates(KP a, unsigned char* lds, int tid, int G, int l) {
    using pg8::i32x8_; using pg8::i32x4_;
    unsigned char* ws = a->ws;
    const unsigned char* X = ws + WS_X8; const unsigned char* W = ws + WS_WIN + (size_t)l * NPAD * D_ + (size_t)NGEMM * D_;
    const float* bias = (const float*)(ws + WS_BIASP) + l * NPAD + NGEMM; float* gates = (float*)(ws + WS_GATES);
    const int lane = tid & 63, wave = tid >> 6, g4 = lane >> 4, l15 = lane & 15;
    f32x4* red = (f32x4*)lds;
    float* gl = (float*)(lds + 131072);
    const int sclW = 0x79797979, sclA = 0x7f7f7f7f;
    for (int unit = blockIdx.x; unit < M_ / 64; unit += G) {
        const unsigned char* ap = X + (size_t)(unit * 64 + l15) * D_ + wave * 256 + 32 * g4;
        const unsigned char* bp = W + (size_t)l15 * D_ + wave * 256 + 32 * g4;
        i32x8_ af[4][2], bf[4][2];
#pragma unroll
        for (int t = 0; t < 4; ++t)
#pragma unroll
            for (int ks = 0; ks < 2; ++ks) {
                af[t][ks] = __builtin_shufflevector(*(const i32x4_*)(ap + (size_t)t * 16 * D_ + 128 * ks), *(const i32x4_*)(ap + (size_t)t * 16 * D_ + 128 * ks + 16), 0, 1, 2, 3, 4, 5, 6, 7);
                bf[t][ks] = __builtin_shufflevector(*(const i32x4_*)(bp + (size_t)t * 16 * D_ + 128 * ks), *(const i32x4_*)(bp + (size_t)t * 16 * D_ + 128 * ks + 16), 0, 1, 2, 3, 4, 5, 6, 7); }
        f32x4 acc[4][4];
#pragma unroll
        for (int rt = 0; rt < 4; ++rt)
#pragma unroll
            for (int ct = 0; ct < 4; ++ct) acc[rt][ct] = (f32x4){0.f, 0.f, 0.f, 0.f};
#pragma unroll
        for (int ks = 0; ks < 2; ++ks)
#pragma unroll
            for (int rt = 0; rt < 4; ++rt)
#pragma unroll
                for (int ct = 0; ct < 4; ++ct) asm volatile("v_mfma_scale_f32_16x16x128_f8f6f4 %0, %1, %2, %0, %3, %4 op_sel_hi:[0,0,0]" : "+v"(acc[rt][ct]) : "v"(bf[ct][ks]), "v"(af[rt][ks]), "v"(sclW), "v"(sclA));
        asm volatile("s_nop 15\n\ts_nop 15\n\ts_nop 15\n\ts_nop 15" ::: "memory");
#pragma unroll
        for (int rt = 0; rt < 4; ++rt)
#pragma unroll
            for (int ct = 0; ct < 4; ++ct) red[(wave * 16 + rt * 4 + ct) * 64 + lane] = acc[rt][ct];
        __syncthreads();
#pragma unroll
        for (int q = 0; q < 2; ++q) { const int tile = 2 * wave + q, rt = tile >> 2, ct = tile & 3, row = unit * 64 + rt * 16 + l15, col = ct * 16 + 4 * g4;
            f32x4 v = red[tile * 64 + lane];
#pragma unroll
            for (int w = 1; w < 8; ++w) v = v + red[(w * 16 + tile) * 64 + lane];
            if (col < 56) { const f32x4 gv_ = v + *(const f32x4*)(bias + col); *(f32x4*)(gates + (size_t)row * 64 + col) = gv_;
                if (col < 8) *(f32x4*)(gl + (rt * 16 + l15) * 8 + col) = gv_; } }
        __syncthreads();
        if (wave < 4) {
            const float ig = gl[lane * 8 + wave], fg = gl[lane * 8 + 4 + wave];
            float bc = fminf(fg, 0.f) - log1pf(__expf(-fabsf(fg)));
#pragma unroll
            for (int o = 1; o < 64; o <<= 1) { const float t_ = __shfl_up(bc, o); if (lane >= o) bc += t_; }
            const float L_ = wmax(ig - bc), S_ = __shfl(bc, 63);
            if (lane == 0) { float* ch = (float*)(ws + WS_CHS) + ((size_t)unit * 4 + wave) * 2; ch[0] = S_; ch[1] = L_; } }
        __syncthreads();
    }
}
__global__ void __launch_bounds__(512, 2) fwd_kernel(Args args) {
    extern __shared__ __attribute__((aligned(16))) unsigned char lds_raw[];
    LAS unsigned char* ldsl = (LAS unsigned char*)lds_raw;
    unsigned char* lds = lds_raw;
    const int G = gridDim.x;
    const int wave_sg = __builtin_amdgcn_readfirstlane(threadIdx.x >> 6);
    unsigned char* ws = args.ws;
    volatile LAS unsigned* lctl = (volatile LAS unsigned*)(ldsl + LDSCTL_OFF);
    if (wave_sg == 0) { const int l_ = (int)__builtin_amdgcn_mbcnt_hi(~0u, __builtin_amdgcn_mbcnt_lo(~0u, 0u)); for (int u = l_; u < 256; u += 64) lctl[u] = 0u; }
    __syncthreads();
    const int lo = args.ph_lo, hi = args.ph_hi;
    const bool one = (hi - lo) > 1;
    XcdBarrier bar; bar.bar = (unsigned*)(ws + WS_CTL) + CW_BAR; bar.x = 0; bar.st = lctl; bar.wv = wave_sg;
    if (one) bar = xcd_barrier_post((unsigned*)(ws + WS_CTL) + CW_BAR, lctl, wave_sg);
#ifndef ONLY_PHASE
#define ONLY_PHASE -1
#endif
#define LAUNDER() int wv_ = wave_sg; asm volatile("" : "+s"(wv_)); int tz_ = wv_ * 64 + (int)__builtin_amdgcn_mbcnt_hi(~0u, __builtin_amdgcn_mbcnt_lo(~0u, 0u)); asm volatile("" : "+v"(tz_)); const int tid = tz_, lane = tz_ & 63, wave = wv_; (void)tid; (void)lane; (void)wave; \
    unsigned long long kp_ = (unsigned long long)__builtin_amdgcn_kernarg_segment_ptr(); asm volatile("" : "+s"(kp_)); \
    const KP la = (KP)kp_; unsigned char* const ws = la->ws; (void)ws
#define INR(k) (lo <= (k) && (k) < hi)
#define IN0 ((ONLY_PHASE < 0 || ONLY_PHASE == 0) && INR(0))
#define INL(j) ((ONLY_PHASE < 0 || ONLY_PHASE == 1 + (j)) && INR(pb + (j)))
#define SEAM(k) do { if (INR(k) && INR((k) + 1)) xcd_barrier(bar); else __syncthreads(); } while (0)

    if (IN0) { LAUNDER(); phase_prologue(la, lds, tid, lane, wave, G); phase_experts(la, lds, lane, wave, G, 0); SEAM(0); }

    for (int l = 0; l < 2; ++l) {
        const int pb = 1 + l * PPL;
        if (INL(0)) { LAUNDER();
            pg8::Gemm g{(const u16*)(ws + WS_X8), (const u16*)(ws + WS_WIN + (size_t)l * NPAD * D_), D_ / 2, D_ / 2, 0x79797979, 0x7f7f7f7f};
            pg8::StaticOrder S; S.init(M_, NGEMM, G, (int)blockIdx.x);
            EpiInProj E{(u16*)(ws + WS_Z), (const float*)(ws + WS_BIASP) + l * NPAD, (float*)(ws + WS_GATES), (u16*)(ws + WS_KC), (const float*)(ws + WS_ROPE), (const float*)(ws + WS_ROPE) + 4096 * 64, ws + WS_Z8};
            pg8::gemm_phase<EpiInProj, pg8::StaticOrder, true>(ldsl, g, S, E, tid);
            __syncthreads();
            phase_gates(la, lds, tid, G, l);
            SEAM(pb + 0);
        }
        if (INL(1)) { LAUNDER();
            pg8::Gemm g{(const u16*)(ws + WS_KC), (const u16*)(ws + WS_CW1 + (size_t)l * 512 * 2048), 1024, 1024, 0x79797979, 0x7f7f7f7f};
            CmpOrder S{G, (int)blockIdx.x};
            EpiF32Tile E{(float*)(ws + WS_U), 256};
            pg8::gemm_phase<EpiF32Tile, CmpOrder, true>(ldsl, g, S, E, tid);
            phase_mlstm_pre(la, lds, tid, G, G >= 64 ? 32 : 0);
            SEAM(pb + 1);
        }
        if (INL(2)) { LAUNDER(); phase_mlstm(la, lds, tid, G); phase_cmp2(la, lds, tid, G, l); SEAM(pb + 2); }
        if (INL(3)) { LAUNDER(); phase_nsa1(la, lds, tid, G); phase_norm(la, lane, wave, G, l); SEAM(pb + 3); }
        if (INL(4)) { LAUNDER(); phase_topk(la, lane, wave, G); SEAM(pb + 4); }
        if (INL(5)) { LAUNDER(); phase_nsa2(la, lds, tid, G); __syncthreads();
            {
            pg8::Gemm g{(const u16*)(ws + WS_XBF), (const u16*)(ws + WS_WB) + (size_t)(l * 3 + 0) * D_ * D_, D_ / 2, D_ / 2, 0x79797979, 0x7e7e7e7e};
            pg8::StaticOrder S; S.init(M_, D_, G, (int)blockIdx.x);
            EpiGate<false> E{(u16*)(ws + WS_MRG), (const u16*)(ws + WS_Z), C_GM};
            pg8::gemm_phase<EpiGate<false>, pg8::StaticOrder, true>(ldsl, g, S, E, tid);
            }
            SEAM(pb + 5);
        }
        if (INL(6)) { LAUNDER();
            pg8::Gemm g{(const u16*)(ws + WS_O), (const u16*)(ws + WS_WB) + (size_t)(l * 3 + 1) * D_ * D_, D_ / 2, D_ / 2, 0x79797979, 0x7c7c7c7c};
            pg8::StaticOrder S; S.init(M_, D_, G, (int)blockIdx.x);
            EpiGate<true> E{(u16*)(ws + WS_MRG), (const u16*)(ws + WS_Z), C_GM + 2048};
            pg8::gemm_phase<EpiGate<true>, pg8::StaticOrder, true>(ldsl, g, S, E, tid);
            SEAM(pb + 6);
        }
        if (INL(7)) { LAUNDER();
            pg8::Gemm g{(const u16*)(ws + WS_MRG), (const u16*)(ws + WS_WB) + (size_t)(l * 3 + 2) * D_ * D_, D_, D_};
            pg8::StaticOrder S; S.init(M_, D_, G, (int)blockIdx.x);
            EpiResid E{(u16*)(ws + WS_H), la->in[0], l == 0 ? (const u16*)nullptr : (const u16*)(ws + WS_XB)};
            pg8::gemm_phase(ldsl, g, S, E, tid);
            SEAM(pb + 7);
        }
        if (INL(8)) { LAUNDER(); phase_ln1_router(la, lds, tid, lane, wave, G, l); SEAM(pb + 8); }
        if (INL(9)) { LAUNDER(); phase_moe_gather(la, lds, tid, lane, wave, G, l); SEAM(pb + 9); }
        if (INL(10) || INL(11)) { LAUNDER();
            const unsigned* cnt = (const unsigned*)(ws + WS_CTL) + CW_CNT + l * 32;
            volatile LAS int* tstart = (volatile LAS int*)(lctl + 16);
            if (wave == 0) { int mybase; const int nt_ = moe_base(cnt, lane, mybase); if (lane < 32) tstart[lane] = mybase >> 8; if (lane == 32) tstart[32] = nt_; }
            __syncthreads();
            const int ntiles = tstart[32];
            if (INL(10)) { LAUNDER();
                pg8::Gemm g{(const u16*)(ws + WS_XG), (const u16*)(ws + WS_W13), D_ / 2, D_ / 2, 0x79797979, 0x7f7f7f7f};
                MoeOrder S{G, (int)blockIdx.x, ntiles, tstart};
                EpiSwiGLU E{ws + WS_HB};
                pg8::gemm_phase<EpiSwiGLU, MoeOrder, true>(ldsl, g, S, E, tid);
                SEAM(pb + 10);
            }
            if (INL(11)) { LAUNDER();
                pg8::Gemm g{(const u16*)(ws + WS_HB), (const u16*)(ws + WS_W2), DFF / 2, DFF / 2, 0x79797979, 0x7f7f7f7f};
                MoeOrder S{G, (int)blockIdx.x, ntiles, tstart};
                EpiScaleRow E{(u16*)(ws + WS_Y), (const float*)(ws + WS_MISC + 1 * MiB)};
                pg8::gemm_phase<EpiScaleRow, MoeOrder, true>(ldsl, g, S, E, tid);
                SEAM(pb + 11);
            }
        }
        if (INL(12)) { LAUNDER(); phase_ln2(la, lane, wave, G, l); if (l == 0) phase_experts(la, lds, lane, wave, G, 1); SEAM(pb + 12); }
    }
#undef INR
#undef IN0
#undef INL
#undef SEAM
}

extern "C" void kernel_launch(void* const* d_in, const int* in_sizes, int n_in, void* d_out, int out_size, void* d_ws, size_t ws_size, hipStream_t stream) {
    static int grid = 0;
    if (grid == 0) {
        if (n_in != 26 || out_size != M_ * D_ || ws_size < WS_END5) { fprintf(stderr, "kernel_launch: unexpected problem (n_in %d out %d ws %zu need %zu)\n", n_in, out_size, ws_size, (size_t)WS_END); grid = -1; return; }
        int dev = 0, cus = 0;
        if (hipGetDevice(&dev) != hipSuccess || hipDeviceGetAttribute(&cus, hipDeviceAttributeMultiprocessorCount, dev) != hipSuccess) { grid = -1; return; }
        if (hipFuncSetAttribute((const void*)fwd_kernel, hipFuncAttributeMaxDynamicSharedMemorySize, LDS_BYTES) != hipSuccess) { fprintf(stderr, "kernel_launch: hipFuncSetAttribute failed\n"); grid = -1; return; }
        int per_cu = 0;
        if (hipOccupancyMaxActiveBlocksPerMultiprocessor(&per_cu, (const void*)fwd_kernel, 512, LDS_BYTES) != hipSuccess || per_cu < 1) fprintf(stderr, "kernel_launch: occupancy query reports %d\n", per_cu);
        (void)hipGetLastError();
        grid = cus;
    }
    if (grid < 0) return;
    (void)hipMemsetAsync((char*)d_ws + WS_CTL, 0, CTL_BYTES, stream);
    Args a{};
    for (int i = 0; i < 26; ++i) a.in[i] = (const float*)d_in[i];
    a.out = (float*)d_out; a.ws = (unsigned char*)d_ws;
#if MK_ONE_LAUNCH
    a.ph_lo = 0; a.ph_hi = NPH;
    hipLaunchKernelGGL(fwd_kernel, dim3(grid), dim3(512), LDS_BYTES, stream, a);
#else
#ifdef DBG_STOP
    for (int p = 0; p < DBG_STOP; ++p) { a.ph_lo = p; a.ph_hi = p + 1; hipLaunchKernelGGL(fwd_kernel, dim3(grid), dim3(512), LDS_BYTES, stream, a); }
    (void)hipMemcpyAsync(d_out, (char*)d_ws + DBG_SRC, (size_t)M_ * D_ * 4, hipMemcpyDeviceToDevice, stream);
#else
#ifndef REP_N
#define REP_N 1
#define REP_LO 99
#define REP_HI 99
#endif
    for (int p = 0; p < NPH; ++p) {
        const int j = p == 0 ? -1 : (p - 1) % PPL;
        if (j == REP_LO) { for (int r = 0; r < REP_N; ++r) for (int q = p; q <= p + (REP_HI - REP_LO); ++q) { a.ph_lo = q; a.ph_hi = q + 1; hipLaunchKernelGGL(fwd_kernel, dim3(grid), dim3(512), LDS_BYTES, stream, a); } p += REP_HI - REP_LO; continue; }
        a.ph_lo = p; a.ph_hi = p + 1; hipLaunchKernelGGL(fwd_kernel, dim3(grid), dim3(512), LDS_BYTES, stream, a); }
#endif
#endif
}
```

```cpp
#include <hip/hip_runtime.h>
#include <cstdio>
#include <cstdint>

#ifndef MK_ONE_LAUNCH
#define MK_ONE_LAUNCH 1
#endif

#define LAS __attribute__((address_space(3)))
#define DEVI __device__ __forceinline__
typedef unsigned short u16;
typedef short bf16x8 __attribute__((ext_vector_type(8)));
typedef float f32x4 __attribute__((ext_vector_type(4)));
typedef float f32x2 __attribute__((ext_vector_type(2)));
typedef unsigned u32x4 __attribute__((ext_vector_type(4)));
typedef unsigned u32x2 __attribute__((ext_vector_type(2)));

constexpr int T_ = 4096, D_ = 2048, M_ = 16384;
constexpr int NPAD = 15616, IN_W = 15416;
constexpr int C_MQ = 0, C_MK = 1024, C_MV = 2048, C_MO = 4096, C_NQ = 6144, C_KC = 8192, C_VC = 8704, C_KS = 9216, C_VS = 9728, C_KW = 10240,
              C_VW = 10752, C_GM = 11264, C_GT = 15360;
constexpr int S_MI = 6144, S_NQ = 6152, S_KC = 8200, S_KS = 9224, S_VS = 9736, S_KW = 10248, S_VW = 10760, S_NG = 11272, S_GM = 11320;
constexpr float ALPHA = 1.4142135623730951f;
constexpr float LN_EPS = 1e-5f;
constexpr int NEXP = 32, DFF = 1024;
constexpr int MOE_ROWS = 40960;

constexpr size_t MiB = 1u << 20;
constexpr size_t WS_CTL = 0, CTL_BYTES = 1 * MiB;
constexpr size_t WS_ROPE = 1 * MiB;
constexpr size_t WS_BIASP = 3 * MiB;
constexpr size_t WS_WIN = 4 * MiB;
constexpr size_t WS_WB = 126 * MiB;
constexpr size_t WS_CW1 = 174 * MiB;
constexpr size_t WS_W13 = 178 * MiB;
constexpr size_t WS_W2 = 434 * MiB;
constexpr size_t WS_XBF = 562 * MiB;
constexpr size_t WS_XA = 626 * MiB;
constexpr size_t WS_XB = 754 * MiB;
constexpr size_t WS_Z = 882 * MiB;
constexpr size_t WS_GATES = 1370 * MiB;
constexpr size_t WS_KC = 1374 * MiB;
constexpr size_t WS_U = 1406 * MiB;
constexpr size_t WS_KCMP = 1414 * MiB;
constexpr size_t WS_MISC = 1416 * MiB;
constexpr size_t WS_CHS = WS_MISC + 1800 * 1024;
constexpr size_t WS_H = 1418 * MiB;
constexpr size_t WS_HG = 1546 * MiB;
constexpr size_t WS_O = 1610 * MiB;
constexpr size_t WS_MRG = 1674 * MiB;
constexpr size_t WS_END = 1738 * MiB, WS_END2 = 1739 * MiB;
constexpr size_t WS_OC = WS_H, WS_OW = WS_H + 64 * MiB, WS_IMP = WS_MRG, WS_OVL = WS_MISC + 1728 * 1024, WS_SEL = WS_END;
constexpr size_t WS_RWT = WS_MISC + 512 * 1024;
constexpr size_t WS_X8 = 1739 * MiB, WS_END3 = 1771 * MiB;
constexpr size_t WS_Z8 = 1771 * MiB, WS_KCMP8 = 1819 * MiB, WS_END4 = 1820 * MiB;
constexpr size_t WS_OCG = 1820 * MiB, WS_END5 = 1884 * MiB;
constexpr size_t WS_XG = WS_Z, WS_HB = WS_Z + 160 * MiB, WS_Y = WS_Z + 240 * MiB;
constexpr int CW_BAR = 4096;
constexpr int CW_CNT = 16384;
constexpr int CW_B1P = 16640;

constexpr int RING_BYTES = 131072;
constexpr int LDSCTL_OFF = 143360;
constexpr int LDS_BYTES = 147456;

DEVI float bf2f(unsigned h) { return __uint_as_float(h << 16); }
DEVI unsigned f2bf(float f) { unsigned u = __float_as_uint(f); return (u + 0x7fffu + ((u >> 16) & 1u)) >> 16; }
DEVI unsigned pk2(float lo, float hi) { unsigned r; asm("v_cvt_pk_bf16_f32 %0, %1, %2" : "=v"(r) : "v"(lo), "v"(hi)); return r; }
DEVI unsigned pk4_fp8(float a, float b, float c, float d) {
    a = __builtin_amdgcn_fmed3f(a, 448.f, -448.f); b = __builtin_amdgcn_fmed3f(b, 448.f, -448.f); c = __builtin_amdgcn_fmed3f(c, 448.f, -448.f); d = __builtin_amdgcn_fmed3f(d, 448.f, -448.f);
    int w = __builtin_amdgcn_cvt_pk_fp8_f32(a, b, 0, false); w = __builtin_amdgcn_cvt_pk_fp8_f32(c, d, w, true); return (unsigned)w; }
DEVI float sigm(float x) { return 1.f / (1.f + __expf(-x)); }
DEVI float wsum(float v) {
#pragma unroll
    for (int o = 32; o; o >>= 1) v += __shfl_xor(v, o);
    return v; }
DEVI float wmax(float v) {
#pragma unroll
    for (int o = 32; o; o >>= 1) v = fmaxf(v, __shfl_xor(v, o));
    return v; }
#define WAVE_SYNC() asm volatile("s_waitcnt lgkmcnt(0)" ::: "memory")
DEVI void unpack8(u32x4 v, float* f) {
    f[0] = __uint_as_float(v.x << 16); f[1] = __uint_as_float(v.x & 0xffff0000u); f[2] = __uint_as_float(v.y << 16); f[3] = __uint_as_float(v.y & 0xffff0000u);
    f[4] = __uint_as_float(v.z << 16); f[5] = __uint_as_float(v.z & 0xffff0000u); f[6] = __uint_as_float(v.w << 16); f[7] = __uint_as_float(v.w & 0xffff0000u); }

#define XB_TMO      128
#define XB_XCNT(j)  (256  + 64 * (j))
#define XB_XSUB(j)  (1280 + 64 * (j))
#define XB_XGEN(j)  (2304 + 64 * (j))
#define XB_TOP      3328
#define XB_TOPGEN   3392
#define XCD_BAR_WORDS 3456
#define XB_SPIN_CAP (1u << 21)
DEVI unsigned xb_ld(unsigned* p)              { return __hip_atomic_load(p, __ATOMIC_RELAXED, __HIP_MEMORY_SCOPE_AGENT); }
DEVI unsigned xb_add(unsigned* p, unsigned v) { return __hip_atomic_fetch_add(p, v, __ATOMIC_RELAXED, __HIP_MEMORY_SCOPE_AGENT); }
DEVI unsigned xb_xcc_id() { return (unsigned)__builtin_amdgcn_s_getreg((3 << 11) | 20) & 0xFu; }
#define XB_SPIN(cond, bar) do { unsigned _sp = 0; while (cond) { __builtin_amdgcn_s_sleep(1); \
    if ((++_sp & 255u) == 0u) { if (xb_ld(&(bar)[XB_TMO])) break; if (_sp > XB_SPIN_CAP) { atomicAdd(&(bar)[XB_TMO], 1u); break; } } } } while (0)
struct XcdBarrier { unsigned* bar; unsigned x; volatile LAS unsigned* st; int wv; };
DEVI bool xb_leader(int wv) { return wv == 0 && __builtin_amdgcn_mbcnt_hi(~0u, __builtin_amdgcn_mbcnt_lo(~0u, 0u)) == 0u; }
DEVI XcdBarrier xcd_barrier_post(unsigned* bar, volatile LAS unsigned* st, int wv) {
    XcdBarrier b; b.bar = bar; b.x = xb_xcc_id(); b.st = st; b.wv = wv;
    if (xb_leader(wv)) (void)xb_add(&bar[XB_XCNT(b.x)], 1u);
    return b;
}
DEVI void xcd_barrier_complete(unsigned* bar, unsigned x, unsigned& nloc, unsigned& nx) {
    const unsigned G = gridDim.x * gridDim.y * gridDim.z;
    unsigned sum, cnt, mine, sp = 0u;
    for (;;) {
        sum = 0u; cnt = 0u; mine = 0u;
#pragma unroll
        for (unsigned j = 0; j < 16; ++j) { const unsigned c = xb_ld(&bar[XB_XCNT(j)]); sum += c; cnt += (c > 0u) ? 1u : 0u; mine = (j == x) ? c : mine; }
        if (sum == G) break;
        __builtin_amdgcn_s_sleep(1);
        if ((++sp & 255u) == 0u) { if (xb_ld(&bar[XB_TMO])) break; if (sp > XB_SPIN_CAP) { atomicAdd(&bar[XB_TMO], 1u); break; } }
    }
    nloc = mine > 0u ? mine : 1u; nx = cnt > 0u ? cnt : 1u;
}
__device__ __noinline__ void xcd_barrier_impl(unsigned* bar_, unsigned x_, volatile LAS unsigned* st_, int wv_) {
    XcdBarrier b; b.bar = bar_; b.x = x_; b.st = st_; b.wv = wv_;
    asm volatile("s_waitcnt vmcnt(0)" ::: "memory");
    __syncthreads();
    if (xb_leader(b.wv)) {
        unsigned* bar = b.bar;
        __builtin_amdgcn_s_waitcnt(0);
        unsigned nloc = b.st[0], nx = b.st[1];
        if (nloc == 0u) { xcd_barrier_complete(bar, b.x, nloc, nx); b.st[0] = nloc; b.st[1] = nx; }
        const unsigned old = xb_add(&bar[XB_XSUB(b.x)], 1u);
        const unsigned gen = old / nloc;
        if (old + 1u == (gen + 1u) * nloc) {
            __builtin_amdgcn_fence(__ATOMIC_RELEASE, "agent");
            asm volatile("s_waitcnt vmcnt(0)" ::: "memory");
            const unsigned og = xb_add(&bar[XB_TOP], 1u);
            const unsigned tg = og / nx;
            if (og + 1u == (tg + 1u) * nx) xb_add(&bar[XB_TOPGEN], 1u);
            else XB_SPIN(xb_ld(&bar[XB_TOPGEN]) == tg, bar);
            __builtin_amdgcn_fence(__ATOMIC_ACQUIRE, "agent");
            xb_add(&bar[XB_XGEN(b.x)], 1u);
            asm volatile("s_waitcnt vmcnt(0)" ::: "memory");
        } else {
            XB_SPIN(xb_ld(&bar[XB_XGEN(b.x)]) == gen, bar);
            __builtin_amdgcn_fence(__ATOMIC_ACQUIRE, "agent");
            asm volatile("s_waitcnt vmcnt(0)" ::: "memory");
        }
    }
    __syncthreads();
}

DEVI void xcd_barrier(const XcdBarrier& b) { xcd_barrier_impl(b.bar, b.x, b.st, b.wv); }

namespace pg8 {
constexpr int BM = 256, BK = 64, HALF = 128, HTB = HALF * BK * 2, STAGE_BYTES = 8 * HTB, NXCD = 8, WGM = 4;
__host__ __device__ __forceinline__ int lds_byte(int r, int c) { const int st = (r >> 4) * 2 + (c >> 5), rr = r & 15, cc = c & 31, ob = rr * 64 + cc * 2; return st * 1024 + (ob ^ (((ob >> 9) & 1) << 5)); }
__host__ __device__ __forceinline__ void stage_rc(int b, int& R, int& C) { const int st = b / 1024, sb = b % 1024, swz = sb ^ (((sb >> 9) & 1) << 5); R = (st >> 1) * 16 + swz / 64; C = (st & 1) * 32 + (swz % 64) / 2; }
__host__ __device__ __forceinline__ int perm32(int rho) { const int n = rho >> 4, i = rho & 15; return 8 * (i >> 2) + 4 * n + (i & 3); }

struct Unit { int pm, pn, pb; };
struct Gemm { const u16* A; const u16* Bt; int lda, K; int sclW = 0x7f7f7f7f, sclA = 0x7f7f7f7f; };

struct StaticOrder {
    int nM, nN, nwg, G, c;
    DEVI void init(int M, int N, int G_, int c_) { nM = M / BM; nN = N / BM; nwg = nM * nN; G = G_; c = c_; }
    DEVI bool next(int i, Unit& u) const {
        const long L = (long)i * G + c; if (L >= nwg) return false;
        int wgid = (int)L; { const int q = nwg / NXCD, r = nwg % NXCD, xcd = wgid % NXCD, off = wgid / NXCD; wgid = (xcd < r ? xcd * (q + 1) : r * (q + 1) + (xcd - r) * q) + off; }
        const int nig = WGM * nN, gid = wgid / nig, fm = gid * WGM, gsz = (nM - fm) < WGM ? (nM - fm) : WGM;
        u.pm = fm + ((wgid % nig) % gsz); u.pn = (wgid % nig) / gsz; u.pb = u.pn; return true;
    }
};

typedef int i32x4_ __attribute__((ext_vector_type(4)));
typedef int i32x8_ __attribute__((ext_vector_type(8)));
template <class Epi, class Sched, bool FP8 = false>
DEVI void gemm_phase(LAS unsigned char* lds, const Gemm g, const Sched& S, const Epi& E, const int tid) {
    const int wid = __builtin_amdgcn_readfirstlane(tid >> 6), lane = tid & 63, wr = wid >> 2, wc = wid & 3, fr = lane & 15, fq = lane >> 4;
    const int K = g.K, nt = K / BK, lda = g.lda; const int sclW = g.sclW, sclA = g.sclA; (void)sclW; (void)sclA;
    unsigned voffA[2], voffB[2];
#pragma unroll
    for (int i = 0; i < 2; ++i) { int R, C; stage_rc(tid * 16 + i * 8192, R, C); const int Rb = Epi::PERM ? ((R & ~31) + perm32(R & 31)) : R;
        voffA[i] = (unsigned)(R * lda + C) * 2u; voffB[i] = (unsigned)(Rb * K + C) * 2u; }
    const size_t kstep = (size_t)(BK * 2);
    const size_t hstepA = (size_t)HALF * lda * 2, tstepA = 2 * hstepA;
    const size_t hstepB = (size_t)HALF * K * 2, tstepB = 2 * hstepB;
    const unsigned ldsw = (unsigned)wid * 1024u;
    const int aoff = lds_byte(wr * 64 + fr, fq * 8), boff = lds_byte(wc * 32 + fr, fq * 8);
#define PG8_SA(b, h) (((b) * 2 + (h)) * HTB)
#define PG8_SB(b, h) ((4 + (b) * 2 + (h)) * HTB)
#define PG8_STAGE(bufoff, gbase, voff) do { _Pragma("unroll") for (int _i = 0; _i < 2; ++_i) \
        __builtin_amdgcn_global_load_lds((const unsigned*)((const char*)(gbase) + (voff)[_i]), (LAS unsigned*)(lds + (bufoff) + ldsw + _i * 8192), 16, 0, 0); } while (0)
#define PG8_LD2(addr) __builtin_shufflevector(*(const LAS i32x4_*)(addr), *(const LAS i32x4_*)((addr) + 1024), 0, 1, 2, 3, 4, 5, 6, 7)
#define PG8_LDA(dst, b, h) do { _Pragma("unroll") for (int m = 0; m < 4; ++m) dst[m] = PG8_LD2(lds + PG8_SA(b, h) + aoff + m * 2048); } while (0)
#define PG8_LDB(dst, b, h) do { _Pragma("unroll") for (int n = 0; n < 2; ++n) dst[n] = PG8_LD2(lds + PG8_SB(b, h) + boff + n * 2048); } while (0)
#define PG8_HALF(v, k) ((k) == 0 ? (bf16x8)__builtin_shufflevector(v, v, 0, 1, 2, 3) : (bf16x8)__builtin_shufflevector(v, v, 4, 5, 6, 7))
#define PG8_MMA(ai, bj, At, Bt) do { __builtin_amdgcn_s_setprio(1); _Pragma("unroll") for (int m = 0; m < 4; ++m) _Pragma("unroll") for (int n = 0; n < 2; ++n) { \
        if constexpr (FP8) { asm volatile("v_mfma_scale_f32_16x16x128_f8f6f4 %0, %1, %2, %0, %3, %4 op_sel_hi:[0,0,0]" : "+v"(acc[ai][bj][m][n]) : "v"(Bt[n]), "v"(At[m]), "v"(sclW), "v"(sclA)); } \
        else { _Pragma("unroll") for (int k = 0; k < 2; ++k) acc[ai][bj][m][n] = __builtin_amdgcn_mfma_f32_16x16x32_bf16(PG8_HALF(Bt[n], k), PG8_HALF(At[m], k), acc[ai][bj][m][n], 0, 0, 0); } } \
        __builtin_amdgcn_s_setprio(0); } while (0)
#define PG8_WAIT_V(n) asm volatile("s_waitcnt vmcnt(" #n ")" ::: "memory")
#define PG8_WAIT_L(n) asm volatile("s_waitcnt lgkmcnt(" #n ")" ::: "memory")
#define PG8_BAR __builtin_amdgcn_s_barrier()
#define PG8_SCHED __builtin_amdgcn_sched_barrier(0)
    Unit cur, nxt; int ui = 0;
    if (!S.next(0, cur)) return;
    f32x4 acc[2][2][4][2];
#pragma unroll
    for (int a = 0; a < 2; ++a)
#pragma unroll
        for (int b = 0; b < 2; ++b)
#pragma unroll
            for (int m = 0; m < 4; ++m)
#pragma unroll
                for (int n = 0; n < 2; ++n) acc[a][b][m][n] = (f32x4){0.f, 0.f, 0.f, 0.f};
    i32x8_ At[4], B0[2], B1[2];
    const char* cA = (const char*)g.A + (size_t)cur.pm * tstepA; const char* cB = (const char*)g.Bt + (size_t)cur.pb * tstepB;
    PG8_STAGE(PG8_SB(0, 0), cB, voffB); PG8_STAGE(PG8_SB(0, 1), cB + hstepB, voffB); PG8_STAGE(PG8_SA(0, 0), cA, voffA); PG8_STAGE(PG8_SA(0, 1), cA + hstepA, voffA);
    if (wr == 1) PG8_BAR;
    PG8_WAIT_V(2); PG8_BAR;
    PG8_STAGE(PG8_SB(1, 0), cB + kstep, voffB); PG8_STAGE(PG8_SA(1, 0), cA + kstep, voffA); PG8_STAGE(PG8_SB(1, 1), cB + hstepB + kstep, voffB);
    PG8_WAIT_V(6); PG8_BAR;
    for (;;) {
        const bool has_next = S.next(ui + 1, nxt);
        const char* nA = has_next ? (const char*)g.A + (size_t)nxt.pm * tstepA : cA; const char* nB = has_next ? (const char*)g.Bt + (size_t)nxt.pb * tstepB : cB;
        for (int t = 0; t < nt; t += 2) {
            const bool last = (t == nt - 2);
            const char* a1 = cA + (size_t)(t + 1) * kstep;
            const char* a2 = last ? nA : cA + (size_t)(t + 2) * kstep; const char* b2 = last ? nB : cB + (size_t)(t + 2) * kstep;
            const char* a3 = a2 + kstep; const char* b3 = b2 + kstep;
            PG8_LDB(B0, 0, 0); PG8_LDB(B1, 0, 1); PG8_SCHED; PG8_LDA(At, 0, 0); PG8_STAGE(PG8_SA(1, 1), a1 + hstepA, voffA);
            PG8_WAIT_V(8); PG8_WAIT_L(0); PG8_BAR; PG8_MMA(0, 0, At, B0); PG8_MMA(0, 1, At, B1); PG8_BAR; PG8_SCHED;
            PG8_LDA(At, 0, 1); PG8_STAGE(PG8_SB(0, 0), b2, voffB); PG8_STAGE(PG8_SB(0, 1), b2 + hstepB, voffB); PG8_STAGE(PG8_SA(0, 0), a2, voffA);
            PG8_WAIT_V(8); PG8_WAIT_L(0); PG8_BAR; PG8_MMA(1, 0, At, B0); PG8_MMA(1, 1, At, B1); PG8_BAR; PG8_SCHED;
            PG8_LDB(B0, 1, 0); PG8_LDB(B1, 1, 1); PG8_SCHED; PG8_LDA(At, 1, 0); PG8_STAGE(PG8_SA(0, 1), a2 + hstepA, voffA);
            PG8_WAIT_V(8); PG8_WAIT_L(0); PG8_BAR; PG8_MMA(0, 0, At, B0); PG8_MMA(0, 1, At, B1); PG8_BAR; PG8_SCHED;
            PG8_LDA(At, 1, 1); PG8_STAGE(PG8_SB(1, 0), b3, voffB); PG8_STAGE(PG8_SB(1, 1), b3 + hstepB, voffB); PG8_STAGE(PG8_SA(1, 0), a3, voffA);
            PG8_WAIT_V(8); PG8_WAIT_L(0); PG8_BAR; PG8_MMA(1, 0, At, B0); PG8_MMA(1, 1, At, B1); PG8_BAR; PG8_SCHED;
        }
        if (wr == 0) PG8_BAR;
        if constexpr (FP8) asm volatile("s_nop 15\n\ts_nop 15\n\ts_nop 15\n\ts_nop 15" ::: "memory");
        E(acc, cur, wr, wc, fr, fq);
        if (!has_next) break;
#pragma unroll
        for (int a = 0; a < 2; ++a)
#pragma unroll
            for (int b = 0; b < 2; ++b)
#pragma unroll
                for (int m = 0; m < 4; ++m)
#pragma unroll
                    for (int n = 0; n < 2; ++n) acc[a][b][m][n] = (f32x4){0.f, 0.f, 0.f, 0.f};
        cur = nxt; cA = nA; cB = nB; ++ui;
        if (wr == 1) PG8_BAR;
    }
    PG8_WAIT_V(0);
    PG8_BAR;
#undef PG8_SA
#undef PG8_SB
#undef PG8_STAGE
#undef PG8_LDA
#undef PG8_LD2
#undef PG8_HALF
#undef PG8_LDB
#undef PG8_MMA
#undef PG8_WAIT_V
#undef PG8_WAIT_L
#undef PG8_BAR
#undef PG8_SCHED
}
}
using pg8::Unit;

struct EpiInProj {
    static constexpr bool PERM = true;
    u16* z; const float* bias; float* gates; u16* kc; const float* cosT; const float* sinT; unsigned char* z8;
    DEVI void operator()(const f32x4 (&acc)[2][2][4][2], const Unit& u, int wr, int wc, int fr, int fq) const {
        const int pn = u.pn, row0 = u.pm * 256 + wr * 64 + fr, colt = pn * 256, cl0 = wc * 32 + 8 * fq;
        f32x4 bv[2][2];
#pragma unroll
        for (int bj = 0; bj < 2; ++bj)
#pragma unroll
            for (int n = 0; n < 2; ++n) bv[bj][n] = *(const f32x4*)(bias + colt + cl0 + bj * 128 + 4 * n);
        const float scale = pn < 4 ? 0.0625f : 1.f;
        const bool rope = (pn >= 24 && pn < 32) || pn == 36 || pn == 37 || pn == 40 || pn == 41;
        const bool kcv = pn >= 32 && pn < 36;
#pragma unroll
        for (int am = 0; am < 4; ++am) { const int ai = am >> 1, m0 = (am & 1) * 2;
            f32x4 csq[4], snq[4];
#pragma unroll
            for (int m = m0; m < m0 + 2; ++m) { csq[m] = (f32x4){1.f, 1.f, 1.f, 1.f}; snq[m] = (f32x4){0.f, 0.f, 0.f, 0.f};
                if (rope) { const int t_ = (row0 + ai * 128 + m * 16) & 4095; csq[m] = *(const f32x4*)(cosT + t_ * 64 + (cl0 >> 1)); snq[m] = *(const f32x4*)(sinT + t_ * 64 + (cl0 >> 1)); } }
#pragma unroll
            for (int m = m0; m < m0 + 2; ++m) { const int row = row0 + ai * 128 + m * 16, t = row & 4095;
                const f32x4 cs = csq[m], sn = snq[m];
#pragma unroll
                for (int bj = 0; bj < 2; ++bj) {
                    f32x4 v0 = (acc[ai][bj][m][0] + bv[bj][0]) * scale, v1 = (acc[ai][bj][m][1] + bv[bj][1]) * scale;
                    if (rope) {
                        const f32x4 a0 = v0, a1 = v1;
                        v0[0] = a0[0] * cs[0] - a0[1] * sn[0]; v0[1] = a0[1] * cs[0] + a0[0] * sn[0];
                        v0[2] = a0[2] * cs[1] - a0[3] * sn[1]; v0[3] = a0[3] * cs[1] + a0[2] * sn[1];
                        v1[0] = a1[0] * cs[2] - a1[1] * sn[2]; v1[1] = a1[1] * cs[2] + a1[0] * sn[2];
                        v1[2] = a1[2] * cs[3] - a1[3] * sn[3]; v1[3] = a1[3] * cs[3] + a1[2] * sn[3];
                    }
                    u32x4 w; w.x = pk2(v0[0], v0[1]); w.y = pk2(v0[2], v0[3]); w.z = pk2(v1[0], v1[1]); w.w = pk2(v1[2], v1[3]);
                    if (rope) { const int c8 = (pn < 32 ? (pn - 24) * 256 : pn < 38 ? 2048 + (pn - 36) * 256 : 2560 + (pn - 40) * 256) + bj * 128 + cl0;
                        u32x2 w8; w8.x = pk4_fp8(v0[0], v0[1], v0[2], v0[3]); w8.y = pk4_fp8(v1[0], v1[1], v1[2], v1[3]); *(u32x2*)(z8 + (size_t)row * 3072 + c8) = w8; }
                    if (rope) { }
                    else if (kcv) { const int cs_ = (pn - 32) * 256 + bj * 128 + cl0, which = cs_ >> 9, gg = (cs_ >> 7) & 3, dd = cs_ & 127, b = row >> 12;
                        u32x2 w8; w8.x = pk4_fp8(v0[0], v0[1], v0[2], v0[3]); w8.y = pk4_fp8(v1[0], v1[1], v1[2], v1[3]);
                        *(u32x2*)((unsigned char*)kc + ((size_t)((which * 16 + b * 4 + gg) * 4096 + t) * 128 + dd)) = w8; }
                    else *(u32x4*)(z + (size_t)row * NPAD + colt + bj * 128 + cl0) = w;
                }
            } }
    }
};
struct EpiF32Tile {
    static constexpr bool PERM = false;
    float* C; int ldc;
    DEVI void operator()(const f32x4 (&acc)[2][2][4][2], const Unit& u, int wr, int wc, int fr, int fq) const {
        const int row0 = u.pm * 256 + wr * 64 + fr, col0 = u.pn * 256 + wc * 32 + 4 * fq;
#pragma unroll
        for (int ai = 0; ai < 2; ++ai)
#pragma unroll
            for (int m = 0; m < 4; ++m) { float* rowp = C + (size_t)(row0 + ai * 128 + m * 16) * ldc + col0;
#pragma unroll
                for (int bj = 0; bj < 2; ++bj)
#pragma unroll
                    for (int n = 0; n < 2; ++n) *(f32x4*)(rowp + bj * 128 + n * 16) = acc[ai][bj][m][n]; }
    }
};
template <bool ADD> struct EpiGate {
    static constexpr bool PERM = true;
    u16* mrg; const u16* z; int gcol0;
    DEVI void operator()(const f32x4 (&acc)[2][2][4][2], const Unit& u, int wr, int wc, int fr, int fq) const {
        const int row0 = u.pm * 256 + wr * 64 + fr, col0 = u.pn * 256 + wc * 32 + 8 * fq;
#pragma unroll
        for (int am = 0; am < 4; ++am) { const int ai = am >> 1, m0 = (am & 1) * 2;
            u32x4 gq[4][2], pq[4][2];
#pragma unroll
            for (int m = m0; m < m0 + 2; ++m)
#pragma unroll
                for (int bj = 0; bj < 2; ++bj) { const int row = row0 + ai * 128 + m * 16, col = col0 + bj * 128;
                    gq[m][bj] = *(const u32x4*)(z + (size_t)row * NPAD + gcol0 + col); if (ADD) pq[m][bj] = *(const u32x4*)(mrg + (size_t)row * D_ + col); }
#pragma unroll
            for (int m = m0; m < m0 + 2; ++m) { const int row = row0 + ai * 128 + m * 16;
#pragma unroll
                for (int bj = 0; bj < 2; ++bj) { const int col = col0 + bj * 128;
                    float gz[8], pv[8]; unpack8(gq[m][bj], gz);
                    u16* dst = mrg + (size_t)row * D_ + col;
                    if (ADD) unpack8(pq[m][bj], pv);
                    float o[8];
#pragma unroll
                    for (int j = 0; j < 4; ++j) { o[j] = acc[ai][bj][m][0][j] * sigm(gz[j]); o[4 + j] = acc[ai][bj][m][1][j] * sigm(gz[4 + j]); }
                    if (ADD) {
#pragma unroll
                        for (int j = 0; j < 8; ++j) o[j] += pv[j]; }
                    u32x4 w; w.x = pk2(o[0], o[1]); w.y = pk2(o[2], o[3]); w.z = pk2(o[4], o[5]); w.w = pk2(o[6], o[7]);
                    *(u32x4*)dst = w; } } }
    }
};
struct EpiResid {
    static constexpr bool PERM = true;
    u16* pre; const float* x; const u16* xh;
    DEVI void operator()(const f32x4 (&acc)[2][2][4][2], const Unit& u, int wr, int wc, int fr, int fq) const {
        const int row0 = u.pm * 256 + wr * 64 + fr, col0 = u.pn * 256 + wc * 32 + 8 * fq;
#pragma unroll
        for (int am = 0; am < 4; ++am) { const int ai = am >> 1, m0 = (am & 1) * 2;
            u32x4 hq[4][2]; f32x4 xq[4][2][2];
#pragma unroll
            for (int m = m0; m < m0 + 2; ++m)
#pragma unroll
                for (int bj = 0; bj < 2; ++bj) { const size_t off = (size_t)(row0 + ai * 128 + m * 16) * D_ + col0 + bj * 128;
                    if (xh) hq[m][bj] = *(const u32x4*)(xh + off); else { xq[m][bj][0] = *(const f32x4*)(x + off); xq[m][bj][1] = *(const f32x4*)(x + off + 4); } }
#pragma unroll
            for (int m = m0; m < m0 + 2; ++m)
#pragma unroll
                for (int bj = 0; bj < 2; ++bj) { const size_t off = (size_t)(row0 + ai * 128 + m * 16) * D_ + col0 + bj * 128; float xv[8];
                    if (xh) unpack8(hq[m][bj], xv);
                    else { const f32x4 x0 = xq[m][bj][0], x1 = xq[m][bj][1]; xv[0] = x0[0]; xv[1] = x0[1]; xv[2] = x0[2]; xv[3] = x0[3]; xv[4] = x1[0]; xv[5] = x1[1]; xv[6] = x1[2]; xv[7] = x1[3]; }
                    float r[8];
#pragma unroll
                    for (int j = 0; j < 4; ++j) { r[j] = xv[j] * ALPHA + acc[ai][bj][m][0][j]; r[4 + j] = xv[4 + j] * ALPHA + acc[ai][bj][m][1][j]; }
                    u32x4 w; w.x = pk2(r[0], r[1]); w.y = pk2(r[2], r[3]); w.z = pk2(r[4], r[5]); w.w = pk2(r[6], r[7]);
                    *(u32x4*)(pre + off) = w; } }
    }
};
struct EpiSwiGLU {
    static constexpr bool PERM = true;
    unsigned char* H;
    DEVI void operator()(const f32x4 (&acc)[2][2][4][2], const Unit& u, int wr, int wc, int fr, int fq) const {
        const int row0 = u.pm * 256 + wr * 64 + fr, f0 = u.pn * 128 + wc * 16 + 4 * fq;
#pragma unroll
        for (int ai = 0; ai < 2; ++ai)
#pragma unroll
            for (int m = 0; m < 4; ++m) { const int row = row0 + ai * 128 + m * 16;
#pragma unroll
                for (int bj = 0; bj < 2; ++bj) { const f32x4 a = acc[ai][bj][m][0], b = acc[ai][bj][m][1]; float o[4];
#pragma unroll
                    for (int j = 0; j < 4; ++j) o[j] = a[j] * sigm(a[j]) * b[j];
                    *(unsigned*)(H + (size_t)row * DFF + f0 + bj * 64) = pk4_fp8(o[0], o[1], o[2], o[3]); } }
    }
};
struct EpiScaleRow {
    static constexpr bool PERM = true;
    u16* Y; const float* roww;
    DEVI void operator()(const f32x4 (&acc)[2][2][4][2], const Unit& u, int wr, int wc, int fr, int fq) const {
        const int row0 = u.pm * 256 + wr * 64 + fr, col0 = u.pn * 256 + wc * 32 + 8 * fq;
        float rwq[2][4];
#pragma unroll
        for (int ai = 0; ai < 2; ++ai)
#pragma unroll
            for (int m = 0; m < 4; ++m) rwq[ai][m] = roww[row0 + ai * 128 + m * 16];
#pragma unroll
        for (int ai = 0; ai < 2; ++ai)
#pragma unroll
            for (int m = 0; m < 4; ++m) { const int row = row0 + ai * 128 + m * 16; const float w_ = rwq[ai][m];
#pragma unroll
                for (int bj = 0; bj < 2; ++bj) { const f32x4 v0 = acc[ai][bj][m][0] * w_, v1 = acc[ai][bj][m][1] * w_;
                    u32x4 w; w.x = pk2(v0[0], v0[1]); w.y = pk2(v0[2], v0[3]); w.z = pk2(v1[0], v1[1]); w.w = pk2(v1[2], v1[3]);
                    *(u32x4*)(Y + (size_t)row * D_ + col0 + bj * 128) = w; } }
    }
};

struct CmpOrder {
    int G, c;
    DEVI bool next(int i, Unit& u) const { const int L = i * G + c; if (L >= 32) return false; u.pm = L; u.pn = 0; u.pb = L >> 4; return true; }
};
struct MoeOrder {
    int G, c, ntiles; const volatile LAS int* tstart;
    DEVI bool next(int i, Unit& u) const {
        const int L = i * G + c; if (L >= ntiles * 8) return false;
        const int tile = L >> 3, pn = L & 7;
        const int lk_ = (int)__builtin_amdgcn_mbcnt_hi(~0u, __builtin_amdgcn_mbcnt_lo(~0u, 0u));
        const int e = __popcll(__ballot(lk_ >= 1 && lk_ < 32 && tstart[lk_ & 31] <= tile));
        u.pm = tile; u.pn = pn; u.pb = e * 8 + pn; return true;
    }
};

struct Args { const float* in[26]; float* out; unsigned char* ws; int ph_lo, ph_hi; };
typedef const __attribute__((address_space(4))) Args* KP;
constexpr int PPL = 13;
constexpr int NPH = 1 + 2 * PPL;

DEVI int src_col(int n) {
    if (n < C_NQ) return n;
    if (n < C_KC) { const int r = n - C_NQ, hd = r >> 7, p = r & 127; return S_NQ + hd * 128 + (p >> 1) + 64 * (p & 1); }
    if (n < C_KS) return S_KC + (n - C_KC);
    if (n < C_VS) { const int r = n - C_KS, hd = r >> 7, p = r & 127; return S_KS + hd * 128 + (p >> 1) + 64 * (p & 1); }
    if (n < C_KW) return S_VS + (n - C_VS);
    if (n < C_VW) { const int r = n - C_KW, hd = r >> 7, p = r & 127; return S_KW + hd * 128 + (p >> 1) + 64 * (p & 1); }
    if (n < C_GM) return S_VW + (n - C_VW);
    if (n < C_GT) return S_GM + (n - C_GM);
    const int r = n - C_GT; if (r < 8) return S_MI + r; if (r < 56) return S_NG + (r - 8); return -1;
}

template <class ColPtr>
DEVI void tr_item32(const ColPtr& cp, size_t ldw, int K, u16* WT, int k0, int n0, float* scr, int lane) {
    const float* src = cp(n0 + (lane & 31));
#pragma unroll 8
    for (int i = 0; i < 32; ++i) { const int kk = 2 * i + (lane >> 5); scr[kk * 33 + (lane & 31)] = src ? src[(size_t)(k0 + kk) * ldw] : 0.f; }
    WAVE_SYNC();
    const int c = lane & 7;
#pragma unroll
    for (int j = 0; j < 4; ++j) { const int n = (lane >> 3) + 8 * j; const float* s = scr + (8 * c) * 33 + n;
        u32x4 o; o.x = pk2(s[0 * 33], s[1 * 33]); o.y = pk2(s[2 * 33], s[3 * 33]); o.z = pk2(s[4 * 33], s[5 * 33]); o.w = pk2(s[6 * 33], s[7 * 33]);
        *(u32x4*)(WT + (size_t)(n0 + n) * K + k0 + 8 * c) = o; }
    WAVE_SYNC();
}
template <class ColPtr>
DEVI void tr_item64(const ColPtr& cp, size_t ldw, int K, u16* WT, int k0, int n0, float* scr, int lane) {
    const int nq = lane & 15, kr = lane >> 4;
    const float* src = cp(n0 + 4 * nq);
    f32x4 v[16];
#pragma unroll
    for (int i = 0; i < 16; ++i) v[i] = src ? __builtin_nontemporal_load((const f32x4*)(src + (size_t)(k0 + kr + 4 * i) * ldw)) : (f32x4){0.f, 0.f, 0.f, 0.f};
#pragma unroll
    for (int i = 0; i < 16; ++i) { float* d = scr + (kr + 4 * i) * 65 + 4 * nq; d[0] = v[i][0]; d[1] = v[i][1]; d[2] = v[i][2]; d[3] = v[i][3]; }
    WAVE_SYNC();
    const int c = lane & 7;
#pragma unroll
    for (int j = 0; j < 8; ++j) { const int n = (lane >> 3) + 8 * j; const float* sp = scr + (8 * c) * 65 + n;
        u32x4 o; o.x = pk2(sp[0 * 65], sp[1 * 65]); o.y = pk2(sp[2 * 65], sp[3 * 65]); o.z = pk2(sp[4 * 65], sp[5 * 65]); o.w = pk2(sp[6 * 65], sp[7 * 65]);
        *(u32x4*)(WT + (size_t)(n0 + n) * K + k0 + 8 * c) = o; }
    WAVE_SYNC();
}
template <class ColPtr>
DEVI void tr_item64_f8(const ColPtr& cp, size_t ldw, int K, unsigned char* WT, int k0, int n0, float* scr, int lane, float scale) {
    const int nq = lane & 15, kr = lane >> 4;
    const float* src = cp(n0 + 4 * nq);
    f32x4 v[16];
#pragma unroll
    for (int i = 0; i < 16; ++i) v[i] = src ? __builtin_nontemporal_load((const f32x4*)(src + (size_t)(k0 + kr + 4 * i) * ldw)) : (f32x4){0.f, 0.f, 0.f, 0.f};
#pragma unroll
    for (int i = 0; i < 16; ++i) { float* d = scr + (kr + 4 * i) * 65 + 4 * nq; d[0] = v[i][0]; d[1] = v[i][1]; d[2] = v[i][2]; d[3] = v[i][3]; }
    WAVE_SYNC();
    const int c = lane & 3;
#pragma unroll
    for (int j = 0; j < 4; ++j) { const int n = (lane >> 2) + 16 * j; const float* sp = scr + (16 * c) * 65 + n;
        u32x4 o; o.x = pk4_fp8(sp[0 * 65] * scale, sp[1 * 65] * scale, sp[2 * 65] * scale, sp[3 * 65] * scale); o.y = pk4_fp8(sp[4 * 65] * scale, sp[5 * 65] * scale, sp[6 * 65] * scale, sp[7 * 65] * scale);
        o.z = pk4_fp8(sp[8 * 65] * scale, sp[9 * 65] * scale, sp[10 * 65] * scale, sp[11 * 65] * scale); o.w = pk4_fp8(sp[12 * 65] * scale, sp[13 * 65] * scale, sp[14 * 65] * scale, sp[15 * 65] * scale);
        *(u32x4*)(WT + (size_t)(n0 + n) * K + k0 + 16 * c) = o; }
    WAVE_SYNC();
}
DEVI void tr_item64_f8_rope(const float* Wh  , size_t ldw, int K, unsigned char* WT, int k0, int n0, float* scr, int lane, float scale) {
    const int nq = lane & 15, kr = lane >> 4, hf = nq >> 3, d4 = 4 * (nq & 7);
    const float* src = Wh + hf * 64 + d4;
    f32x4 v[16];
#pragma unroll
    for (int i = 0; i < 16; ++i) v[i] = __builtin_nontemporal_load((const f32x4*)(src + (size_t)(k0 + kr + 4 * i) * ldw));
#pragma unroll
    for (int i = 0; i < 16; ++i) { float* d = scr + (kr + 4 * i) * 65 + 2 * d4 + hf; d[0] = v[i][0]; d[2] = v[i][1]; d[4] = v[i][2]; d[6] = v[i][3]; }
    WAVE_SYNC();
    const int c = lane & 3;
#pragma unroll
    for (int j = 0; j < 4; ++j) { const int n = (lane >> 2) + 16 * j; const float* sp = scr + (16 * c) * 65 + n;
        u32x4 o; o.x = pk4_fp8(sp[0 * 65] * scale, sp[1 * 65] * scale, sp[2 * 65] * scale, sp[3 * 65] * scale); o.y = pk4_fp8(sp[4 * 65] * scale, sp[5 * 65] * scale, sp[6 * 65] * scale, sp[7 * 65] * scale);
        o.z = pk4_fp8(sp[8 * 65] * scale, sp[9 * 65] * scale, sp[10 * 65] * scale, sp[11 * 65] * scale); o.w = pk4_fp8(sp[12 * 65] * scale, sp[13 * 65] * scale, sp[14 * 65] * scale, sp[15 * 65] * scale);
        *(u32x4*)(WT + (size_t)(n0 + n) * K + k0 + 16 * c) = o; }
    WAVE_SYNC();
}
template <class ColPtr>
DEVI void tr_item32_f8(const ColPtr& cp, size_t ldw, int K, unsigned char* WT, int k0, int n0, float* scr, int lane, float scale) {
    const float* src = cp(n0 + (lane & 31));
#pragma unroll 8
    for (int i = 0; i < 32; ++i) { const int kk = 2 * i + (lane >> 5); scr[kk * 33 + (lane & 31)] = src ? src[(size_t)(k0 + kk) * ldw] : 0.f; }
    WAVE_SYNC();
    const int c = lane & 7;
#pragma unroll
    for (int j = 0; j < 4; ++j) { const int n = (lane >> 3) + 8 * j; const float* sp = scr + (8 * c) * 33 + n;
        u32x2 o; o.x = pk4_fp8(sp[0 * 33] * scale, sp[1 * 33] * scale, sp[2 * 33] * scale, sp[3 * 33] * scale); o.y = pk4_fp8(sp[4 * 33] * scale, sp[5 * 33] * scale, sp[6 * 33] * scale, sp[7 * 33] * scale);
        *(u32x2*)(WT + (size_t)(n0 + n) * K + k0 + 8 * c) = o; }
    WAVE_SYNC();
}
struct ColPlain { const float* W; DEVI const float* operator()(int n) const { return W + n; } };
struct ColInProj { const float* W; DEVI const float* operator()(int n) const { const int s = src_col(n); return s >= 0 ? W + s : nullptr; } };
struct ColW13 { const float* w1; const float* w3; DEVI const float* operator()(int n) const { const int f = (n >> 3) * 4 + (n & 3); return ((n >> 2) & 1) ? w3 + f : w1 + f; } };

DEVI void phase_prologue(KP a, unsigned char* lds, int tid, int lane, int wave, int G) {
    unsigned char* ws = a->ws;
    float* cosT = (float*)(ws + WS_ROPE); float* sinT = cosT + 4096 * 64;
    for (int idx = blockIdx.x * 512 + tid; idx < 4096 * 64; idx += G * 512) {
        const int pos = idx >> 6, i = idx & 63;
        const float inv = exp2f(-(float)i * (13.287712379549449f / 64.f));
        const double ang = (double)pos * (double)inv;
        const double k = __builtin_rint(ang * 0.15915494309189535);
        const float r = (float)(ang - k * 6.283185307179586);
        cosT[idx] = cosf(r); sinT[idx] = sinf(r);
    }
    { const float* x = a->in[0]; unsigned char* x8 = ws + WS_X8;
      const size_t NI = (size_t)M_ * D_ / 8, st = (size_t)G * 512; size_t i = (size_t)blockIdx.x * 512 + tid;
      for (; i + 3 * st < NI; i += 4 * st) {
          f32x4 v0[4], v1[4];
#pragma unroll
          for (int u = 0; u < 4; ++u) { v0[u] = *(const f32x4*)(x + (i + u * st) * 8); v1[u] = *(const f32x4*)(x + (i + u * st) * 8 + 4); }
#pragma unroll
          for (int u = 0; u < 4; ++u) { u32x2 w; w.x = pk4_fp8(v0[u][0], v0[u][1], v0[u][2], v0[u][3]); w.y = pk4_fp8(v1[u][0], v1[u][1], v1[u][2], v1[u][3]); *(u32x2*)(x8 + (i + u * st) * 8) = w; } }
      for (; i < NI; i += st) {
          const f32x4 v0 = *(const f32x4*)(x + i * 8), v1 = *(const f32x4*)(x + i * 8 + 4);
          u32x2 w; w.x = pk4_fp8(v0[0], v0[1], v0[2], v0[3]); w.y = pk4_fp8(v1[0], v1[1], v1[2], v1[3]);
          *(u32x2*)(x8 + i * 8) = w; } }
    { float* bp = (float*)(ws + WS_BIASP);
      for (int i = blockIdx.x * 512 + tid; i < 2 * NPAD; i += G * 512) { const int l = i / NPAD, n = i % NPAD, s = src_col(n); bp[i] = s >= 0 ? a->in[2][l * IN_W + s] : 0.f; } }
    { u16* ov = (u16*)(ws + WS_OVL);
      for (int i = blockIdx.x * 512 + tid; i < 256 * 128; i += G * 512) { const int n = i >> 7, j = i & 127;
          const bool on = j < 64 && n < 255 && (16 * n <= 64 * j + 63) && (16 * n + 31 >= 64 * j); ov[i] = on ? (u16)0x3f80 : (u16)0; } }
    { float* wT = (float*)(ws + WS_RWT); const float* rw = a->in[19];
      for (int i = blockIdx.x * 512 + tid; i < 32 * 2048; i += G * 512) { const int e = i >> 11, d = i & 2047; wT[i] = rw[d * 32 + e]; } }
    const int gw = blockIdx.x * 8 + wave, NGW = G * 8;
    { float* b1p = (float*)(ws + WS_MISC + 1536 * 1024);
      for (int task = gw; task < 512; task += NGW) { const int kc = task & 63, fh = (task >> 6) & 1, kv = (task >> 7) & 1, l = task >> 8;
          const float* pos = a->in[kv ? 9 : 4] + (size_t)l * 4096; const float* w1 = a->in[kv ? 10 : 5] + (size_t)l * 4096 * 128; const int f = fh * 64 + lane;
          float s = 0.f;
          for (int k = kc * 64; k < kc * 64 + 64; ++k) s += pos[k] * w1[(size_t)k * 128 + f];
          b1p[((l * 2 + kv) * 64 + kc) * 128 + f] = s; } }
    float* scr = (float*)(lds + wave * 16640);
    constexpr int IT_WIN = 32 * (NPAD / 64), IT_WB = 32 * 32, IT_CW = 32 * 2;
    constexpr int NIT = 2 * IT_WIN + 6 * IT_WB + 8 * IT_CW;
    for (int it = gw; it < NIT; it += NGW) {
        int r = it;
        if (r < 2 * IT_WIN) { const int l = r / IT_WIN; r %= IT_WIN; const int kb = r / (NPAD / 64), nb = r % (NPAD / 64), n0 = nb * 64;
            const ColInProj cp{a->in[1] + (size_t)l * D_ * IN_W}; unsigned char* WT = ws + WS_WIN + (size_t)l * NPAD * D_;
            const bool rope = (n0 >= C_NQ && n0 < C_KC) || (n0 >= C_KS && n0 < C_VS) || (n0 >= C_KW && n0 < C_VW);
            if (rope) { const int segd = n0 >= C_KW ? C_KW : n0 >= C_KS ? C_KS : C_NQ, segs = n0 >= C_KW ? S_KW : n0 >= C_KS ? S_KS : S_NQ;
                const int r_ = n0 - segd, hd = r_ >> 7, m32 = (r_ & 127) >> 6;
                tr_item64_f8_rope(a->in[1] + (size_t)l * D_ * IN_W + segs + hd * 128 + 32 * m32, IN_W, D_, WT, kb * 64, n0, scr, lane, 64.f); }
            else tr_item64_f8(cp, IN_W, D_, WT, kb * 64, n0, scr, lane, 64.f);
            continue; }
        r -= 2 * IT_WIN;
        if (r < 6 * IT_WB) { const int q = r / IT_WB, l = q / 3, w = q % 3; r %= IT_WB; const int kb = r / 32, nb = r % 32;
            if (w <= 1) tr_item64_f8(ColPlain{a->in[14 + w] + (size_t)l * D_ * D_}, D_, D_, ws + WS_WB + (size_t)(l * 3 + w) * D_ * D_ * 2, kb * 64, nb * 64, scr, lane, 64.f);
            else tr_item64(ColPlain{a->in[14 + w] + (size_t)l * D_ * D_}, D_, D_, (u16*)(ws + WS_WB) + (size_t)(l * 3 + w) * D_ * D_, kb * 64, nb * 64, scr, lane);
            continue; }
        r -= 6 * IT_WB;
        { const int q = r / IT_CW, l = q >> 2, kv = (q >> 1) & 1, ab = q & 1; r %= IT_CW; const int kb = r / 2, nb = r % 2;
          const float* w1 = a->in[kv ? 10 : 5] + (size_t)l * 4096 * 128 + (size_t)ab * 2048 * 128;
          tr_item64_f8(ColPlain{w1}, 128, 2048, ws + WS_CW1 + (size_t)(l * 512 + kv * 256 + ab * 128) * 2048, kb * 64, nb * 64, scr, lane, 64.f); }
    }
}
DEVI void phase_experts(KP a, unsigned char* lds, int lane, int wave, int G, int l) {
    unsigned char* ws = a->ws;
    float* scr = (float*)(lds + wave * 16640);
    const int gw = blockIdx.x * 8 + wave, NGW = G * 8;
    constexpr int IT13 = 32 * 32, IT2 = 16 * 32;
    for (int it = gw; it < NEXP * (IT13 + IT2); it += NGW) {
        const int e = it / (IT13 + IT2); int r = it % (IT13 + IT2);
        if (r < IT13) { const int kb = r / 32, nb = r % 32;
            const float* w1 = a->in[21] + ((size_t)l * NEXP + e) * D_ * DFF; const float* w3 = a->in[22] + ((size_t)l * NEXP + e) * D_ * DFF;
            tr_item64_f8(ColW13{w1, w3}, DFF, D_, ws + WS_W13 + (size_t)e * 2048 * D_, kb * 64, nb * 64, scr, lane, 64.f); }
        else { r -= IT13; const int kb = r / 32, nb = r % 32;
            const float* w2 = a->in[23] + ((size_t)l * NEXP + e) * DFF * D_;
            tr_item64_f8(ColPlain{w2}, D_, DFF, ws + WS_W2 + (size_t)e * D_ * DFF, kb * 64, nb * 64, scr, lane, 64.f); }
    }
}

namespace ml {
constexpr int QP = 272, VP = 72;
constexpr int O_Q = 0, O_K = 34816, O_CB = 69632, O_VT = 95744, O_VW = 102656, O_SP = 109568, O_SC = 118784;
constexpr int S_A = 0, S_M = 64, S_WI = 128, S_EN = 192, S_WS = 256, S_DEN = 320, S_DEC = 384;
typedef short s16x4 __attribute__((ext_vector_type(4)));
DEVI bf16x8 frag(const unsigned char* lds, int off) { return *(const bf16x8*)(lds + off); }
DEVI bf16x8 frag_tr(unsigned addr) {
    s16x4 lo, hi;
    asm volatile("ds_read_b64_tr_b16 %0, %2\n\tds_read_b64_tr_b16 %1, %2 offset:2176\n\ts_waitcnt lgkmcnt(0)" : "=&v"(lo), "=&v"(hi) : "v"(addr) : "memory");
    return (bf16x8){lo[0], lo[1], lo[2], lo[3], hi[0], hi[1], hi[2], hi[3]};
}
}
constexpr size_t WS_SP = WS_O, WS_MSC = WS_O + 16 * MiB, WS_MDEC = WS_O + 20 * MiB;
DEVI void phase_mlstm_pre(KP a, unsigned char* lds, const int tid, int G, int first_blk) {
    using namespace ml;
    unsigned char* ws = a->ws;
    const u16* z = (const u16*)(ws + WS_Z); const float* gates = (const float*)(ws + WS_GATES);
    u16* SPg = (u16*)(ws + WS_SP); float* MSC = (float*)(ws + WS_MSC); float* MDEC = (float*)(ws + WS_MDEC);
    const int lane = tid & 63, wave = __builtin_amdgcn_readfirstlane(tid >> 6), g4 = lane >> 4, l15 = lane & 15;
    float* sc = (float*)(lds + O_SC);
    const int nblk = G - first_blk, bi = (int)blockIdx.x - first_blk;
    if (bi < 0) return;
    const int u0 = (int)(((long)bi * 1024) / nblk), u1 = (int)(((long)(bi + 1) * 1024) / nblk);
    float off = 0.f, Gp = 0.f; int have = -1;
    const unsigned qkoff = (unsigned)((tid >> 5) * NPAD + (tid & 31) * 8) * 2u; const int qklds = (tid >> 5) * (QP * 2) + (tid & 31) * 16;
    for (int u = u0; u < u1; ++u) { const int bh = u >> 6, c = u & 63, b = bh >> 2, h = bh & 3;
        const char* zq = (const char*)(z + (size_t)(b * 4096 + c * 64) * NPAD + C_MQ + h * 256);
        const char* zk = (const char*)(z + (size_t)(b * 4096 + c * 64) * NPAD + C_MK + h * 256);
        const float* gp = gates + (size_t)b * 4096 * 64 + h;
#pragma unroll
        for (int k = 0; k < 4; ++k) { *(u32x4*)(lds + O_Q + qklds + k * 16 * QP * 2) = *(const u32x4*)(zq + qkoff + (size_t)k * 16 * NPAD * 2); *(u32x4*)(lds + O_K + qklds + k * 16 * QP * 2) = *(const u32x4*)(zk + qkoff + (size_t)k * 16 * NPAD * 2); }
        if (wave == 0) {
            if (have != u) { off = 0.f; Gp = 0.f;
                if (c > 0) { const float* ch = (const float*)(ws + WS_CHS) + ((size_t)(b * 64) * 4 + h) * 2;
                    float Sv = 0.f, Lv = -INFINITY; if (lane < c) { Sv = ch[lane * 8]; Lv = ch[lane * 8 + 1]; }
#pragma unroll
                    for (int cc = 0; cc < 63; ++cc) { const float s_ = __int_as_float(__builtin_amdgcn_readlane(__float_as_int(Sv), cc)), l_ = __int_as_float(__builtin_amdgcn_readlane(__float_as_int(Lv), cc));
                        Gp = fmaxf(Gp, l_ - off); off += s_; } } }
            const float fg = gp[(size_t)(c * 64 + lane) * 64 + 4], ig = gp[(size_t)(c * 64 + lane) * 64];
            float bc = fminf(fg, 0.f) - log1pf(__expf(-fabsf(fg)));
#pragma unroll
            for (int o = 1; o < 64; o <<= 1) { const float t_ = __shfl_up(bc, o); if (lane >= o) bc += t_; }
            const float Bg = off + bc, gv = ig - Bg; float pm = gv;
#pragma unroll
            for (int o = 1; o < 64; o <<= 1) { const float t_ = __shfl_up(pm, o); if (lane >= o) pm = fmaxf(pm, t_); }
            const float Gt = fmaxf(Gp, pm), Ge = __shfl(Gt, 63);
            sc[S_A + lane] = gv; sc[S_M + lane] = Gt;
            *(f32x4*)(MSC + ((size_t)bh * 4096 + c * 64 + lane) * 4) = (f32x4){__expf(Gp - Gt), __expf(-(Bg + Gt)), __expf(gv - Ge), 0.f};
            if (lane == 0) MDEC[bh * 64 + c] = __expf(Gp - Ge);
            off = __shfl(Bg, 63); Gp = Ge; have = u + 1;
            if (c == 63) have = -1;
        }
        __syncthreads();
        const int tt = wave >> 1, st0 = 2 * (wave & 1); const int t = 16 * tt + l15; const float Gt_ = sc[S_M + t];
        u16* spo = SPg + (size_t)u * 4096 + (size_t)t * 64;
#pragma unroll
        for (int si = 0; si < 2; ++si) { const int st = st0 + si; u32x2 pk_ = {0u, 0u};
            if (st <= tt) { f32x4 sacc = {0.f, 0.f, 0.f, 0.f};
#pragma unroll
                for (int ks = 0; ks < 8; ++ks) sacc = __builtin_amdgcn_mfma_f32_16x16x32_bf16(frag(lds, O_K + (16 * st + l15) * (QP * 2) + (32 * ks + 8 * g4) * 2), frag(lds, O_Q + (16 * tt + l15) * (QP * 2) + (32 * ks + 8 * g4) * 2), sacc, 0, 0, 0);
                float w_[4];
#pragma unroll
                for (int j = 0; j < 4; ++j) { const int sj = 16 * st + 4 * g4 + j; w_[j] = sj <= t ? sacc[j] * __expf(sc[S_A + sj] - Gt_) : 0.f; }
                pk_.x = pk2(w_[0], w_[1]); pk_.y = pk2(w_[2], w_[3]); }
            *(u32x2*)(spo + 16 * st + 4 * g4) = pk_; }
        __syncthreads();
    }
}
DEVI void phase_mlstm(KP a, unsigned char* lds, const int tid, int G) {
    using namespace ml;
    unsigned char* ws = a->ws;
    const u16* z = (const u16*)(ws + WS_Z); u16* hbuf = (u16*)(ws + WS_HG);
    const u16* SPg = (const u16*)(ws + WS_SP); const float* MSC = (const float*)(ws + WS_MSC); const float* MDEC = (const float*)(ws + WS_MDEC);
    const int lane = tid & 63, wave = __builtin_amdgcn_readfirstlane(tid >> 6), g4 = lane >> 4, l15 = lane & 15;
    float* sc = (float*)(lds + O_SC);
    const unsigned lds32 = (unsigned)(uintptr_t)lds;
    const unsigned qkoff = (unsigned)((tid >> 5) * NPAD + (tid & 31) * 8) * 2u;
    const int qklds = (tid >> 5) * (QP * 2) + (tid & 31) * 16;
    const int vs_ = tid >> 3, v4 = (tid & 7) * 4;
    for (int unit0 = blockIdx.x; unit0 < 256; unit0 += G) {
        const int unit = (G % 8 == 0 && G >= 256) ? (((unit0 & 7) + 8 * (unit0 >> 7)) * 16 + ((unit0 >> 3) & 15)) : unit0;
        const int b = unit >> 6, h = (unit >> 4) & 3, jv = unit & 15, bh = b * 4 + h;
        const char* zq = (const char*)(z + (size_t)b * 4096 * NPAD + C_MQ + h * 256);
        const char* zk = (const char*)(z + (size_t)b * 4096 * NPAD + C_MK + h * 256);
        const char* zv = (const char*)(z + (size_t)b * 4096 * NPAD + C_MV + h * 512 + jv * 32);
        const char* spg = (const char*)(SPg + (size_t)bh * 64 * 4096);
        const float* msc = MSC + (size_t)bh * 4096 * 4;
        for (int i = tid; i < 48 * QP / 2; i += 512) ((unsigned*)(lds + O_CB))[i] = 0u;
        for (int i = tid; i < 16 * VP / 2; i += 512) { ((unsigned*)(lds + O_VT + 32 * VP * 2))[i] = i < VP / 2 ? 0x3f803f80u : 0u; ((unsigned*)(lds + O_VW + 32 * VP * 2))[i] = 0u; }
        f32x4 Cacc[2][3];
#pragma unroll
        for (int i = 0; i < 2; ++i)
#pragma unroll
            for (int j = 0; j < 3; ++j) Cacc[i][j] = (f32x4){0.f, 0.f, 0.f, 0.f};
        u32x4 pq[4], pk[4], psp; u32x2 pv; f32x4 pms = {0.f, 0.f, 0.f, 0.f}; float pdec = 0.f, pws = 0.f;
#pragma unroll
        for (int k = 0; k < 4; ++k) { pq[k] = *(const u32x4*)(zq + qkoff + (size_t)k * 16 * NPAD * 2); pk[k] = *(const u32x4*)(zk + qkoff + (size_t)k * 16 * NPAD * 2); }
        pv = *(const u32x2*)(zv + ((size_t)vs_ * NPAD + v4) * 2); pws = msc[(size_t)vs_ * 4 + 2];
        psp = *(const u32x4*)(spg + (size_t)tid * 16);
        if (wave == 0) { pms = *(const f32x4*)(msc + (size_t)lane * 4); pdec = MDEC[bh * 64]; }
        for (int c = 0; c < 64; ++c) {
#pragma unroll
            for (int k = 0; k < 4; ++k) { *(u32x4*)(lds + O_Q + qklds + k * 16 * QP * 2) = pq[k]; *(u32x4*)(lds + O_K + qklds + k * 16 * QP * 2) = pk[k]; }
            { u16* vt = (u16*)(lds + O_VT); u16* vw = (u16*)(lds + O_VW); const unsigned short e0 = (u16)(pv.x & 0xffffu), e1 = (u16)(pv.x >> 16), e2 = (u16)(pv.y & 0xffffu), e3 = (u16)(pv.y >> 16);
              vt[(v4 + 0) * VP + vs_] = e0; vt[(v4 + 1) * VP + vs_] = e1; vt[(v4 + 2) * VP + vs_] = e2; vt[(v4 + 3) * VP + vs_] = e3;
              vw[(v4 + 0) * VP + vs_] = (u16)f2bf(bf2f(e0) * pws); vw[(v4 + 1) * VP + vs_] = (u16)f2bf(bf2f(e1) * pws); vw[(v4 + 2) * VP + vs_] = (u16)f2bf(bf2f(e2) * pws); vw[(v4 + 3) * VP + vs_] = (u16)f2bf(bf2f(e3) * pws); }
            *(u32x4*)(lds + O_SP + (tid >> 3) * (VP * 2) + (tid & 7) * 16) = psp;
            if (wave == 0) { sc[S_WI + lane] = pms[0]; sc[S_EN + lane] = pms[1]; ((u16*)(lds + O_VW))[32 * VP + lane] = (u16)f2bf(pms[2]); if (lane == 0) sc[S_DEC] = pdec; }
            __syncthreads();
            { const int cn = c < 63 ? c + 1 : 63; const size_t ro = (size_t)cn * 64 * NPAD * 2;
#pragma unroll
              for (int k = 0; k < 4; ++k) { pq[k] = *(const u32x4*)(zq + ro + qkoff + (size_t)k * 16 * NPAD * 2); pk[k] = *(const u32x4*)(zk + ro + qkoff + (size_t)k * 16 * NPAD * 2); }
              pv = *(const u32x2*)(zv + ro + ((size_t)vs_ * NPAD + v4) * 2); pws = msc[(size_t)(cn * 64 + vs_) * 4 + 2];
              psp = *(const u32x4*)(spg + (size_t)cn * 8192 + (size_t)tid * 16);
              if (wave == 0) { pms = *(const f32x4*)(msc + (size_t)(cn * 64 + lane) * 4); pdec = MDEC[bh * 64 + cn]; } }
            const int tt1 = wave & 3, vt1 = wave >> 2;
            f32x4 inter1 = {0.f, 0.f, 0.f, 0.f}, inter2 = {0.f, 0.f, 0.f, 0.f};
#pragma unroll
            for (int ks = 0; ks < 8; ++ks) { const bf16x8 aq = frag(lds, O_Q + (16 * tt1 + l15) * (QP * 2) + (32 * ks + 8 * g4) * 2);
                inter1 = __builtin_amdgcn_mfma_f32_16x16x32_bf16(aq, frag(lds, O_CB + (16 * vt1 + l15) * (QP * 2) + (32 * ks + 8 * g4) * 2), inter1, 0, 0, 0);
                inter2 = __builtin_amdgcn_mfma_f32_16x16x32_bf16(aq, frag(lds, O_CB + (32 + l15) * (QP * 2) + (32 * ks + 8 * g4) * 2), inter2, 0, 0, 0); }
            f32x4 num1 = {0.f, 0.f, 0.f, 0.f}, num2 = {0.f, 0.f, 0.f, 0.f};
#pragma unroll
            for (int ks = 0; ks < 2; ++ks) { const bf16x8 ap = frag(lds, O_SP + (16 * tt1 + l15) * (VP * 2) + (32 * ks + 8 * g4) * 2);
                num1 = __builtin_amdgcn_mfma_f32_16x16x32_bf16(ap, frag(lds, O_VT + (16 * vt1 + l15) * (VP * 2) + (32 * ks + 8 * g4) * 2), num1, 0, 0, 0);
                num2 = __builtin_amdgcn_mfma_f32_16x16x32_bf16(ap, frag(lds, O_VT + (32 + l15) * (VP * 2) + (32 * ks + 8 * g4) * 2), num2, 0, 0, 0); }
            { const int row0 = b * 4096 + c * 64;
#pragma unroll
              for (int j = 0; j < 4; ++j) { const int tj = 16 * tt1 + 4 * g4 + j; const float wi = sc[S_WI + tj];
                  float d_ = num2[j] + wi * inter2[j];
                  d_ = __shfl(d_, lane & 48);
                  const float den = fmaxf(fabsf(d_), sc[S_EN + tj]);
                  const float hv = (num1[j] + wi * inter1[j]) / den;
                  const float hn = __int_as_float(__builtin_amdgcn_mov_dpp(__float_as_int(hv), 0xB1, 0xF, 0xF, true));
                  if ((l15 & 1) == 0) *(unsigned*)(hbuf + (size_t)(row0 + tj) * D_ + h * 512 + jv * 32 + 16 * vt1 + l15) = pk2(hv, hn); } }
            { const float decay = sc[S_DEC];
#pragma unroll
              for (int di = 0; di < 2; ++di) { const int dt = 2 * wave + di;
#pragma unroll
                  for (int vt = 0; vt < 3; ++vt) Cacc[di][vt] = Cacc[di][vt] * decay;
#pragma unroll
                  for (int ks = 0; ks < 2; ++ks) { const bf16x8 ak = frag_tr(lds32 + O_K + (32 * ks + 8 * g4 + (l15 >> 2)) * (QP * 2) + (16 * dt + 4 * (lane & 3)) * 2);
#pragma unroll
                      for (int vt = 0; vt < 3; ++vt) Cacc[di][vt] = __builtin_amdgcn_mfma_f32_16x16x32_bf16(ak, frag(lds, O_VW + (16 * vt + l15) * (VP * 2) + (32 * ks + 8 * g4) * 2), Cacc[di][vt], 0, 0, 0); }
              } }
            __syncthreads();
#pragma unroll
            for (int di = 0; di < 2; ++di) { const int dt = 2 * wave + di;
#pragma unroll
                for (int vt = 0; vt < 3; ++vt) { u32x2 w_; w_.x = pk2(Cacc[di][vt][0], Cacc[di][vt][1]); w_.y = pk2(Cacc[di][vt][2], Cacc[di][vt][3]);
                    *(u32x2*)(lds + O_CB + (16 * vt + l15) * (QP * 2) + (16 * dt + 4 * g4) * 2) = w_; } }
        }
        __syncthreads();
    }
}

DEVI void phase_cmp2(KP a, unsigned char* lds, int tid, int G, int l) {
    unsigned char* ws = a->ws;
    const float* U = (const float*)(ws + WS_U); u16* kcmp = (u16*)(ws + WS_KCMP);
    const float* cosT = (const float*)(ws + WS_ROPE); const float* sinT = cosT + 4096 * 64;
    const float* b1part = (const float*)(ws + WS_MISC + 1536 * 1024);
    constexpr int HP = 132;
    float* hs = (float*)lds;
    float* os = hs + 32 * HP;
    float* b1p = os + 32 * HP;
    const int sub = tid >> 7, f = tid & 127, lane = tid & 63, wv = tid >> 6, g4 = lane >> 4, l15 = lane & 15;
    __syncthreads();
    if (tid < 256) { const int which = tid >> 7; float s = a->in[which ? 11 : 6][l * 128 + f]; float p[64];
#pragma unroll
        for (int kc = 0; kc < 64; ++kc) p[kc] = b1part[((l * 2 + which) * 64 + kc) * 128 + f];
#pragma unroll
        for (int kc = 0; kc < 64; ++kc) s += p[kc];
        b1p[tid] = s; }
    __syncthreads();
    for (int unit = blockIdx.x; unit < 256; unit += G) {
        const int which = unit >> 7, rb = which * 4096 + (unit & 127) * 32;
        const float* w2 = a->in[which ? 12 : 7] + (size_t)l * 128 * 128; const float* b2 = a->in[which ? 13 : 8] + l * 128;
        float bw[8][4];
#pragma unroll
        for (int ks = 0; ks < 8; ++ks)
#pragma unroll
            for (int u = 0; u < 4; ++u) bw[ks][u] = w2[(16 * ks + 4 * g4 + u) * 128 + wv * 16 + l15];
        float ua[8], ub[8];
#pragma unroll
        for (int j = 0; j < 8; ++j) { const int r = rb + sub + 4 * j; const bool ok = (r & 255) < 255;
            ua[j] = ok ? U[(size_t)r * 256 + f] : 0.f; ub[j] = ok ? U[(size_t)(r + 1) * 256 + 128 + f] : 0.f; }
        const float b1v = b1p[which * 128 + f];
#pragma unroll
        for (int j = 0; j < 8; ++j) { const int r = rb + sub + 4 * j; float hp = 0.f;
            if ((r & 255) < 255) { hp = ua[j] + ub[j] + b1v;
                const float u_ = 0.7978845608028654f * (hp + 0.044715f * hp * hp * hp); const float th = 1.f - 2.f / (1.f + __expf(2.f * u_)); hp = 0.5f * hp * (1.f + th); }
            hs[(sub + 4 * j) * HP + f] = hp; }
        __syncthreads();
        { f32x4 acc0 = {0.f, 0.f, 0.f, 0.f}, acc1 = {0.f, 0.f, 0.f, 0.f};
#pragma unroll
          for (int ks = 0; ks < 8; ++ks) { const f32x4 a0 = *(const f32x4*)(hs + l15 * HP + 16 * ks + 4 * g4), a1 = *(const f32x4*)(hs + (16 + l15) * HP + 16 * ks + 4 * g4);
#pragma unroll
              for (int u = 0; u < 4; ++u) { acc0 = __builtin_amdgcn_mfma_f32_16x16x4f32(a0[u], bw[ks][u], acc0, 0, 0, 0); acc1 = __builtin_amdgcn_mfma_f32_16x16x4f32(a1[u], bw[ks][u], acc1, 0, 0, 0); } }
          const float bb = b2[wv * 16 + l15];
#pragma unroll
          for (int j = 0; j < 4; ++j) { os[(4 * g4 + j) * HP + wv * 16 + l15] = acc0[j] + bb; os[(16 + 4 * g4 + j) * HP + wv * 16 + l15] = acc1[j] + bb; } }
        __syncthreads();
        if (which == 0) { const int i = f >> 1; float cs[8], sn[8];
#pragma unroll
            for (int j = 0; j < 8; ++j) { const int r = rb + sub + 4 * j, n = r & 255, pos = 16 * n + 31; cs[j] = n < 255 ? cosT[pos * 64 + i] : 1.f; sn[j] = n < 255 ? sinT[pos * 64 + i] : 0.f; }
#pragma unroll
            for (int j = 0; j < 8; ++j) { const int lr = sub + 4 * j, r = rb + lr, n = r & 255; const float x1 = os[lr * HP + i], x2 = os[lr * HP + i + 64];
                float val = (f & 1) ? x2 * cs[j] + x1 * sn[j] : x1 * cs[j] - x2 * sn[j]; if (n == 255) val = 0.f;
                kcmp[(size_t)r * 128 + f] = (u16)f2bf(val); (ws + WS_KCMP8)[(size_t)r * 128 + f] = (unsigned char)(pk4_fp8(val, 0.f, 0.f, 0.f) & 0xffu); } }
        else {
#pragma unroll
            for (int j = 0; j < 8; ++j) { const int lr = sub + 4 * j, r = rb + lr, n = r & 255; float val = os[lr * HP + f]; if (n == 255) val = 0.f;
                kcmp[(size_t)r * 128 + f] = (u16)f2bf(val); } }
        __syncthreads();
    }
}
DEVI void phase_norm(KP a, int lane, int wave, int G, int l) {
    unsigned char* ws = a->ws;
    const u16* z = (const u16*)(ws + WS_Z); u16* hg = (u16*)(ws + WS_HG); const float* mw = a->in[3] + l * 2048;
    const int gw = blockIdx.x * 8 + wave, NGW = G * 8;
    f32x4 mwq[4][2];
#pragma unroll
    for (int h = 0; h < 4; ++h) { mwq[h][0] = *(const f32x4*)(mw + h * 512 + lane * 8); mwq[h][1] = *(const f32x4*)(mw + h * 512 + lane * 8 + 4); }
    for (int row = gw; row < M_; row += NGW) {
        u32x4 hv[4], ov[4];
#pragma unroll
        for (int h = 0; h < 4; ++h) { hv[h] = *(const u32x4*)(hg + (size_t)row * D_ + h * 512 + lane * 8); ov[h] = *(const u32x4*)(z + (size_t)row * NPAD + C_MO + h * 512 + lane * 8); }
#pragma unroll
        for (int h = 0; h < 4; ++h) {
            float v[8]; unpack8(hv[h], v);
            float s = 0.f;
#pragma unroll
            for (int j = 0; j < 8; ++j) s += v[j];
            const float mean = wsum(s) * (1.f / 512.f); float q = 0.f;
#pragma unroll
            for (int j = 0; j < 8; ++j) { v[j] -= mean; q += v[j] * v[j]; }
            const float rstd = 1.f / sqrtf(wsum(q) * (1.f / 512.f) + LN_EPS);
            float og[8]; unpack8(ov[h], og);
            const f32x4 w0 = mwq[h][0], w1 = mwq[h][1];
            const float wv[8] = {w0[0], w0[1], w0[2], w0[3], w1[0], w1[1], w1[2], w1[3]};
            float o[8];
#pragma unroll
            for (int j = 0; j < 8; ++j) o[j] = v[j] * rstd * wv[j] * sigm(og[j]);
            u32x2 w8; w8.x = pk4_fp8(o[0] * 2.f, o[1] * 2.f, o[2] * 2.f, o[3] * 2.f); w8.y = pk4_fp8(o[4] * 2.f, o[5] * 2.f, o[6] * 2.f, o[7] * 2.f);
            *(u32x2*)(ws + WS_XBF + (size_t)row * D_ + h * 512 + lane * 8) = w8; }
    }
}

#ifndef GQ_CV
#define GQ_CV true
#endif
#ifndef GQ_CI
#define GQ_CI true
#endif
#ifndef GQ_W
#define GQ_W true
#endif
#ifndef GQ_S
#define GQ_S false
#endif
namespace att {
constexpr int NW = 8, QBLK = 32, KVBLK = 64, QB = 256, D = 128, WIN = 512;
constexpr int SHM_V = KVBLK * D * 2, SHM_K = KVBLK * D * 2;
constexpr float SCALE = 0.08838834764831845f, THR = 8.f;
typedef short s16x4 __attribute__((ext_vector_type(4)));
typedef float f32x16 __attribute__((ext_vector_type(16)));
enum { M_WIN = 0, M_SEL = 1, M_CMP = 2 };
enum { E_GATED = 0, E_IMP = 1, E_FINAL = 2 };
#define KSWZ8(row, colB) ((row) * 128 + ((colB) ^ (((row) & 7) << 4)))
#define SBAR() __builtin_amdgcn_sched_barrier(0)
DEVI int v_st(int k, int c) { const int kk = (k & ~0xC) | ((k & 4) << 1) | ((k & 8) >> 1); return ((kk >> 3) * 4 + (c >> 5)) * 512 + ((kk & 7) * 32 + (c & 31)) * 2; }
DEVI int v_rd_base(int lane) { return ((lane & 3) << 3) | (((lane >> 2) & 3) << 6) | (((lane >> 4) & 1) << 5) | (((lane >> 5) & 1) << 8); }
constexpr int v_rd_off(int d0, int ks, int half) { return d0 * 512 + ks * 4096 + half * 2048; }
DEVI int crow(int r, int hi) { return (r & 3) + 8 * (r >> 2) + 4 * hi; }
DEVI unsigned cvtpk(float lo, float hi) { unsigned r; asm volatile("v_cvt_pk_bf16_f32 %0, %1, %2" : "=v"(r) : "v"(lo), "v"(hi)); return r; }
DEVI bf16x8 load8(const u16* p) { return *reinterpret_cast<const bf16x8*>(p); }
DEVI int nvis(int pos) { return pos >= 31 ? ((pos - 31) >> 4) + 1 : 0; }
DEVI void mask_tile(f32x16& p0, f32x16& p1, int dq, unsigned W) {
    const float NEG = -__builtin_inff();
#pragma unroll
    for (int r = 0; r < 16; ++r) { const int c = (r & 3) + 8 * (r >> 2);
        if ((unsigned)(dq - c) >= W) p0[r] = NEG;
        if ((unsigned)(dq - c - 32) >= W) p1[r] = NEG; }
}
DEVI void mask_cmp(f32x16& p0, f32x16& p1, int lim) {
    const float NEG = -__builtin_inff();
#pragma unroll
    for (int r = 0; r < 16; ++r) { const int c = (r & 3) + 8 * (r >> 2);
        if (c >= lim) p0[r] = NEG;
        if (c + 32 >= lim) p1[r] = NEG; }
}
DEVI void mask_all(f32x16& p0, f32x16& p1, bool kill) {
    const float NEG = -__builtin_inff();
#pragma unroll
    for (int r = 0; r < 16; ++r) { if (kill) p0[r] = NEG; if (kill) p1[r] = NEG; }
}
DEVI void partialSM(f32x16& p0, f32x16& p1, float& m_reg, float& mn, float& alpha, const bool kill = false) {
    float pmax = p0[0];
#pragma unroll
    for (int r = 1; r < 16; ++r) pmax = fmaxf(pmax, p0[r]);
#pragma unroll
    for (int r = 0; r < 16; ++r) pmax = fmaxf(pmax, p1[r]);
    { auto rr = __builtin_amdgcn_permlane32_swap(__float_as_uint(pmax), __float_as_uint(pmax), false, false);
      pmax = fmaxf(__uint_as_float(rr[0]), __uint_as_float(rr[1])); }
    if (kill) pmax = -__builtin_inff();
    constexpr float C2 = 1.4426950408889634f * SCALE;
    if (__builtin_expect(__all((pmax - m_reg) * SCALE <= THR), 1)) { mn = m_reg; alpha = 1.f; }
    else { mn = fmaxf(m_reg, pmax); alpha = __builtin_amdgcn_exp2f((m_reg - mn) * C2); m_reg = mn; }
    const float mnL = kill ? -__builtin_inff() : -mn * C2;
#pragma unroll
    for (int r = 0; r < 16; ++r) p0[r] = fmaf(p0[r], C2, mnL);
#pragma unroll
    for (int r = 0; r < 16; ++r) p1[r] = fmaf(p1[r], C2, mnL);
#pragma unroll
    for (int r = 0; r < 16; ++r) p0[r] = __builtin_amdgcn_exp2f(p0[r]);
}
DEVI void finishSM(f32x16& p0, f32x16& p1, float alpha, float& l_reg, bf16x8& pa0, bf16x8& pa1, bf16x8& pa2, bf16x8& pa3) {
#pragma unroll
    for (int r = 0; r < 16; ++r) p1[r] = __builtin_amdgcn_exp2f(p1[r]);
    float ps = 0;
#pragma unroll
    for (int r = 0; r < 16; ++r) ps += p0[r];
#pragma unroll
    for (int r = 0; r < 16; ++r) ps += p1[r];
    { auto rr = __builtin_amdgcn_permlane32_swap(__float_as_uint(ps), __float_as_uint(ps), false, false);
      ps = __uint_as_float(rr[0]) + __uint_as_float(rr[1]); }
    l_reg = l_reg * alpha + ps;
#define PK4(P, B_, OUT) do { unsigned a0 = cvtpk(P[B_+0], P[B_+1]), a1 = cvtpk(P[B_+2], P[B_+3]);                          \
        unsigned b0 = cvtpk(P[B_+4], P[B_+5]), b1 = cvtpk(P[B_+6], P[B_+7]);                                             \
        auto r0 = __builtin_amdgcn_permlane32_swap(a0, b0, false, false); auto r1 = __builtin_amdgcn_permlane32_swap(a1, b1, false, false); \
        u32x4 w = {r0[0], r1[0], r0[1], r1[1]}; OUT = *reinterpret_cast<bf16x8*>(&w); } while (0)
    PK4(p0, 0, pa0); PK4(p0, 8, pa1); PK4(p1, 0, pa2); PK4(p1, 8, pa3);
#undef PK4
}
template <int KB, bool SK>
DEVI void qkt(f32x16& p0, f32x16& p1, const char* K_lds, int r32, int hi, const pg8::i32x8_* q8, bool act) {
    if (SK && !act) { const float NEG = -__builtin_inff();
#pragma unroll
        for (int r = 0; r < 16; ++r) { p0[r] = NEG; p1[r] = NEG; } return; }
    const char* kb = K_lds + KB * SHM_K;
    const int one = 0x7f7f7f7f;
    typedef int i4 __attribute__((ext_vector_type(4)));
    { const pg8::i32x8_ a00 = __builtin_shufflevector(*(const i4*)(kb + KSWZ8(r32, 32 * hi)), *(const i4*)(kb + KSWZ8(r32, 32 * hi + 16)), 0, 1, 2, 3, 4, 5, 6, 7);
      const pg8::i32x8_ a10 = __builtin_shufflevector(*(const i4*)(kb + 4096 + KSWZ8(r32, 32 * hi)), *(const i4*)(kb + 4096 + KSWZ8(r32, 32 * hi + 16)), 0, 1, 2, 3, 4, 5, 6, 7);
      asm volatile("s_waitcnt lgkmcnt(0)\n\tv_mfma_scale_f32_32x32x64_f8f6f4 %0, %2, %4, 0, %5, %5 op_sel_hi:[0,0,0]\n\tv_mfma_scale_f32_32x32x64_f8f6f4 %1, %3, %4, 0, %5, %5 op_sel_hi:[0,0,0]"
                   : "=&v"(p0), "=&v"(p1) : "v"(a00), "v"(a10), "v"(q8[0]), "v"(one) : "memory"); }
    { const pg8::i32x8_ a01 = __builtin_shufflevector(*(const i4*)(kb + KSWZ8(r32, 64 + 32 * hi)), *(const i4*)(kb + KSWZ8(r32, 64 + 32 * hi + 16)), 0, 1, 2, 3, 4, 5, 6, 7);
      const pg8::i32x8_ a11 = __builtin_shufflevector(*(const i4*)(kb + 4096 + KSWZ8(r32, 64 + 32 * hi)), *(const i4*)(kb + 4096 + KSWZ8(r32, 64 + 32 * hi + 16)), 0, 1, 2, 3, 4, 5, 6, 7);
      asm volatile("s_waitcnt lgkmcnt(0)\n\tv_mfma_scale_f32_32x32x64_f8f6f4 %0, %2, %4, %0, %5, %5 op_sel_hi:[0,0,0]\n\tv_mfma_scale_f32_32x32x64_f8f6f4 %1, %3, %4, %1, %5, %5 op_sel_hi:[0,0,0]\n\ts_nop 15\n\ts_nop 15\n\ts_nop 15\n\ts_nop 15"
                   : "+v"(p0), "+v"(p1) : "v"(a01), "v"(a11), "v"(q8[1]), "v"(one) : "memory"); }
}
template <int VB, bool SK>
DEVI void pv_tile(f32x16* o, int vb0, bf16x8 pa0, bf16x8 pa1, bf16x8 pa2, bf16x8 pa3, bool act) {
    if (SK && !act) return;
#define TRRD(dst, off) asm volatile("ds_read_b64_tr_b16 %0, %1 offset:%2" : "=&v"(dst) : "v"(vb0), "i"(off) : "memory")
#define PV_D0(d0) do { s16x4 l0, l1, l2, l3, h0, h1, h2, h3; constexpr int b_ = VB * SHM_V + v_rd_off(d0, 0, 0); \
        TRRD(l0, b_); TRRD(h0, b_ + 2048); TRRD(l1, b_ + 4096); TRRD(h1, b_ + 6144); TRRD(l2, b_ + 8192); TRRD(h2, b_ + 10240); TRRD(l3, b_ + 12288); TRRD(h3, b_ + 14336); \
        asm volatile("s_waitcnt lgkmcnt(0)" ::: "memory"); SBAR();   \
        o[d0] = __builtin_amdgcn_mfma_f32_32x32x16_bf16(pa0, (bf16x8){l0[0], l0[1], l0[2], l0[3], h0[0], h0[1], h0[2], h0[3]}, o[d0], 0, 0, 0);   \
        o[d0] = __builtin_amdgcn_mfma_f32_32x32x16_bf16(pa1, (bf16x8){l1[0], l1[1], l1[2], l1[3], h1[0], h1[1], h1[2], h1[3]}, o[d0], 0, 0, 0);   \
        o[d0] = __builtin_amdgcn_mfma_f32_32x32x16_bf16(pa2, (bf16x8){l2[0], l2[1], l2[2], l2[3], h2[0], h2[1], h2[2], h2[3]}, o[d0], 0, 0, 0);   \
        o[d0] = __builtin_amdgcn_mfma_f32_32x32x16_bf16(pa3, (bf16x8){l3[0], l3[1], l3[2], l3[3], h3[0], h3[1], h3[2], h3[3]}, o[d0], 0, 0, 0); } while (0)
    PV_D0(0); PV_D0(1); PV_D0(2); PV_D0(3);
#undef PV_D0
#undef TRRD
}
struct ABlock { const unsigned char* Q; const unsigned char* K; const u16* V; int P0, row0, b, head; };
struct Seam { pg8::i32x8_ q8[2]; u32x4 st_k; bf16x8 st_v0, st_v1; };
struct Epi { const float* gates; u16* dst; const u16* oc; const u16* ow; float* imp; const unsigned long long* sel; };
template <int MODE> DEVI int jlo(int P0) { if (MODE == M_WIN) { const int lowk = P0 - WIN + 1; return lowk > 0 ? lowk / KVBLK : 0; } return 0; }
template <int MODE, int QBE = QB> DEVI int jhi(int P0) {
    if (MODE == M_CMP) { const int n = (nvis(P0 + QBE - 1) + KVBLK - 1) / KVBLK; return n < 1 ? 1 : n; }
    return (P0 + QBE - 1) / KVBLK + 1; }
#define ROWB(p, k0) ((const char*)((p) + (size_t)(k0) * LDK))
#define VMW() asm volatile("s_waitcnt vmcnt(0)" ::: "memory")
#define VMWN(n) asm volatile("s_waitcnt vmcnt(%0)" :: "i"(n) : "memory")
#define SLOAD_H(Kp, Vp, k0) do { const char* vb_ = ROWB(Vp, k0); const char* kb__ = (const char*)(Kp) + (size_t)(k0) * LDK8;                     \
                         S.st_v0 = load8((const u16*)(vb_ + voff0)); S.st_v1 = load8((const u16*)(vb_ + voff1));              \
                         S.st_k = *(const u32x4*)(kb__ + koff8); } while (0)
#define SWRITE_HK(bf) do { *(u32x4*)(K_lds + (bf) * SHM_K + kws) = S.st_k; } while (0)
#define SWRITE_HV(bf) do { *(bf16x8*)(V_lds + (bf) * SHM_V + vst0) = S.st_v0; *(bf16x8*)(V_lds + (bf) * SHM_V + vst1) = S.st_v1; } while (0)
#define SWRITE_H(bf) do { SWRITE_HV(bf); SWRITE_HK(bf); } while (0)
template <int MODE, int LDK, int LDK8, bool GQ = false>
DEVI void prime(const ABlock& cur, char* lds, Seam& S, const int tid) {
    const int wid = __builtin_amdgcn_readfirstlane(tid >> 6), lane = tid & 63, r32 = lane & 31, hi = lane >> 5;
    const int sr = tid >> 4, sc = (tid & 15) * 8, kws = KSWZ8(tid >> 3, (tid & 7) * 16); char* K_lds = lds + 2 * SHM_V;
    const unsigned voff0 = (unsigned)(sr * LDK + sc) * 2u, voff1 = (unsigned)((32 + sr) * LDK + sc) * 2u, koff8 = (unsigned)((tid >> 3) * LDK8 + (tid & 7) * 16);
    const unsigned qoff = GQ ? (unsigned)(((wid & 1) * QBLK + r32) * 3072 + (wid >> 1) * 128 + hi * 32) : (unsigned)((wid * QBLK + r32) * 3072 + hi * 32);
    const int kb0 = jlo<MODE>(cur.P0) * KVBLK;
    { typedef int i4 __attribute__((ext_vector_type(4)));
#pragma unroll
      for (int s_ = 0; s_ < 2; ++s_) S.q8[s_] = __builtin_shufflevector(*(const i4*)(cur.Q + qoff + 64 * s_), *(const i4*)(cur.Q + qoff + 64 * s_ + 16), 0, 1, 2, 3, 4, 5, 6, 7); }
    SLOAD_H(cur.K, cur.V, kb0); VMW(); SWRITE_HK(0);
    __syncthreads();
}
template <int MODE, int EPI, int GK, int LDK, int LDK8, bool SK, bool GQ = false>
DEVI void block(const ABlock& cur, const ABlock& nxt, char* lds, Seam& S, const Epi& E, const int tid) {
    const int wid = __builtin_amdgcn_readfirstlane(tid >> 6), lane = tid & 63, r32 = lane & 31, hi = lane >> 5;
    const int wrow = GQ ? (wid & 1) * QBLK : wid * QBLK, whead = GQ ? cur.head + (wid >> 1) : cur.head;
    const int j_lo = jlo<MODE>(cur.P0), j_hi = jhi<MODE, GQ ? 64 : QB>(cur.P0);
    const int NT = j_hi - j_lo;
    const int kbn = jlo<MODE>(nxt.P0) * KVBLK;
    const int qlo = cur.P0 + wrow, qm = qlo + r32 - 4 * hi;
    char* V_lds = lds; char* K_lds = lds + 2 * SHM_V;
    float* wsl = (float*)(lds + 2 * SHM_V + 2 * SHM_K) + wid * 64; float* li_l = wsl, * al_l = wsl + 32;
    float m_reg = -1e30f, l_reg = 0; f32x16 o[4] = {};
    const int sr = tid >> 4, sc = (tid & 15) * 8, vst0 = v_st(sr, sc), vst1 = v_st(32 + sr, sc), kws = KSWZ8(tid >> 3, (tid & 7) * 16);
    const unsigned voff0 = (unsigned)(sr * LDK + sc) * 2u, voff1 = (unsigned)((32 + sr) * LDK + sc) * 2u, koff8 = (unsigned)((tid >> 3) * LDK8 + (tid & 7) * 16);
    const unsigned qoff = GQ ? (unsigned)(((wid & 1) * QBLK + r32) * 3072 + (wid >> 1) * 128 + hi * 32) : (unsigned)((wid * QBLK + r32) * 3072 + hi * 32);
    const int vb0 = (int)(uintptr_t)V_lds + v_rd_base(lane);
    const unsigned char* Kh = cur.K; const u16* Vh = cur.V;
    float gpre = 0.f;
    if (EPI != E_IMP && GK >= 0) gpre = E.gates[(size_t)(cur.row0 + wrow + r32) * 64 + 8 + whead * 3 + (GK < 0 ? 0 : GK)];
    unsigned sello = 0u, selhi = 0u; int nvl = 0;
    if (MODE == M_SEL) { const unsigned long long sw = E.sel[(size_t)(cur.b * 4 + (cur.head >> 2)) * 4096 + qlo + r32]; sello = (unsigned)sw; selhi = (unsigned)(sw >> 32); }
    if (MODE == M_CMP) nvl = nvis(qlo + r32) - 4 * hi;
#define RESC(a) do { if (__any((a) < 1.f)) { if (hi == 0) al_l[r32] = (a); asm volatile("s_waitcnt lgkmcnt(0)" ::: "memory");              \
                     for (int d_ = 0; d_ < 4; ++d_) for (int r = 0; r < 16; ++r) o[d_][r] *= al_l[crow(r, hi)]; } } while (0)
#define KBASE(t) ((j_lo + (t)) * KVBLK)
#define ACT(t) (MODE == M_WIN ? (KBASE(t) <= qlo + QBLK - 1 && KBASE(t) + KVBLK - 1 >= qlo - WIN + 1) : MODE == M_SEL ? (KBASE(t) <= qlo + QBLK - 1) : (KBASE(t) < nvis(qlo + QBLK - 1)))
#define MASKT(P0_, P1_, t) do { const int kb_ = KBASE(t); if (!SK || ACT(t)) {                                                             \
        if (MODE == M_WIN) { if (kb_ + KVBLK - 1 > qlo || kb_ <= qlo + QBLK - 1 - WIN) mask_tile(P0_, P1_, qm - kb_, (unsigned)WIN); }       \
        else if (MODE == M_SEL) { if (kb_ + KVBLK - 1 > qlo) mask_tile(P0_, P1_, qm - kb_, 0x40000000u);                                    \
            const int jt_ = j_lo + (t); const unsigned w_ = (jt_ & 32) ? selhi : sello; killf = ((w_ >> (jt_ & 31)) & 1u) == 0u; } \
        else { mask_cmp(P0_, P1_, nvl - kb_); } } } while (0)
    constexpr int NQL = 4;
#define SEAM_K0() do { VMWN(NQL); SWRITE_HK(0); SBAR(); } while (0)
    f32x16 pA0, pA1, pB0, pB1; float mnA, mnB, alA, alB; bf16x8 pa0, pa1, pa2, pa3; bool killf = false;
    SWRITE_HV(0); SBAR();
    if (NT > 1) { SLOAD_H(Kh, Vh, KBASE(1)); }
    SBAR(); qkt<0, SK>(pA0, pA1, K_lds, r32, hi, S.q8, ACT(0));
    MASKT(pA0, pA1, 0); partialSM(pA0, pA1, m_reg, mnA, alA, MODE == M_SEL && killf);
    if (NT > 1) { VMW(); SWRITE_H(1); }
    __syncthreads();
#define HALF_STEP(PX0, PX1, mnX, alX, PY0, PY1, alY, t, KB, VB, SB) do {                                                      \
        SBAR(); qkt<KB, SK>(PX0, PX1, K_lds, r32, hi, S.q8, ACT(t));                                             \
        finishSM(PY0, PY1, alY, l_reg, pa0, pa1, pa2, pa3); SBAR();                                                           \
        if ((t) + 1 < NT) { SLOAD_H(Kh, Vh, KBASE((t) + 1)); SBAR(); }                                               \
        pv_tile<VB, SK>(o, vb0, pa0, pa1, pa2, pa3, ACT((t) - 1)); MASKT(PX0, PX1, (t)); partialSM(PX0, PX1, m_reg, mnX, alX, MODE == M_SEL && killf);                                        \
        __syncthreads();                                                                                                      \
        if ((t) + 1 < NT) { VMW(); SWRITE_H(SB); }                                                                          \
        RESC(alX); __syncthreads(); } while (0)
    for (int t = 1; t + 1 < NT; t += 2) {
        HALF_STEP(pB0, pB1, mnB, alB, pA0, pA1, alA, t, 1, 0, 0);
        HALF_STEP(pA0, pA1, mnA, alA, pB0, pB1, alB, t + 1, 0, 1, 1);
    }
    const bool even = (NT & 1) == 0;
    if (even) { SBAR(); qkt<1, SK>(pB0, pB1, K_lds, r32, hi, S.q8, ACT(NT - 1)); SBAR(); }
    { const unsigned char* nK = nxt.K; const u16* nV = nxt.V; SLOAD_H(nK, nV, kbn); SBAR();
      typedef int i4 __attribute__((ext_vector_type(4)));
#pragma unroll
      for (int s_ = 0; s_ < 2; ++s_) S.q8[s_] = __builtin_shufflevector(*(const i4*)(nxt.Q + qoff + 64 * s_), *(const i4*)(nxt.Q + qoff + 64 * s_ + 16), 0, 1, 2, 3, 4, 5, 6, 7); }
    SBAR();
    finishSM(pA0, pA1, alA, l_reg, pa0, pa1, pa2, pa3); SBAR();
    pv_tile<0, SK>(o, vb0, pa0, pa1, pa2, pa3, ACT(even ? NT - 2 : NT - 1));
    if (even) { MASKT(pB0, pB1, NT - 1); partialSM(pB0, pB1, m_reg, mnB, alB, MODE == M_SEL && killf); __syncthreads(); RESC(alB);
        finishSM(pB0, pB1, alB, l_reg, pa0, pa1, pa2, pa3); SBAR(); pv_tile<1, SK>(o, vb0, pa0, pa1, pa2, pa3, ACT(NT - 1)); }
    SBAR(); SEAM_K0();
    if (hi == 0) { li_l[r32] = l_reg; if (EPI != E_IMP && GK >= 0) al_l[r32] = sigm(gpre); }
    asm volatile("s_waitcnt lgkmcnt(0)" ::: "memory");
    float rli[16];
#pragma unroll
    for (int r = 0; r < 16; ++r) { const float l_ = li_l[crow(r, hi)]; rli[r] = l_ > 0.f ? __builtin_amdgcn_rcpf(l_) : 0.f; if (EPI != E_IMP && GK >= 0) rli[r] *= al_l[crow(r, hi)]; }
    const size_t ebase = ((size_t)cur.row0 * D_ + whead * 128) * 2;
    const unsigned elane = (unsigned)((wrow + 4 * hi) * D_ + r32) * 2u;
    float* impb = E.imp + ((size_t)(cur.b * 16 + whead) * 4096 + cur.P0) * 64;
    const unsigned ilane = (unsigned)((wrow + 4 * hi) * 64 + r32) * 4u;
    const size_t frb = ((((size_t)(cur.b * 16 + whead) * 128 + ((cur.P0 + wrow) >> 5)) * 64 + lane) * 64) * 2;
    if (EPI == E_GATED) {
#pragma unroll
        for (int i = 0; i < 8; ++i) { const int r0 = 2 * i, r1 = 2 * i + 1; u32x4 w;
            w.x = cvtpk(o[0][r0] * rli[r0], o[1][r0] * rli[r0]); w.y = cvtpk(o[2][r0] * rli[r0], o[3][r0] * rli[r0]);
            w.z = cvtpk(o[0][r1] * rli[r1], o[1][r1] * rli[r1]); w.w = cvtpk(o[2][r1] * rli[r1], o[3][r1] * rli[r1]);
            *(u32x4*)((char*)E.dst + frb + i * 16) = w; }
    } else if (EPI == E_FINAL) {
        u32x4 cq[8], wq[8];
#pragma unroll
        for (int i = 0; i < 8; ++i) { cq[i] = *(const u32x4*)((const char*)E.oc + frb + i * 16); wq[i] = *(const u32x4*)((const char*)E.ow + frb + i * 16); }
#pragma unroll
        for (int r = 0; r < 16; ++r) { const int cr = (r & 3) + 8 * (r >> 2);
#pragma unroll
            for (int d0 = 0; d0 < 4; ++d0) { const float v = o[d0][r] * rli[r];
                const unsigned cw = cq[r >> 1][(r & 1) * 2 + (d0 >> 1)], ww = wq[r >> 1][(r & 1) * 2 + (d0 >> 1)];
                const float cv = __uint_as_float((d0 & 1) ? (cw & 0xffff0000u) : (cw << 16)), wv = __uint_as_float((d0 & 1) ? (ww & 0xffff0000u) : (ww << 16));
                const unsigned off = elane + (unsigned)(cr * D_ + d0 * 32) * 2u;
                const float f = (v + cv + wv) * 8.f;
                const float f1 = __int_as_float(__builtin_amdgcn_mov_dpp(__float_as_int(f), 0x55, 0xF, 0xF, true)), f2 = __int_as_float(__builtin_amdgcn_mov_dpp(__float_as_int(f), 0xAA, 0xF, 0xF, true)),
                            f3 = __int_as_float(__builtin_amdgcn_mov_dpp(__float_as_int(f), 0xFF, 0xF, 0xF, true));
                if ((r32 & 3) == 0) *(unsigned*)((char*)E.dst + (ebase >> 1) + (off >> 1)) = pk4_fp8(f, f1, f2, f3); } }
    } else {
#pragma unroll
        for (int r = 0; r < 16; ++r) { const int cr = (r & 3) + 8 * (r >> 2);
#pragma unroll
            for (int d0 = 0; d0 < 2; ++d0) *(float*)((char*)impb + ilane + (unsigned)(cr * 64 + d0 * 32) * 4u) = o[d0][r] * rli[r]; }
    }
    __syncthreads();
#undef RESC
#undef KBASE
#undef ACT
#undef MASKT
#undef SEAM_K0
#undef HALF_STEP
}
#undef ROWB
#undef VMW
#undef VMWN
#undef SLOAD_H
#undef SWRITE_HK
#undef SWRITE_HV
#undef SWRITE_H
struct Item { int b, head, qb0, qb1; };
template <bool PAIRED> DEVI Item decode(int L) {
    Item it; const int xcd = L & 7, k = L >> 3;
    if (PAIRED) { const int gi = k >> 5, r = k & 31, hl = r >> 3, x = r & 7; const int bg = gi * 8 + xcd; it.b = bg >> 2; it.head = (bg & 3) * 4 + hl; it.qb0 = x; it.qb1 = 15 - x; }
    else { const int gi = k >> 6, r = k & 63, hl = r >> 4, x = r & 15; const int bg = gi * 8 + xcd; it.b = bg >> 2; it.head = (bg & 3) * 4 + hl; it.qb0 = it.qb1 = (hl & 2) ? x : 15 - x; }
    return it;
}
template <bool PAIRED> DEVI Item decode_gq(int L) {
    Item it; const int xcd = L & 7, k = L >> 3;
    if (PAIRED) { const int gi = k >> 5, x = k & 31, bg = gi * 8 + xcd; it.b = bg >> 2; it.head = (bg & 3) * 4; it.qb0 = x; it.qb1 = 63 - x; }
    else { const int gi = k >> 6, x = k & 63, bg = gi * 8 + xcd; it.b = bg >> 2; it.head = (bg & 3) * 4; it.qb0 = it.qb1 = (x & 32) ? 63 - (x & 31) : (x & 31); }
    return it;
}
template <int MODE, bool GQ = false> DEVI ABlock mkref(const Item& it, int pass, const u16* z, const unsigned char* z8, const unsigned char* kcmp8, const u16* vcmp) {
    const int qb = pass ? it.qb1 : it.qb0; ABlock r; r.b = it.b; r.head = it.head; r.P0 = qb * (GQ ? 64 : QB); r.row0 = it.b * 4096 + r.P0;
    r.Q = z8 + (size_t)r.row0 * 3072 + it.head * 128;
    const int g = it.head >> 2;
    if (MODE == M_WIN) { r.K = z8 + (size_t)it.b * 4096 * 3072 + 2560 + g * 128; r.V = z + (size_t)it.b * 4096 * NPAD + C_VW + g * 128; }
    else if (MODE == M_SEL) { r.K = z8 + (size_t)it.b * 4096 * 3072 + 2048 + g * 128; r.V = z + (size_t)it.b * 4096 * NPAD + C_VS + g * 128; }
    else { r.K = kcmp8 + (size_t)(it.b * 4 + g) * 256 * 128; r.V = vcmp; }
    return r;
}
template <int MODE, int EPI, int GK, int LDK, int LDK8, bool SK, bool PAIRED, bool GQ = false>
DEVI void run_pass(const u16* z, const unsigned char* z8, const unsigned char* kcmp8, const u16* vcmp, size_t vcmp_stride, char* lds, const Epi& E, const int tid_in, int G) {
    int tz_ = tid_in; asm volatile("" : "+v"(tz_)); const int tid = tz_;
    constexpr int total = PAIRED ? 512 : 1024;
    int L = blockIdx.x; if (L >= total) return;
    Item it = GQ ? decode_gq<PAIRED>(L) : decode<PAIRED>(L); int pass = 0;
    ABlock cur = mkref<MODE, GQ>(it, 0, z, z8, kcmp8, vcmp + (size_t)(it.b * 4 + (it.head >> 2)) * vcmp_stride);
    Seam S;
    prime<MODE, LDK, LDK8, GQ>(cur, lds, S, tid);
    for (;;) {
        const bool more_pass = pass == 0 && it.qb1 != it.qb0, more_item = L + G < total, last = !more_pass && !more_item;
        Item itn = it; int passn = pass + 1, Ln = L;
        if (!more_pass) { passn = 0; Ln = more_item ? L + G : L; itn = GQ ? decode_gq<PAIRED>(Ln) : decode<PAIRED>(Ln); }
        const ABlock nxt = last ? cur : mkref<MODE, GQ>(itn, passn, z, z8, kcmp8, vcmp + (size_t)(itn.b * 4 + (itn.head >> 2)) * vcmp_stride);
        block<MODE, EPI, GK, LDK, LDK8, SK, GQ>(cur, nxt, lds, S, E, tid);
        if (last) break;
        cur = nxt; it = itn; pass = passn; L = Ln;
    }
}
}

DEVI void phase_nsa1(KP a, unsigned char* lds, const int tid, int G) {
    unsigned char* ws = a->ws;
    const u16* z = (const u16*)(ws + WS_Z); const u16* kcmp = (const u16*)(ws + WS_KCMP); const u16* vcmp = kcmp + (size_t)16 * 256 * 128;
    att::Epi E{(const float*)(ws + WS_GATES), (u16*)(ws + WS_OC), nullptr, nullptr, (float*)(ws + WS_IMP), nullptr};
#ifndef NSA1_PASSES
#define NSA1_PASSES 7
#endif
#ifndef WIN_SK
#define WIN_SK false
#endif
    const unsigned char* z8 = ws + WS_Z8; const unsigned char* kcmp8 = ws + WS_KCMP8;
    if (NSA1_PASSES & 1) att::run_pass<att::M_CMP, att::E_GATED, 0, 128, 128, false, false, GQ_CV>(z, z8, kcmp8, vcmp, (size_t)256 * 128, (char*)lds, E, tid, G);
    __syncthreads();
    if (NSA1_PASSES & 2) att::run_pass<att::M_CMP, att::E_IMP, 0, 128, 128, false, false, GQ_CI>(z, z8, kcmp8, (const u16*)(ws + WS_OVL), 0, (char*)lds, E, tid, G);
    __syncthreads();
    E.dst = (u16*)(ws + WS_OW);
    if (NSA1_PASSES & 4) att::run_pass<att::M_WIN, att::E_GATED, 2, NPAD, 3072, WIN_SK, false, GQ_W>(z, z8, kcmp8, nullptr, 0, (char*)lds, E, tid, G);
}
DEVI void phase_topk(KP a, int lane, int wave, int G) {
    unsigned char* ws = a->ws; const float* imp = (const float*)(ws + WS_IMP); unsigned long long* sel = (unsigned long long*)(ws + WS_SEL);
    const int gw = blockIdx.x * 8 + wave, NGW = G * 8;
    float pf0[4], pf1[4];
    { const int task = gw * 2; if (task < M_ * 4) { const int bg = task >> 12, t = task & 4095, b = bg >> 2, g = bg & 3;
#pragma unroll
        for (int h = 0; h < 4; ++h) { const float* p = imp + ((size_t)(b * 16 + g * 4 + h) * 4096 + t) * 64 + lane; pf0[h] = p[0]; pf1[h] = p[64]; } } }
    for (int task = gw * 2; task < M_ * 4; task += NGW * 2) { const int bg = task >> 12, t = task & 4095;
        const float v0 = (pf0[0] + pf0[1]) + (pf0[2] + pf0[3]), v1 = (pf1[0] + pf1[1]) + (pf1[2] + pf1[3]);
        { const int tn = task + NGW * 2; if (tn < M_ * 4) { const int bgn = tn >> 12, t2 = tn & 4095, b = bgn >> 2, g = bgn & 3;
#pragma unroll
            for (int h = 0; h < 4; ++h) { const float* p = imp + ((size_t)(b * 16 + g * 4 + h) * 4096 + t2) * 64 + lane; pf0[h] = p[0]; pf1[h] = p[64]; } } }
        const int cur0 = t >> 6, cur1 = (t + 1) >> 6;
        const float s0 = ((lane == 0) || (lane == cur0) || (lane == cur0 - 1)) ? INFINITY : (lane <= cur0 ? v0 : -INFINITY);
        const float s1 = ((lane == 0) || (lane == cur1) || (lane == cur1 - 1)) ? INFINITY : (lane <= cur1 ? v1 : -INFINITY);
        int r0 = 0, r1 = 0;
#pragma unroll
        for (int jj = 0; jj < 64; ++jj) { const float a0 = __int_as_float(__builtin_amdgcn_readlane(__float_as_int(s0), jj)), a1 = __int_as_float(__builtin_amdgcn_readlane(__float_as_int(s1), jj));
            r0 += (a0 > s0 || (a0 == s0 && jj < lane)) ? 1 : 0; r1 += (a1 > s1 || (a1 == s1 && jj < lane)) ? 1 : 0; }
        const unsigned long long m0 = __ballot(r0 < 16 && lane <= cur0), m1 = __ballot(r1 < 16 && lane <= cur1);
        if (lane == 0) { sel[(size_t)bg * 4096 + t] = m0; sel[(size_t)bg * 4096 + t + 1] = m1; } }
}
DEVI void phase_nsa2(KP a, unsigned char* lds, const int tid, int G) {
    unsigned char* ws = a->ws;
    const u16* z = (const u16*)(ws + WS_Z);
    att::Epi E{(const float*)(ws + WS_GATES), (u16*)(ws + WS_O), (const u16*)(ws + WS_OC), (const u16*)(ws + WS_OW), nullptr, (const unsigned long long*)(ws + WS_SEL)};
    att::run_pass<att::M_SEL, att::E_FINAL, 1, NPAD, 3072, false, true, GQ_S>(z, ws + WS_Z8, nullptr, nullptr, 0, (char*)lds, E, tid, G);
}

typedef float f32x4_t __attribute__((ext_vector_type(4)));
DEVI void phase_ln1_router(KP a, unsigned char* lds, int tid, int lane, int wave, int G, int l) {
    unsigned char* ws = a->ws;
    const u16* pre = (const u16*)(ws + WS_H); u16* xa = (u16*)(ws + WS_XA); unsigned char* xb = ws + WS_XBF;
    const float* g1 = a->in[17] + l * D_; const float* b1 = a->in[18] + l * D_; const float* rb = a->in[20]; const float* wT = (const float*)(ws + WS_RWT);
    int* tokinfo = (int*)(ws + WS_MISC); int* hist = (int*)(ws + WS_MISC + 1280 * 1024);
    int* be = (int*)lds;
    float* lg = (float*)(lds + 1024);
    const int g4 = lane >> 4, l15 = lane & 15;
    for (int chunk = blockIdx.x; chunk < 256; chunk += G) {
      f32x4 gq[4][2], bq[4][2];
#pragma unroll
      for (int j = 0; j < 4; ++j)
#pragma unroll
          for (int hh = 0; hh < 2; ++hh) { gq[j][hh] = *(const f32x4*)(g1 + j * 512 + lane * 8 + 4 * hh); bq[j][hh] = *(const f32x4*)(b1 + j * 512 + lane * 8 + 4 * hh); }
      u32x4 pc[4], pn[4];
#pragma unroll
      for (int j = 0; j < 4; ++j) pc[j] = *(const u32x4*)(pre + (size_t)(chunk * 64 + wave * 8) * D_ + j * 512 + lane * 8);
      for (int rr = 0; rr < 8; ++rr) {
        const int row = chunk * 64 + wave * 8 + rr;
        if (rr < 7) {
#pragma unroll
            for (int j = 0; j < 4; ++j) pn[j] = *(const u32x4*)(pre + (size_t)(row + 1) * D_ + j * 512 + lane * 8); }
        float v[4][8]; float s = 0.f;
#pragma unroll
        for (int j = 0; j < 4; ++j) { unpack8(pc[j], v[j]); s += ((v[j][0] + v[j][1]) + (v[j][2] + v[j][3])) + ((v[j][4] + v[j][5]) + (v[j][6] + v[j][7])); }
        const float mean = wsum(s) * (1.f / D_); float q = 0.f;
#pragma unroll
        for (int j = 0; j < 4; ++j)
#pragma unroll
            for (int e = 0; e < 8; ++e) { v[j][e] -= mean; q += v[j][e] * v[j][e]; }
        const float rstd = 1.f / sqrtf(wsum(q) * (1.f / D_) + LN_EPS);
#pragma unroll
        for (int j = 0; j < 4; ++j) { const int c0 = j * 512 + lane * 8; float y[8];
#pragma unroll
            for (int e = 0; e < 8; ++e) y[e] = v[j][e] * rstd * gq[j][e >> 2][e & 3] + bq[j][e >> 2][e & 3];
            u32x4 wx; wx.x = pk2(y[0], y[1]); wx.y = pk2(y[2], y[3]); wx.z = pk2(y[4], y[5]); wx.w = pk2(y[6], y[7]); *(u32x4*)(xa + (size_t)row * D_ + c0) = wx;
            u32x2 w8; w8.x = pk4_fp8(y[0], y[1], y[2], y[3]); w8.y = pk4_fp8(y[4], y[5], y[6], y[7]); *(u32x2*)(xb + (size_t)row * D_ + c0) = w8; }
#pragma unroll
        for (int j = 0; j < 4; ++j) pc[j] = pn[j];
      }
      asm volatile("s_waitcnt vmcnt(0)" ::: "memory"); __syncthreads();
      {
          f32x4 racc[4][2];
#pragma unroll
          for (int rt = 0; rt < 4; ++rt) { racc[rt][0] = (f32x4){0.f, 0.f, 0.f, 0.f}; racc[rt][1] = (f32x4){0.f, 0.f, 0.f, 0.f}; }
          const u16* ap = xa + (size_t)(chunk * 64 + l15) * D_ + wave * 256 + 8 * g4; const float* bp = wT + (size_t)l15 * D_ + wave * 256 + 8 * g4;
#pragma unroll 2
          for (int blk = 0; blk < 8; ++blk) { u32x4 ar[4]; f32x4 br[2][2];
#pragma unroll
              for (int rt = 0; rt < 4; ++rt) ar[rt] = *(const u32x4*)(ap + (size_t)rt * 16 * D_ + 32 * blk);
#pragma unroll
              for (int et = 0; et < 2; ++et) { br[et][0] = *(const f32x4*)(bp + (size_t)et * 16 * D_ + 32 * blk); br[et][1] = *(const f32x4*)(bp + (size_t)et * 16 * D_ + 32 * blk + 4); }
#pragma unroll
              for (int rt = 0; rt < 4; ++rt) { float af[8]; unpack8(ar[rt], af);
#pragma unroll
                  for (int e = 0; e < 8; ++e) { racc[rt][0] = __builtin_amdgcn_mfma_f32_16x16x4f32(af[e], br[0][e >> 2][e & 3], racc[rt][0], 0, 0, 0); racc[rt][1] = __builtin_amdgcn_mfma_f32_16x16x4f32(af[e], br[1][e >> 2][e & 3], racc[rt][1], 0, 0, 0); } } }
          f32x4* part = (f32x4*)(lds + 16384);
#pragma unroll
          for (int rt = 0; rt < 4; ++rt) { part[(wave * 8 + rt * 2) * 64 + lane] = racc[rt][0]; part[(wave * 8 + rt * 2 + 1) * 64 + lane] = racc[rt][1]; }
          __syncthreads();
          { f32x4 v = part[wave * 64 + lane];
#pragma unroll
            for (int w2 = 1; w2 < 8; ++w2) v = v + part[(w2 * 8 + wave) * 64 + lane];
#pragma unroll
            for (int j = 0; j < 4; ++j) lg[((wave >> 1) * 16 + 4 * g4 + j) * 33 + (wave & 1) * 16 + l15] = v[j]; }
      }
      __syncthreads();
      if (tid < 64) { const int row = chunk * 64 + tid;
        float aff[32], sel[32];
#pragma unroll
        for (int e = 0; e < 32; ++e) { aff[e] = sigm(lg[tid * 33 + e]); sel[e] = aff[e] + rb[e]; }
        int bg_ = 0; float bs = -INFINITY;
#pragma unroll
        for (int gq = 0; gq < 8; ++gq) { const float s0 = sel[gq * 4], s1 = sel[gq * 4 + 1], s2 = sel[gq * 4 + 2], s3 = sel[gq * 4 + 3];
            const float mx = fmaxf(fmaxf(s0, s1), fmaxf(s2, s3));
            const float m2 = fmaxf(fmaxf(fminf(s0, s1), fminf(s2, s3)), fminf(fmaxf(s0, s1), fmaxf(s2, s3)));
            const float gs = mx + m2; if (gs > bs) { bs = gs; bg_ = gq; } }
        float c0 = 0.f, c1 = 0.f, c2 = 0.f, c3 = 0.f, a0 = 0.f, a1 = 0.f, a2 = 0.f, a3 = 0.f;
#pragma unroll
        for (int gq = 0; gq < 8; ++gq) if (gq == bg_) { c0 = sel[gq * 4]; c1 = sel[gq * 4 + 1]; c2 = sel[gq * 4 + 2]; c3 = sel[gq * 4 + 3]; a0 = aff[gq * 4]; a1 = aff[gq * 4 + 1]; a2 = aff[gq * 4 + 2]; a3 = aff[gq * 4 + 3]; }
        int i1 = 0; float m1 = c0;
        if (c1 > m1) { m1 = c1; i1 = 1; } if (c2 > m1) { m1 = c2; i1 = 2; } if (c3 > m1) { m1 = c3; i1 = 3; }
        int i2 = -1; float m2v = -INFINITY;
        if (i1 != 0 && c0 > m2v) { m2v = c0; i2 = 0; } if (i1 != 1 && c1 > m2v) { m2v = c1; i2 = 1; } if (i1 != 2 && c2 > m2v) { m2v = c2; i2 = 2; } if (i1 != 3 && c3 > m2v) { m2v = c3; i2 = 3; }
        if (i2 < 0) i2 = (i1 == 0) ? 1 : 0;
        float w1 = i1 == 0 ? a0 : i1 == 1 ? a1 : i1 == 2 ? a2 : a3, w2 = i2 == 0 ? a0 : i2 == 1 ? a1 : i2 == 2 ? a2 : a3;
        const float ws_ = w1 + w2; w1 /= ws_; w2 /= ws_;
        const int e1 = bg_ * 4 + i1, e2 = bg_ * 4 + i2;
        int* ti = tokinfo + (size_t)row * 8; ti[0] = e1; ti[2] = e2; ti[4] = __float_as_int(w1); ti[5] = __float_as_int(w2);
        int r1 = 0, r2 = 0, myh = 0;
        const unsigned long long lt = (1ull << lane) - 1ull;
        for (int e = 0; e < 32; ++e) { const unsigned long long mm1 = __ballot(e1 == e), mm2 = __ballot(e2 == e);
            const int below = __popcll(mm1 & lt) + __popcll(mm2 & lt);
            if (e1 == e) r1 = below; if (e2 == e) r2 = below; if (lane == e) myh = __popcll(mm1) + __popcll(mm2); }
        ti[1] = r1; ti[3] = r2;
        if (lane < 32) hist[chunk * 32 + lane] = myh; }
      __syncthreads();
    }
    (void)be;
}
DEVI int moe_base(const unsigned* cnt, int lane, int& base_out) {
    const unsigned c = cnt[lane & 31]; const int tiles = (int)((c + 255u) >> 8); int incl = tiles;
#pragma unroll
    for (int o = 1; o < 32; o <<= 1) { const int t_ = __shfl_up(incl, o); if ((lane & 31) >= o) incl += t_; }
    base_out = (incl - tiles) * 256; return __shfl(incl, 31);
}
DEVI void phase_moe_gather(KP a, unsigned char* lds, int tid, int lane, int wave, int G, int l) {
    unsigned char* ws = a->ws;
    unsigned* cnt = (unsigned*)(ws + WS_CTL) + CW_CNT + l * 32; int* tokinfo = (int*)(ws + WS_MISC); const int* hist = (const int*)(ws + WS_MISC + 1280 * 1024);
    const unsigned char* xb = ws + WS_XBF; unsigned char* xg = ws + WS_XG; float* roww = (float*)(ws + WS_MISC + 1 * MiB);
    int* so = (int*)lds;
    for (int chunk = blockIdx.x; chunk < 256; chunk += G) {
        if (tid < 64) so[tid] = 0;
        __syncthreads();
        { const int e = tid & 31, seg = tid >> 5; int below = 0, all = 0;
          for (int b2 = seg * 16; b2 < seg * 16 + 16; ++b2) { const int h = hist[b2 * 32 + e]; all += h; if (b2 < chunk) below += h; }
          atomicAdd(&so[e], below); atomicAdd(&so[32 + e], all); }
        __syncthreads();
        if (wave == 0) { const int c = so[32 + (lane & 31)]; const int tiles = (c + 255) >> 8; int incl = tiles;
#pragma unroll
            for (int o = 1; o < 32; o <<= 1) { const int t_ = __shfl_up(incl, o); if ((lane & 31) >= o) incl += t_; }
            if (lane < 32) { so[64 + lane] = (incl - tiles) * 256; if (chunk == 0) cnt[lane] = (unsigned)c; } }
        __syncthreads();
        for (int r0 = 0; r0 < 8; r0 += 4) { u32x4 cp[4][2]; int sl0[4], sl1[4];
#pragma unroll
            for (int q = 0; q < 4; ++q) { const int row = chunk * 64 + wave * 8 + r0 + q; const int* ti = tokinfo + (size_t)row * 8;
                const int e0 = ti[0], rk0 = ti[1], e1 = ti[2], rk1 = ti[3]; sl0[q] = so[64 + e0] + so[e0] + rk0; sl1[q] = so[64 + e1] + so[e1] + rk1;
                const u32x4* src = (const u32x4*)(xb + (size_t)row * D_); cp[q][0] = src[lane]; cp[q][1] = src[64 + lane]; }
#pragma unroll
            for (int q = 0; q < 4; ++q) { const int row = chunk * 64 + wave * 8 + r0 + q; int* ti = tokinfo + (size_t)row * 8;
                u32x4* d0 = (u32x4*)(xg + (size_t)sl0[q] * D_); u32x4* d1 = (u32x4*)(xg + (size_t)sl1[q] * D_);
                d0[lane] = cp[q][0]; d0[64 + lane] = cp[q][1]; d1[lane] = cp[q][0]; d1[64 + lane] = cp[q][1];
                if (lane == 0) { roww[sl0[q]] = __int_as_float(ti[4]); roww[sl1[q]] = __int_as_float(ti[5]); ti[6] = sl0[q]; ti[7] = sl1[q]; } } }
        __syncthreads();
    }
}
DEVI void phase_ln2(KP a, int lane, int wave, int G, int l) {
    unsigned char* ws = a->ws;
    const int* tokinfo = (const int*)(ws + WS_MISC);
    const u16* xa = (const u16*)(ws + WS_XA); const u16* Y = (const u16*)(ws + WS_Y); unsigned char* x8 = ws + WS_X8;
    float* xo = a->out; u16* xoh = (u16*)(ws + WS_XB);
    const float* g2 = a->in[24] + l * D_; const float* b2 = a->in[25] + l * D_;
    const int gw = blockIdx.x * 8 + wave, NGW = G * 8;
    int row = gw; if (row >= M_) return;
    f32x4 gq[4][2], bq[4][2];
#pragma unroll
    for (int j = 0; j < 4; ++j)
#pragma unroll
        for (int hh = 0; hh < 2; ++hh) { gq[j][hh] = *(const f32x4*)(g2 + j * 512 + lane * 8 + 4 * hh); bq[j][hh] = *(const f32x4*)(b2 + j * 512 + lane * 8 + 4 * hh); }
    u32x4 cx[4], c1[4], c2[4], nx[4], n1[4], n2[4];
    int s1 = tokinfo[(size_t)row * 8 + 6], s2 = tokinfo[(size_t)row * 8 + 7];
#pragma unroll
    for (int j = 0; j < 4; ++j) { const int c0 = j * 512 + lane * 8; cx[j] = *(const u32x4*)(xa + (size_t)row * D_ + c0); c1[j] = *(const u32x4*)(Y + (size_t)s1 * D_ + c0); c2[j] = *(const u32x4*)(Y + (size_t)s2 * D_ + c0); }
    int rn = row + NGW, t1 = 0, t2 = 0;
    if (rn < M_) { t1 = tokinfo[(size_t)rn * 8 + 6]; t2 = tokinfo[(size_t)rn * 8 + 7]; }
    for (;;) {
        const bool more = rn < M_;
        if (more) {
#pragma unroll
            for (int j = 0; j < 4; ++j) { const int c0 = j * 512 + lane * 8; nx[j] = *(const u32x4*)(xa + (size_t)rn * D_ + c0); n1[j] = *(const u32x4*)(Y + (size_t)t1 * D_ + c0); n2[j] = *(const u32x4*)(Y + (size_t)t2 * D_ + c0); } }
        const int rnn = rn + NGW; int u1 = 0, u2 = 0;
        if (rnn < M_) { u1 = tokinfo[(size_t)rnn * 8 + 6]; u2 = tokinfo[(size_t)rnn * 8 + 7]; }
        float v[4][8]; float s = 0.f;
#pragma unroll
        for (int j = 0; j < 4; ++j) { float xv[8], y1[8], y2[8]; unpack8(cx[j], xv); unpack8(c1[j], y1); unpack8(c2[j], y2);
#pragma unroll
            for (int e = 0; e < 8; ++e) { v[j][e] = xv[e] * ALPHA + (y1[e] + y2[e]); }
            s += ((v[j][0] + v[j][1]) + (v[j][2] + v[j][3])) + ((v[j][4] + v[j][5]) + (v[j][6] + v[j][7])); }
        const float mean = wsum(s) * (1.f / D_); float q = 0.f;
#pragma unroll
        for (int j = 0; j < 4; ++j)
#pragma unroll
            for (int e = 0; e < 8; ++e) { v[j][e] -= mean; q += v[j][e] * v[j][e]; }
        const float rstd = 1.f / sqrtf(wsum(q) * (1.f / D_) + LN_EPS);
#pragma unroll
        for (int j = 0; j < 4; ++j) { const int c0 = j * 512 + lane * 8; float y[8];
#pragma unroll
            for (int e = 0; e < 8; ++e) y[e] = v[j][e] * rstd * gq[j][e >> 2][e & 3] + bq[j][e >> 2][e & 3];
            if (l == 0) { u32x4 wo; wo.x = pk2(y[0], y[1]); wo.y = pk2(y[2], y[3]); wo.z = pk2(y[4], y[5]); wo.w = pk2(y[6], y[7]); *(u32x4*)(xoh + (size_t)row * D_ + c0) = wo;
                u32x2 w8; w8.x = pk4_fp8(y[0], y[1], y[2], y[3]); w8.y = pk4_fp8(y[4], y[5], y[6], y[7]); *(u32x2*)(x8 + (size_t)row * D_ + c0) = w8; }
            else { *(f32x4*)(xo + (size_t)row * D_ + c0) = (f32x4){y[0], y[1], y[2], y[3]}; *(f32x4*)(xo + (size_t)row * D_ + c0 + 4) = (f32x4){y[4], y[5], y[6], y[7]}; } }
        if (!more) break;
        row = rn; rn = rnn; t1 = u1; t2 = u2;
#pragma unroll
        for (int j = 0; j < 4; ++j) { cx[j] = nx[j]; c1[j] = n1[j]; c2[j] = n2[j]; }
    }
}

constexpr int NGEMM = 15360;
DEVI void phase_gates(KP a, unsigned char* lds, int tid, int G, int l) {
    using pg8::i32x8_; using pg8::i32x4_;
    unsigned char* ws = a->ws;
    const unsigned char* X = ws + WS_X8; const unsigned char* W = ws + WS_WIN + (size_t)l * NPAD * D_ + (size_t)NGEMM * D_;
    const float* bias = (const float*)(ws + WS_BIASP) + l * NPAD + NGEMM; float* gates = (float*)(ws + WS_GATES);
    const int lane = tid & 63, wave = tid >> 6, g4 = lane >> 4, l15 = lane & 15;
    f32x4* red = (f32x4*)lds;
    float* gl = (float*)(lds + 131072);
    const int sclW = 0x79797979, sclA = 0x7f7f7f7f;
    for (int unit = blockIdx.x; unit < M_ / 64; unit += G) {
        const unsigned char* ap = X + (size_t)(unit * 64 + l15) * D_ + wave * 256 + 32 * g4;
        const unsigned char* bp = W + (size_t)l15 * D_ + wave * 256 + 32 * g4;
        i32x8_ af[4][2], bf[4][2];
#pragma unroll
        for (int t = 0; t < 4; ++t)
#pragma unroll
            for (int ks = 0; ks < 2; ++ks) {
                af[t][ks] = __builtin_shufflevector(*(const i32x4_*)(ap + (size_t)t * 16 * D_ + 128 * ks), *(const i32x4_*)(ap + (size_t)t * 16 * D_ + 128 * ks + 16), 0, 1, 2, 3, 4, 5, 6, 7);
                bf[t][ks] = __builtin_shufflevector(*(const i32x4_*)(bp + (size_t)t * 16 * D_ + 128 * ks), *(const i32x4_*)(bp + (size_t)t * 16 * D_ + 128 * ks + 16), 0, 1, 2, 3, 4, 5, 6, 7); }
        f32x4 acc[4][4];
#pragma unroll
        for (int rt = 0; rt < 4; ++rt)
#pragma unroll
            for (int ct = 0; ct < 4; ++ct) acc[rt][ct] = (f32x4){0.f, 0.f, 0.f, 0.f};
#pragma unroll
        for (int ks = 0; ks < 2; ++ks)
#pragma unroll
            for (int rt = 0; rt < 4; ++rt)
#pragma unroll
                for (int ct = 0; ct < 4; ++ct) asm volatile("v_mfma_scale_f32_16x16x128_f8f6f4 %0, %1, %2, %0, %3, %4 op_sel_hi:[0,0,0]" : "+v"(acc[rt][ct]) : "v"(bf[ct][ks]), "v"(af[rt][ks]), "v"(sclW), "v"(sclA));
        asm volatile("s_nop 15\n\ts_nop 15\n\ts_nop 15\n\ts_nop 15" ::: "memory");
#pragma unroll
        for (int rt = 0; rt < 4; ++rt)
#pragma unroll
            for (int ct = 0; ct < 4; ++ct) red[(wave * 16 + rt * 4 + ct) * 64 + lane] = acc[rt][ct];
        __syncthreads();
#pragma unroll
        for (int q = 0; q < 2; ++q) { const int tile = 2 * wave + q, rt = tile >> 2, ct = tile & 3, row = unit * 64 + rt * 16 + l15, col = ct * 16 + 4 * g4;
            f32x4 v = red[tile * 64 + lane];
#pragma unroll
            for (int w = 1; w < 8; ++w) v = v + red[(w * 16 + tile) * 64 + lane];
            if (col < 56) { const f32x4 gv_ = v + *(const f32x4*)(bias + col); *(f32x4*)(gates + (size_t)row * 64 + col) = gv_;
                if (col < 8) *(f32x4*)(gl + (rt * 16 + l15) * 8 + col) = gv_; } }
        __syncthreads();
        if (wave < 4) {
            const float ig = gl[lane * 8 + wave], fg = gl[lane * 8 + 4 + wave];
            float bc = fminf(fg, 0.f) - log1pf(__expf(-fabsf(fg)));
#pragma unroll
            for (int o = 1; o < 64; o <<= 1) { const float t_ = __shfl_up(bc, o); if (lane >= o) bc += t_; }
            const float L_ = wmax(ig - bc), S_ = __shfl(bc, 63);
            if (lane == 0) { float* ch = (float*)(ws + WS_CHS) + ((size_t)unit * 4 + wave) * 2; ch[0] = S_; ch[1] = L_; } }
        __syncthreads();
    }
}
__global__ void __launch_bounds__(512, 2) fwd_kernel(Args args) {
    extern __shared__ __attribute__((aligned(16))) unsigned char lds_raw[];
    LAS unsigned char* ldsl = (LAS unsigned char*)lds_raw;
    unsigned char* lds = lds_raw;
    const int G = gridDim.x;
    const int wave_sg = __builtin_amdgcn_readfirstlane(threadIdx.x >> 6);
    unsigned char* ws = args.ws;
    volatile LAS unsigned* lctl = (volatile LAS unsigned*)(ldsl + LDSCTL_OFF);
    if (wave_sg == 0) { const int l_ = (int)__builtin_amdgcn_mbcnt_hi(~0u, __builtin_amdgcn_mbcnt_lo(~0u, 0u)); for (int u = l_; u < 256; u += 64) lctl[u] = 0u; }
    __syncthreads();
    const int lo = args.ph_lo, hi = args.ph_hi;
    const bool one = (hi - lo) > 1;
    XcdBarrier bar; bar.bar = (unsigned*)(ws + WS_CTL) + CW_BAR; bar.x = 0; bar.st = lctl; bar.wv = wave_sg;
    if (one) bar = xcd_barrier_post((unsigned*)(ws + WS_CTL) + CW_BAR, lctl, wave_sg);
#ifndef ONLY_PHASE
#define ONLY_PHASE -1
#endif
#define LAUNDER() int wv_ = wave_sg; asm volatile("" : "+s"(wv_)); int tz_ = wv_ * 64 + (int)__builtin_amdgcn_mbcnt_hi(~0u, __builtin_amdgcn_mbcnt_lo(~0u, 0u)); asm volatile("" : "+v"(tz_)); const int tid = tz_, lane = tz_ & 63, wave = wv_; (void)tid; (void)lane; (void)wave; \
    unsigned long long kp_ = (unsigned long long)__builtin_amdgcn_kernarg_segment_ptr(); asm volatile("" : "+s"(kp_)); \
    const KP la = (KP)kp_; unsigned char* const ws = la->ws; (void)ws
#define INR(k) (lo <= (k) && (k) < hi)
#define IN0 ((ONLY_PHASE < 0 || ONLY_PHASE == 0) && INR(0))
#define INL(j) ((ONLY_PHASE < 0 || ONLY_PHASE == 1 + (j)) && INR(pb + (j)))
#define SEAM(k) do { if (INR(k) && INR((k) + 1)) xcd_barrier(bar); else __syncthreads(); } while (0)

    if (IN0) { LAUNDER(); phase_prologue(la, lds, tid, lane, wave, G); phase_experts(la, lds, lane, wave, G, 0); SEAM(0); }

    for (int l = 0; l < 2; ++l) {
        const int pb = 1 + l * PPL;
        if (INL(0)) { LAUNDER();
            pg8::Gemm g{(const u16*)(ws + WS_X8), (const u16*)(ws + WS_WIN + (size_t)l * NPAD * D_), D_ / 2, D_ / 2, 0x79797979, 0x7f7f7f7f};
            pg8::StaticOrder S; S.init(M_, NGEMM, G, (int)blockIdx.x);
            EpiInProj E{(u16*)(ws + WS_Z), (const float*)(ws + WS_BIASP) + l * NPAD, (float*)(ws + WS_GATES), (u16*)(ws + WS_KC), (const float*)(ws + WS_ROPE), (const float*)(ws + WS_ROPE) + 4096 * 64, ws + WS_Z8};
            pg8::gemm_phase<EpiInProj, pg8::StaticOrder, true>(ldsl, g, S, E, tid);
            __syncthreads();
            phase_gates(la, lds, tid, G, l);
            SEAM(pb + 0);
        }
        if (INL(1)) { LAUNDER();
            pg8::Gemm g{(const u16*)(ws + WS_KC), (const u16*)(ws + WS_CW1 + (size_t)l * 512 * 2048), 1024, 1024, 0x79797979, 0x7f7f7f7f};
            CmpOrder S{G, (int)blockIdx.x};
            EpiF32Tile E{(float*)(ws + WS_U), 256};
            pg8::gemm_phase<EpiF32Tile, CmpOrder, true>(ldsl, g, S, E, tid);
            phase_mlstm_pre(la, lds, tid, G, G >= 64 ? 32 : 0);
            SEAM(pb + 1);
        }
        if (INL(2)) { LAUNDER(); phase_mlstm(la, lds, tid, G); phase_cmp2(la, lds, tid, G, l); SEAM(pb + 2); }
        if (INL(3)) { LAUNDER(); phase_nsa1(la, lds, tid, G); phase_norm(la, lane, wave, G, l); SEAM(pb + 3); }
        if (INL(4)) { LAUNDER(); phase_topk(la, lane, wave, G); SEAM(pb + 4); }
        if (INL(5)) { LAUNDER(); phase_nsa2(la, lds, tid, G); __syncthreads();
            {
            pg8::Gemm g{(const u16*)(ws + WS_XBF), (const u16*)(ws + WS_WB) + (size_t)(l * 3 + 0) * D_ * D_, D_ / 2, D_ / 2, 0x79797979, 0x7e7e7e7e};
            pg8::StaticOrder S; S.init(M_, D_, G, (int)blockIdx.x);
            EpiGate<false> E{(u16*)(ws + WS_MRG), (const u16*)(ws + WS_Z), C_GM};
            pg8::gemm_phase<EpiGate<false>, pg8::StaticOrder, true>(ldsl, g, S, E, tid);
            }
            SEAM(pb + 5);
        }
        if (INL(6)) { LAUNDER();
            pg8::Gemm g{(const u16*)(ws + WS_O), (const u16*)(ws + WS_WB) + (size_t)(l * 3 + 1) * D_ * D_, D_ / 2, D_ / 2, 0x79797979, 0x7c7c7c7c};
            pg8::StaticOrder S; S.init(M_, D_, G, (int)blockIdx.x);
            EpiGate<true> E{(u16*)(ws + WS_MRG), (const u16*)(ws + WS_Z), C_GM + 2048};
            pg8::gemm_phase<EpiGate<true>, pg8::StaticOrder, true>(ldsl, g, S, E, tid);
            SEAM(pb + 6);
        }
        if (INL(7)) { LAUNDER();
            pg8::Gemm g{(const u16*)(ws + WS_MRG), (const u16*)(ws + WS_WB) + (size_t)(l * 3 + 2) * D_ * D_, D_, D_};
            pg8::StaticOrder S; S.init(M_, D_, G, (int)blockIdx.x);
            EpiResid E{(u16*)(ws + WS_H), la->in[0], l == 0 ? (const u16*)nullptr : (const u16*)(ws + WS_XB)};
            pg8::gemm_phase(ldsl, g, S, E, tid);
            SEAM(pb + 7);
        }
        if (INL(8)) { LAUNDER(); phase_ln1_router(la, lds, tid, lane, wave, G, l); SEAM(pb + 8); }
        if (INL(9)) { LAUNDER(); phase_moe_gather(la, lds, tid, lane, wave, G, l); SEAM(pb + 9); }
        if (INL(10) || INL(11)) { LAUNDER();
            const unsigned* cnt = (const unsigned*)(ws + WS_CTL) + CW_CNT + l * 32;
            volatile LAS int* tstart = (volatile LAS int*)(lctl + 16);
            if (wave == 0) { int mybase; const int nt_ = moe_base(cnt, lane, mybase); if (lane < 32) tstart[lane] = mybase >> 8; if (lane == 32) tstart[32] = nt_; }
            __syncthreads();
            const int ntiles = tstart[32];
            if (INL(10)) { LAUNDER();
                pg8::Gemm g{(const u16*)(ws + WS_XG), (const u16*)(ws + WS_W13), D_ / 2, D_ / 2, 0x79797979, 0x7f7f7f7f};
                MoeOrder S{G, (int)blockIdx.x, ntiles, tstart};
                EpiSwiGLU E{ws + WS_HB};
                pg8::gemm_phase<EpiSwiGLU, MoeOrder, true>(ldsl, g, S, E, tid);
                SEAM(pb + 10);
            }
            if (INL(11)) { LAUNDER();
                pg8::Gemm g{(const u16*)(ws + WS_HB), (const u16*)(ws + WS_W2), DFF / 2, DFF / 2, 0x79797979, 0x7f7f7f7f};
                MoeOrder S{G, (int)blockIdx.x, ntiles, tstart};
                EpiScaleRow E{(u16*)(ws + WS_Y), (const float*)(ws + WS_MISC + 1 * MiB)};
                pg8::gemm_phase<EpiScaleRow, MoeOrder, true>(ldsl, g, S, E, tid);
                SEAM(pb + 11);
            }
        }
        if (INL(12)) { LAUNDER(); phase_ln2(la, lane, wave, G, l); if (l == 0) phase_experts(la, lds, lane, wave, G, 1); SEAM(pb + 12); }
    }
#undef INR
#undef IN0
#undef INL
#undef SEAM
}

extern "C" void kernel_launch(void* const* d_in, const int* in_sizes, int n_in, void* d_out, int out_size, void* d_ws, size_t ws_size, hipStream_t stream) {
    static int grid = 0;
    if (grid == 0) {
        if (n_in != 26 || out_size != M_ * D_ || ws_size < WS_END5) { fprintf(stderr, "kernel_launch: unexpected problem (n_in %d out %d ws %zu need %zu)\n", n_in, out_size, ws_size, (size_t)WS_END); grid = -1; return; }
        int dev = 0, cus = 0;
        if (hipGetDevice(&dev) != hipSuccess || hipDeviceGetAttribute(&cus, hipDeviceAttributeMultiprocessorCount, dev) != hipSuccess) { grid = -1; return; }
        if (hipFuncSetAttribute((const void*)fwd_kernel, hipFuncAttributeMaxDynamicSharedMemorySize, LDS_BYTES) != hipSuccess) { fprintf(stderr, "kernel_launch: hipFuncSetAttribute failed\n"); grid = -1; return; }
        int per_cu = 0;
        if (hipOccupancyMaxActiveBlocksPerMultiprocessor(&per_cu, (const void*)fwd_kernel, 512, LDS_BYTES) != hipSuccess || per_cu < 1) fprintf(stderr, "kernel_launch: occupancy query reports %d\n", per_cu);
        (void)hipGetLastError();
        grid = cus;
    }
    if (grid < 0) return;
    (void)hipMemsetAsync((char*)d_ws + WS_CTL, 0, CTL_BYTES, stream);
    Args a{};
    for (int i = 0; i < 26; ++i) a.in[i] = (const float*)d_in[i];
    a.out = (float*)d_out; a.ws = (unsigned char*)d_ws;
#if MK_ONE_LAUNCH
    a.ph_lo = 0; a.ph_hi = NPH;
    hipLaunchKernelGGL(fwd_kernel, dim3(grid), dim3(512), LDS_BYTES, stream, a);
#else
#ifdef DBG_STOP
    for (int p = 0; p < DBG_STOP; ++p) { a.ph_lo = p; a.ph_hi = p + 1; hipLaunchKernelGGL(fwd_kernel, dim3(grid), dim3(512), LDS_BYTES, stream, a); }
    (void)hipMemcpyAsync(d_out, (char*)d_ws + DBG_SRC, (size_t)M_ * D_ * 4, hipMemcpyDeviceToDevice, stream);
#else
#ifndef REP_N
#define REP_N 1
#define REP_LO 99
#define REP_HI 99
#endif
    for (int p = 0; p < NPH; ++p) {
        const int j = p == 0 ? -1 : (p - 1) % PPL;
        if (j == REP_LO) { for (int r = 0; r < REP_N; ++r) for (int q = p; q <= p + (REP_HI - REP_LO); ++q) { a.ph_lo = q; a.ph_hi = q + 1; hipLaunchKernelGGL(fwd_kernel, dim3(grid), dim3(512), LDS_BYTES, stream, a); } p += REP_HI - REP_LO; continue; }
        a.ph_lo = p; a.ph_hi = p + 1; hipLaunchKernelGGL(fwd_kernel, dim3(grid), dim3(512), LDS_BYTES, stream, a); }
#endif
#endif
}
```

```cpp
#include <hip/hip_runtime.h>
#include <cstdio>
#include <cstdint>

#ifndef MK_ONE_LAUNCH
#define MK_ONE_LAUNCH 1
#endif

#define LAS __attribute__((address_space(3)))
#define DEVI __device__ __forceinline__
typedef unsigned short u16;
typedef short bf16x8 __attribute__((ext_vector_type(8)));
typedef float f32x4 __attribute__((ext_vector_type(4)));
typedef float f32x2 __attribute__((ext_vector_type(2)));
typedef unsigned u32x4 __attribute__((ext_vector_type(4)));
typedef unsigned u32x2 __attribute__((ext_vector_type(2)));

constexpr int T_ = 4096, D_ = 2048, M_ = 16384;
constexpr int NPAD = 15616, IN_W = 15416;
constexpr int C_MQ = 0, C_MK = 1024, C_MV = 2048, C_MO = 4096, C_NQ = 6144, C_KC = 8192, C_VC = 8704, C_KS = 9216, C_VS = 9728, C_KW = 10240,
              C_VW = 10752, C_GM = 11264, C_GT = 15360;
constexpr int S_MI = 6144, S_NQ = 6152, S_KC = 8200, S_KS = 9224, S_VS = 9736, S_KW = 10248, S_VW = 10760, S_NG = 11272, S_GM = 11320;
constexpr float ALPHA = 1.4142135623730951f;
constexpr float LN_EPS = 1e-5f;
constexpr int NEXP = 32, DFF = 1024;
constexpr int MOE_ROWS = 40960;

constexpr size_t MiB = 1u << 20;
constexpr size_t WS_CTL = 0, CTL_BYTES = 1 * MiB;
constexpr size_t WS_ROPE = 1 * MiB;
constexpr size_t WS_BIASP = 3 * MiB;
constexpr size_t WS_WIN = 4 * MiB;
constexpr size_t WS_WB = 126 * MiB;
constexpr size_t WS_CW1 = 174 * MiB;
constexpr size_t WS_W13 = 178 * MiB;
constexpr size_t WS_W2 = 434 * MiB;
constexpr size_t WS_XBF = 562 * MiB;
constexpr size_t WS_XA = 626 * MiB;
constexpr size_t WS_XB = 754 * MiB;
constexpr size_t WS_Z = 882 * MiB;
constexpr size_t WS_GATES = 1370 * MiB;
constexpr size_t WS_KC = 1374 * MiB;
constexpr size_t WS_U = 1406 * MiB;
constexpr size_t WS_KCMP = 1414 * MiB;
constexpr size_t WS_MISC = 1416 * MiB;
constexpr size_t WS_CHS = WS_MISC + 1800 * 1024;
constexpr size_t WS_H = 1418 * MiB;
constexpr size_t WS_HG = 1546 * MiB;
constexpr size_t WS_O = 1610 * MiB;
constexpr size_t WS_MRG = 1674 * MiB;
constexpr size_t WS_END = 1738 * MiB, WS_END2 = 1739 * MiB;
constexpr size_t WS_OC = WS_H, WS_OW = WS_H + 64 * MiB, WS_IMP = WS_MRG, WS_OVL = WS_MISC + 1728 * 1024, WS_SEL = WS_END;
constexpr size_t WS_RWT = WS_MISC + 512 * 1024;
constexpr size_t WS_X8 = 1739 * MiB, WS_END3 = 1771 * MiB;
constexpr size_t WS_Z8 = 1771 * MiB, WS_KCMP8 = 1819 * MiB, WS_END4 = 1820 * MiB;
constexpr size_t WS_OCG = 1820 * MiB, WS_END5 = 1884 * MiB;
constexpr size_t WS_XG = WS_Z, WS_HB = WS_Z + 160 * MiB, WS_Y = WS_Z + 240 * MiB;
constexpr int CW_BAR = 4096;
constexpr int CW_CNT = 16384;
constexpr int CW_B1P = 16640;

constexpr int RING_BYTES = 131072;
constexpr int LDSCTL_OFF = 143360;
constexpr int LDS_BYTES = 147456;

DEVI float bf2f(unsigned h) { return __uint_as_float(h << 16); }
DEVI unsigned f2bf(float f) { unsigned u = __float_as_uint(f); return (u + 0x7fffu + ((u >> 16) & 1u)) >> 16; }
DEVI unsigned pk2(float lo, float hi) { unsigned r; asm("v_cvt_pk_bf16_f32 %0, %1, %2" : "=v"(r) : "v"(lo), "v"(hi)); return r; }
DEVI unsigned pk4_fp8(float a, float b, float c, float d) {
    a = __builtin_amdgcn_fmed3f(a, 448.f, -448.f); b = __builtin_amdgcn_fmed3f(b, 448.f, -448.f); c = __builtin_amdgcn_fmed3f(c, 448.f, -448.f); d = __builtin_amdgcn_fmed3f(d, 448.f, -448.f);
    int w = __builtin_amdgcn_cvt_pk_fp8_f32(a, b, 0, false); w = __builtin_amdgcn_cvt_pk_fp8_f32(c, d, w, true); return (unsigned)w; }
DEVI float sigm(float x) { return 1.f / (1.f + __expf(-x)); }
DEVI float wsum(float v) {
#pragma unroll
    for (int o = 32; o; o >>= 1) v += __shfl_xor(v, o);
    return v; }
DEVI float wmax(float v) {
#pragma unroll
    for (int o = 32; o; o >>= 1) v = fmaxf(v, __shfl_xor(v, o));
    return v; }
#define WAVE_SYNC() asm volatile("s_waitcnt lgkmcnt(0)" ::: "memory")
DEVI void unpack8(u32x4 v, float* f) {
    f[0] = __uint_as_float(v.x << 16); f[1] = __uint_as_float(v.x & 0xffff0000u); f[2] = __uint_as_float(v.y << 16); f[3] = __uint_as_float(v.y & 0xffff0000u);
    f[4] = __uint_as_float(v.z << 16); f[5] = __uint_as_float(v.z & 0xffff0000u); f[6] = __uint_as_float(v.w << 16); f[7] = __uint_as_float(v.w & 0xffff0000u); }

#define XB_TMO      128
#define XB_XCNT(j)  (256  + 64 * (j))
#define XB_XSUB(j)  (1280 + 64 * (j))
#define XB_XGEN(j)  (2304 + 64 * (j))
#define XB_TOP      3328
#define XB_TOPGEN   3392
#define XCD_BAR_WORDS 3456
#define XB_SPIN_CAP (1u << 21)
DEVI unsigned xb_ld(unsigned* p)              { return __hip_atomic_load(p, __ATOMIC_RELAXED, __HIP_MEMORY_SCOPE_AGENT); }
DEVI unsigned xb_add(unsigned* p, unsigned v) { return __hip_atomic_fetch_add(p, v, __ATOMIC_RELAXED, __HIP_MEMORY_SCOPE_AGENT); }
DEVI unsigned xb_xcc_id() { return (unsigned)__builtin_amdgcn_s_getreg((3 << 11) | 20) & 0xFu; }
#define XB_SPIN(cond, bar) do { unsigned _sp = 0; while (cond) { __builtin_amdgcn_s_sleep(1); \
    if ((++_sp & 255u) == 0u) { if (xb_ld(&(bar)[XB_TMO])) break; if (_sp > XB_SPIN_CAP) { atomicAdd(&(bar)[XB_TMO], 1u); break; } } } } while (0)
struct XcdBarrier { unsigned* bar; unsigned x; volatile LAS unsigned* st; int wv; };
DEVI bool xb_leader(int wv) { return wv == 0 && __builtin_amdgcn_mbcnt_hi(~0u, __builtin_amdgcn_mbcnt_lo(~0u, 0u)) == 0u; }
DEVI XcdBarrier xcd_barrier_post(unsigned* bar, volatile LAS unsigned* st, int wv) {
    XcdBarrier b; b.bar = bar; b.x = xb_xcc_id(); b.st = st; b.wv = wv;
    if (xb_leader(wv)) (void)xb_add(&bar[XB_XCNT(b.x)], 1u);
    return b;
}
DEVI void xcd_barrier_complete(unsigned* bar, unsigned x, unsigned& nloc, unsigned& nx) {
    const unsigned G = gridDim.x * gridDim.y * gridDim.z;
    unsigned sum, cnt, mine, sp = 0u;
    for (;;) {
        sum = 0u; cnt = 0u; mine = 0u;
#pragma unroll
        for (unsigned j = 0; j < 16; ++j) { const unsigned c = xb_ld(&bar[XB_XCNT(j)]); sum += c; cnt += (c > 0u) ? 1u : 0u; mine = (j == x) ? c : mine; }
        if (sum == G) break;
        __builtin_amdgcn_s_sleep(1);
        if ((++sp & 255u) == 0u) { if (xb_ld(&bar[XB_TMO])) break; if (sp > XB_SPIN_CAP) { atomicAdd(&bar[XB_TMO], 1u); break; } }
    }
    nloc = mine > 0u ? mine : 1u; nx = cnt > 0u ? cnt : 1u;
}
__device__ __noinline__ void xcd_barrier_impl(unsigned* bar_, unsigned x_, volatile LAS unsigned* st_, int wv_) {
    XcdBarrier b; b.bar = bar_; b.x = x_; b.st = st_; b.wv = wv_;
    asm volatile("s_waitcnt vmcnt(0)" ::: "memory");
    __syncthreads();
    if (xb_leader(b.wv)) {
        unsigned* bar = b.bar;
        __builtin_amdgcn_s_waitcnt(0);
        unsigned nloc = b.st[0], nx = b.st[1];
        if (nloc == 0u) { xcd_barrier_complete(bar, b.x, nloc, nx); b.st[0] = nloc; b.st[1] = nx; }
        const unsigned old = xb_add(&bar[XB_XSUB(b.x)], 1u);
        const unsigned gen = old / nloc;
        if (old + 1u == (gen + 1u) * nloc) {
            __builtin_amdgcn_fence(__ATOMIC_RELEASE, "agent");
            asm volatile("s_waitcnt vmcnt(0)" ::: "memory");
            const unsigned og = xb_add(&bar[XB_TOP], 1u);
            const unsigned tg = og / nx;
            if (og + 1u == (tg + 1u) * nx) xb_add(&bar[XB_TOPGEN], 1u);
            else XB_SPIN(xb_ld(&bar[XB_TOPGEN]) == tg, bar);
            __builtin_amdgcn_fence(__ATOMIC_ACQUIRE, "agent");
            xb_add(&bar[XB_XGEN(b.x)], 1u);
            asm volatile("s_waitcnt vmcnt(0)" ::: "memory");
        } else {
            XB_SPIN(xb_ld(&bar[XB_XGEN(b.x)]) == gen, bar);
            __builtin_amdgcn_fence(__ATOMIC_ACQUIRE, "agent");
            asm volatile("s_waitcnt vmcnt(0)" ::: "memory");
        }
    }
    __syncthreads();
}

DEVI void xcd_barrier(const XcdBarrier& b) { xcd_barrier_impl(b.bar, b.x, b.st, b.wv); }

namespace pg8 {
constexpr int BM = 256, BK = 64, HALF = 128, HTB = HALF * BK * 2, STAGE_BYTES = 8 * HTB, NXCD = 8, WGM = 4;
__host__ __device__ __forceinline__ int lds_byte(int r, int c) { const int st = (r >> 4) * 2 + (c >> 5), rr = r & 15, cc = c & 31, ob = rr * 64 + cc * 2; return st * 1024 + (ob ^ (((ob >> 9) & 1) << 5)); }
__host__ __device__ __forceinline__ void stage_rc(int b, int& R, int& C) { const int st = b / 1024, sb = b % 1024, swz = sb ^ (((sb >> 9) & 1) << 5); R = (st >> 1) * 16 + swz / 64; C = (st & 1) * 32 + (swz % 64) / 2; }
__host__ __device__ __forceinline__ int perm32(int rho) { const int n = rho >> 4, i = rho & 15; return 8 * (i >> 2) + 4 * n + (i & 3); }

struct Unit { int pm, pn, pb; };
struct Gemm { const u16* A; const u16* Bt; int lda, K; int sclW = 0x7f7f7f7f, sclA = 0x7f7f7f7f; };

struct StaticOrder {
    int nM, nN, nwg, G, c;
    DEVI void init(int M, int N, int G_, int c_) { nM = M / BM; nN = N / BM; nwg = nM * nN; G = G_; c = c_; }
    DEVI bool next(int i, Unit& u) const {
        const long L = (long)i * G + c; if (L >= nwg) return false;
        int wgid = (int)L; { const int q = nwg / NXCD, r = nwg % NXCD, xcd = wgid % NXCD, off = wgid / NXCD; wgid = (xcd < r ? xcd * (q + 1) : r * (q + 1) + (xcd - r) * q) + off; }
        const int nig = WGM * nN, gid = wgid / nig, fm = gid * WGM, gsz = (nM - fm) < WGM ? (nM - fm) : WGM;
        u.pm = fm + ((wgid % nig) % gsz); u.pn = (wgid % nig) / gsz; u.pb = u.pn; return true;
    }
};

typedef int i32x4_ __attribute__((ext_vector_type(4)));
typedef int i32x8_ __attribute__((ext_vector_type(8)));
template <class Epi, class Sched, bool FP8 = false>
DEVI void gemm_phase(LAS unsigned char* lds, const Gemm g, const Sched& S, const Epi& E, const int tid) {
    const int wid = __builtin_amdgcn_readfirstlane(tid >> 6), lane = tid & 63, wr = wid >> 2, wc = wid & 3, fr = lane & 15, fq = lane >> 4;
    const int K = g.K, nt = K / BK, lda = g.lda; const int sclW = g.sclW, sclA = g.sclA; (void)sclW; (void)sclA;
    unsigned voffA[2], voffB[2];
#pragma unroll
    for (int i = 0; i < 2; ++i) { int R, C; stage_rc(tid * 16 + i * 8192, R, C); const int Rb = Epi::PERM ? ((R & ~31) + perm32(R & 31)) : R;
        voffA[i] = (unsigned)(R * lda + C) * 2u; voffB[i] = (unsigned)(Rb * K + C) * 2u; }
    const size_t kstep = (size_t)(BK * 2);
    const size_t hstepA = (size_t)HALF * lda * 2, tstepA = 2 * hstepA;
    const size_t hstepB = (size_t)HALF * K * 2, tstepB = 2 * hstepB;
    const unsigned ldsw = (unsigned)wid * 1024u;
    const int aoff = lds_byte(wr * 64 + fr, fq * 8), boff = lds_byte(wc * 32 + fr, fq * 8);
#define PG8_SA(b, h) (((b) * 2 + (h)) * HTB)
#define PG8_SB(b, h) ((4 + (b) * 2 + (h)) * HTB)
#define PG8_STAGE(bufoff, gbase, voff) do { _Pragma("unroll") for (int _i = 0; _i < 2; ++_i) \
        __builtin_amdgcn_global_load_lds((const unsigned*)((const char*)(gbase) + (voff)[_i]), (LAS unsigned*)(lds + (bufoff) + ldsw + _i * 8192), 16, 0, 0); } while (0)
#define PG8_LD2(addr) __builtin_shufflevector(*(const LAS i32x4_*)(addr), *(const LAS i32x4_*)((addr) + 1024), 0, 1, 2, 3, 4, 5, 6, 7)
#define PG8_LDA(dst, b, h) do { _Pragma("unroll") for (int m = 0; m < 4; ++m) dst[m] = PG8_LD2(lds + PG8_SA(b, h) + aoff + m * 2048); } while (0)
#define PG8_LDB(dst, b, h) do { _Pragma("unroll") for (int n = 0; n < 2; ++n) dst[n] = PG8_LD2(lds + PG8_SB(b, h) + boff + n * 2048); } while (0)
#define PG8_HALF(v, k) ((k) == 0 ? (bf16x8)__builtin_shufflevector(v, v, 0, 1, 2, 3) : (bf16x8)__builtin_shufflevector(v, v, 4, 5, 6, 7))
#define PG8_MMA(ai, bj, At, Bt) do { __builtin_amdgcn_s_setprio(1); _Pragma("unroll") for (int m = 0; m < 4; ++m) _Pragma("unroll") for (int n = 0; n < 2; ++n) { \
        if constexpr (FP8) { asm volatile("v_mfma_scale_f32_16x16x128_f8f6f4 %0, %1, %2, %0, %3, %4 op_sel_hi:[0,0,0]" : "+v"(acc[ai][bj][m][n]) : "v"(Bt[n]), "v"(At[m]), "v"(sclW), "v"(sclA)); } \
        else { _Pragma("unroll") for (int k = 0; k < 2; ++k) acc[ai][bj][m][n] = __builtin_amdgcn_mfma_f32_16x16x32_bf16(PG8_HALF(Bt[n], k), PG8_HALF(At[m], k), acc[ai][bj][m][n], 0, 0, 0); } } \
        __builtin_amdgcn_s_setprio(0); } while (0)
#define PG8_WAIT_V(n) asm volatile("s_waitcnt vmcnt(" #n ")" ::: "memory")
#define PG8_WAIT_L(n) asm volatile("s_waitcnt lgkmcnt(" #n ")" ::: "memory")
#define PG8_BAR __builtin_amdgcn_s_barrier()
#define PG8_SCHED __builtin_amdgcn_sched_barrier(0)
    Unit cur, nxt; int ui = 0;
    if (!S.next(0, cur)) return;
    f32x4 acc[2][2][4][2];
#pragma unroll
    for (int a = 0; a < 2; ++a)
#pragma unroll
        for (int b = 0; b < 2; ++b)
#pragma unroll
            for (int m = 0; m < 4; ++m)
#pragma unroll
                for (int n = 0; n < 2; ++n) acc[a][b][m][n] = (f32x4){0.f, 0.f, 0.f, 0.f};
    i32x8_ At[4], B0[2], B1[2];
    const char* cA = (const char*)g.A + (size_t)cur.pm * tstepA; const char* cB = (const char*)g.Bt + (size_t)cur.pb * tstepB;
    PG8_STAGE(PG8_SB(0, 0), cB, voffB); PG8_STAGE(PG8_SB(0, 1), cB + hstepB, voffB); PG8_STAGE(PG8_SA(0, 0), cA, voffA); PG8_STAGE(PG8_SA(0, 1), cA + hstepA, voffA);
    if (wr == 1) PG8_BAR;
    PG8_WAIT_V(2); PG8_BAR;
    PG8_STAGE(PG8_SB(1, 0), cB + kstep, voffB); PG8_STAGE(PG8_SA(1, 0), cA + kstep, voffA); PG8_STAGE(PG8_SB(1, 1), cB + hstepB + kstep, voffB);
    PG8_WAIT_V(6); PG8_BAR;
    for (;;) {
        const bool has_next = S.next(ui + 1, nxt);
        const char* nA = has_next ? (const char*)g.A + (size_t)nxt.pm * tstepA : cA; const char* nB = has_next ? (const char*)g.Bt + (size_t)nxt.pb * tstepB : cB;
        for (int t = 0; t < nt; t += 2) {
            const bool last = (t == nt - 2);
            const char* a1 = cA + (size_t)(t + 1) * kstep;
            const char* a2 = last ? nA : cA + (size_t)(t + 2) * kstep; const char* b2 = last ? nB : cB + (size_t)(t + 2) * kstep;
            const char* a3 = a2 + kstep; const char* b3 = b2 + kstep;
            PG8_LDB(B0, 0, 0); PG8_LDB(B1, 0, 1); PG8_SCHED; PG8_LDA(At, 0, 0); PG8_STAGE(PG8_SA(1, 1), a1 + hstepA, voffA);
            PG8_WAIT_V(8); PG8_WAIT_L(0); PG8_BAR; PG8_MMA(0, 0, At, B0); PG8_MMA(0, 1, At, B1); PG8_BAR; PG8_SCHED;
            PG8_LDA(At, 0, 1); PG8_STAGE(PG8_SB(0, 0), b2, voffB); PG8_STAGE(PG8_SB(0, 1), b2 + hstepB, voffB); PG8_STAGE(PG8_SA(0, 0), a2, voffA);
            PG8_WAIT_V(8); PG8_WAIT_L(0); PG8_BAR; PG8_MMA(1, 0, At, B0); PG8_MMA(1, 1, At, B1); PG8_BAR; PG8_SCHED;
            PG8_LDB(B0, 1, 0); PG8_LDB(B1, 1, 1); PG8_SCHED; PG8_LDA(At, 1, 0); PG8_STAGE(PG8_SA(0, 1), a2 + hstepA, voffA);
            PG8_WAIT_V(8); PG8_WAIT_L(0); PG8_BAR; PG8_MMA(0, 0, At, B0); PG8_MMA(0, 1, At, B1); PG8_BAR; PG8_SCHED;
            PG8_LDA(At, 1, 1); PG8_STAGE(PG8_SB(1, 0), b3, voffB); PG8_STAGE(PG8_SB(1, 1), b3 + hstepB, voffB); PG8_STAGE(PG8_SA(1, 0), a3, voffA);
            PG8_WAIT_V(8); PG8_WAIT_L(0); PG8_BAR; PG8_MMA(1, 0, At, B0); PG8_MMA(1, 1, At, B1); PG8_BAR; PG8_SCHED;
        }
        if (wr == 0) PG8_BAR;
        if constexpr (FP8) asm volatile("s_nop 15\n\ts_nop 15\n\ts_nop 15\n\ts_nop 15" ::: "memory");
        E(acc, cur, wr, wc, fr, fq);
        if (!has_next) break;
#pragma unroll
        for (int a = 0; a < 2; ++a)
#pragma unroll
            for (int b = 0; b < 2; ++b)
#pragma unroll
                for (int m = 0; m < 4; ++m)
#pragma unroll
                    for (int n = 0; n < 2; ++n) acc[a][b][m][n] = (f32x4){0.f, 0.f, 0.f, 0.f};
        cur = nxt; cA = nA; cB = nB; ++ui;
        if (wr == 1) PG8_BAR;
    }
    PG8_WAIT_V(0);
    PG8_BAR;
#undef PG8_SA
#undef PG8_SB
#undef PG8_STAGE
#undef PG8_LDA
#undef PG8_LD2
#undef PG8_HALF
#undef PG8_LDB
#undef PG8_MMA
#undef PG8_WAIT_V
#undef PG8_WAIT_L
#undef PG8_BAR
#undef PG8_SCHED
}
}
using pg8::Unit;

struct EpiInProj {
    static constexpr bool PERM = true;
    u16* z; const float* bias; float* gates; u16* kc; const float* cosT; const float* sinT; unsigned char* z8;
    DEVI void operator()(const f32x4 (&acc)[2][2][4][2], const Unit& u, int wr, int wc, int fr, int fq) const {
        const int pn = u.pn, row0 = u.pm * 256 + wr * 64 + fr, colt = pn * 256, cl0 = wc * 32 + 8 * fq;
        f32x4 bv[2][2];
#pragma unroll
        for (int bj = 0; bj < 2; ++bj)
#pragma unroll
            for (int n = 0; n < 2; ++n) bv[bj][n] = *(const f32x4*)(bias + colt + cl0 + bj * 128 + 4 * n);
        const float scale = pn < 4 ? 0.0625f : 1.f;
        const bool rope = (pn >= 24 && pn < 32) || pn == 36 || pn == 37 || pn == 40 || pn == 41;
        const bool kcv = pn >= 32 && pn < 36;
#pragma unroll
        for (int am = 0; am < 4; ++am) { const int ai = am >> 1, m0 = (am & 1) * 2;
            f32x4 csq[4], snq[4];
#pragma unroll
            for (int m = m0; m < m0 + 2; ++m) { csq[m] = (f32x4){1.f, 1.f, 1.f, 1.f}; snq[m] = (f32x4){0.f, 0.f, 0.f, 0.f};
                if (rope) { const int t_ = (row0 + ai * 128 + m * 16) & 4095; csq[m] = *(const f32x4*)(cosT + t_ * 64 + (cl0 >> 1)); snq[m] = *(const f32x4*)(sinT + t_ * 64 + (cl0 >> 1)); } }
#pragma unroll
            for (int m = m0; m < m0 + 2; ++m) { const int row = row0 + ai * 128 + m * 16, t = row & 4095;
                const f32x4 cs = csq[m], sn = snq[m];
#pragma unroll
                for (int bj = 0; bj < 2; ++bj) {
                    f32x4 v0 = (acc[ai][bj][m][0] + bv[bj][0]) * scale, v1 = (acc[ai][bj][m][1] + bv[bj][1]) * scale;
                    if (rope) {
                        const f32x4 a0 = v0, a1 = v1;
                        v0[0] = a0[0] * cs[0] - a0[1] * sn[0]; v0[1] = a0[1] * cs[0] + a0[0] * sn[0];
                        v0[2] = a0[2] * cs[1] - a0[3] * sn[1]; v0[3] = a0[3] * cs[1] + a0[2] * sn[1];
                        v1[0] = a1[0] * cs[2] - a1[1] * sn[2]; v1[1] = a1[1] * cs[2] + a1[0] * sn[2];
                        v1[2] = a1[2] * cs[3] - a1[3] * sn[3]; v1[3] = a1[3] * cs[3] + a1[2] * sn[3];
                    }
                    u32x4 w; w.x = pk2(v0[0], v0[1]); w.y = pk2(v0[2], v0[3]); w.z = pk2(v1[0], v1[1]); w.w = pk2(v1[2], v1[3]);
                    if (rope) { const int c8 = (pn < 32 ? (pn - 24) * 256 : pn < 38 ? 2048 + (pn - 36) * 256 : 2560 + (pn - 40) * 256) + bj * 128 + cl0;
                        u32x2 w8; w8.x = pk4_fp8(v0[0], v0[1], v0[2], v0[3]); w8.y = pk4_fp8(v1[0], v1[1], v1[2], v1[3]); *(u32x2*)(z8 + (size_t)row * 3072 + c8) = w8; }
                    if (rope) { }
                    else if (kcv) { const int cs_ = (pn - 32) * 256 + bj * 128 + cl0, which = cs_ >> 9, gg = (cs_ >> 7) & 3, dd = cs_ & 127, b = row >> 12;
                        u32x2 w8; w8.x = pk4_fp8(v0[0], v0[1], v0[2], v0[3]); w8.y = pk4_fp8(v1[0], v1[1], v1[2], v1[3]);
                        *(u32x2*)((unsigned char*)kc + ((size_t)((which * 16 + b * 4 + gg) * 4096 + t) * 128 + dd)) = w8; }
                    else *(u32x4*)(z + (size_t)row * NPAD + colt + bj * 128 + cl0) = w;
                }
            } }
    }
};
struct EpiF32Tile {
    static constexpr bool PERM = false;
    float* C; int ldc;
    DEVI void operator()(const f32x4 (&acc)[2][2][4][2], const Unit& u, int wr, int wc, int fr, int fq) const {
        const int row0 = u.pm * 256 + wr * 64 + fr, col0 = u.pn * 256 + wc * 32 + 4 * fq;
#pragma unroll
        for (int ai = 0; ai < 2; ++ai)
#pragma unroll
            for (int m = 0; m < 4; ++m) { float* rowp = C + (size_t)(row0 + ai * 128 + m * 16) * ldc + col0;
#pragma unroll
                for (int bj = 0; bj < 2; ++bj)
#pragma unroll
                    for (int n = 0; n < 2; ++n) *(f32x4*)(rowp + bj * 128 + n * 16) = acc[ai][bj][m][n]; }
    }
};
template <bool ADD> struct EpiGate {
    static constexpr bool PERM = true;
    u16* mrg; const u16* z; int gcol0;
    DEVI void operator()(const f32x4 (&acc)[2][2][4][2], const Unit& u, int wr, int wc, int fr, int fq) const {
        const int row0 = u.pm * 256 + wr * 64 + fr, col0 = u.pn * 256 + wc * 32 + 8 * fq;
#pragma unroll
        for (int am = 0; am < 4; ++am) { const int ai = am >> 1, m0 = (am & 1) * 2;
            u32x4 gq[4][2], pq[4][2];
#pragma unroll
            for (int m = m0; m < m0 + 2; ++m)
#pragma unroll
                for (int bj = 0; bj < 2; ++bj) { const int row = row0 + ai * 128 + m * 16, col = col0 + bj * 128;
                    gq[m][bj] = *(const u32x4*)(z + (size_t)row * NPAD + gcol0 + col); if (ADD) pq[m][bj] = *(const u32x4*)(mrg + (size_t)row * D_ + col); }
#pragma unroll
            for (int m = m0; m < m0 + 2; ++m) { const int row = row0 + ai * 128 + m * 16;
#pragma unroll
                for (int bj = 0; bj < 2; ++bj) { const int col = col0 + bj * 128;
                    float gz[8], pv[8]; unpack8(gq[m][bj], gz);
                    u16* dst = mrg + (size_t)row * D_ + col;
                    if (ADD) unpack8(pq[m][bj], pv);
                    float o[8];
#pragma unroll
                    for (int j = 0; j < 4; ++j) { o[j] = acc[ai][bj][m][0][j] * sigm(gz[j]); o[4 + j] = acc[ai][bj][m][1][j] * sigm(gz[4 + j]); }
                    if (ADD) {
#pragma unroll
                        for (int j = 0; j < 8; ++j) o[j] += pv[j]; }
                    u32x4 w; w.x = pk2(o[0], o[1]); w.y = pk2(o[2], o[3]); w.z = pk2(o[4], o[5]); w.w = pk2(o[6], o[7]);
                    *(u32x4*)dst = w; } } }
    }
};
struct EpiResid {
    static constexpr bool PERM = true;
    u16* pre; const float* x; const u16* xh;
    DEVI void operator()(const f32x4 (&acc)[2][2][4][2], const Unit& u, int wr, int wc, int fr, int fq) const {
        const int row0 = u.pm * 256 + wr * 64 + fr, col0 = u.pn * 256 + wc * 32 + 8 * fq;
#pragma unroll
        for (int am = 0; am < 4; ++am) { const int ai = am >> 1, m0 = (am & 1) * 2;
            u32x4 hq[4][2]; f32x4 xq[4][2][2];
#pragma unroll
            for (int m = m0; m < m0 + 2; ++m)
#pragma unroll
                for (int bj = 0; bj < 2; ++bj) { const size_t off = (size_t)(row0 + ai * 128 + m * 16) * D_ + col0 + bj * 128;
                    if (xh) hq[m][bj] = *(const u32x4*)(xh + off); else { xq[m][bj][0] = *(const f32x4*)(x + off); xq[m][bj][1] = *(const f32x4*)(x + off + 4); } }
#pragma unroll
            for (int m = m0; m < m0 + 2; ++m)
#pragma unroll
                for (int bj = 0; bj < 2; ++bj) { const size_t off = (size_t)(row0 + ai * 128 + m * 16) * D_ + col0 + bj * 128; float xv[8];
                    if (xh) unpack8(hq[m][bj], xv);
                    else { const f32x4 x0 = xq[m][bj][0], x1 = xq[m][bj][1]; xv[0] = x0[0]; xv[1] = x0[1]; xv[2] = x0[2]; xv[3] = x0[3]; xv[4] = x1[0]; xv[5] = x1[1]; xv[6] = x1[2]; xv[7] = x1[3]; }
                    float r[8];
#pragma unroll
                    for (int j = 0; j < 4; ++j) { r[j] = xv[j] * ALPHA + acc[ai][bj][m][0][j]; r[4 + j] = xv[4 + j] * ALPHA + acc[ai][bj][m][1][j]; }
                    u32x4 w; w.x = pk2(r[0], r[1]); w.y = pk2(r[2], r[3]); w.z = pk2(r[4], r[5]); w.w = pk2(r[6], r[7]);
                    *(u32x4*)(pre + off) = w; } }
    }
};
struct EpiSwiGLU {
    static constexpr bool PERM = true;
    unsigned char* H;
    DEVI void operator()(const f32x4 (&acc)[2][2][4][2], const Unit& u, int wr, int wc, int fr, int fq) const {
        const int row0 = u.pm * 256 + wr * 64 + fr, f0 = u.pn * 128 + wc * 16 + 4 * fq;
#pragma unroll
        for (int ai = 0; ai < 2; ++ai)
#pragma unroll
            for (int m = 0; m < 4; ++m) { const int row = row0 + ai * 128 + m * 16;
#pragma unroll
                for (int bj = 0; bj < 2; ++bj) { const f32x4 a = acc[ai][bj][m][0], b = acc[ai][bj][m][1]; float o[4];
#pragma unroll
                    for (int j = 0; j < 4; ++j) o[j] = a[j] * sigm(a[j]) * b[j];
                    *(unsigned*)(H + (size_t)row * DFF + f0 + bj * 64) = pk4_fp8(o[0], o[1], o[2], o[3]); } }
    }
};
struct EpiScaleRow {
    static constexpr bool PERM = true;
    u16* Y; const float* roww;
    DEVI void operator()(const f32x4 (&acc)[2][2][4][2], const Unit& u, int wr, int wc, int fr, int fq) const {
        const int row0 = u.pm * 256 + wr * 64 + fr, col0 = u.pn * 256 + wc * 32 + 8 * fq;
        float rwq[2][4];
#pragma unroll
        for (int ai = 0; ai < 2; ++ai)
#pragma unroll
            for (int m = 0; m < 4; ++m) rwq[ai][m] = roww[row0 + ai * 128 + m * 16];
#pragma unroll
        for (int ai = 0; ai < 2; ++ai)
#pragma unroll
            for (int m = 0; m < 4; ++m) { const int row = row0 + ai * 128 + m * 16; const float w_ = rwq[ai][m];
#pragma unroll
                for (int bj = 0; bj < 2; ++bj) { const f32x4 v0 = acc[ai][bj][m][0] * w_, v1 = acc[ai][bj][m][1] * w_;
                    u32x4 w; w.x = pk2(v0[0], v0[1]); w.y = pk2(v0[2], v0[3]); w.z = pk2(v1[0], v1[1]); w.w = pk2(v1[2], v1[3]);
                    *(u32x4*)(Y + (size_t)row * D_ + col0 + bj * 128) = w; } }
    }
};

struct CmpOrder {
    int G, c;
    DEVI bool next(int i, Unit& u) const { const int L = i * G + c; if (L >= 32) return false; u.pm = L; u.pn = 0; u.pb = L >> 4; return true; }
};
struct MoeOrder {
    int G, c, ntiles; const volatile LAS int* tstart;
    DEVI bool next(int i, Unit& u) const {
        const int L = i * G + c; if (L >= ntiles * 8) return false;
        const int tile = L >> 3, pn = L & 7;
        const int lk_ = (int)__builtin_amdgcn_mbcnt_hi(~0u, __builtin_amdgcn_mbcnt_lo(~0u, 0u));
        const int e = __popcll(__ballot(lk_ >= 1 && lk_ < 32 && tstart[lk_ & 31] <= tile));
        u.pm = tile; u.pn = pn; u.pb = e * 8 + pn; return true;
    }
};

struct Args { const float* in[26]; float* out; unsigned char* ws; int ph_lo, ph_hi; };
typedef const __attribute__((address_space(4))) Args* KP;
constexpr int PPL = 13;
constexpr int NPH = 1 + 2 * PPL;

DEVI int src_col(int n) {
    if (n < C_NQ) return n;
    if (n < C_KC) { const int r = n - C_NQ, hd = r >> 7, p = r & 127; return S_NQ + hd * 128 + (p >> 1) + 64 * (p & 1); }
    if (n < C_KS) return S_KC + (n - C_KC);
    if (n < C_VS) { const int r = n - C_KS, hd = r >> 7, p = r & 127; return S_KS + hd * 128 + (p >> 1) + 64 * (p & 1); }
    if (n < C_KW) return S_VS + (n - C_VS);
    if (n < C_VW) { const int r = n - C_KW, hd = r >> 7, p = r & 127; return S_KW + hd * 128 + (p >> 1) + 64 * (p & 1); }
    if (n < C_GM) return S_VW + (n - C_VW);
    if (n < C_GT) return S_GM + (n - C_GM);
    const int r = n - C_GT; if (r < 8) return S_MI + r; if (r < 56) return S_NG + (r - 8); return -1;
}

template <class ColPtr>
DEVI void tr_item32(const ColPtr& cp, size_t ldw, int K, u16* WT, int k0, int n0, float* scr, int lane) {
    const float* src = cp(n0 + (lane & 31));
#pragma unroll 8
    for (int i = 0; i < 32; ++i) { const int kk = 2 * i + (lane >> 5); scr[kk * 33 + (lane & 31)] = src ? src[(size_t)(k0 + kk) * ldw] : 0.f; }
    WAVE_SYNC();
    const int c = lane & 7;
#pragma unroll
    for (int j = 0; j < 4; ++j) { const int n = (lane >> 3) + 8 * j; const float* s = scr + (8 * c) * 33 + n;
        u32x4 o; o.x = pk2(s[0 * 33], s[1 * 33]); o.y = pk2(s[2 * 33], s[3 * 33]); o.z = pk2(s[4 * 33], s[5 * 33]); o.w = pk2(s[6 * 33], s[7 * 33]);
        *(u32x4*)(WT + (size_t)(n0 + n) * K + k0 + 8 * c) = o; }
    WAVE_SYNC();
}
template <class ColPtr>
DEVI void tr_item64(const ColPtr& cp, size_t ldw, int K, u16* WT, int k0, int n0, float* scr, int lane) {
    const int nq = lane & 15, kr = lane >> 4;
    const float* src = cp(n0 + 4 * nq);
    f32x4 v[16];
#pragma unroll
    for (int i = 0; i < 16; ++i) v[i] = src ? __builtin_nontemporal_load((const f32x4*)(src + (size_t)(k0 + kr + 4 * i) * ldw)) : (f32x4){0.f, 0.f, 0.f, 0.f};
#pragma unroll
    for (int i = 0; i < 16; ++i) { float* d = scr + (kr + 4 * i) * 65 + 4 * nq; d[0] = v[i][0]; d[1] = v[i][1]; d[2] = v[i][2]; d[3] = v[i][3]; }
    WAVE_SYNC();
    const int c = lane & 7;
#pragma unroll
    for (int j = 0; j < 8; ++j) { const int n = (lane >> 3) + 8 * j; const float* sp = scr + (8 * c) * 65 + n;
        u32x4 o; o.x = pk2(sp[0 * 65], sp[1 * 65]); o.y = pk2(sp[2 * 65], sp[3 * 65]); o.z = pk2(sp[4 * 65], sp[5 * 65]); o.w = pk2(sp[6 * 65], sp[7 * 65]);
        *(u32x4*)(WT + (size_t)(n0 + n) * K + k0 + 8 * c) = o; }
    WAVE_SYNC();
}
template <class ColPtr>
DEVI void tr_item64_f8(const ColPtr& cp, size_t ldw, int K, unsigned char* WT, int k0, int n0, float* scr, int lane, float scale) {
    const int nq = lane & 15, kr = lane >> 4;
    const float* src = cp(n0 + 4 * nq);
    f32x4 v[16];
#pragma unroll
    for (int i = 0; i < 16; ++i) v[i] = src ? __builtin_nontemporal_load((const f32x4*)(src + (size_t)(k0 + kr + 4 * i) * ldw)) : (f32x4){0.f, 0.f, 0.f, 0.f};
#pragma unroll
    for (int i = 0; i < 16; ++i) { float* d = scr + (kr + 4 * i) * 65 + 4 * nq; d[0] = v[i][0]; d[1] = v[i][1]; d[2] = v[i][2]; d[3] = v[i][3]; }
    WAVE_SYNC();
    const int c = lane & 3;
#pragma unroll
    for (int j = 0; j < 4; ++j) { const int n = (lane >> 2) + 16 * j; const float* sp = scr + (16 * c) * 65 + n;
        u32x4 o; o.x = pk4_fp8(sp[0 * 65] * scale, sp[1 * 65] * scale, sp[2 * 65] * scale, sp[3 * 65] * scale); o.y = pk4_fp8(sp[4 * 65] * scale, sp[5 * 65] * scale, sp[6 * 65] * scale, sp[7 * 65] * scale);
        o.z = pk4_fp8(sp[8 * 65] * scale, sp[9 * 65] * scale, sp[10 * 65] * scale, sp[11 * 65] * scale); o.w = pk4_fp8(sp[12 * 65] * scale, sp[13 * 65] * scale, sp[14 * 65] * scale, sp[15 * 65] * scale);
        *(u32x4*)(WT + (size_t)(n0 + n) * K + k0 + 16 * c) = o; }
    WAVE_SYNC();
}
DEVI void tr_item64_f8_rope(const float* Wh  , size_t ldw, int K, unsigned char* WT, int k0, int n0, float* scr, int lane, float scale) {
    const int nq = lane & 15, kr = lane >> 4, hf = nq >> 3, d4 = 4 * (nq & 7);
    const float* src = Wh + hf * 64 + d4;
    f32x4 v[16];
#pragma unroll
    for (int i = 0; i < 16; ++i) v[i] = __builtin_nontemporal_load((const f32x4*)(src + (size_t)(k0 + kr + 4 * i) * ldw));
#pragma unroll
    for (int i = 0; i < 16; ++i) { float* d = scr + (kr + 4 * i) * 65 + 2 * d4 + hf; d[0] = v[i][0]; d[2] = v[i][1]; d[4] = v[i][2]; d[6] = v[i][3]; }
    WAVE_SYNC();
    const int c = lane & 3;
#pragma unroll
    for (int j = 0; j < 4; ++j) { const int n = (lane >> 2) + 16 * j; const float* sp = scr + (16 * c) * 65 + n;
        u32x4 o; o.x = pk4_fp8(sp[0 * 65] * scale, sp[1 * 65] * scale, sp[2 * 65] * scale, sp[3 * 65] * scale); o.y = pk4_fp8(sp[4 * 65] * scale, sp[5 * 65] * scale, sp[6 * 65] * scale, sp[7 * 65] * scale);
        o.z = pk4_fp8(sp[8 * 65] * scale, sp[9 * 65] * scale, sp[10 * 65] * scale, sp[11 * 65] * scale); o.w = pk4_fp8(sp[12 * 65] * scale, sp[13 * 65] * scale, sp[14 * 65] * scale, sp[15 * 65] * scale);
        *(u32x4*)(WT + (size_t)(n0 + n) * K + k0 + 16 * c) = o; }
    WAVE_SYNC();
}
template <class ColPtr>
DEVI void tr_item32_f8(const ColPtr& cp, size_t ldw, int K, unsigned char* WT, int k0, int n0, float* scr, int lane, float scale) {
    const float* src = cp(n0 + (lane & 31));
#pragma unroll 8
    for (int i = 0; i < 32; ++i) { const int kk = 2 * i + (lane >> 5); scr[kk * 33 + (lane & 31)] = src ? src[(size_t)(k0 + kk) * ldw] : 0.f; }
    WAVE_SYNC();
    const int c = lane & 7;
#pragma unroll
    for (int j = 0; j < 4; ++j) { const int n = (lane >> 3) + 8 * j; const float* sp = scr + (8 * c) * 33 + n;
        u32x2 o; o.x = pk4_fp8(sp[0 * 33] * scale, sp[1 * 33] * scale, sp[2 * 33] * scale, sp[3 * 33] * scale); o.y = pk4_fp8(sp[4 * 33] * scale, sp[5 * 33] * scale, sp[6 * 33] * scale, sp[7 * 33] * scale);
        *(u32x2*)(WT + (size_t)(n0 + n) * K + k0 + 8 * c) = o; }
    WAVE_SYNC();
}
struct ColPlain { const float* W; DEVI const float* operator()(int n) const { return W + n; } };
struct ColInProj { const float* W; DEVI const float* operator()(int n) const { const int s = src_col(n); return s >= 0 ? W + s : nullptr; } };
struct ColW13 { const float* w1; const float* w3; DEVI const float* operator()(int n) const { const int f = (n >> 3) * 4 + (n & 3); return ((n >> 2) & 1) ? w3 + f : w1 + f; } };

DEVI void phase_prologue(KP a, unsigned char* lds, int tid, int lane, int wave, int G) {
    unsigned char* ws = a->ws;
    float* cosT = (float*)(ws + WS_ROPE); float* sinT = cosT + 4096 * 64;
    for (int idx = blockIdx.x * 512 + tid; idx < 4096 * 64; idx += G * 512) {
        const int pos = idx >> 6, i = idx & 63;
        const float inv = exp2f(-(float)i * (13.287712379549449f / 64.f));
        const double ang = (double)pos * (double)inv;
        const double k = __builtin_rint(ang * 0.15915494309189535);
        const float r = (float)(ang - k * 6.283185307179586);
        cosT[idx] = cosf(r); sinT[idx] = sinf(r);
    }
    { const float* x = a->in[0]; unsigned char* x8 = ws + WS_X8;
      const size_t NI = (size_t)M_ * D_ / 8, st = (size_t)G * 512; size_t i = (size_t)blockIdx.x * 512 + tid;
      for (; i + 3 * st < NI; i += 4 * st) {
          f32x4 v0[4], v1[4];
#pragma unroll
          for (int u = 0; u < 4; ++u) { v0[u] = *(const f32x4*)(x + (i + u * st) * 8); v1[u] = *(const f32x4*)(x + (i + u * st) * 8 + 4); }
#pragma unroll
          for (int u = 0; u < 4; ++u) { u32x2 w; w.x = pk4_fp8(v0[u][0], v0[u][1], v0[u][2], v0[u][3]); w.y = pk4_fp8(v1[u][0], v1[u][1], v1[u][2], v1[u][3]); *(u32x2*)(x8 + (i + u * st) * 8) = w; } }
      for (; i < NI; i += st) {
          const f32x4 v0 = *(const f32x4*)(x + i * 8), v1 = *(const f32x4*)(x + i * 8 + 4);
          u32x2 w; w.x = pk4_fp8(v0[0], v0[1], v0[2], v0[3]); w.y = pk4_fp8(v1[0], v1[1], v1[2], v1[3]);
          *(u32x2*)(x8 + i * 8) = w; } }
    { float* bp = (float*)(ws + WS_BIASP);
      for (int i = blockIdx.x * 512 + tid; i < 2 * NPAD; i += G * 512) { const int l = i / NPAD, n = i % NPAD, s = src_col(n); bp[i] = s >= 0 ? a->in[2][l * IN_W + s] : 0.f; } }
    { u16* ov = (u16*)(ws + WS_OVL);
      for (int i = blockIdx.x * 512 + tid; i < 256 * 128; i += G * 512) { const int n = i >> 7, j = i & 127;
          const bool on = j < 64 && n < 255 && (16 * n <= 64 * j + 63) && (16 * n + 31 >= 64 * j); ov[i] = on ? (u16)0x3f80 : (u16)0; } }
    { float* wT = (float*)(ws + WS_RWT); const float* rw = a->in[19];
      for (int i = blockIdx.x * 512 + tid; i < 32 * 2048; i += G * 512) { const int e = i >> 11, d = i & 2047; wT[i] = rw[d * 32 + e]; } }
    const int gw = blockIdx.x * 8 + wave, NGW = G * 8;
    { float* b1p = (float*)(ws + WS_MISC + 1536 * 1024);
      for (int task = gw; task < 512; task += NGW) { const int kc = task & 63, fh = (task >> 6) & 1, kv = (task >> 7) & 1, l = task >> 8;
          const float* pos = a->in[kv ? 9 : 4] + (size_t)l * 4096; const float* w1 = a->in[kv ? 10 : 5] + (size_t)l * 4096 * 128; const int f = fh * 64 + lane;
          float s = 0.f;
          for (int k = kc * 64; k < kc * 64 + 64; ++k) s += pos[k] * w1[(size_t)k * 128 + f];
          b1p[((l * 2 + kv) * 64 + kc) * 128 + f] = s; } }
    float* scr = (float*)(lds + wave * 16640);
    constexpr int IT_WIN = 32 * (NPAD / 64), IT_WB = 32 * 32, IT_CW = 32 * 2;
    constexpr int NIT = 2 * IT_WIN + 6 * IT_WB + 8 * IT_CW;
    for (int it = gw; it < NIT; it += NGW) {
        int r = it;
        if (r < 2 * IT_WIN) { const int l = r / IT_WIN; r %= IT_WIN; const int kb = r / (NPAD / 64), nb = r % (NPAD / 64), n0 = nb * 64;
            const ColInProj cp{a->in[1] + (size_t)l * D_ * IN_W}; unsigned char* WT = ws + WS_WIN + (size_t)l * NPAD * D_;
            const bool rope = (n0 >= C_NQ && n0 < C_KC) || (n0 >= C_KS && n0 < C_VS) || (n0 >= C_KW && n0 < C_VW);
            if (rope) { const int segd = n0 >= C_KW ? C_KW : n0 >= C_KS ? C_KS : C_NQ, segs = n0 >= C_KW ? S_KW : n0 >= C_KS ? S_KS : S_NQ;
                const int r_ = n0 - segd, hd = r_ >> 7, m32 = (r_ & 127) >> 6;
                tr_item64_f8_rope(a->in[1] + (size_t)l * D_ * IN_W + segs + hd * 128 + 32 * m32, IN_W, D_, WT, kb * 64, n0, scr, lane, 64.f); }
            else tr_item64_f8(cp, IN_W, D_, WT, kb * 64, n0, scr, lane, 64.f);
            continue; }
        r -= 2 * IT_WIN;
        if (r < 6 * IT_WB) { const int q = r / IT_WB, l = q / 3, w = q % 3; r %= IT_WB; const int kb = r / 32, nb = r % 32;
            if (w <= 1) tr_item64_f8(ColPlain{a->in[14 + w] + (size_t)l * D_ * D_}, D_, D_, ws + WS_WB + (size_t)(l * 3 + w) * D_ * D_ * 2, kb * 64, nb * 64, scr, lane, 64.f);
            else tr_item64(ColPlain{a->in[14 + w] + (size_t)l * D_ * D_}, D_, D_, (u16*)(ws + WS_WB) + (size_t)(l * 3 + w) * D_ * D_, kb * 64, nb * 64, scr, lane);
            continue; }
        r -= 6 * IT_WB;
        { const int q = r / IT_CW, l = q >> 2, kv = (q >> 1) & 1, ab = q & 1; r %= IT_CW; const int kb = r / 2, nb = r % 2;
          const float* w1 = a->in[kv ? 10 : 5] + (size_t)l * 4096 * 128 + (size_t)ab * 2048 * 128;
          tr_item64_f8(ColPlain{w1}, 128, 2048, ws + WS_CW1 + (size_t)(l * 512 + kv * 256 + ab * 128) * 2048, kb * 64, nb * 64, scr, lane, 64.f); }
    }
}
DEVI void phase_experts(KP a, unsigned char* lds, int lane, int wave, int G, int l) {
    unsigned char* ws = a->ws;
    float* scr = (float*)(lds + wave * 16640);
    const int gw = blockIdx.x * 8 + wave, NGW = G * 8;
    constexpr int IT13 = 32 * 32, IT2 = 16 * 32;
    for (int it = gw; it < NEXP * (IT13 + IT2); it += NGW) {
        const int e = it / (IT13 + IT2); int r = it % (IT13 + IT2);
        if (r < IT13) { const int kb = r / 32, nb = r % 32;
            const float* w1 = a->in[21] + ((size_t)l * NEXP + e) * D_ * DFF; const float* w3 = a->in[22] + ((size_t)l * NEXP + e) * D_ * DFF;
            tr_item64_f8(ColW13{w1, w3}, DFF, D_, ws + WS_W13 + (size_t)e * 2048 * D_, kb * 64, nb * 64, scr, lane, 64.f); }
        else { r -= IT13; const int kb = r / 32, nb = r % 32;
            const float* w2 = a->in[23] + ((size_t)l * NEXP + e) * DFF * D_;
            tr_item64_f8(ColPlain{w2}, D_, DFF, ws + WS_W2 + (size_t)e * D_ * DFF, kb * 64, nb * 64, scr, lane, 64.f); }
    }
}

namespace ml {
constexpr int QP = 272, VP = 72;
constexpr int O_Q = 0, O_K = 34816, O_CB = 69632, O_VT = 95744, O_VW = 102656, O_SP = 109568, O_SC = 118784;
constexpr int S_A = 0, S_M = 64, S_WI = 128, S_EN = 192, S_WS = 256, S_DEN = 320, S_DEC = 384;
typedef short s16x4 __attribute__((ext_vector_type(4)));
DEVI bf16x8 frag(const unsigned char* lds, int off) { return *(const bf16x8*)(lds + off); }
DEVI bf16x8 frag_tr(unsigned addr) {
    s16x4 lo, hi;
    asm volatile("ds_read_b64_tr_b16 %0, %2\n\tds_read_b64_tr_b16 %1, %2 offset:2176\n\ts_waitcnt lgkmcnt(0)" : "=&v"(lo), "=&v"(hi) : "v"(addr) : "memory");
    return (bf16x8){lo[0], lo[1], lo[2], lo[3], hi[0], hi[1], hi[2], hi[3]};
}
}
constexpr size_t WS_SP = WS_O, WS_MSC = WS_O + 16 * MiB, WS_MDEC = WS_O + 20 * MiB;
DEVI void phase_mlstm_pre(KP a, unsigned char* lds, const int tid, int G, int first_blk) {
    using namespace ml;
    unsigned char* ws = a->ws;
    const u16* z = (const u16*)(ws + WS_Z); const float* gates = (const float*)(ws + WS_GATES);
    u16* SPg = (u16*)(ws + WS_SP); float* MSC = (float*)(ws + WS_MSC); float* MDEC = (float*)(ws + WS_MDEC);
    const int lane = tid & 63, wave = __builtin_amdgcn_readfirstlane(tid >> 6), g4 = lane >> 4, l15 = lane & 15;
    float* sc = (float*)(lds + O_SC);
    const int nblk = G - first_blk, bi = (int)blockIdx.x - first_blk;
    if (bi < 0) return;
    const int u0 = (int)(((long)bi * 1024) / nblk), u1 = (int)(((long)(bi + 1) * 1024) / nblk);
    float off = 0.f, Gp = 0.f; int have = -1;
    const unsigned qkoff = (unsigned)((tid >> 5) * NPAD + (tid & 31) * 8) * 2u; const int qklds = (tid >> 5) * (QP * 2) + (tid & 31) * 16;
    for (int u = u0; u < u1; ++u) { const int bh = u >> 6, c = u & 63, b = bh >> 2, h = bh & 3;
        const char* zq = (const char*)(z + (size_t)(b * 4096 + c * 64) * NPAD + C_MQ + h * 256);
        const char* zk = (const char*)(z + (size_t)(b * 4096 + c * 64) * NPAD + C_MK + h * 256);
        const float* gp = gates + (size_t)b * 4096 * 64 + h;
#pragma unroll
        for (int k = 0; k < 4; ++k) { *(u32x4*)(lds + O_Q + qklds + k * 16 * QP * 2) = *(const u32x4*)(zq + qkoff + (size_t)k * 16 * NPAD * 2); *(u32x4*)(lds + O_K + qklds + k * 16 * QP * 2) = *(const u32x4*)(zk + qkoff + (size_t)k * 16 * NPAD * 2); }
        if (wave == 0) {
            if (have != u) { off = 0.f; Gp = 0.f;
                if (c > 0) { const float* ch = (const float*)(ws + WS_CHS) + ((size_t)(b * 64) * 4 + h) * 2;
                    float Sv = 0.f, Lv = -INFINITY; if (lane < c) { Sv = ch[lane * 8]; Lv = ch[lane * 8 + 1]; }
#pragma unroll
                    for (int cc = 0; cc < 63; ++cc) { const float s_ = __int_as_float(__builtin_amdgcn_readlane(__float_as_int(Sv), cc)), l_ = __int_as_float(__builtin_amdgcn_readlane(__float_as_int(Lv), cc));
                        Gp = fmaxf(Gp, l_ - off); off += s_; } } }
            const float fg = gp[(size_t)(c * 64 + lane) * 64 + 4], ig = gp[(size_t)(c * 64 + lane) * 64];
            float bc = fminf(fg, 0.f) - log1pf(__expf(-fabsf(fg)));
#pragma unroll
            for (int o = 1; o < 64; o <<= 1) { const float t_ = __shfl_up(bc, o); if (lane >= o) bc += t_; }
            const float Bg = off + bc, gv = ig - Bg; float pm = gv;
#pragma unroll
            for (int o = 1; o < 64; o <<= 1) { const float t_ = __shfl_up(pm, o); if (lane >= o) pm = fmaxf(pm, t_); }
            const float Gt = fmaxf(Gp, pm), Ge = __shfl(Gt, 63);
            sc[S_A + lane] = gv; sc[S_M + lane] = Gt;
            *(f32x4*)(MSC + ((size_t)bh * 4096 + c * 64 + lane) * 4) = (f32x4){__expf(Gp - Gt), __expf(-(Bg + Gt)), __expf(gv - Ge), 0.f};
            if (lane == 0) MDEC[bh * 64 + c] = __expf(Gp - Ge);
            off = __shfl(Bg, 63); Gp = Ge; have = u + 1;
            if (c == 63) have = -1;
        }
        __syncthreads();
        const int tt = wave >> 1, st0 = 2 * (wave & 1); const int t = 16 * tt + l15; const float Gt_ = sc[S_M + t];
        u16* spo = SPg + (size_t)u * 4096 + (size_t)t * 64;
#pragma unroll
        for (int si = 0; si < 2; ++si) { const int st = st0 + si; u32x2 pk_ = {0u, 0u};
            if (st <= tt) { f32x4 sacc = {0.f, 0.f, 0.f, 0.f};
#pragma unroll
                for (int ks = 0; ks < 8; ++ks) sacc = __builtin_amdgcn_mfma_f32_16x16x32_bf16(frag(lds, O_K + (16 * st + l15) * (QP * 2) + (32 * ks + 8 * g4) * 2), frag(lds, O_Q + (16 * tt + l15) * (QP * 2) + (32 * ks + 8 * g4) * 2), sacc, 0, 0, 0);
                float w_[4];
#pragma unroll
                for (int j = 0; j < 4; ++j) { const int sj = 16 * st + 4 * g4 + j; w_[j] = sj <= t ? sacc[j] * __expf(sc[S_A + sj] - Gt_) : 0.f; }
                pk_.x = pk2(w_[0], w_[1]); pk_.y = pk2(w_[2], w_[3]); }
            *(u32x2*)(spo + 16 * st + 4 * g4) = pk_; }
        __syncthreads();
    }
}
DEVI void phase_mlstm(KP a, unsigned char* lds, const int tid, int G) {
    using namespace ml;
    unsigned char* ws = a->ws;
    const u16* z = (const u16*)(ws + WS_Z); u16* hbuf = (u16*)(ws + WS_HG);
    const u16* SPg = (const u16*)(ws + WS_SP); const float* MSC = (const float*)(ws + WS_MSC); const float* MDEC = (const float*)(ws + WS_MDEC);
    const int lane = tid & 63, wave = __builtin_amdgcn_readfirstlane(tid >> 6), g4 = lane >> 4, l15 = lane & 15;
    float* sc = (float*)(lds + O_SC);
    const unsigned lds32 = (unsigned)(uintptr_t)lds;
    const unsigned qkoff = (unsigned)((tid >> 5) * NPAD + (tid & 31) * 8) * 2u;
    const int qklds = (tid >> 5) * (QP * 2) + (tid & 31) * 16;
    const int vs_ = tid >> 3, v4 = (tid & 7) * 4;
    for (int unit0 = blockIdx.x; unit0 < 256; unit0 += G) {
        const int unit = (G % 8 == 0 && G >= 256) ? (((unit0 & 7) + 8 * (unit0 >> 7)) * 16 + ((unit0 >> 3) & 15)) : unit0;
        const int b = unit >> 6, h = (unit >> 4) & 3, jv = unit & 15, bh = b * 4 + h;
        const char* zq = (const char*)(z + (size_t)b * 4096 * NPAD + C_MQ + h * 256);
        const char* zk = (const char*)(z + (size_t)b * 4096 * NPAD + C_MK + h * 256);
        const char* zv = (const char*)(z + (size_t)b * 4096 * NPAD + C_MV + h * 512 + jv * 32);
        const char* spg = (const char*)(SPg + (size_t)bh * 64 * 4096);
        const float* msc = MSC + (size_t)bh * 4096 * 4;
        for (int i = tid; i < 48 * QP / 2; i += 512) ((unsigned*)(lds + O_CB))[i] = 0u;
        for (int i = tid; i < 16 * VP / 2; i += 512) { ((unsigned*)(lds + O_VT + 32 * VP * 2))[i] = i < VP / 2 ? 0x3f803f80u : 0u; ((unsigned*)(lds + O_VW + 32 * VP * 2))[i] = 0u; }
        f32x4 Cacc[2][3];
#pragma unroll
        for (int i = 0; i < 2; ++i)
#pragma unroll
            for (int j = 0; j < 3; ++j) Cacc[i][j] = (f32x4){0.f, 0.f, 0.f, 0.f};
        u32x4 pq[4], pk[4], psp; u32x2 pv; f32x4 pms = {0.f, 0.f, 0.f, 0.f}; float pdec = 0.f, pws = 0.f;
#pragma unroll
        for (int k = 0; k < 4; ++k) { pq[k] = *(const u32x4*)(zq + qkoff + (size_t)k * 16 * NPAD * 2); pk[k] = *(const u32x4*)(zk + qkoff + (size_t)k * 16 * NPAD * 2); }
        pv = *(const u32x2*)(zv + ((size_t)vs_ * NPAD + v4) * 2); pws = msc[(size_t)vs_ * 4 + 2];
        psp = *(const u32x4*)(spg + (size_t)tid * 16);
        if (wave == 0) { pms = *(const f32x4*)(msc + (size_t)lane * 4); pdec = MDEC[bh * 64]; }
        for (int c = 0; c < 64; ++c) {
#pragma unroll
            for (int k = 0; k < 4; ++k) { *(u32x4*)(lds + O_Q + qklds + k * 16 * QP * 2) = pq[k]; *(u32x4*)(lds + O_K + qklds + k * 16 * QP * 2) = pk[k]; }
            { u16* vt = (u16*)(lds + O_VT); u16* vw = (u16*)(lds + O_VW); const unsigned short e0 = (u16)(pv.x & 0xffffu), e1 = (u16)(pv.x >> 16), e2 = (u16)(pv.y & 0xffffu), e3 = (u16)(pv.y >> 16);
              vt[(v4 + 0) * VP + vs_] = e0; vt[(v4 + 1) * VP + vs_] = e1; vt[(v4 + 2) * VP + vs_] = e2; vt[(v4 + 3) * VP + vs_] = e3;
              vw[(v4 + 0) * VP + vs_] = (u16)f2bf(bf2f(e0) * pws); vw[(v4 + 1) * VP + vs_] = (u16)f2bf(bf2f(e1) * pws); vw[(v4 + 2) * VP + vs_] = (u16)f2bf(bf2f(e2) * pws); vw[(v4 + 3) * VP + vs_] = (u16)f2bf(bf2f(e3) * pws); }
            *(u32x4*)(lds + O_SP + (tid >> 3) * (VP * 2) + (tid & 7) * 16) = psp;
            if (wave == 0) { sc[S_WI + lane] = pms[0]; sc[S_EN + lane] = pms[1]; ((u16*)(lds + O_VW))[32 * VP + lane] = (u16)f2bf(pms[2]); if (lane == 0) sc[S_DEC] = pdec; }
            __syncthreads();
            { const int cn = c < 63 ? c + 1 : 63; const size_t ro = (size_t)cn * 64 * NPAD * 2;
#pragma unroll
              for (int k = 0; k < 4; ++k) { pq[k] = *(const u32x4*)(zq + ro + qkoff + (size_t)k * 16 * NPAD * 2); pk[k] = *(const u32x4*)(zk + ro + qkoff + (size_t)k * 16 * NPAD * 2); }
              pv = *(const u32x2*)(zv + ro + ((size_t)vs_ * NPAD + v4) * 2); pws = msc[(size_t)(cn * 64 + vs_) * 4 + 2];
              psp = *(const u32x4*)(spg + (size_t)cn * 8192 + (size_t)tid * 16);
              if (wave == 0) { pms = *(const f32x4*)(msc + (size_t)(cn * 64 + lane) * 4); pdec = MDEC[bh * 64 + cn]; } }
            const int tt1 = wave & 3, vt1 = wave >> 2;
            f32x4 inter1 = {0.f, 0.f, 0.f, 0.f}, inter2 = {0.f, 0.f, 0.f, 0.f};
#pragma unroll
            for (int ks = 0; ks < 8; ++ks) { const bf16x8 aq = frag(lds, O_Q + (16 * tt1 + l15) * (QP * 2) + (32 * ks + 8 * g4) * 2);
                inter1 = __builtin_amdgcn_mfma_f32_16x16x32_bf16(aq, frag(lds, O_CB + (16 * vt1 + l15) * (QP * 2) + (32 * ks + 8 * g4) * 2), inter1, 0, 0, 0);
                inter2 = __builtin_amdgcn_mfma_f32_16x16x32_bf16(aq, frag(lds, O_CB + (32 + l15) * (QP * 2) + (32 * ks + 8 * g4) * 2), inter2, 0, 0, 0); }
            f32x4 num1 = {0.f, 0.f, 0.f, 0.f}, num2 = {0.f, 0.f, 0.f, 0.f};
#pragma unroll
            for (int ks = 0; ks < 2; ++ks) { const bf16x8 ap = frag(lds, O_SP + (16 * tt1 + l15) * (VP * 2) + (32 * ks + 8 * g4) * 2);
                num1 = __builtin_amdgcn_mfma_f32_16x16x32_bf16(ap, frag(lds, O_VT + (16 * vt1 + l15) * (VP * 2) + (32 * ks + 8 * g4) * 2), num1, 0, 0, 0);
                num2 = __builtin_amdgcn_mfma_f32_16x16x32_bf16(ap, frag(lds, O_VT + (32 + l15) * (VP * 2) + (32 * ks + 8 * g4) * 2), num2, 0, 0, 0); }
            { const int row0 = b * 4096 + c * 64;
#pragma unroll
              for (int j = 0; j < 4; ++j) { const int tj = 16 * tt1 + 4 * g4 + j; const float wi = sc[S_WI + tj];
                  float d_ = num2[j] + wi * inter2[j];
                  d_ = __shfl(d_, lane & 48);
                  const float den = fmaxf(fabsf(d_), sc[S_EN + tj]);
                  const float hv = (num1[j] + wi * inter1[j]) / den;
                  const float hn = __int_as_float(__builtin_amdgcn_mov_dpp(__float_as_int(hv), 0xB1, 0xF, 0xF, true));
                  if ((l15 & 1) == 0) *(unsigned*)(hbuf + (size_t)(row0 + tj) * D_ + h * 512 + jv * 32 + 16 * vt1 + l15) = pk2(hv, hn); } }
            { const float decay = sc[S_DEC];
#pragma unroll
              for (int di = 0; di < 2; ++di) { const int dt = 2 * wave + di;
#pragma unroll
                  for (int vt = 0; vt < 3; ++vt) Cacc[di][vt] = Cacc[di][vt] * decay;
#pragma unroll
                  for (int ks = 0; ks < 2; ++ks) { const bf16x8 ak = frag_tr(lds32 + O_K + (32 * ks + 8 * g4 + (l15 >> 2)) * (QP * 2) + (16 * dt + 4 * (lane & 3)) * 2);
#pragma unroll
                      for (int vt = 0; vt < 3; ++vt) Cacc[di][vt] = __builtin_amdgcn_mfma_f32_16x16x32_bf16(ak, frag(lds, O_VW + (16 * vt + l15) * (VP * 2) + (32 * ks + 8 * g4) * 2), Cacc[di][vt], 0, 0, 0); }
              } }
            __syncthreads();
#pragma unroll
            for (int di = 0; di < 2; ++di) { const int dt = 2 * wave + di;
#pragma unroll
                for (int vt = 0; vt < 3; ++vt) { u32x2 w_; w_.x = pk2(Cacc[di][vt][0], Cacc[di][vt][1]); w_.y = pk2(Cacc[di][vt][2], Cacc[di][vt][3]);
                    *(u32x2*)(lds + O_CB + (16 * vt + l15) * (QP * 2) + (16 * dt + 4 * g4) * 2) = w_; } }
        }
        __syncthreads();
    }
}

DEVI void phase_cmp2(KP a, unsigned char* lds, int tid, int G, int l) {
    unsigned char* ws = a->ws;
    const float* U = (const float*)(ws + WS_U); u16* kcmp = (u16*)(ws + WS_KCMP);
    const float* cosT = (const float*)(ws + WS_ROPE); const float* sinT = cosT + 4096 * 64;
    const float* b1part = (const float*)(ws + WS_MISC + 1536 * 1024);
    constexpr int HP = 132;
    float* hs = (float*)lds;
    float* os = hs + 32 * HP;
    float* b1p = os + 32 * HP;
    const int sub = tid >> 7, f = tid & 127, lane = tid & 63, wv = tid >> 6, g4 = lane >> 4, l15 = lane & 15;
    __syncthreads();
    if (tid < 256) { const int which = tid >> 7; float s = a->in[which ? 11 : 6][l * 128 + f]; float p[64];
#pragma unroll
        for (int kc = 0; kc < 64; ++kc) p[kc] = b1part[((l * 2 + which) * 64 + kc) * 128 + f];
#pragma unroll
        for (int kc = 0; kc < 64; ++kc) s += p[kc];
        b1p[tid] = s; }
    __syncthreads();
    for (int unit = blockIdx.x; unit < 256; unit += G) {
        const int which = unit >> 7, rb = which * 4096 + (unit & 127) * 32;
        const float* w2 = a->in[which ? 12 : 7] + (size_t)l * 128 * 128; const float* b2 = a->in[which ? 13 : 8] + l * 128;
        float bw[8][4];
#pragma unroll
        for (int ks = 0; ks < 8; ++ks)
#pragma unroll
            for (int u = 0; u < 4; ++u) bw[ks][u] = w2[(16 * ks + 4 * g4 + u) * 128 + wv * 16 + l15];
        float ua[8], ub[8];
#pragma unroll
        for (int j = 0; j < 8; ++j) { const int r = rb + sub + 4 * j; const bool ok = (r & 255) < 255;
            ua[j] = ok ? U[(size_t)r * 256 + f] : 0.f; ub[j] = ok ? U[(size_t)(r + 1) * 256 + 128 + f] : 0.f; }
        const float b1v = b1p[which * 128 + f];
#pragma unroll
        for (int j = 0; j < 8; ++j) { const int r = rb + sub + 4 * j; float hp = 0.f;
            if ((r & 255) < 255) { hp = ua[j] + ub[j] + b1v;
                const float u_ = 0.7978845608028654f * (hp + 0.044715f * hp * hp * hp); const float th = 1.f - 2.f / (1.f + __expf(2.f * u_)); hp = 0.5f * hp * (1.f + th); }
            hs[(sub + 4 * j) * HP + f] = hp; }
        __syncthreads();
        { f32x4 acc0 = {0.f, 0.f, 0.f, 0.f}, acc1 = {0.f, 0.f, 0.f, 0.f};
#pragma unroll
          for (int ks = 0; ks < 8; ++ks) { const f32x4 a0 = *(const f32x4*)(hs + l15 * HP + 16 * ks + 4 * g4), a1 = *(const f32x4*)(hs + (16 + l15) * HP + 16 * ks + 4 * g4);
#pragma unroll
              for (int u = 0; u < 4; ++u) { acc0 = __builtin_amdgcn_mfma_f32_16x16x4f32(a0[u], bw[ks][u], acc0, 0, 0, 0); acc1 = __builtin_amdgcn_mfma_f32_16x16x4f32(a1[u], bw[ks][u], acc1, 0, 0, 0); } }
          const float bb = b2[wv * 16 + l15];
#pragma unroll
          for (int j = 0; j < 4; ++j) { os[(4 * g4 + j) * HP + wv * 16 + l15] = acc0[j] + bb; os[(16 + 4 * g4 + j) * HP + wv * 16 + l15] = acc1[j] + bb; } }
        __syncthreads();
        if (which == 0) { const int i = f >> 1; float cs[8], sn[8];
#pragma unroll
            for (int j = 0; j < 8; ++j) { const int r = rb + sub + 4 * j, n = r & 255, pos = 16 * n + 31; cs[j] = n < 255 ? cosT[pos * 64 + i] : 1.f; sn[j] = n < 255 ? sinT[pos * 64 + i] : 0.f; }
#pragma unroll
            for (int j = 0; j < 8; ++j) { const int lr = sub + 4 * j, r = rb + lr, n = r & 255; const float x1 = os[lr * HP + i], x2 = os[lr * HP + i + 64];
                float val = (f & 1) ? x2 * cs[j] + x1 * sn[j] : x1 * cs[j] - x2 * sn[j]; if (n == 255) val = 0.f;
                kcmp[(size_t)r * 128 + f] = (u16)f2bf(val); (ws + WS_KCMP8)[(size_t)r * 128 + f] = (unsigned char)(pk4_fp8(val, 0.f, 0.f, 0.f) & 0xffu); } }
        else {
#pragma unroll
            for (int j = 0; j < 8; ++j) { const int lr = sub + 4 * j, r = rb + lr, n = r & 255; float val = os[lr * HP + f]; if (n == 255) val = 0.f;
                kcmp[(size_t)r * 128 + f] = (u16)f2bf(val); } }
        __syncthreads();
    }
}
DEVI void phase_norm(KP a, int lane, int wave, int G, int l) {
    unsigned char* ws = a->ws;
    const u16* z = (const u16*)(ws + WS_Z); u16* hg = (u16*)(ws + WS_HG); const float* mw = a->in[3] + l * 2048;
    const int gw = blockIdx.x * 8 + wave, NGW = G * 8;
    f32x4 mwq[4][2];
#pragma unroll
    for (int h = 0; h < 4; ++h) { mwq[h][0] = *(const f32x4*)(mw + h * 512 + lane * 8); mwq[h][1] = *(const f32x4*)(mw + h * 512 + lane * 8 + 4); }
    for (int row = gw; row < M_; row += NGW) {
        u32x4 hv[4], ov[4];
#pragma unroll
        for (int h = 0; h < 4; ++h) { hv[h] = *(const u32x4*)(hg + (size_t)row * D_ + h * 512 + lane * 8); ov[h] = *(const u32x4*)(z + (size_t)row * NPAD + C_MO + h * 512 + lane * 8); }
#pragma unroll
        for (int h = 0; h < 4; ++h) {
            float v[8]; unpack8(hv[h], v);
            float s = 0.f;
#pragma unroll
            for (int j = 0; j < 8; ++j) s += v[j];
            const float mean = wsum(s) * (1.f / 512.f); float q = 0.f;
#pragma unroll
            for (int j = 0; j < 8; ++j) { v[j] -= mean; q += v[j] * v[j]; }
            const float rstd = 1.f / sqrtf(wsum(q) * (1.f / 512.f) + LN_EPS);
            float og[8]; unpack8(ov[h], og);
            const f32x4 w0 = mwq[h][0], w1 = mwq[h][1];
            const float wv[8] = {w0[0], w0[1], w0[2], w0[3], w1[0], w1[1], w1[2], w1[3]};
            float o[8];
#pragma unroll
            for (int j = 0; j < 8; ++j) o[j] = v[j] * rstd * wv[j] * sigm(og[j]);
            u32x2 w8; w8.x = pk4_fp8(o[0] * 2.f, o[1] * 2.f, o[2] * 2.f, o[3] * 2.f); w8.y = pk4_fp8(o[4] * 2.f, o[5] * 2.f, o[6] * 2.f, o[7] * 2.f);
            *(u32x2*)(ws + WS_XBF + (size_t)row * D_ + h * 512 + lane * 8) = w8; }
    }
}

#ifndef GQ_CV
#define GQ_CV true
#endif
#ifndef GQ_CI
#define GQ_CI true
#endif
#ifndef GQ_W
#define GQ_W true
#endif
#ifndef GQ_S
#define GQ_S false
#endif
namespace att {
constexpr int NW = 8, QBLK = 32, KVBLK = 64, QB = 256, D = 128, WIN = 512;
constexpr int SHM_V = KVBLK * D * 2, SHM_K = KVBLK * D * 2;
constexpr float SCALE = 0.08838834764831845f, THR = 8.f;
typedef short s16x4 __attribute__((ext_vector_type(4)));
typedef float f32x16 __attribute__((ext_vector_type(16)));
enum { M_WIN = 0, M_SEL = 1, M_CMP = 2 };
enum { E_GATED = 0, E_IMP = 1, E_FINAL = 2 };
#define KSWZ8(row, colB) ((row) * 128 + ((colB) ^ (((row) & 7) << 4)))
#define SBAR() __builtin_amdgcn_sched_barrier(0)
DEVI int v_st(int k, int c) { const int kk = (k & ~0xC) | ((k & 4) << 1) | ((k & 8) >> 1); return ((kk >> 3) * 4 + (c >> 5)) * 512 + ((kk & 7) * 32 + (c & 31)) * 2; }
DEVI int v_rd_base(int lane) { return ((lane & 3) << 3) | (((lane >> 2) & 3) << 6) | (((lane >> 4) & 1) << 5) | (((lane >> 5) & 1) << 8); }
constexpr int v_rd_off(int d0, int ks, int half) { return d0 * 512 + ks * 4096 + half * 2048; }
DEVI int crow(int r, int hi) { return (r & 3) + 8 * (r >> 2) + 4 * hi; }
DEVI unsigned cvtpk(float lo, float hi) { unsigned r; asm volatile("v_cvt_pk_bf16_f32 %0, %1, %2" : "=v"(r) : "v"(lo), "v"(hi)); return r; }
DEVI bf16x8 load8(const u16* p) { return *reinterpret_cast<const bf16x8*>(p); }
DEVI int nvis(int pos) { return pos >= 31 ? ((pos - 31) >> 4) + 1 : 0; }
DEVI void mask_tile(f32x16& p0, f32x16& p1, int dq, unsigned W) {
    const float NEG = -__builtin_inff();
#pragma unroll
    for (int r = 0; r < 16; ++r) { const int c = (r & 3) + 8 * (r >> 2);
        if ((unsigned)(dq - c) >= W) p0[r] = NEG;
        if ((unsigned)(dq - c - 32) >= W) p1[r] = NEG; }
}
DEVI void mask_cmp(f32x16& p0, f32x16& p1, int lim) {
    const float NEG = -__builtin_inff();
#pragma unroll
    for (int r = 0; r < 16; ++r) { const int c = (r & 3) + 8 * (r >> 2);
        if (c >= lim) p0[r] = NEG;
        if (c + 32 >= lim) p1[r] = NEG; }
}
DEVI void mask_all(f32x16& p0, f32x16& p1, bool kill) {
    const float NEG = -__builtin_inff();
#pragma unroll
    for (int r = 0; r < 16; ++r) { if (kill) p0[r] = NEG; if (kill) p1[r] = NEG; }
}
DEVI void partialSM(f32x16& p0, f32x16& p1, float& m_reg, float& mn, float& alpha, const bool kill = false) {
    float pmax = p0[0];
#pragma unroll
    for (int r = 1; r < 16; ++r) pmax = fmaxf(pmax, p0[r]);
#pragma unroll
    for (int r = 0; r < 16; ++r) pmax = fmaxf(pmax, p1[r]);
    { auto rr = __builtin_amdgcn_permlane32_swap(__float_as_uint(pmax), __float_as_uint(pmax), false, false);
      pmax = fmaxf(__uint_as_float(rr[0]), __uint_as_float(rr[1])); }
    if (kill) pmax = -__builtin_inff();
    constexpr float C2 = 1.4426950408889634f * SCALE;
    if (__builtin_expect(__all((pmax - m_reg) * SCALE <= THR), 1)) { mn = m_reg; alpha = 1.f; }
    else { mn = fmaxf(m_reg, pmax); alpha = __builtin_amdgcn_exp2f((m_reg - mn) * C2); m_reg = mn; }
    const float mnL = kill ? -__builtin_inff() : -mn * C2;
#pragma unroll
    for (int r = 0; r < 16; ++r) p0[r] = fmaf(p0[r], C2, mnL);
#pragma unroll
    for (int r = 0; r < 16; ++r) p1[r] = fmaf(p1[r], C2, mnL);
#pragma unroll
    for (int r = 0; r < 16; ++r) p0[r] = __builtin_amdgcn_exp2f(p0[r]);
}
DEVI void finishSM(f32x16& p0, f32x16& p1, float alpha, float& l_reg, bf16x8& pa0, bf16x8& pa1, bf16x8& pa2, bf16x8& pa3) {
#pragma unroll
    for (int r = 0; r < 16; ++r) p1[r] = __builtin_amdgcn_exp2f(p1[r]);
    float ps = 0;
#pragma unroll
    for (int r = 0; r < 16; ++r) ps += p0[r];
#pragma unroll
    for (int r = 0; r < 16; ++r) ps += p1[r];
    { auto rr = __builtin_amdgcn_permlane32_swap(__float_as_uint(ps), __float_as_uint(ps), false, false);
      ps = __uint_as_float(rr[0]) + __uint_as_float(rr[1]); }
    l_reg = l_reg * alpha + ps;
#define PK4(P, B_, OUT) do { unsigned a0 = cvtpk(P[B_+0], P[B_+1]), a1 = cvtpk(P[B_+2], P[B_+3]);                          \
        unsigned b0 = cvtpk(P[B_+4], P[B_+5]), b1 = cvtpk(P[B_+6], P[B_+7]);                                             \
        auto r0 = __builtin_amdgcn_permlane32_swap(a0, b0, false, false); auto r1 = __builtin_amdgcn_permlane32_swap(a1, b1, false, false); \
        u32x4 w = {r0[0], r1[0], r0[1], r1[1]}; OUT = *reinterpret_cast<bf16x8*>(&w); } while (0)
    PK4(p0, 0, pa0); PK4(p0, 8, pa1); PK4(p1, 0, pa2); PK4(p1, 8, pa3);
#undef PK4
}
template <int KB, bool SK>
DEVI void qkt(f32x16& p0, f32x16& p1, const char* K_lds, int r32, int hi, const pg8::i32x8_* q8, bool act) {
    if (SK && !act) { const float NEG = -__builtin_inff();
#pragma unroll
        for (int r = 0; r < 16; ++r) { p0[r] = NEG; p1[r] = NEG; } return; }
    const char* kb = K_lds + KB * SHM_K;
    const int one = 0x7f7f7f7f;
    typedef int i4 __attribute__((ext_vector_type(4)));
    { const pg8::i32x8_ a00 = __builtin_shufflevector(*(const i4*)(kb + KSWZ8(r32, 32 * hi)), *(const i4*)(kb + KSWZ8(r32, 32 * hi + 16)), 0, 1, 2, 3, 4, 5, 6, 7);
      const pg8::i32x8_ a10 = __builtin_shufflevector(*(const i4*)(kb + 4096 + KSWZ8(r32, 32 * hi)), *(const i4*)(kb + 4096 + KSWZ8(r32, 32 * hi + 16)), 0, 1, 2, 3, 4, 5, 6, 7);
      asm volatile("s_waitcnt lgkmcnt(0)\n\tv_mfma_scale_f32_32x32x64_f8f6f4 %0, %2, %4, 0, %5, %5 op_sel_hi:[0,0,0]\n\tv_mfma_scale_f32_32x32x64_f8f6f4 %1, %3, %4, 0, %5, %5 op_sel_hi:[0,0,0]"
                   : "=&v"(p0), "=&v"(p1) : "v"(a00), "v"(a10), "v"(q8[0]), "v"(one) : "memory"); }
    { const pg8::i32x8_ a01 = __builtin_shufflevector(*(const i4*)(kb + KSWZ8(r32, 64 + 32 * hi)), *(const i4*)(kb + KSWZ8(r32, 64 + 32 * hi + 16)), 0, 1, 2, 3, 4, 5, 6, 7);
      const pg8::i32x8_ a11 = __builtin_shufflevector(*(const i4*)(kb + 4096 + KSWZ8(r32, 64 + 32 * hi)), *(const i4*)(kb + 4096 + KSWZ8(r32, 64 + 32 * hi + 16)), 0, 1, 2, 3, 4, 5, 6, 7);
      asm volatile("s_waitcnt lgkmcnt(0)\n\tv_mfma_scale_f32_32x32x64_f8f6f4 %0, %2, %4, %0, %5, %5 op_sel_hi:[0,0,0]\n\tv_mfma_scale_f32_32x32x64_f8f6f4 %1, %3, %4, %1, %5, %5 op_sel_hi:[0,0,0]\n\ts_nop 15\n\ts_nop 15\n\ts_nop 15\n\ts_nop 15"
                   : "+v"(p0), "+v"(p1) : "v"(a01), "v"(a11), "v"(q8[1]), "v"(one) : "memory"); }
}
template <int VB, bool SK>
DEVI void pv_tile(f32x16* o, int vb0, bf16x8 pa0, bf16x8 pa1, bf16x8 pa2, bf16x8 pa3, bool act) {
    if (SK && !act) return;
#define TRRD(dst, off) asm volatile("ds_read_b64_tr_b16 %0, %1 offset:%2" : "=&v"(dst) : "v"(vb0), "i"(off) : "memory")
#define PV_D0(d0) do { s16x4 l0, l1, l2, l3, h0, h1, h2, h3; constexpr int b_ = VB * SHM_V + v_rd_off(d0, 0, 0); \
        TRRD(l0, b_); TRRD(h0, b_ + 2048); TRRD(l1, b_ + 4096); TRRD(h1, b_ + 6144); TRRD(l2, b_ + 8192); TRRD(h2, b_ + 10240); TRRD(l3, b_ + 12288); TRRD(h3, b_ + 14336); \
        asm volatile("s_waitcnt lgkmcnt(0)" ::: "memory"); SBAR();   \
        o[d0] = __builtin_amdgcn_mfma_f32_32x32x16_bf16(pa0, (bf16x8){l0[0], l0[1], l0[2], l0[3], h0[0], h0[1], h0[2], h0[3]}, o[d0], 0, 0, 0);   \
        o[d0] = __builtin_amdgcn_mfma_f32_32x32x16_bf16(pa1, (bf16x8){l1[0], l1[1], l1[2], l1[3], h1[0], h1[1], h1[2], h1[3]}, o[d0], 0, 0, 0);   \
        o[d0] = __builtin_amdgcn_mfma_f32_32x32x16_bf16(pa2, (bf16x8){l2[0], l2[1], l2[2], l2[3], h2[0], h2[1], h2[2], h2[3]}, o[d0], 0, 0, 0);   \
        o[d0] = __builtin_amdgcn_mfma_f32_32x32x16_bf16(pa3, (bf16x8){l3[0], l3[1], l3[2], l3[3], h3[0], h3[1], h3[2], h3[3]}, o[d0], 0, 0, 0); } while (0)
    PV_D0(0); PV_D0(1); PV_D0(2); PV_D0(3);
#undef PV_D0
#undef TRRD
}
struct ABlock { const unsigned char* Q; const unsigned char* K; const u16* V; int P0, row0, b, head; };
struct Seam { pg8::i32x8_ q8[2]; u32x4 st_k; bf16x8 st_v0, st_v1; unsigned selw0, selw1; };
struct Epi { const float* gates; u16* dst; const u16* oc; const u16* ow; float* imp; const unsigned long long* sel; };
template <int MODE> DEVI int jlo(int P0) { if (MODE == M_WIN) { const int lowk = P0 - WIN + 1; return lowk > 0 ? lowk / KVBLK : 0; } return 0; }
template <int MODE, int QBE = QB> DEVI int jhi(int P0) {
    if (MODE == M_CMP) { const int n = (nvis(P0 + QBE - 1) + KVBLK - 1) / KVBLK; return n < 1 ? 1 : n; }
    return (P0 + QBE - 1) / KVBLK + 1; }
#define ROWB(p, k0) ((const char*)((p) + (size_t)(k0) * LDK))
#define VMW() asm volatile("s_waitcnt vmcnt(0)" ::: "memory")
#define VMWN(n) asm volatile("s_waitcnt vmcnt(%0)" :: "i"(n) : "memory")
#define SLOAD_H(Kp, Vp, k0) do { const char* vb_ = ROWB(Vp, k0); const char* kb__ = (const char*)(Kp) + (size_t)(k0) * LDK8;                     \
                         S.st_v0 = load8((const u16*)(vb_ + voff0)); S.st_v1 = load8((const u16*)(vb_ + voff1));              \
                         S.st_k = *(const u32x4*)(kb__ + koff8); } while (0)
#define SWRITE_HK(bf) do { *(u32x4*)(K_lds + (bf) * SHM_K + kws) = S.st_k; } while (0)
#define SWRITE_HV(bf) do { *(bf16x8*)(V_lds + (bf) * SHM_V + vst0) = S.st_v0; *(bf16x8*)(V_lds + (bf) * SHM_V + vst1) = S.st_v1; } while (0)
#define SWRITE_H(bf) do { SWRITE_HV(bf); SWRITE_HK(bf); } while (0)
template <int MODE, int LDK, int LDK8, bool GQ = false>
DEVI void prime(const ABlock& cur, char* lds, Seam& S, const int tid, const unsigned long long* selp) {
    const int wid = __builtin_amdgcn_readfirstlane(tid >> 6), lane = tid & 63, r32 = lane & 31, hi = lane >> 5;
    const int sr = tid >> 4, sc = (tid & 15) * 8, kws = KSWZ8(tid >> 3, (tid & 7) * 16); char* K_lds = lds + 2 * SHM_V;
    const unsigned voff0 = (unsigned)(sr * LDK + sc) * 2u, voff1 = (unsigned)((32 + sr) * LDK + sc) * 2u, koff8 = (unsigned)((tid >> 3) * LDK8 + (tid & 7) * 16);
    const unsigned qoff = GQ ? (unsigned)(((wid & 1) * QBLK + r32) * 3072 + (wid >> 1) * 128 + hi * 32) : (unsigned)((wid * QBLK + r32) * 3072 + hi * 32);
    const int kb0 = jlo<MODE>(cur.P0) * KVBLK;
    { typedef int i4 __attribute__((ext_vector_type(4)));
#pragma unroll
      for (int s_ = 0; s_ < 2; ++s_) S.q8[s_] = __builtin_shufflevector(*(const i4*)(cur.Q + qoff + 64 * s_), *(const i4*)(cur.Q + qoff + 64 * s_ + 16), 0, 1, 2, 3, 4, 5, 6, 7); }
    S.selw0 = 0u; S.selw1 = 0u;
    if (MODE == M_SEL) { const int wrow_ = GQ ? (wid & 1) * QBLK : wid * QBLK; const unsigned long long sw = selp[(size_t)(cur.b * 4 + (cur.head >> 2)) * 4096 + cur.P0 + wrow_ + r32]; S.selw0 = (unsigned)sw; S.selw1 = (unsigned)(sw >> 32); }
    SLOAD_H(cur.K, cur.V, kb0); VMW(); SWRITE_HK(0);
    __syncthreads();
}
template <int MODE, int EPI, int GK, int LDK, int LDK8, bool SK, bool GQ = false>
DEVI void block(const ABlock& cur, const ABlock& nxt, char* lds, Seam& S, const Epi& E, const int tid) {
    const int wid = __builtin_amdgcn_readfirstlane(tid >> 6), lane = tid & 63, r32 = lane & 31, hi = lane >> 5;
    const int wrow = GQ ? (wid & 1) * QBLK : wid * QBLK, whead = GQ ? cur.head + (wid >> 1) : cur.head;
    const int j_lo = jlo<MODE>(cur.P0), j_hi = jhi<MODE, GQ ? 64 : QB>(cur.P0);
    const int NT = j_hi - j_lo;
    const int kbn = jlo<MODE>(nxt.P0) * KVBLK;
    const int qlo = cur.P0 + wrow, qm = qlo + r32 - 4 * hi;
    char* V_lds = lds; char* K_lds = lds + 2 * SHM_V;
    float* wsl = (float*)(lds + 2 * SHM_V + 2 * SHM_K) + wid * 64; float* li_l = wsl, * al_l = wsl + 32;
    float m_reg = -1e30f, l_reg = 0; f32x16 o[4] = {};
    const int sr = tid >> 4, sc = (tid & 15) * 8, vst0 = v_st(sr, sc), vst1 = v_st(32 + sr, sc), kws = KSWZ8(tid >> 3, (tid & 7) * 16);
    const unsigned voff0 = (unsigned)(sr * LDK + sc) * 2u, voff1 = (unsigned)((32 + sr) * LDK + sc) * 2u, koff8 = (unsigned)((tid >> 3) * LDK8 + (tid & 7) * 16);
    const unsigned qoff = GQ ? (unsigned)(((wid & 1) * QBLK + r32) * 3072 + (wid >> 1) * 128 + hi * 32) : (unsigned)((wid * QBLK + r32) * 3072 + hi * 32);
    const int vb0 = (int)(uintptr_t)V_lds + v_rd_base(lane);
    const unsigned char* Kh = cur.K; const u16* Vh = cur.V;
    float gpre = 0.f;
    if (EPI != E_IMP && GK >= 0) gpre = E.gates[(size_t)(cur.row0 + wrow + r32) * 64 + 8 + whead * 3 + (GK < 0 ? 0 : GK)];
    unsigned sello = 0u, selhi = 0u; int nvl = 0;
    if (MODE == M_SEL) { sello = S.selw0; selhi = S.selw1; }
    if (MODE == M_CMP) nvl = nvis(qlo + r32) - 4 * hi;
#define RESC(a) do { if (__any((a) < 1.f)) { if (hi == 0) al_l[r32] = (a); asm volatile("s_waitcnt lgkmcnt(0)" ::: "memory");              \
                     for (int d_ = 0; d_ < 4; ++d_) for (int r = 0; r < 16; ++r) o[d_][r] *= al_l[crow(r, hi)]; } } while (0)
#define KBASE(t) ((j_lo + (t)) * KVBLK)
#define ACT(t) (MODE == M_WIN ? (KBASE(t) <= qlo + QBLK - 1 && KBASE(t) + KVBLK - 1 >= qlo - WIN + 1) : MODE == M_SEL ? (KBASE(t) <= qlo + QBLK - 1) : (KBASE(t) < nvis(qlo + QBLK - 1)))
#define MASKT(P0_, P1_, t) do { const int kb_ = KBASE(t); if (!SK || ACT(t)) {                                                             \
        if (MODE == M_WIN) { if (kb_ + KVBLK - 1 > qlo || kb_ <= qlo + QBLK - 1 - WIN) mask_tile(P0_, P1_, qm - kb_, (unsigned)WIN); }       \
        else if (MODE == M_SEL) { if (kb_ + KVBLK - 1 > qlo) mask_tile(P0_, P1_, qm - kb_, 0x40000000u);                                    \
            const int jt_ = j_lo + (t); const unsigned w_ = (jt_ & 32) ? selhi : sello; killf = ((w_ >> (jt_ & 31)) & 1u) == 0u; } \
        else { mask_cmp(P0_, P1_, nvl - kb_); } } } while (0)
    constexpr int NQL = 4;
#define SEAM_K0() do { VMWN(NQL); SWRITE_HK(0); SBAR(); } while (0)
    f32x16 pA0, pA1, pB0, pB1; float mnA, mnB, alA, alB; bf16x8 pa0, pa1, pa2, pa3; bool killf = false;
    SWRITE_HV(0); SBAR();
    if (NT > 1) { SLOAD_H(Kh, Vh, KBASE(1)); }
    SBAR(); qkt<0, SK>(pA0, pA1, K_lds, r32, hi, S.q8, ACT(0));
    MASKT(pA0, pA1, 0); partialSM(pA0, pA1, m_reg, mnA, alA, MODE == M_SEL && killf);
    if (NT > 1) { VMW(); SWRITE_H(1); }
    __syncthreads();
#define HALF_STEP(PX0, PX1, mnX, alX, PY0, PY1, alY, t, KB, VB, SB) do {                                                      \
        SBAR(); qkt<KB, SK>(PX0, PX1, K_lds, r32, hi, S.q8, ACT(t));                                             \
        finishSM(PY0, PY1, alY, l_reg, pa0, pa1, pa2, pa3); SBAR();                                                           \
        if ((t) + 1 < NT) { SLOAD_H(Kh, Vh, KBASE((t) + 1)); SBAR(); }                                               \
        pv_tile<VB, SK>(o, vb0, pa0, pa1, pa2, pa3, ACT((t) - 1)); MASKT(PX0, PX1, (t)); partialSM(PX0, PX1, m_reg, mnX, alX, MODE == M_SEL && killf);                                        \
        __syncthreads();                                                                                                      \
        if ((t) + 1 < NT) { VMW(); SWRITE_H(SB); }                                                                          \
        RESC(alX); __syncthreads(); } while (0)
    for (int t = 1; t + 1 < NT; t += 2) {
        HALF_STEP(pB0, pB1, mnB, alB, pA0, pA1, alA, t, 1, 0, 0);
        HALF_STEP(pA0, pA1, mnA, alA, pB0, pB1, alB, t + 1, 0, 1, 1);
    }
    const bool even = (NT & 1) == 0;
    if (even) { SBAR(); qkt<1, SK>(pB0, pB1, K_lds, r32, hi, S.q8, ACT(NT - 1)); SBAR(); }
    { const unsigned char* nK = nxt.K; const u16* nV = nxt.V; SLOAD_H(nK, nV, kbn); SBAR();
      typedef int i4 __attribute__((ext_vector_type(4)));
#pragma unroll
      for (int s_ = 0; s_ < 2; ++s_) S.q8[s_] = __builtin_shufflevector(*(const i4*)(nxt.Q + qoff + 64 * s_), *(const i4*)(nxt.Q + qoff + 64 * s_ + 16), 0, 1, 2, 3, 4, 5, 6, 7);
      if (MODE == M_SEL) { const unsigned long long sw = E.sel[(size_t)(nxt.b * 4 + (nxt.head >> 2)) * 4096 + nxt.P0 + wrow + r32]; S.selw0 = (unsigned)sw; S.selw1 = (unsigned)(sw >> 32); } }
    SBAR();
    finishSM(pA0, pA1, alA, l_reg, pa0, pa1, pa2, pa3); SBAR();
    pv_tile<0, SK>(o, vb0, pa0, pa1, pa2, pa3, ACT(even ? NT - 2 : NT - 1));
    if (even) { MASKT(pB0, pB1, NT - 1); partialSM(pB0, pB1, m_reg, mnB, alB, MODE == M_SEL && killf); __syncthreads(); RESC(alB);
        finishSM(pB0, pB1, alB, l_reg, pa0, pa1, pa2, pa3); SBAR(); pv_tile<1, SK>(o, vb0, pa0, pa1, pa2, pa3, ACT(NT - 1)); }
    SBAR(); SEAM_K0();
    if (hi == 0) { li_l[r32] = l_reg; if (EPI != E_IMP && GK >= 0) al_l[r32] = sigm(gpre); }
    asm volatile("s_waitcnt lgkmcnt(0)" ::: "memory");
    float rli[16];
#pragma unroll
    for (int r = 0; r < 16; ++r) { const float l_ = li_l[crow(r, hi)]; rli[r] = l_ > 0.f ? __builtin_amdgcn_rcpf(l_) : 0.f; if (EPI != E_IMP && GK >= 0) rli[r] *= al_l[crow(r, hi)]; }
    const size_t ebase = ((size_t)cur.row0 * D_ + whead * 128) * 2;
    const unsigned elane = (unsigned)((wrow + 4 * hi) * D_ + r32) * 2u;
    float* impb = E.imp + ((size_t)(cur.b * 16 + whead) * 4096 + cur.P0) * 64;
    const unsigned ilane = (unsigned)((wrow + 4 * hi) * 64 + r32) * 4u;
    const size_t frb = ((((size_t)(cur.b * 16 + whead) * 128 + ((cur.P0 + wrow) >> 5)) * 64 + lane) * 64) * 2;
    if (EPI == E_GATED) {
#pragma unroll
        for (int i = 0; i < 8; ++i) { const int r0 = 2 * i, r1 = 2 * i + 1; u32x4 w;
            w.x = cvtpk(o[0][r0] * rli[r0], o[1][r0] * rli[r0]); w.y = cvtpk(o[2][r0] * rli[r0], o[3][r0] * rli[r0]);
            w.z = cvtpk(o[0][r1] * rli[r1], o[1][r1] * rli[r1]); w.w = cvtpk(o[2][r1] * rli[r1], o[3][r1] * rli[r1]);
            *(u32x4*)((char*)E.dst + frb + i * 16) = w; }
    } else if (EPI == E_FINAL) {
        u32x4 cq[8], wq[8];
#pragma unroll
        for (int i = 0; i < 8; ++i) { cq[i] = *(const u32x4*)((const char*)E.oc + frb + i * 16); wq[i] = *(const u32x4*)((const char*)E.ow + frb + i * 16); }
#pragma unroll
        for (int r = 0; r < 16; ++r) { const int cr = (r & 3) + 8 * (r >> 2);
#pragma unroll
            for (int d0 = 0; d0 < 4; ++d0) { const float v = o[d0][r] * rli[r];
                const unsigned cw = cq[r >> 1][(r & 1) * 2 + (d0 >> 1)], ww = wq[r >> 1][(r & 1) * 2 + (d0 >> 1)];
                const float cv = __uint_as_float((d0 & 1) ? (cw & 0xffff0000u) : (cw << 16)), wv = __uint_as_float((d0 & 1) ? (ww & 0xffff0000u) : (ww << 16));
                const unsigned off = elane + (unsigned)(cr * D_ + d0 * 32) * 2u;
                const float f = (v + cv + wv) * 8.f;
                const float f1 = __int_as_float(__builtin_amdgcn_mov_dpp(__float_as_int(f), 0x55, 0xF, 0xF, true)), f2 = __int_as_float(__builtin_amdgcn_mov_dpp(__float_as_int(f), 0xAA, 0xF, 0xF, true)),
                            f3 = __int_as_float(__builtin_amdgcn_mov_dpp(__float_as_int(f), 0xFF, 0xF, 0xF, true));
                if ((r32 & 3) == 0) *(unsigned*)((char*)E.dst + (ebase >> 1) + (off >> 1)) = pk4_fp8(f, f1, f2, f3); } }
    } else {
#pragma unroll
        for (int r = 0; r < 16; ++r) { const int cr = (r & 3) + 8 * (r >> 2);
#pragma unroll
            for (int d0 = 0; d0 < 2; ++d0) *(float*)((char*)impb + ilane + (unsigned)(cr * 64 + d0 * 32) * 4u) = o[d0][r] * rli[r]; }
    }
    __syncthreads();
#undef RESC
#undef KBASE
#undef ACT
#undef MASKT
#undef SEAM_K0
#undef HALF_STEP
}
#undef ROWB
#undef VMW
#undef VMWN
#undef SLOAD_H
#undef SWRITE_HK
#undef SWRITE_HV
#undef SWRITE_H
struct Item { int b, head, qb0, qb1; };
template <bool PAIRED> DEVI Item decode(int L) {
    Item it; const int xcd = L & 7, k = L >> 3;
    if (PAIRED) { const int gi = k >> 5, r = k & 31, hl = r >> 3, x = r & 7; const int bg = gi * 8 + xcd; it.b = bg >> 2; it.head = (bg & 3) * 4 + hl; it.qb0 = x; it.qb1 = 15 - x; }
    else { const int gi = k >> 6, r = k & 63, hl = r >> 4, x = r & 15; const int bg = gi * 8 + xcd; it.b = bg >> 2; it.head = (bg & 3) * 4 + hl; it.qb0 = it.qb1 = (hl & 2) ? x : 15 - x; }
    return it;
}
template <bool PAIRED> DEVI Item decode_gq(int L) {
    Item it; const int xcd = L & 7, k = L >> 3;
    if (PAIRED) { const int gi = k >> 5, x = k & 31, bg = gi * 8 + xcd; it.b = bg >> 2; it.head = (bg & 3) * 4; it.qb0 = x; it.qb1 = 63 - x; }
    else { const int gi = k >> 6, x = k & 63, bg = gi * 8 + xcd; it.b = bg >> 2; it.head = (bg & 3) * 4; it.qb0 = it.qb1 = (x & 32) ? 63 - (x & 31) : (x & 31); }
    return it;
}
template <int MODE, bool GQ = false> DEVI ABlock mkref(const Item& it, int pass, const u16* z, const unsigned char* z8, const unsigned char* kcmp8, const u16* vcmp) {
    const int qb = pass ? it.qb1 : it.qb0; ABlock r; r.b = it.b; r.head = it.head; r.P0 = qb * (GQ ? 64 : QB); r.row0 = it.b * 4096 + r.P0;
    r.Q = z8 + (size_t)r.row0 * 3072 + it.head * 128;
    const int g = it.head >> 2;
    if (MODE == M_WIN) { r.K = z8 + (size_t)it.b * 4096 * 3072 + 2560 + g * 128; r.V = z + (size_t)it.b * 4096 * NPAD + C_VW + g * 128; }
    else if (MODE == M_SEL) { r.K = z8 + (size_t)it.b * 4096 * 3072 + 2048 + g * 128; r.V = z + (size_t)it.b * 4096 * NPAD + C_VS + g * 128; }
    else { r.K = kcmp8 + (size_t)(it.b * 4 + g) * 256 * 128; r.V = vcmp; }
    return r;
}
template <int MODE, int EPI, int GK, int LDK, int LDK8, bool SK, bool PAIRED, bool GQ = false>
DEVI void run_pass(const u16* z, const unsigned char* z8, const unsigned char* kcmp8, const u16* vcmp, size_t vcmp_stride, char* lds, const Epi& E, const int tid_in, int G) {
    int tz_ = tid_in; asm volatile("" : "+v"(tz_)); const int tid = tz_;
    constexpr int total = PAIRED ? 512 : 1024;
    int L = blockIdx.x; if (L >= total) return;
    Item it = GQ ? decode_gq<PAIRED>(L) : decode<PAIRED>(L); int pass = 0;
    ABlock cur = mkref<MODE, GQ>(it, 0, z, z8, kcmp8, vcmp + (size_t)(it.b * 4 + (it.head >> 2)) * vcmp_stride);
    Seam S;
    prime<MODE, LDK, LDK8, GQ>(cur, lds, S, tid, E.sel);
    for (;;) {
        const bool more_pass = pass == 0 && it.qb1 != it.qb0, more_item = L + G < total, last = !more_pass && !more_item;
        Item itn = it; int passn = pass + 1, Ln = L;
        if (!more_pass) { passn = 0; Ln = more_item ? L + G : L; itn = GQ ? decode_gq<PAIRED>(Ln) : decode<PAIRED>(Ln); }
        const ABlock nxt = last ? cur : mkref<MODE, GQ>(itn, passn, z, z8, kcmp8, vcmp + (size_t)(itn.b * 4 + (itn.head >> 2)) * vcmp_stride);
        block<MODE, EPI, GK, LDK, LDK8, SK, GQ>(cur, nxt, lds, S, E, tid);
        if (last) break;
        cur = nxt; it = itn; pass = passn; L = Ln;
    }
}
}

DEVI void phase_nsa1(KP a, unsigned char* lds, const int tid, int G) {
    unsigned char* ws = a->ws;
    const u16* z = (const u16*)(ws + WS_Z); const u16* kcmp = (const u16*)(ws + WS_KCMP); const u16* vcmp = kcmp + (size_t)16 * 256 * 128;
    att::Epi E{(const float*)(ws + WS_GATES), (u16*)(ws + WS_OC), nullptr, nullptr, (float*)(ws + WS_IMP), nullptr};
#ifndef NSA1_PASSES
#define NSA1_PASSES 7
#endif
#ifndef WIN_SK
#define WIN_SK false
#endif
    const unsigned char* z8 = ws + WS_Z8; const unsigned char* kcmp8 = ws + WS_KCMP8;
    if (NSA1_PASSES & 1) att::run_pass<att::M_CMP, att::E_GATED, 0, 128, 128, false, false, GQ_CV>(z, z8, kcmp8, vcmp, (size_t)256 * 128, (char*)lds, E, tid, G);
    __syncthreads();
    if (NSA1_PASSES & 2) att::run_pass<att::M_CMP, att::E_IMP, 0, 128, 128, false, false, GQ_CI>(z, z8, kcmp8, (const u16*)(ws + WS_OVL), 0, (char*)lds, E, tid, G);
    __syncthreads();
    E.dst = (u16*)(ws + WS_OW);
    if (NSA1_PASSES & 4) att::run_pass<att::M_WIN, att::E_GATED, 2, NPAD, 3072, WIN_SK, false, GQ_W>(z, z8, kcmp8, nullptr, 0, (char*)lds, E, tid, G);
}
DEVI void phase_topk(KP a, int lane, int wave, int G) {
    unsigned char* ws = a->ws; const float* imp = (const float*)(ws + WS_IMP); unsigned long long* sel = (unsigned long long*)(ws + WS_SEL);
    const int gw = blockIdx.x * 8 + wave, NGW = G * 8;
    float pf0[4], pf1[4];
    { const int task = gw * 2; if (task < M_ * 4) { const int bg = task >> 12, t = task & 4095, b = bg >> 2, g = bg & 3;
#pragma unroll
        for (int h = 0; h < 4; ++h) { const float* p = imp + ((size_t)(b * 16 + g * 4 + h) * 4096 + t) * 64 + lane; pf0[h] = p[0]; pf1[h] = p[64]; } } }
    for (int task = gw * 2; task < M_ * 4; task += NGW * 2) { const int bg = task >> 12, t = task & 4095;
        const float v0 = (pf0[0] + pf0[1]) + (pf0[2] + pf0[3]), v1 = (pf1[0] + pf1[1]) + (pf1[2] + pf1[3]);
        { const int tn = task + NGW * 2; if (tn < M_ * 4) { const int bgn = tn >> 12, t2 = tn & 4095, b = bgn >> 2, g = bgn & 3;
#pragma unroll
            for (int h = 0; h < 4; ++h) { const float* p = imp + ((size_t)(b * 16 + g * 4 + h) * 4096 + t2) * 64 + lane; pf0[h] = p[0]; pf1[h] = p[64]; } } }
        const int cur0 = t >> 6, cur1 = (t + 1) >> 6;
        const float s0 = ((lane == 0) || (lane == cur0) || (lane == cur0 - 1)) ? INFINITY : (lane <= cur0 ? v0 : -INFINITY);
        const float s1 = ((lane == 0) || (lane == cur1) || (lane == cur1 - 1)) ? INFINITY : (lane <= cur1 ? v1 : -INFINITY);
        int r0 = 0, r1 = 0;
#pragma unroll
        for (int jj = 0; jj < 64; ++jj) { const float a0 = __int_as_float(__builtin_amdgcn_readlane(__float_as_int(s0), jj)), a1 = __int_as_float(__builtin_amdgcn_readlane(__float_as_int(s1), jj));
            r0 += (a0 > s0 || (a0 == s0 && jj < lane)) ? 1 : 0; r1 += (a1 > s1 || (a1 == s1 && jj < lane)) ? 1 : 0; }
        const unsigned long long m0 = __ballot(r0 < 16 && lane <= cur0), m1 = __ballot(r1 < 16 && lane <= cur1);
        if (lane == 0) { sel[(size_t)bg * 4096 + t] = m0; sel[(size_t)bg * 4096 + t + 1] = m1; } }
}
DEVI void phase_nsa2(KP a, unsigned char* lds, const int tid, int G) {
    unsigned char* ws = a->ws;
    const u16* z = (const u16*)(ws + WS_Z);
    att::Epi E{(const float*)(ws + WS_GATES), (u16*)(ws + WS_O), (const u16*)(ws + WS_OC), (const u16*)(ws + WS_OW), nullptr, (const unsigned long long*)(ws + WS_SEL)};
    att::run_pass<att::M_SEL, att::E_FINAL, 1, NPAD, 3072, false, true, GQ_S>(z, ws + WS_Z8, nullptr, nullptr, 0, (char*)lds, E, tid, G);
}

typedef float f32x4_t __attribute__((ext_vector_type(4)));
DEVI void phase_ln1_router(KP a, unsigned char* lds, int tid, int lane, int wave, int G, int l) {
    unsigned char* ws = a->ws;
    const u16* pre = (const u16*)(ws + WS_H); u16* xa = (u16*)(ws + WS_XA); unsigned char* xb = ws + WS_XBF;
    const float* g1 = a->in[17] + l * D_; const float* b1 = a->in[18] + l * D_; const float* rb = a->in[20]; const float* wT = (const float*)(ws + WS_RWT);
    int* tokinfo = (int*)(ws + WS_MISC); int* hist = (int*)(ws + WS_MISC + 1280 * 1024);
    int* be = (int*)lds;
    float* lg = (float*)(lds + 1024);
    const int g4 = lane >> 4, l15 = lane & 15;
    for (int chunk = blockIdx.x; chunk < 256; chunk += G) {
      f32x4 gq[4][2], bq[4][2];
#pragma unroll
      for (int j = 0; j < 4; ++j)
#pragma unroll
          for (int hh = 0; hh < 2; ++hh) { gq[j][hh] = *(const f32x4*)(g1 + j * 512 + lane * 8 + 4 * hh); bq[j][hh] = *(const f32x4*)(b1 + j * 512 + lane * 8 + 4 * hh); }
      u32x4 pc[4], pn[4];
#pragma unroll
      for (int j = 0; j < 4; ++j) pc[j] = *(const u32x4*)(pre + (size_t)(chunk * 64 + wave * 8) * D_ + j * 512 + lane * 8);
      for (int rr = 0; rr < 8; ++rr) {
        const int row = chunk * 64 + wave * 8 + rr;
        if (rr < 7) {
#pragma unroll
            for (int j = 0; j < 4; ++j) pn[j] = *(const u32x4*)(pre + (size_t)(row + 1) * D_ + j * 512 + lane * 8); }
        float v[4][8]; float s = 0.f;
#pragma unroll
        for (int j = 0; j < 4; ++j) { unpack8(pc[j], v[j]); s += ((v[j][0] + v[j][1]) + (v[j][2] + v[j][3])) + ((v[j][4] + v[j][5]) + (v[j][6] + v[j][7])); }
        const float mean = wsum(s) * (1.f / D_); float q = 0.f;
#pragma unroll
        for (int j = 0; j < 4; ++j)
#pragma unroll
            for (int e = 0; e < 8; ++e) { v[j][e] -= mean; q += v[j][e] * v[j][e]; }
        const float rstd = 1.f / sqrtf(wsum(q) * (1.f / D_) + LN_EPS);
#pragma unroll
        for (int j = 0; j < 4; ++j) { const int c0 = j * 512 + lane * 8; float y[8];
#pragma unroll
            for (int e = 0; e < 8; ++e) y[e] = v[j][e] * rstd * gq[j][e >> 2][e & 3] + bq[j][e >> 2][e & 3];
            u32x4 wx; wx.x = pk2(y[0], y[1]); wx.y = pk2(y[2], y[3]); wx.z = pk2(y[4], y[5]); wx.w = pk2(y[6], y[7]); *(u32x4*)(xa + (size_t)row * D_ + c0) = wx;
            u32x2 w8; w8.x = pk4_fp8(y[0], y[1], y[2], y[3]); w8.y = pk4_fp8(y[4], y[5], y[6], y[7]); *(u32x2*)(xb + (size_t)row * D_ + c0) = w8; }
#pragma unroll
        for (int j = 0; j < 4; ++j) pc[j] = pn[j];
      }
      asm volatile("s_waitcnt vmcnt(0)" ::: "memory"); __syncthreads();
      {
          f32x4 racc[4][2];
#pragma unroll
          for (int rt = 0; rt < 4; ++rt) { racc[rt][0] = (f32x4){0.f, 0.f, 0.f, 0.f}; racc[rt][1] = (f32x4){0.f, 0.f, 0.f, 0.f}; }
          const u16* ap = xa + (size_t)(chunk * 64 + l15) * D_ + wave * 256 + 8 * g4; const float* bp = wT + (size_t)l15 * D_ + wave * 256 + 8 * g4;
#pragma unroll 2
          for (int blk = 0; blk < 8; ++blk) { u32x4 ar[4]; f32x4 br[2][2];
#pragma unroll
              for (int rt = 0; rt < 4; ++rt) ar[rt] = *(const u32x4*)(ap + (size_t)rt * 16 * D_ + 32 * blk);
#pragma unroll
              for (int et = 0; et < 2; ++et) { br[et][0] = *(const f32x4*)(bp + (size_t)et * 16 * D_ + 32 * blk); br[et][1] = *(const f32x4*)(bp + (size_t)et * 16 * D_ + 32 * blk + 4); }
#pragma unroll
              for (int rt = 0; rt < 4; ++rt) { float af[8]; unpack8(ar[rt], af);
#pragma unroll
                  for (int e = 0; e < 8; ++e) { racc[rt][0] = __builtin_amdgcn_mfma_f32_16x16x4f32(af[e], br[0][e >> 2][e & 3], racc[rt][0], 0, 0, 0); racc[rt][1] = __builtin_amdgcn_mfma_f32_16x16x4f32(af[e], br[1][e >> 2][e & 3], racc[rt][1], 0, 0, 0); } } }
          f32x4* part = (f32x4*)(lds + 16384);
#pragma unroll
          for (int rt = 0; rt < 4; ++rt) { part[(wave * 8 + rt * 2) * 64 + lane] = racc[rt][0]; part[(wave * 8 + rt * 2 + 1) * 64 + lane] = racc[rt][1]; }
          __syncthreads();
          { f32x4 v = part[wave * 64 + lane];
#pragma unroll
            for (int w2 = 1; w2 < 8; ++w2) v = v + part[(w2 * 8 + wave) * 64 + lane];
#pragma unroll
            for (int j = 0; j < 4; ++j) lg[((wave >> 1) * 16 + 4 * g4 + j) * 33 + (wave & 1) * 16 + l15] = v[j]; }
      }
      __syncthreads();
      if (tid < 64) { const int row = chunk * 64 + tid;
        float aff[32], sel[32];
#pragma unroll
        for (int e = 0; e < 32; ++e) { aff[e] = sigm(lg[tid * 33 + e]); sel[e] = aff[e] + rb[e]; }
        int bg_ = 0; float bs = -INFINITY;
#pragma unroll
        for (int gq = 0; gq < 8; ++gq) { const float s0 = sel[gq * 4], s1 = sel[gq * 4 + 1], s2 = sel[gq * 4 + 2], s3 = sel[gq * 4 + 3];
            const float mx = fmaxf(fmaxf(s0, s1), fmaxf(s2, s3));
            const float m2 = fmaxf(fmaxf(fminf(s0, s1), fminf(s2, s3)), fminf(fmaxf(s0, s1), fmaxf(s2, s3)));
            const float gs = mx + m2; if (gs > bs) { bs = gs; bg_ = gq; } }
        float c0 = 0.f, c1 = 0.f, c2 = 0.f, c3 = 0.f, a0 = 0.f, a1 = 0.f, a2 = 0.f, a3 = 0.f;
#pragma unroll
        for (int gq = 0; gq < 8; ++gq) if (gq == bg_) { c0 = sel[gq * 4]; c1 = sel[gq * 4 + 1]; c2 = sel[gq * 4 + 2]; c3 = sel[gq * 4 + 3]; a0 = aff[gq * 4]; a1 = aff[gq * 4 + 1]; a2 = aff[gq * 4 + 2]; a3 = aff[gq * 4 + 3]; }
        int i1 = 0; float m1 = c0;
        if (c1 > m1) { m1 = c1; i1 = 1; } if (c2 > m1) { m1 = c2; i1 = 2; } if (c3 > m1) { m1 = c3; i1 = 3; }
        int i2 = -1; float m2v = -INFINITY;
        if (i1 != 0 && c0 > m2v) { m2v = c0; i2 = 0; } if (i1 != 1 && c1 > m2v) { m2v = c1; i2 = 1; } if (i1 != 2 && c2 > m2v) { m2v = c2; i2 = 2; } if (i1 != 3 && c3 > m2v) { m2v = c3; i2 = 3; }
        if (i2 < 0) i2 = (i1 == 0) ? 1 : 0;
        float w1 = i1 == 0 ? a0 : i1 == 1 ? a1 : i1 == 2 ? a2 : a3, w2 = i2 == 0 ? a0 : i2 == 1 ? a1 : i2 == 2 ? a2 : a3;
        const float ws_ = w1 + w2; w1 /= ws_; w2 /= ws_;
        const int e1 = bg_ * 4 + i1, e2 = bg_ * 4 + i2;
        int* ti = tokinfo + (size_t)row * 8; ti[0] = e1; ti[2] = e2; ti[4] = __float_as_int(w1); ti[5] = __float_as_int(w2);
        int r1 = 0, r2 = 0, myh = 0;
        const unsigned long long lt = (1ull << lane) - 1ull;
        for (int e = 0; e < 32; ++e) { const unsigned long long mm1 = __ballot(e1 == e), mm2 = __ballot(e2 == e);
            const int below = __popcll(mm1 & lt) + __popcll(mm2 & lt);
            if (e1 == e) r1 = below; if (e2 == e) r2 = below; if (lane == e) myh = __popcll(mm1) + __popcll(mm2); }
        ti[1] = r1; ti[3] = r2;
        if (lane < 32) hist[chunk * 32 + lane] = myh; }
      __syncthreads();
    }
    (void)be;
}
DEVI int moe_base(const unsigned* cnt, int lane, int& base_out) {
    const unsigned c = cnt[lane & 31]; const int tiles = (int)((c + 255u) >> 8); int incl = tiles;
#pragma unroll
    for (int o = 1; o < 32; o <<= 1) { const int t_ = __shfl_up(incl, o); if ((lane & 31) >= o) incl += t_; }
    base_out = (incl - tiles) * 256; return __shfl(incl, 31);
}
DEVI void phase_moe_gather(KP a, unsigned char* lds, int tid, int lane, int wave, int G, int l) {
    unsigned char* ws = a->ws;
    unsigned* cnt = (unsigned*)(ws + WS_CTL) + CW_CNT + l * 32; int* tokinfo = (int*)(ws + WS_MISC); const int* hist = (const int*)(ws + WS_MISC + 1280 * 1024);
    const unsigned char* xb = ws + WS_XBF; unsigned char* xg = ws + WS_XG; float* roww = (float*)(ws + WS_MISC + 1 * MiB);
    int* so = (int*)lds;
    for (int chunk = blockIdx.x; chunk < 256; chunk += G) {
        if (tid < 64) so[tid] = 0;
        __syncthreads();
        { const int e = tid & 31, seg = tid >> 5; int below = 0, all = 0;
          for (int b2 = seg * 16; b2 < seg * 16 + 16; ++b2) { const int h = hist[b2 * 32 + e]; all += h; if (b2 < chunk) below += h; }
          atomicAdd(&so[e], below); atomicAdd(&so[32 + e], all); }
        __syncthreads();
        if (wave == 0) { const int c = so[32 + (lane & 31)]; const int tiles = (c + 255) >> 8; int incl = tiles;
#pragma unroll
            for (int o = 1; o < 32; o <<= 1) { const int t_ = __shfl_up(incl, o); if ((lane & 31) >= o) incl += t_; }
            if (lane < 32) { so[64 + lane] = (incl - tiles) * 256; if (chunk == 0) cnt[lane] = (unsigned)c; } }
        __syncthreads();
        for (int r0 = 0; r0 < 8; r0 += 4) { u32x4 cp[4][2]; int sl0[4], sl1[4];
#pragma unroll
            for (int q = 0; q < 4; ++q) { const int row = chunk * 64 + wave * 8 + r0 + q; const int* ti = tokinfo + (size_t)row * 8;
                const int e0 = ti[0], rk0 = ti[1], e1 = ti[2], rk1 = ti[3]; sl0[q] = so[64 + e0] + so[e0] + rk0; sl1[q] = so[64 + e1] + so[e1] + rk1;
                const u32x4* src = (const u32x4*)(xb + (size_t)row * D_); cp[q][0] = src[lane]; cp[q][1] = src[64 + lane]; }
#pragma unroll
            for (int q = 0; q < 4; ++q) { const int row = chunk * 64 + wave * 8 + r0 + q; int* ti = tokinfo + (size_t)row * 8;
                u32x4* d0 = (u32x4*)(xg + (size_t)sl0[q] * D_); u32x4* d1 = (u32x4*)(xg + (size_t)sl1[q] * D_);
                d0[lane] = cp[q][0]; d0[64 + lane] = cp[q][1]; d1[lane] = cp[q][0]; d1[64 + lane] = cp[q][1];
                if (lane == 0) { roww[sl0[q]] = __int_as_float(ti[4]); roww[sl1[q]] = __int_as_float(ti[5]); ti[6] = sl0[q]; ti[7] = sl1[q]; } } }
        __syncthreads();
    }
}
DEVI void phase_ln2(KP a, int lane, int wave, int G, int l) {
    unsigned char* ws = a->ws;
    const int* tokinfo = (const int*)(ws + WS_MISC);
    const u16* xa = (const u16*)(ws + WS_XA); const u16* Y = (const u16*)(ws + WS_Y); unsigned char* x8 = ws + WS_X8;
    float* xo = a->out; u16* xoh = (u16*)(ws + WS_XB);
    const float* g2 = a->in[24] + l * D_; const float* b2 = a->in[25] + l * D_;
    const int gw = blockIdx.x * 8 + wave, NGW = G * 8;
    int row = gw; if (row >= M_) return;
    f32x4 gq[4][2], bq[4][2];
#pragma unroll
    for (int j = 0; j < 4; ++j)
#pragma unroll
        for (int hh = 0; hh < 2; ++hh) { gq[j][hh] = *(const f32x4*)(g2 + j * 512 + lane * 8 + 4 * hh); bq[j][hh] = *(const f32x4*)(b2 + j * 512 + lane * 8 + 4 * hh); }
    u32x4 cx[4], c1[4], c2[4], nx[4], n1[4], n2[4];
    int s1 = tokinfo[(size_t)row * 8 + 6], s2 = tokinfo[(size_t)row * 8 + 7];
#pragma unroll
    for (int j = 0; j < 4; ++j) { const int c0 = j * 512 + lane * 8; cx[j] = *(const u32x4*)(xa + (size_t)row * D_ + c0); c1[j] = *(const u32x4*)(Y + (size_t)s1 * D_ + c0); c2[j] = *(const u32x4*)(Y + (size_t)s2 * D_ + c0); }
    int rn = row + NGW, t1 = 0, t2 = 0;
    if (rn < M_) { t1 = tokinfo[(size_t)rn * 8 + 6]; t2 = tokinfo[(size_t)rn * 8 + 7]; }
    for (;;) {
        const bool more = rn < M_;
        if (more) {
#pragma unroll
            for (int j = 0; j < 4; ++j) { const int c0 = j * 512 + lane * 8; nx[j] = *(const u32x4*)(xa + (size_t)rn * D_ + c0); n1[j] = *(const u32x4*)(Y + (size_t)t1 * D_ + c0); n2[j] = *(const u32x4*)(Y + (size_t)t2 * D_ + c0); } }
        const int rnn = rn + NGW; int u1 = 0, u2 = 0;
        if (rnn < M_) { u1 = tokinfo[(size_t)rnn * 8 + 6]; u2 = tokinfo[(size_t)rnn * 8 + 7]; }
        float v[4][8]; float s = 0.f;
#pragma unroll
        for (int j = 0; j < 4; ++j) { float xv[8], y1[8], y2[8]; unpack8(cx[j], xv); unpack8(c1[j], y1); unpack8(c2[j], y2);
#pragma unroll
            for (int e = 0; e < 8; ++e) { v[j][e] = xv[e] * ALPHA + (y1[e] + y2[e]); }
            s += ((v[j][0] + v[j][1]) + (v[j][2] + v[j][3])) + ((v[j][4] + v[j][5]) + (v[j][6] + v[j][7])); }
        const float mean = wsum(s) * (1.f / D_); float q = 0.f;
#pragma unroll
        for (int j = 0; j < 4; ++j)
#pragma unroll
            for (int e = 0; e < 8; ++e) { v[j][e] -= mean; q += v[j][e] * v[j][e]; }
        const float rstd = 1.f / sqrtf(wsum(q) * (1.f / D_) + LN_EPS);
#pragma unroll
        for (int j = 0; j < 4; ++j) { const int c0 = j * 512 + lane * 8; float y[8];
#pragma unroll
            for (int e = 0; e < 8; ++e) y[e] = v[j][e] * rstd * gq[j][e >> 2][e & 3] + bq[j][e >> 2][e & 3];
            if (l == 0) { u32x4 wo; wo.x = pk2(y[0], y[1]); wo.y = pk2(y[2], y[3]); wo.z = pk2(y[4], y[5]); wo.w = pk2(y[6], y[7]); *(u32x4*)(xoh + (size_t)row * D_ + c0) = wo;
                u32x2 w8; w8.x = pk4_fp8(y[0], y[1], y[2], y[3]); w8.y = pk4_fp8(y[4], y[5], y[6], y[7]); *(u32x2*)(x8 + (size_t)row * D_ + c0) = w8; }
            else { *(f32x4*)(xo + (size_t)row * D_ + c0) = (f32x4){y[0], y[1], y[2], y[3]}; *(f32x4*)(xo + (size_t)row * D_ + c0 + 4) = (f32x4){y[4], y[5], y[6], y[7]}; } }
        if (!more) break;
        row = rn; rn = rnn; t1 = u1; t2 = u2;
#pragma unroll
        for (int j = 0; j < 4; ++j) { cx[j] = nx[j]; c1[j] = n1[j]; c2[j] = n2[j]; }
    }
}

constexpr int NGEMM = 15360;
DEVI void phase_gates(KP a, unsigned char* lds, int tid, int G, int l) {
    using pg8::i32x8_; using pg8::i32x4_;
    unsigned char* ws = a->ws;
    const unsigned char* X = ws + WS_X8; const unsigned char* W = ws + WS_WIN + (size_t)l * NPAD * D_ + (size_t)NGEMM * D_;
    const float* bias = (const float*)(ws + WS_BIASP) + l * NPAD + NGEMM; float* gates = (float*)(ws + WS_GATES);
    const int lane = tid & 63, wave = tid >> 6, g4 = lane >> 4, l15 = lane & 15;
    f32x4* red = (f32x4*)lds;
    float* gl = (float*)(lds + 131072);
    const int sclW = 0x79797979, sclA = 0x7f7f7f7f;
    for (int unit = blockIdx.x; unit < M_ / 64; unit += G) {
        const unsigned char* ap = X + (size_t)(unit * 64 + l15) * D_ + wave * 256 + 32 * g4;
        const unsigned char* bp = W + (size_t)l15 * D_ + wave * 256 + 32 * g4;
        i32x8_ af[4][2], bf[4][2];
#pragma unroll
        for (int t = 0; t < 4; ++t)
#pragma unroll
            for (int ks = 0; ks < 2; ++ks) {
                af[t][ks] = __builtin_shufflevector(*(const i32x4_*)(ap + (size_t)t * 16 * D_ + 128 * ks), *(const i32x4_*)(ap + (size_t)t * 16 * D_ + 128 * ks + 16), 0, 1, 2, 3, 4, 5, 6, 7);
                bf[t][ks] = __builtin_shufflevector(*(const i32x4_*)(bp + (size_t)t * 16 * D_ + 128 * ks), *(const i32x4_*)(bp + (size_t)t * 16 * D_ + 128 * ks + 16), 0, 1, 2, 3, 4, 5, 6, 7); }
        f32x4 acc[4][4];
#pragma unroll
        for (int rt = 0; rt < 4; ++rt)
#pragma unroll
            for (int ct = 0; ct < 4; ++ct) acc[rt][ct] = (f32x4){0.f, 0.f, 0.f, 0.f};
#pragma unroll
        for (int ks = 0; ks < 2; ++ks)
#pragma unroll
            for (int rt = 0; rt < 4; ++rt)
#pragma unroll
                for (int ct = 0; ct < 4; ++ct) asm volatile("v_mfma_scale_f32_16x16x128_f8f6f4 %0, %1, %2, %0, %3, %4 op_sel_hi:[0,0,0]" : "+v"(acc[rt][ct]) : "v"(bf[ct][ks]), "v"(af[rt][ks]), "v"(sclW), "v"(sclA));
        asm volatile("s_nop 15\n\ts_nop 15\n\ts_nop 15\n\ts_nop 15" ::: "memory");
#pragma unroll
        for (int rt = 0; rt < 4; ++rt)
#pragma unroll
            for (int ct = 0; ct < 4; ++ct) red[(wave * 16 + rt * 4 + ct) * 64 + lane] = acc[rt][ct];
        __syncthreads();
#pragma unroll
        for (int q = 0; q < 2; ++q) { const int tile = 2 * wave + q, rt = tile >> 2, ct = tile & 3, row = unit * 64 + rt * 16 + l15, col = ct * 16 + 4 * g4;
            f32x4 v = red[tile * 64 + lane];
#pragma unroll
            for (int w = 1; w < 8; ++w) v = v + red[(w * 16 + tile) * 64 + lane];
            if (col < 56) { const f32x4 gv_ = v + *(const f32x4*)(bias + col); *(f32x4*)(gates + (size_t)row * 64 + col) = gv_;
                if (col < 8) *(f32x4*)(gl + (rt * 16 + l15) * 8 + col) = gv_; } }
        __syncthreads();
        if (wave < 4) {
            const float ig = gl[lane * 8 + wave], fg = gl[lane * 8 + 4 + wave];
            float bc = fminf(fg, 0.f) - log1pf(__expf(-fabsf(fg)));
#pragma unroll
            for (int o = 1; o < 64; o <<= 1) { const float t_ = __shfl_up(bc, o); if (lane >= o) bc += t_; }
            const float L_ = wmax(ig - bc), S_ = __shfl(bc, 63);
            if (lane == 0) { float* ch = (float*)(ws + WS_CHS) + ((size_t)unit * 4 + wave) * 2; ch[0] = S_; ch[1] = L_; } }
        __syncthreads();
    }
}
__global__ void __launch_bounds__(512, 2) fwd_kernel(Args args) {
    extern __shared__ __attribute__((aligned(16))) unsigned char lds_raw[];
    LAS unsigned char* ldsl = (LAS unsigned char*)lds_raw;
    unsigned char* lds = lds_raw;
    const int G = gridDim.x;
    const int wave_sg = __builtin_amdgcn_readfirstlane(threadIdx.x >> 6);
    unsigned char* ws = args.ws;
    volatile LAS unsigned* lctl = (volatile LAS unsigned*)(ldsl + LDSCTL_OFF);
    if (wave_sg == 0) { const int l_ = (int)__builtin_amdgcn_mbcnt_hi(~0u, __builtin_amdgcn_mbcnt_lo(~0u, 0u)); for (int u = l_; u < 256; u += 64) lctl[u] = 0u; }
    __syncthreads();
    const int lo = args.ph_lo, hi = args.ph_hi;
    const bool one = (hi - lo) > 1;
    XcdBarrier bar; bar.bar = (unsigned*)(ws + WS_CTL) + CW_BAR; bar.x = 0; bar.st = lctl; bar.wv = wave_sg;
    if (one) bar = xcd_barrier_post((unsigned*)(ws + WS_CTL) + CW_BAR, lctl, wave_sg);
#ifndef ONLY_PHASE
#define ONLY_PHASE -1
#endif
#define LAUNDER() int wv_ = wave_sg; asm volatile("" : "+s"(wv_)); int tz_ = wv_ * 64 + (int)__builtin_amdgcn_mbcnt_hi(~0u, __builtin_amdgcn_mbcnt_lo(~0u, 0u)); asm volatile("" : "+v"(tz_)); const int tid = tz_, lane = tz_ & 63, wave = wv_; (void)tid; (void)lane; (void)wave; \
    unsigned long long kp_ = (unsigned long long)__builtin_amdgcn_kernarg_segment_ptr(); asm volatile("" : "+s"(kp_)); \
    const KP la = (KP)kp_; unsigned char* const ws = la->ws; (void)ws
#define INR(k) (lo <= (k) && (k) < hi)
#define IN0 ((ONLY_PHASE < 0 || ONLY_PHASE == 0) && INR(0))
#define INL(j) ((ONLY_PHASE < 0 || ONLY_PHASE == 1 + (j)) && INR(pb + (j)))
#define SEAM(k) do { if (INR(k) && INR((k) + 1)) xcd_barrier(bar); else __syncthreads(); } while (0)

    if (IN0) { LAUNDER(); phase_prologue(la, lds, tid, lane, wave, G); phase_experts(la, lds, lane, wave, G, 0); SEAM(0); }

    for (int l = 0; l < 2; ++l) {
        const int pb = 1 + l * PPL;
        if (INL(0)) { LAUNDER();
            pg8::Gemm g{(const u16*)(ws + WS_X8), (const u16*)(ws + WS_WIN + (size_t)l * NPAD * D_), D_ / 2, D_ / 2, 0x79797979, 0x7f7f7f7f};
            pg8::StaticOrder S; S.init(M_, NGEMM, G, (int)blockIdx.x);
            EpiInProj E{(u16*)(ws + WS_Z), (const float*)(ws + WS_BIASP) + l * NPAD, (float*)(ws + WS_GATES), (u16*)(ws + WS_KC), (const float*)(ws + WS_ROPE), (const float*)(ws + WS_ROPE) + 4096 * 64, ws + WS_Z8};
            pg8::gemm_phase<EpiInProj, pg8::StaticOrder, true>(ldsl, g, S, E, tid);
            __syncthreads();
            phase_gates(la, lds, tid, G, l);
            SEAM(pb + 0);
        }
        if (INL(1)) { LAUNDER();
            pg8::Gemm g{(const u16*)(ws + WS_KC), (const u16*)(ws + WS_CW1 + (size_t)l * 512 * 2048), 1024, 1024, 0x79797979, 0x7f7f7f7f};
            CmpOrder S{G, (int)blockIdx.x};
            EpiF32Tile E{(float*)(ws + WS_U), 256};
            pg8::gemm_phase<EpiF32Tile, CmpOrder, true>(ldsl, g, S, E, tid);
            phase_mlstm_pre(la, lds, tid, G, G >= 64 ? 32 : 0);
            SEAM(pb + 1);
        }
        if (INL(2)) { LAUNDER(); phase_mlstm(la, lds, tid, G); phase_cmp2(la, lds, tid, G, l); SEAM(pb + 2); }
        if (INL(3)) { LAUNDER(); phase_nsa1(la, lds, tid, G); phase_norm(la, lane, wave, G, l); SEAM(pb + 3); }
        if (INL(4)) { LAUNDER(); phase_topk(la, lane, wave, G); SEAM(pb + 4); }
        if (INL(5)) { LAUNDER(); phase_nsa2(la, lds, tid, G); __syncthreads();
            {
            pg8::Gemm g{(const u16*)(ws + WS_XBF), (const u16*)(ws + WS_WB) + (size_t)(l * 3 + 0) * D_ * D_, D_ / 2, D_ / 2, 0x79797979, 0x7e7e7e7e};
            pg8::StaticOrder S; S.init(M_, D_, G, (int)blockIdx.x);
            EpiGate<false> E{(u16*)(ws + WS_MRG), (const u16*)(ws + WS_Z), C_GM};
            pg8::gemm_phase<EpiGate<false>, pg8::StaticOrder, true>(ldsl, g, S, E, tid);
            }
            SEAM(pb + 5);
        }
        if (INL(6)) { LAUNDER();
            pg8::Gemm g{(const u16*)(ws + WS_O), (const u16*)(ws + WS_WB) + (size_t)(l * 3 + 1) * D_ * D_, D_ / 2, D_ / 2, 0x79797979, 0x7c7c7c7c};
            pg8::StaticOrder S; S.init(M_, D_, G, (int)blockIdx.x);
            EpiGate<true> E{(u16*)(ws + WS_MRG), (const u16*)(ws + WS_Z), C_GM + 2048};
            pg8::gemm_phase<EpiGate<true>, pg8::StaticOrder, true>(ldsl, g, S, E, tid);
            SEAM(pb + 6);
        }
        if (INL(7)) { LAUNDER();
            pg8::Gemm g{(const u16*)(ws + WS_MRG), (const u16*)(ws + WS_WB) + (size_t)(l * 3 + 2) * D_ * D_, D_, D_};
            pg8::StaticOrder S; S.init(M_, D_, G, (int)blockIdx.x);
            EpiResid E{(u16*)(ws + WS_H), la->in[0], l == 0 ? (const u16*)nullptr : (const u16*)(ws + WS_XB)};
            pg8::gemm_phase(ldsl, g, S, E, tid);
            SEAM(pb + 7);
        }
        if (INL(8)) { LAUNDER(); phase_ln1_router(la, lds, tid, lane, wave, G, l); SEAM(pb + 8); }
        if (INL(9)) { LAUNDER(); phase_moe_gather(la, lds, tid, lane, wave, G, l); SEAM(pb + 9); }
        if (INL(10) || INL(11)) { LAUNDER();
            const unsigned* cnt = (const unsigned*)(ws + WS_CTL) + CW_CNT + l * 32;
            volatile LAS int* tstart = (volatile LAS int*)(lctl + 16);
            if (wave == 0) { int mybase; const int nt_ = moe_base(cnt, lane, mybase); if (lane < 32) tstart[lane] = mybase >> 8; if (lane == 32) tstart[32] = nt_; }
            __syncthreads();
            const int ntiles = tstart[32];
            if (INL(10)) { LAUNDER();
                pg8::Gemm g{(const u16*)(ws + WS_XG), (const u16*)(ws + WS_W13), D_ / 2, D_ / 2, 0x79797979, 0x7f7f7f7f};
                MoeOrder S{G, (int)blockIdx.x, ntiles, tstart};
                EpiSwiGLU E{ws + WS_HB};
                pg8::gemm_phase<EpiSwiGLU, MoeOrder, true>(ldsl, g, S, E, tid);
                SEAM(pb + 10);
            }
            if (INL(11)) { LAUNDER();
                pg8::Gemm g{(const u16*)(ws + WS_HB), (const u16*)(ws + WS_W2), DFF / 2, DFF / 2, 0x79797979, 0x7f7f7f7f};
                MoeOrder S{G, (int)blockIdx.x, ntiles, tstart};
                EpiScaleRow E{(u16*)(ws + WS_Y), (const float*)(ws + WS_MISC + 1 * MiB)};
                pg8::gemm_phase<EpiScaleRow, MoeOrder, true>(ldsl, g, S, E, tid);
                SEAM(pb + 11);
            }
        }
        if (INL(12)) { LAUNDER(); phase_ln2(la, lane, wave, G, l); if (l == 0) phase_experts(la, lds, lane, wave, G, 1); SEAM(pb + 12); }
    }
#undef INR
#undef IN0
#undef INL
#undef SEAM
}

extern "C" void kernel_launch(void* const* d_in, const int* in_sizes, int n_in, void* d_out, int out_size, void* d_ws, size_t ws_size, hipStream_t stream) {
    static int grid = 0;
    if (grid == 0) {
        if (n_in != 26 || out_size != M_ * D_ || ws_size < WS_END5) { fprintf(stderr, "kernel_launch: unexpected problem (n_in %d out %d ws %zu need %zu)\n", n_in, out_size, ws_size, (size_t)WS_END); grid = -1; return; }
        int dev = 0, cus = 0;
        if (hipGetDevice(&dev) != hipSuccess || hipDeviceGetAttribute(&cus, hipDeviceAttributeMultiprocessorCount, dev) != hipSuccess) { grid = -1; return; }
        if (hipFuncSetAttribute((const void*)fwd_kernel, hipFuncAttributeMaxDynamicSharedMemorySize, LDS_BYTES) != hipSuccess) { fprintf(stderr, "kernel_launch: hipFuncSetAttribute failed\n"); grid = -1; return; }
        int per_cu = 0;
        if (hipOccupancyMaxActiveBlocksPerMultiprocessor(&per_cu, (const void*)fwd_kernel, 512, LDS_BYTES) != hipSuccess || per_cu < 1) fprintf(stderr, "kernel_launch: occupancy query reports %d\n", per_cu);
        (void)hipGetLastError();
        grid = cus;
    }
    if (grid < 0) return;
    (void)hipMemsetAsync((char*)d_ws + WS_CTL, 0, CTL_BYTES, stream);
    Args a{};
    for (int i = 0; i < 26; ++i) a.in[i] = (const float*)d_in[i];
    a.out = (float*)d_out; a.ws = (unsigned char*)d_ws;
#if MK_ONE_LAUNCH
    a.ph_lo = 0; a.ph_hi = NPH;
    hipLaunchKernelGGL(fwd_kernel, dim3(grid), dim3(512), LDS_BYTES, stream, a);
#else
#ifdef DBG_STOP
    for (int p = 0; p < DBG_STOP; ++p) { a.ph_lo = p; a.ph_hi = p + 1; hipLaunchKernelGGL(fwd_kernel, dim3(grid), dim3(512), LDS_BYTES, stream, a); }
    (void)hipMemcpyAsync(d_out, (char*)d_ws + DBG_SRC, (size_t)M_ * D_ * 4, hipMemcpyDeviceToDevice, stream);
#else
#ifndef REP_N
#define REP_N 1
#define REP_LO 99
#define REP_HI 99
#endif
    for (int p = 0; p < NPH; ++p) {
        const int j = p == 0 ? -1 : (p - 1) % PPL;
        if (j == REP_LO) { for (int r = 0; r < REP_N; ++r) for (int q = p; q <= p + (REP_HI - REP_LO); ++q) { a.ph_lo = q; a.ph_hi = q + 1; hipLaunchKernelGGL(fwd_kernel, dim3(grid), dim3(512), LDS_BYTES, stream, a); } p += REP_HI - REP_LO; continue; }
        a.ph_lo = p; a.ph_hi = p + 1; hipLaunchKernelGGL(fwd_kernel, dim3(grid), dim3(512), LDS_BYTES, stream, a); }
#endif
#endif
}
```
